# Optimizing an MI355X kernel written in HIP

```python
import math
import jax, jax.numpy as jnp
from jax import lax
import numpy as np

D_MODEL = 1024
BATCH = 2
SEQ = 8192
DEPTH = 2

CTX_LEN = 256
GRID_W = 64

A_HEADS = 4
A_QK_DIM = 64
A_V_DIM = 2 * A_QK_DIM
A_WIDTH = A_HEADS * A_V_DIM
B_GROUPS = 4
B_GROUP_DIM = 64
B_WIDTH = B_GROUPS * B_GROUP_DIM
C_GROUPS = 4
C_GROUP_DIM = 64
C_WIDTH = C_GROUPS * C_GROUP_DIM
CHUNK = 128

N_BRANCH = 3
Q_BLOCK = 128
ROPE_BASE = 10000.0
AXIS_DIM = A_QK_DIM // 2
EPS = 1e-6

OFF_Q = 0
OFF_K = OFF_Q + A_WIDTH
OFF_V = OFF_K + A_WIDTH
OFF_F = OFF_V + A_WIDTH
OFF_U = OFF_F + B_WIDTH
OFF_VC = OFF_U + C_WIDTH
OFF_GATE = OFF_VC + C_WIDTH
GATE_WIDTH = A_WIDTH + B_WIDTH + C_WIDTH
OFF_MERGE = OFF_GATE + GATE_WIDTH
IN_WIDTH = OFF_MERGE + N_BRANCH * D_MODEL

kernel_name = "hybrid_diffattn_fnet_gmlp_prefix_dit"


def rms_norm(x, g):
    xf = x.astype(jnp.float32)
    y = xf * lax.rsqrt(jnp.mean(xf * xf, axis=-1, keepdims=True) + EPS)
    return (y * g.astype(jnp.float32)).astype(x.dtype)


def axial_rope_tables(n_tok):
    n_rows = n_tok // GRID_W
    row = jnp.repeat(jnp.arange(n_rows), GRID_W).astype(jnp.float32)
    col = jnp.tile(jnp.arange(GRID_W), n_rows).astype(jnp.float32)
    freqs = ROPE_BASE ** (-jnp.arange(0, AXIS_DIM, 2, dtype=jnp.float32) / AXIS_DIM)
    ang_r = row[:, None] * freqs
    ang_c = col[:, None] * freqs
    ang = jnp.concatenate([ang_r, ang_r, ang_c, ang_c], axis=-1)
    return jnp.cos(ang), jnp.sin(ang)


def rotate_half_axial(x):
    xs = x.reshape(x.shape[:-1] + (2, 2, AXIS_DIM // 2))
    x1, x2 = xs[..., 0, :], xs[..., 1, :]
    return jnp.stack([-x2, x1], axis=-2).reshape(x.shape)


def apply_rope(t, cos, sin):
    cos = cos[None, :, None, None, :].astype(t.dtype)
    sin = sin[None, :, None, None, :].astype(t.dtype)
    return t * cos + rotate_half_axial(t) * sin


def diff_attend(q, k, v, lam):
    s = jnp.einsum('bqhcd,bkhcd->bhcqk', q, k).astype(jnp.float32) * (A_QK_DIM ** -0.5)
    a = jax.nn.softmax(s, axis=-1)
    w = a[:, :, 0] - lam * a[:, :, 1]
    return jnp.einsum('bhqk,bkhe->bqhe', w.astype(v.dtype), v)


def blocked_latent_attention(q, k, v, lam):
    b, n = q.shape[:2]
    qb = q.reshape(b, n // Q_BLOCK, Q_BLOCK, A_HEADS, 2, A_QK_DIM).swapaxes(0, 1)
    ob = lax.map(lambda blk: diff_attend(blk, k, v, lam), qb)
    return ob.swapaxes(0, 1).reshape(b, n, A_HEADS, A_V_DIM)


def fourier_mix(f, w_f, b_f):
    b, n, _ = f.shape
    fg = f.reshape(b, n, B_GROUPS, B_GROUP_DIM).astype(jnp.float32)
    fr = jnp.fft.fft2(fg, axes=(1, 3), norm="ortho").real.astype(f.dtype)
    y = jnp.einsum('bngc,gcd->bngd', fr, w_f) + b_f
    return y.reshape(b, n, B_WIDTH)


def chunk_sgu(u, vc, ln_g, ln_b, w_s, b_s):
    b, n, _ = vc.shape
    vf = vc.astype(jnp.float32)
    mu = jnp.mean(vf, axis=-1, keepdims=True)
    var = jnp.mean(jnp.square(vf - mu), axis=-1, keepdims=True)
    vn = ((vf - mu) * lax.rsqrt(var + EPS) * ln_g.astype(jnp.float32)
          + ln_b.astype(jnp.float32)).astype(vc.dtype)
    vn = vn.reshape(b, n // CHUNK, CHUNK, C_GROUPS, C_GROUP_DIM)
    s = jnp.einsum('gpq,bnqgc->bnpgc', w_s, vn) + b_s.T[:, :, None]
    return u * s.reshape(b, n, C_WIDTH)


def merge_branches(p, o_a, w_f, b_f, ln_g, ln_b, w_s, b_s, w_br_a, w_br_b, w_br_c, w_out):
    o_b = fourier_mix(p[..., OFF_F:OFF_U], w_f, b_f)
    o_c = chunk_sgu(p[..., OFF_U:OFF_VC], p[..., OFF_VC:OFF_GATE], ln_g, ln_b, w_s, b_s)
    gate = jax.nn.silu(p[..., OFF_GATE:OFF_MERGE])
    ya = (o_a * gate[..., :A_WIDTH]) @ w_br_a
    yb = (o_b * gate[..., A_WIDTH:A_WIDTH + B_WIDTH]) @ w_br_b
    yc = (o_c * gate[..., A_WIDTH + B_WIDTH:]) @ w_br_c
    m = jax.nn.sigmoid(p[..., OFF_MERGE:])
    y = (m[..., :D_MODEL] * ya + m[..., D_MODEL:2 * D_MODEL] * yb
         + m[..., 2 * D_MODEL:] * yc)
    return y @ w_out


def setup_inputs(seed: int = 0) -> dict:
    key = jax.random.key(seed)
    ks = jax.random.split(key, 28)
    L, D = DEPTH, D_MODEL

    def nrm(k, shape, scale):
        return jax.random.normal(k, shape, jnp.float32) * scale

    return {
        "x": nrm(ks[0], (BATCH, SEQ, D), 1.0),
        "c": nrm(ks[1], (BATCH, D), 1.0),
        "ctx": nrm(ks[2], (BATCH, CTX_LEN, D), 1.0),
        "c_ctx": nrm(ks[3], (D,), 1.0),
        "w_ada": nrm(ks[4], (L, D, 3 * D), 0.5 * D ** -0.5),
        "b_ada": nrm(ks[5], (L, 3 * D), 0.02),
        "g_norm": 1.0 + nrm(ks[6], (L, D), 0.02),
        "w_in": nrm(ks[7], (L, D, IN_WIDTH), D ** -0.5),
        "g_q": 1.0 + nrm(ks[8], (L, A_QK_DIM), 0.02),
        "g_k": 1.0 + nrm(ks[9], (L, A_QK_DIM), 0.02),
        "lam_q1": nrm(ks[10], (L, A_QK_DIM), 0.1),
        "lam_k1": nrm(ks[11], (L, A_QK_DIM), 0.1),
        "lam_q2": nrm(ks[12], (L, A_QK_DIM), 0.1),
        "lam_k2": nrm(ks[13], (L, A_QK_DIM), 0.1),
        "g_sub": 1.0 + nrm(ks[14], (L, A_V_DIM), 0.02),
        "w_f": nrm(ks[15], (L, B_GROUPS, B_GROUP_DIM, B_GROUP_DIM), B_GROUP_DIM ** -0.5),
        "b_f": nrm(ks[16], (L, B_GROUPS, B_GROUP_DIM), 0.02),
        "ln_g": 1.0 + nrm(ks[17], (L, C_WIDTH), 0.02),
        "ln_b": nrm(ks[18], (L, C_WIDTH), 0.02),
        "w_s": nrm(ks[19], (L, C_GROUPS, CHUNK, CHUNK), CHUNK ** -0.5),
        "b_s": 1.0 + nrm(ks[20], (L, C_GROUPS, CHUNK), 0.02),
        "w_br_a": nrm(ks[21], (L, A_WIDTH, D), A_WIDTH ** -0.5),
        "w_br_b": nrm(ks[22], (L, B_WIDTH, D), B_WIDTH ** -0.5),
        "w_br_c": nrm(ks[23], (L, C_WIDTH, D), C_WIDTH ** -0.5),
        "w_out": nrm(ks[24], (L, D, D), D ** -0.5),
    }


def reference(x, c, ctx, c_ctx, w_ada, b_ada, g_norm, w_in, g_q, g_k,
              lam_q1, lam_k1, lam_q2, lam_k2, g_sub, w_f, b_f, ln_g, ln_b,
              w_s, b_s, w_br_a, w_br_b, w_br_c, w_out):
    b, n, _ = x.shape
    n_ctx = ctx.shape[1]
    cos, sin = axial_rope_tables(n)
    for l in range(DEPTH):
        last = l == DEPTH - 1
        lam_init = 0.8 - 0.6 * math.exp(-0.3 * l)
        lam = (jnp.exp(jnp.sum(lam_q1[l].astype(jnp.float32) * lam_k1[l].astype(jnp.float32)))
               - jnp.exp(jnp.sum(lam_q2[l].astype(jnp.float32) * lam_k2[l].astype(jnp.float32)))
               + lam_init)

        shift, scale, gate = jnp.split(jax.nn.silu(c) @ w_ada[l] + b_ada[l], 3, axis=-1)
        shift_c, scale_c, gate_c = jnp.split(jax.nn.silu(c_ctx) @ w_ada[l] + b_ada[l], 3, axis=-1)
        h = rms_norm(x, g_norm[l]) * (1.0 + scale[:, None, :]) + shift[:, None, :]
        h_ctx = rms_norm(ctx, g_norm[l]) * (1.0 + scale_c) + shift_c

        if last:
            kv_ctx = h_ctx @ w_in[l][:, OFF_K:OFF_F]
        else:
            p_ctx = h_ctx @ w_in[l]
            kv_ctx = p_ctx[..., OFF_K:OFF_F]
        k_ctx = rms_norm(kv_ctx[..., :A_WIDTH].reshape(b, n_ctx, A_HEADS, 2, A_QK_DIM), g_k[l])
        v_ctx = kv_ctx[..., A_WIDTH:].reshape(b, n_ctx, A_HEADS, A_V_DIM)

        p = h @ w_in[l]
        q = apply_rope(rms_norm(p[..., OFF_Q:OFF_K].reshape(b, n, A_HEADS, 2, A_QK_DIM), g_q[l]), cos, sin)
        k = apply_rope(rms_norm(p[..., OFF_K:OFF_V].reshape(b, n, A_HEADS, 2, A_QK_DIM), g_k[l]), cos, sin)
        v = p[..., OFF_V:OFF_F].reshape(b, n, A_HEADS, A_V_DIM)
        k_all = jnp.concatenate([k, k_ctx], axis=1)
        v_all = jnp.concatenate([v, v_ctx], axis=1)
        o_a = blocked_latent_attention(q, k_all, v_all, lam)
        o_a = (rms_norm(o_a, g_sub[l]) * (1.0 - lam_init)).reshape(b, n, A_WIDTH)
        out = merge_branches(p, o_a, w_f[l], b_f[l], ln_g[l], ln_b[l], w_s[l], b_s[l],
                             w_br_a[l], w_br_b[l], w_br_c[l], w_out[l])

        if not last:
            q_c = rms_norm(p_ctx[..., OFF_Q:OFF_K].reshape(b, n_ctx, A_HEADS, 2, A_QK_DIM), g_q[l])
            o_ac = diff_attend(q_c, k_ctx, v_ctx, lam)
            o_ac = (rms_norm(o_ac, g_sub[l]) * (1.0 - lam_init)).reshape(b, n_ctx, A_WIDTH)
            out_c = merge_branches(p_ctx, o_ac, w_f[l], b_f[l], ln_g[l], ln_b[l], w_s[l], b_s[l],
                                   w_br_a[l], w_br_b[l], w_br_c[l], w_out[l])
            ctx = ctx + gate_c * out_c

        x = x + gate[:, None, :] * out
    return x
```

```cpp
#include <hip/hip_runtime.h>
#include <cstdio>
#include <cstdint>

#ifndef MK_N_LAUNCHES
#define MK_N_LAUNCHES 1
#endif

#define LAS __attribute__((address_space(3)))
#define GAS __attribute__((address_space(1)))
typedef unsigned short bf16_t;
typedef short bf16x8 __attribute__((ext_vector_type(8)));
typedef short s16x4 __attribute__((ext_vector_type(4)));
typedef float f32x4 __attribute__((ext_vector_type(4)));
typedef float f32x2 __attribute__((ext_vector_type(2)));
typedef float f32x16 __attribute__((ext_vector_type(16)));
typedef unsigned u32x4 __attribute__((ext_vector_type(4)));
typedef unsigned u32x2 __attribute__((ext_vector_type(2)));

constexpr int DM = 1024, BATCH = 2, SEQ = 8192, NCTX = 256, DEPTH = 2;
constexpr int MLAT = BATCH * SEQ, MCTX = BATCH * NCTX, MT = MLAT + MCTX;
constexpr int NKEY = SEQ + NCTX, NKT = NKEY / 64;
constexpr int INW = 6400;
constexpr int OFF_Q = 0, OFF_K = 512, OFF_V = 1024, OFF_F = 1536, OFF_U = 1792, OFF_VC = 2048, OFF_GATE = 2304, OFF_MERGE = 3328;
constexpr int NPHYS = 6656;
constexpr float EPS = 1e-6f;
constexpr float QSCALE = 0.125f * 1.4426950408889634f;

constexpr size_t KiB = 1024, MiB = 1u << 20;
constexpr size_t WS_CTL = 0, CTL_ZERO_BYTES = 64 * KiB;
constexpr size_t WS_MODP = 1 * MiB;
constexpr size_t WS_MODF = WS_MODP + 2304 * KiB;
constexpr size_t WS_ROPE = WS_MODF + 72 * KiB;
constexpr size_t WS_TW = WS_ROPE + 16 * KiB;
constexpr size_t WS_LAM = WS_TW + 64 * KiB;
constexpr size_t WS_C128 = WS_LAM + 1 * KiB;
constexpr size_t WS_S128 = WS_C128 + 32 * KiB;
constexpr size_t WS_T64 = WS_S128 + 32 * KiB;
constexpr size_t WS_TC256 = WS_T64 + 16 * KiB;
constexpr size_t WS_WSIMG = WS_TC256 + 256 * KiB;
constexpr size_t WS_SMALL_END = WS_WSIMG + 256 * KiB;
static_assert(WS_SMALL_END <= 5 * MiB, "small tables");
constexpr size_t WS_WIN = 5 * MiB;
constexpr size_t WS_WBR = 31 * MiB;
constexpr size_t WS_WOUT = 35 * MiB;
constexpr size_t WS_CTX1 = 39 * MiB;
constexpr size_t WS_H = 41 * MiB;
constexpr size_t WS_A = 74 * MiB;
constexpr size_t WS_R = 107 * MiB;
constexpr size_t SZ_QG = (size_t)MT * 512 * 2, SZ_KIMG = (size_t)BATCH * 4 * NKT * 16384, SZ_Z2 = (size_t)MT * 512 * 2, SZ_UG = (size_t)MT * 256 * 2, SZ_GS = (size_t)MT * 768 * 2;
constexpr size_t WS_QG = WS_R, WS_KIMG = WS_QG + SZ_QG, WS_VIMG = WS_KIMG + SZ_KIMG, WS_Z2 = WS_VIMG + SZ_KIMG, WS_UG = WS_Z2 + SZ_Z2, WS_VC = WS_UG + SZ_UG, WS_GS = WS_VC + SZ_UG;
constexpr size_t WS_MS = WS_R;
constexpr size_t WS_END = WS_GS + SZ_GS;
static_assert(WS_R + (size_t)MT * 3072 * 2 <= 256 * MiB && WS_END <= 256 * MiB, "d_ws map");

__device__ __forceinline__ unsigned f2bf(float f) { unsigned u = __builtin_bit_cast(unsigned, f); return (u + 0x7fffu + ((u >> 16) & 1u)) >> 16; }
__device__ __forceinline__ unsigned pk2(float lo, float hi) { return f2bf(lo) | (f2bf(hi) << 16); }
__device__ __forceinline__ unsigned cvt_pk_bf16(float lo, float hi) { unsigned r; asm volatile("v_cvt_pk_bf16_f32 %0, %1, %2" : "=v"(r) : "v"(lo), "v"(hi)); return r; }
__device__ __forceinline__ float bf2f(unsigned short v) { return __builtin_bit_cast(float, (unsigned)v << 16); }
__device__ __forceinline__ float bflo(unsigned w) { return __builtin_bit_cast(float, w << 16); }
__device__ __forceinline__ float bfhi(unsigned w) { return __builtin_bit_cast(float, w & 0xffff0000u); }
__device__ __forceinline__ float fast_sigmoid(float x) { return __builtin_amdgcn_rcpf(1.0f + __builtin_amdgcn_exp2f(-1.4426950408889634f * x)); }
__device__ __forceinline__ float fast_silu(float x) { return x * fast_sigmoid(x); }
__device__ __forceinline__ int crow(int r, int hi) { return (r & 3) + 8 * (r >> 2) + 4 * hi; }
__host__ __device__ __forceinline__ int perm32(int rho) { const int n = rho >> 4, i = rho & 15; return 8 * (i >> 2) + 4 * n + (i & 3); }
__host__ __device__ __forceinline__ int invperm32(int c) { return 16 * ((c >> 2) & 1) + 4 * (c >> 3) + (c & 3); }
#define LDS_WAIT() asm volatile("s_waitcnt lgkmcnt(0)" ::: "memory")
#define VM_WAIT() asm volatile("s_waitcnt vmcnt(0)" ::: "memory")

namespace pg8 {
constexpr int BM = 256, BK = 64, HALF = 128, HTB = HALF * BK * 2  , STAGE_BYTES = 8 * HTB;
__host__ __device__ __forceinline__ int lds_byte(int r, int c) { const int st = (r >> 4) * 2 + (c >> 5), rr = r & 15, cc = c & 31, ob = rr * 64 + cc * 2; return st * 1024 + (ob ^ (((ob >> 9) & 1) << 5)); }
__host__ __device__ __forceinline__ void stage_rc(int b, int& R, int& C) { const int st = b / 1024, sb = b % 1024, swz = sb ^ (((sb >> 9) & 1) << 5); R = (st >> 1) * 16 + swz / 64; C = (st & 1) * 32 + (swz % 64) / 2; }

struct Unit { int pm, pn, seg; };
struct Gemm { const bf16_t* A; const bf16_t* Bt; int lda, ldb; int k0_0, k0_1, k0_2; int nt_0, nt_1, nt_2; };

template <class Epi, class Sched, bool ALIGN_EPI = false, bool SP2 = false>
__device__ __forceinline__ void gemm_phase(LAS unsigned char* lds, const Gemm g, const Sched& S, const Epi& E, const int tid) {
    const int wid = __builtin_amdgcn_readfirstlane(tid >> 6), lane = tid & 63, wr = wid >> 2, wc = wid & 3, fr = lane & 15, fq = lane >> 4;
    unsigned voffA[2], voffB[2];
#pragma unroll
    for (int i = 0; i < 2; ++i) { int R, C; stage_rc(tid * 16 + i * 8192, R, C); voffA[i] = (unsigned)(R * g.lda + C) * 2u; voffB[i] = (unsigned)(R * g.ldb + C) * 2u; }
    const size_t kstep = (size_t)(BK * 2);
    const size_t hstepA = (size_t)HALF * g.lda * 2, hstepB = (size_t)HALF * g.ldb * 2;
    const size_t tstepA = 2 * hstepA, tstepB = 2 * hstepB;
    const unsigned ldsw = (unsigned)wid * 1024u;
    const int aoff = lds_byte(wr * 64 + fr, fq * 8), boff = lds_byte(wc * 32 + fr, fq * 8);
#define PG8_SA(b, h) (((b) * 2 + (h)) * HTB)
#define PG8_SB(b, h) ((4 + (b) * 2 + (h)) * HTB)
#define PG8_STAGE(bufoff, gbase, voff) do { _Pragma("unroll") for (int _i = 0; _i < 2; ++_i) \
        __builtin_amdgcn_global_load_lds((const unsigned*)((const char*)(gbase) + (voff)[_i]), (LAS unsigned*)(lds + (bufoff) + ldsw + _i * 8192), 16, 0, 0); } while (0)
#define PG8_LDA(dst, b, h) do { _Pragma("unroll") for (int m = 0; m < 4; ++m) _Pragma("unroll") for (int k = 0; k < 2; ++k) dst[m][k] = *(const LAS bf16x8*)(lds + PG8_SA(b, h) + aoff + m * 2048 + k * 1024); } while (0)
#define PG8_LDB(dst, b, h) do { _Pragma("unroll") for (int n = 0; n < 2; ++n) _Pragma("unroll") for (int k = 0; k < 2; ++k) dst[n][k] = *(const LAS bf16x8*)(lds + PG8_SB(b, h) + boff + n * 2048 + k * 1024); } while (0)
#define PG8_MMA(ai, bj, At, Bt) do { __builtin_amdgcn_s_setprio(1); _Pragma("unroll") for (int m = 0; m < 4; ++m) _Pragma("unroll") for (int n = 0; n < 2; ++n) _Pragma("unroll") for (int k = 0; k < 2; ++k) \
        acc[ai][bj][m][n] = __builtin_amdgcn_mfma_f32_16x16x32_bf16(Bt[n][k], At[m][k], acc[ai][bj][m][n], 0, 0, 0); __builtin_amdgcn_s_setprio(0); } while (0)
#define PG8_WAIT_V(n) asm volatile("s_waitcnt vmcnt(" #n ")" ::: "memory")
#define PG8_WAIT_L(n) asm volatile("s_waitcnt lgkmcnt(" #n ")" ::: "memory")
#define PG8_BAR __builtin_amdgcn_s_barrier()
#define PG8_SCHED __builtin_amdgcn_sched_barrier(0)
#define PG8_K0(u) ((u).seg == 0 ? g.k0_0 : ((u).seg == 1 ? g.k0_1 : g.k0_2))
#define PG8_NT(u) ((u).seg == 0 ? g.nt_0 : ((u).seg == 1 ? g.nt_1 : g.nt_2))
#define PG8_UA(u) ((const char*)g.A + (size_t)(u).pm * tstepA + (size_t)PG8_K0(u) * 2)
#define PG8_UB(u) ((const char*)g.Bt + (size_t)(u).pn * tstepB + (size_t)PG8_K0(u) * 2)
    Unit cur, nxt; int ui = 0;
    if (!S.next(0, cur)) return;
    f32x4 acc[2][2][4][2];
#pragma unroll
    for (int a = 0; a < 2; ++a)
#pragma unroll
        for (int b = 0; b < 2; ++b)
#pragma unroll
            for (int m = 0; m < 4; ++m)
#pragma unroll
                for (int n = 0; n < 2; ++n) acc[a][b][m][n] = (f32x4){0.f, 0.f, 0.f, 0.f};
    bf16x8 At[4][2], B0[2][2], B1[2][2];
    const char* cA = PG8_UA(cur); const char* cB = PG8_UB(cur); int nt = PG8_NT(cur);
    if constexpr (SP2) {
        PG8_STAGE(PG8_SB(0, 0), cB, voffB); PG8_STAGE(PG8_SB(0, 1), cB + hstepB, voffB); PG8_STAGE(PG8_SA(0, 0), cA, voffA); PG8_STAGE(PG8_SA(0, 1), cA + hstepA, voffA);
        if (wr == 1) PG8_BAR;
        PG8_WAIT_V(2); PG8_BAR;
        PG8_STAGE(PG8_SB(1, 0), cB + kstep, voffB); PG8_STAGE(PG8_SA(1, 0), cA + kstep, voffA); PG8_STAGE(PG8_SB(1, 1), cB + hstepB + kstep, voffB);
        PG8_WAIT_V(6); PG8_BAR;
    } else {
        PG8_STAGE(PG8_SB(0, 0), cB, voffB); PG8_STAGE(PG8_SA(0, 0), cA, voffA); PG8_STAGE(PG8_SB(0, 1), cB + hstepB, voffB); PG8_STAGE(PG8_SA(0, 1), cA + hstepA, voffA);
        if (wr == 1) PG8_BAR;
        PG8_WAIT_V(4); PG8_BAR;
        PG8_STAGE(PG8_SB(1, 0), cB + kstep, voffB); PG8_STAGE(PG8_SA(1, 0), cA + kstep, voffA); PG8_STAGE(PG8_SB(1, 1), cB + hstepB + kstep, voffB);
        PG8_WAIT_V(6); PG8_BAR;
    }
    for (;;) {
        const bool has_next = S.next(ui + 1, nxt);
        const char* nA = has_next ? PG8_UA(nxt) : cA; const char* nB = has_next ? PG8_UB(nxt) : cB;
        for (int t = 0; t < nt; t += 2) {
            const bool last = (t == nt - 2);
            const char* a1 = cA + (size_t)(t + 1) * kstep;
            const char* a2 = last ? nA : cA + (size_t)(t + 2) * kstep; const char* b2 = last ? nB : cB + (size_t)(t + 2) * kstep;
            const char* a3 = a2 + kstep; const char* b3 = b2 + kstep;
            if constexpr (SP2) {
            PG8_LDB(B0, 0, 0); PG8_LDB(B1, 0, 1); PG8_SCHED; PG8_LDA(At, 0, 0); PG8_STAGE(PG8_SA(1, 1), a1 + hstepA, voffA);
            PG8_WAIT_V(8); PG8_WAIT_L(0); PG8_BAR; PG8_MMA(0, 0, At, B0); PG8_MMA(0, 1, At, B1); PG8_BAR; PG8_SCHED;
            PG8_LDA(At, 0, 1); PG8_STAGE(PG8_SB(0, 0), b2, voffB); PG8_STAGE(PG8_SB(0, 1), b2 + hstepB, voffB); PG8_STAGE(PG8_SA(0, 0), a2, voffA);
            PG8_WAIT_V(8); PG8_WAIT_L(0); PG8_BAR; PG8_MMA(1, 0, At, B0); PG8_MMA(1, 1, At, B1); PG8_BAR; PG8_SCHED;
            PG8_LDB(B0, 1, 0); PG8_LDB(B1, 1, 1); PG8_SCHED; PG8_LDA(At, 1, 0); PG8_STAGE(PG8_SA(0, 1), a2 + hstepA, voffA);
            PG8_WAIT_V(8); PG8_WAIT_L(0); PG8_BAR; PG8_MMA(0, 0, At, B0); PG8_MMA(0, 1, At, B1); PG8_BAR; PG8_SCHED;
            PG8_LDA(At, 1, 1); PG8_STAGE(PG8_SB(1, 0), b3, voffB); PG8_STAGE(PG8_SB(1, 1), b3 + hstepB, voffB); PG8_STAGE(PG8_SA(1, 0), a3, voffA);
            PG8_WAIT_V(8); PG8_WAIT_L(0); PG8_BAR; PG8_MMA(1, 0, At, B0); PG8_MMA(1, 1, At, B1); PG8_BAR; PG8_SCHED;
            } else {
            PG8_LDB(B0, 0, 0); PG8_SCHED; PG8_LDA(At, 0, 0); PG8_STAGE(PG8_SA(1, 1), a1 + hstepA, voffA);
            PG8_WAIT_L(8); PG8_BAR; PG8_WAIT_L(0); PG8_MMA(0, 0, At, B0); PG8_BAR; PG8_SCHED;
            PG8_LDB(B1, 0, 1); PG8_STAGE(PG8_SB(0, 0), b2, voffB);
            PG8_BAR; PG8_WAIT_L(0); PG8_MMA(0, 1, At, B1); PG8_BAR;
            PG8_LDA(At, 0, 1); PG8_STAGE(PG8_SA(0, 0), a2, voffA);
            PG8_BAR; PG8_WAIT_L(0); PG8_MMA(1, 0, At, B0); PG8_BAR; PG8_SCHED;
            PG8_STAGE(PG8_SB(0, 1), b2 + hstepB, voffB);
            PG8_WAIT_V(6); PG8_BAR; PG8_MMA(1, 1, At, B1); PG8_BAR;
            PG8_LDB(B0, 1, 0); PG8_SCHED; PG8_LDA(At, 1, 0); PG8_STAGE(PG8_SA(0, 1), a2 + hstepA, voffA);
            PG8_WAIT_L(8); PG8_BAR; PG8_WAIT_L(0); PG8_MMA(0, 0, At, B0); PG8_BAR; PG8_SCHED;
            PG8_LDB(B1, 1, 1); PG8_STAGE(PG8_SB(1, 0), b3, voffB);
            PG8_BAR; PG8_WAIT_L(0); PG8_MMA(0, 1, At, B1); PG8_BAR;
            PG8_LDA(At, 1, 1); PG8_STAGE(PG8_SA(1, 0), a3, voffA);
            PG8_BAR; PG8_WAIT_L(0); PG8_MMA(1, 0, At, B0); PG8_BAR; PG8_SCHED;
            PG8_STAGE(PG8_SB(1, 1), b3 + hstepB, voffB);
            PG8_WAIT_V(6); PG8_BAR; PG8_MMA(1, 1, At, B1); PG8_BAR;
            }
        }
        if constexpr (ALIGN_EPI) { if (wr == 0) PG8_BAR; }
        E(acc, cur, wr, wc, fr, fq);
        if (!has_next) break;
#pragma unroll
        for (int a = 0; a < 2; ++a)
#pragma unroll
            for (int b = 0; b < 2; ++b)
#pragma unroll
                for (int m = 0; m < 4; ++m)
#pragma unroll
                    for (int n = 0; n < 2; ++n) acc[a][b][m][n] = (f32x4){0.f, 0.f, 0.f, 0.f};
        cur = nxt; cA = nA; cB = nB; nt = PG8_NT(cur); ++ui;
        if constexpr (ALIGN_EPI) { if (wr == 1) PG8_BAR; }
    }
    PG8_WAIT_V(0);
    if constexpr (!ALIGN_EPI) { if (wr == 0) PG8_BAR; }
    PG8_BAR;
#undef PG8_SA
#undef PG8_SB
#undef PG8_STAGE
#undef PG8_LDA
#undef PG8_LDB
#undef PG8_MMA
#undef PG8_WAIT_V
#undef PG8_WAIT_L
#undef PG8_BAR
#undef PG8_SCHED
#undef PG8_K0
#undef PG8_NT
#undef PG8_UA
#undef PG8_UB
}
}

#define XB_TMO      128
#define XB_XCNT(j)  (256  + 64 * (j))
#define XB_XSUB(j)  (1280 + 64 * (j))
#define XB_XGEN(j)  (2304 + 64 * (j))
#define XB_TOP      3328
#define XB_TOPGEN   3392
#define XCD_BAR_WORDS 3456
#define XB_SPIN_CAP (1u << 18)
__device__ __forceinline__ unsigned xb_ld(unsigned* p)              { return __hip_atomic_load(p, __ATOMIC_RELAXED, __HIP_MEMORY_SCOPE_AGENT); }
__device__ __forceinline__ unsigned xb_add(unsigned* p, unsigned v) { return __hip_atomic_fetch_add(p, v, __ATOMIC_RELAXED, __HIP_MEMORY_SCOPE_AGENT); }
__device__ __forceinline__ unsigned xb_xcc_id() { return (unsigned)__builtin_amdgcn_s_getreg((3 << 11) | 20) & 0xFu; }
#define XB_SPIN(cond, bar) do { unsigned _sp = 0; while (cond) { __builtin_amdgcn_s_sleep(1); \
    if ((++_sp & 255u) == 0u) { if (xb_ld(&(bar)[XB_TMO])) break; if (_sp > XB_SPIN_CAP) { atomicAdd(&(bar)[XB_TMO], 1u); break; } } } } while (0)
struct XcdBarrier { unsigned* bar; unsigned x; volatile LAS unsigned* st; };
__device__ __forceinline__ XcdBarrier xcd_barrier_post(unsigned* bar, volatile LAS unsigned* st) {
    XcdBarrier b; b.bar = bar; b.x = xb_xcc_id(); b.st = st;
    if (threadIdx.x == 0) (void)xb_add(&bar[XB_XCNT(b.x)], 1u);
    return b;
}
__device__ __forceinline__ void xcd_barrier_complete(unsigned* bar, unsigned x, unsigned& nloc, unsigned& nx) {
    const unsigned G = gridDim.x * gridDim.y * gridDim.z;
    unsigned sum, cnt, mine, sp = 0u;
    for (;;) {
        sum = 0u; cnt = 0u; mine = 0u;
#pragma unroll
        for (unsigned j = 0; j < 16; ++j) { const unsigned c = xb_ld(&bar[XB_XCNT(j)]); sum += c; cnt += (c > 0u) ? 1u : 0u; mine = (j == x) ? c : mine; }
        if (sum == G) break;
        __builtin_amdgcn_s_sleep(1);
        if ((++sp & 255u) == 0u) { if (xb_ld(&bar[XB_TMO])) break; if (sp > XB_SPIN_CAP) { atomicAdd(&bar[XB_TMO], 1u); break; } }
    }
    nloc = mine > 0u ? mine : 1u; nx = cnt > 0u ? cnt : 1u;
}
__device__ __forceinline__ void xcd_barrier(const XcdBarrier& b) {
    asm volatile("s_waitcnt vmcnt(0)" ::: "memory");
    __syncthreads();
    if (threadIdx.x == 0) {
        unsigned* bar = b.bar;
        __builtin_amdgcn_s_waitcnt(0);
        unsigned nloc = b.st[0], nx = b.st[1];
        if (nloc == 0u) { xcd_barrier_complete(bar, b.x, nloc, nx); b.st[0] = nloc; b.st[1] = nx; }
        const unsigned old = xb_add(&bar[XB_XSUB(b.x)], 1u);
        const unsigned gen = old / nloc;
        if (old + 1u == (gen + 1u) * nloc) {
            __builtin_amdgcn_fence(__ATOMIC_RELEASE, "agent");
            asm volatile("s_waitcnt vmcnt(0)" ::: "memory");
            const unsigned og = xb_add(&bar[XB_TOP], 1u);
            const unsigned tg = og / nx;
            if (og + 1u == (tg + 1u) * nx) xb_add(&bar[XB_TOPGEN], 1u);
            else XB_SPIN(xb_ld(&bar[XB_TOPGEN]) == tg, bar);
            __builtin_amdgcn_fence(__ATOMIC_ACQUIRE, "agent");
            xb_add(&bar[XB_XGEN(b.x)], 1u);
            asm volatile("s_waitcnt vmcnt(0)" ::: "memory");
        } else {
            XB_SPIN(xb_ld(&bar[XB_XGEN(b.x)]) == gen, bar);
            __builtin_amdgcn_fence(__ATOMIC_ACQUIRE, "agent");
            asm volatile("s_waitcnt vmcnt(0)" ::: "memory");
        }
    }
    __syncthreads();
}

constexpr int NWAVES = 8, NTHREADS = 512, GRID = 256;
constexpr int LDS_BYTES = 147456;
constexpr int MISC_OFF = 131072 + 320;
constexpr int CW_BAR = 4096;

struct Args {
    const float* in[25];
    float* out; unsigned char* ws;
    int ph_lo, ph_hi;
};

struct Frame {
    LAS unsigned char* lds;
    int tid, lane, wave, vcu;
    const float* const* in;
    float* out; unsigned char* ws;
};
enum { I_X = 0, I_C, I_CTX, I_CCTX, I_WADA, I_BADA, I_GNORM, I_WIN, I_GQ, I_GK, I_LQ1, I_LK1, I_LQ2, I_LK2, I_GSUB, I_WF, I_BF, I_LNG, I_LNB, I_WS, I_BS, I_WBRA, I_WBRB, I_WBRC, I_WOUT };

__device__ __forceinline__ void transpose_item(const float* W, int ldw, int k0, int lcol0, bool perm, bf16_t* dst, int ldd, int prow0, int dcol0, LAS float* scr, int lane) {
#pragma unroll 8
    for (int i = 0; i < 32; ++i) { const int kk = 2 * i + (lane >> 5); scr[kk * 33 + (lane & 31)] = W[(size_t)(k0 + kk) * ldw + lcol0 + (lane & 31)]; }
    LDS_WAIT(); asm volatile("" ::: "memory");
    const int c = lane & 7;
#pragma unroll
    for (int j = 0; j < 4; ++j) { const int n = (lane >> 3) + 8 * j; const int jn = perm ? perm32(n) : n; const LAS float* s = scr + (8 * c) * 33 + jn;
        u32x4 o; o.x = pk2(s[0 * 33], s[1 * 33]); o.y = pk2(s[2 * 33], s[3 * 33]); o.z = pk2(s[4 * 33], s[5 * 33]); o.w = pk2(s[6 * 33], s[7 * 33]);
        *(GAS u32x4*)(dst + (size_t)(prow0 + n) * ldd + dcol0 + k0 + 8 * c) = o; }
    LDS_WAIT(); asm volatile("" ::: "memory");
}
__device__ __forceinline__ bool win_block_map(int pb, int& lcol, bool& perm) {
    const int tile = pb >> 3, w = pb & 7, bj = w >> 2, wc = w & 3;
    if (tile < 2) { lcol = OFF_Q + (4 * (tile & 1) + wc) * 64 + 32 * bj; perm = false; return true; }
    if (tile < 4) { lcol = OFF_K + (4 * (tile & 1) + wc) * 64 + 32 * bj; perm = false; return true; }
    perm = true;
    if (tile < 6) { lcol = OFF_V + 256 * (tile - 4) + 32 * w; return true; }
    if (tile < 8) return false;
    if (tile < 10) { lcol = (bj == 0 ? OFF_U : OFF_GATE + 768) + 128 * (tile - 8) + 32 * wc; return true; }
    if (tile == 10) { lcol = OFF_VC + 32 * w; return true; }
    if (tile < 14) { lcol = OFF_GATE + 256 * (tile - 11) + 32 * w; return true; }
    lcol = OFF_MERGE + 256 * (tile - 14) + 32 * w; return true;
}
__device__ __forceinline__ float cos2pi(int a, int n) { return cospif(2.0f * (float)a / (float)n); }
__device__ __forceinline__ float sin2pi(int a, int n) { return sinpif(2.0f * (float)a / (float)n); }

__device__ __forceinline__ void ph0_prologue(const Args& a, LAS unsigned char* lds, int tid, int lane, int wave, int vcu) {
    unsigned char* ws = a.ws;
    const int gw = vcu * NWAVES + wave, NGW = GRID * NWAVES;
    const int gt = vcu * NTHREADS + tid, NGT = GRID * NTHREADS;
    {
        LAS float* scr = (LAS float*)(lds + wave * 16384);
        constexpr int I_WIN_N = DEPTH * 208 * 16;
        constexpr int I_BR_N = DEPTH * 32 * 16;
        constexpr int I_OUT_N = DEPTH * 32 * 16;
        for (int it = gw; it < I_WIN_N + I_BR_N + I_OUT_N; it += NGW) {
            int r = it;
            if (r < I_WIN_N) {
                const int l = r / (208 * 16), q = r % (208 * 16), pb = q >> 4, kb = q & 15; int lcol; bool perm;
                if (!win_block_map(pb, lcol, perm)) continue;
                transpose_item(a.in[I_WIN] + (size_t)l * DM * INW, INW, 64 * kb, lcol, perm, (bf16_t*)(ws + WS_WIN) + (size_t)l * NPHYS * DM, DM, 32 * pb, 0, scr, lane);
                continue;
            }
            r -= I_WIN_N;
            if (r < I_BR_N) {
                const int l = r / 512, q = r % 512, pb = q >> 4, kb = q & 15;
                const float* W; int ksrc;
                if (kb < 8) { W = a.in[I_WBRA] + (size_t)l * 512 * DM; ksrc = 64 * kb; } else if (kb < 12) { W = a.in[I_WBRB] + (size_t)l * 256 * DM; ksrc = 64 * (kb - 8); } else { W = a.in[I_WBRC] + (size_t)l * 256 * DM; ksrc = 64 * (kb - 12); }
                transpose_item(W, DM, ksrc, 32 * pb, true, (bf16_t*)(ws + WS_WBR) + (size_t)l * DM * DM, DM, 32 * pb, 64 * kb - ksrc, scr, lane);
                continue;
            }
            r -= I_BR_N;
            { const int l = r / 512, q = r % 512, pb = q >> 4, kb = q & 15;
              transpose_item(a.in[I_WOUT] + (size_t)l * DM * DM, DM, 64 * kb, 32 * pb, false, (bf16_t*)(ws + WS_WOUT) + (size_t)l * DM * DM, DM, 32 * pb, 0, scr, lane); }
        }
    }
    __syncthreads();
    {
        LAS float* Wb = (LAS float*)lds;
        LAS float* Tt = Wb + 64 * 65;
        LAS float* Wf = Tt + 64 * 2 * 65;
        LAS float* tc = Wf + 64 * 65;
        for (int it = vcu; it < DEPTH * 4 * 16; it += GRID) {
            const int l = it / 64, g = (it >> 4) & 3, kb = it & 15;
            const float* win = a.in[I_WIN] + (size_t)l * DM * INW; const float* wf = a.in[I_WF] + (size_t)(l * 4 + g) * 64 * 64;
            for (int e = tid; e < 4096; e += NTHREADS) { const int r = e >> 6, c = e & 63; Wb[r * 65 + c] = win[(size_t)(64 * kb + r) * INW + OFF_F + 64 * g + c]; Wf[r * 65 + c] = wf[r * 64 + c]; }
            if (tid < 64) { tc[tid] = cos2pi(tid, 64); tc[64 + tid] = sin2pi(tid, 64); }
            __syncthreads();
            for (int e = tid; e < 64 * 128; e += NTHREADS) { const int k = e >> 7, ri = (e >> 6) & 1, cp = e & 63; float s = 0.f;
                for (int c = 0; c < 64; ++c) s += Wb[k * 65 + c] * tc[ri * 64 + ((c * cp) & 63)];
                Tt[(k * 2 + ri) * 65 + cp] = ri ? -s : s; }
            __syncthreads();
            bf16_t* dst = (bf16_t*)(ws + WS_WIN) + (size_t)l * NPHYS * DM;
            for (int e = tid; e < 128 * 64; e += NTHREADS) { const int k = e & 63, rd = e >> 6, ri = rd >> 6, d = rd & 63; float s = 0.f;
                for (int cp = 0; cp < 64; ++cp) s += Tt[(k * 2 + ri) * 65 + cp] * Wf[cp * 65 + d];
                const int ch = 64 * g + d, prow = 6 * 256 + ri * 256 + (ch & ~31) + invperm32(ch & 31);
                dst[(size_t)prow * DM + 64 * kb + k] = (bf16_t)f2bf(s); }
            __syncthreads();
        }
    }
    {
        float* ropec = (float*)(ws + WS_ROPE); float* ropes = ropec + 2048;
        for (int e = gt; e < 2048; e += NGT) { const int pos = e >> 4, f = e & 15; const float freq = powf(10000.0f, -(float)(2 * f) / 32.0f); const float ang = (float)pos * freq; ropec[e] = cosf(ang); ropes[e] = sinf(ang); }
        f32x2* tw = (f32x2*)(ws + WS_TW);
        for (int e = gt; e < 8192; e += NGT) tw[e] = (f32x2){cos2pi(e, 8192), sin2pi(e, 8192)};
        bf16_t* c128 = (bf16_t*)(ws + WS_C128); bf16_t* s128 = (bf16_t*)(ws + WS_S128);
        for (int e = gt; e < 4 * 8 * 64 * 8; e += NGT) { const int j = e & 7, ln = (e >> 3) & 63, s = (e >> 9) & 7, mb = e >> 12; const int row = 32 * mb + (ln & 31), k = 16 * s + 8 * (j >> 2) + 4 * (ln >> 5) + (j & 3);
            const int ph = (row * k) & 127; c128[e] = (bf16_t)f2bf(cos2pi(ph, 128)); s128[e] = (bf16_t)f2bf(sin2pi(ph, 128)); }
        bf16_t* t64 = (bf16_t*)(ws + WS_T64);
        for (int e = gt; e < 2 * 8 * 64 * 8; e += NGT) { const int j = e & 7, ln = (e >> 3) & 63, s = (e >> 9) & 7, mb = e >> 12; const int row = 32 * mb + (ln & 31), k = 16 * s + 8 * (j >> 2) + 4 * (ln >> 5) + (j & 3);
            const int ri = k >> 6, c = k & 63, ph = (row * c) & 63; t64[e] = (bf16_t)f2bf(ri ? sin2pi(ph, 64) : cos2pi(ph, 64)); }
        bf16_t* tc256 = (bf16_t*)(ws + WS_TC256);
        for (int e = gt; e < 8 * 32 * 64 * 8; e += NGT) { const int j = e & 7, ln = (e >> 3) & 63, s = (e >> 9) & 31, mb = e >> 14; const int row = 32 * mb + (ln & 31), k = 16 * s + 8 * (j >> 2) + 4 * (ln >> 5) + (j & 3);
            const int ri = k >> 8, n = k & 255, ph = (row * n) & 255; tc256[e] = (bf16_t)f2bf(ri ? sin2pi(ph, 256) : cos2pi(ph, 256)); }
        bf16_t* wsimg = (bf16_t*)(ws + WS_WSIMG);
        for (int e = gt; e < DEPTH * 4 * 4 * 8 * 64 * 8; e += NGT) { const int j = e & 7, ln = (e >> 3) & 63, s = (e >> 9) & 7, mb = (e >> 12) & 3, lg = e >> 14; const int row = 32 * mb + (ln & 31), k = 16 * s + 8 * (j >> 2) + 4 * (ln >> 5) + (j & 3);
            wsimg[e] = (bf16_t)f2bf(a.in[I_WS][(size_t)lg * 128 * 128 + row * 128 + k]); }
        if (gt < DEPTH) { const int l = gt; float s1 = 0.f, s2 = 0.f;
            for (int i = 0; i < 64; ++i) { s1 += a.in[I_LQ1][l * 64 + i] * a.in[I_LK1][l * 64 + i]; s2 += a.in[I_LQ2][l * 64 + i] * a.in[I_LK2][l * 64 + i]; }
            const float lam_init = 0.8f - 0.6f * expf(-0.3f * (float)l);
            float* lam = (float*)(ws + WS_LAM); lam[2 * l] = expf(s1) - expf(s2) + lam_init; lam[2 * l + 1] = 1.0f - lam_init; }
    }
    {
        float* part = (float*)(ws + WS_MODP);
        for (int it = gw; it < DEPTH * 12 * 32; it += NGW) {
            const int l = it / 384, q = it % 384, cc = q >> 5, kc = q & 31; const int col = 256 * cc + 4 * lane;
            const float* w = a.in[I_WADA] + (size_t)l * DM * 3072 + col;
            f32x4 s0 = {0.f, 0.f, 0.f, 0.f}, s1 = s0, s2 = s0;
#pragma unroll 8
            for (int kk = 0; kk < 32; ++kk) { const int k = 32 * kc + kk; const f32x4 wv = *(const f32x4*)(w + (size_t)k * 3072);
                const float a0 = fast_silu(a.in[I_C][k]), a1 = fast_silu(a.in[I_C][DM + k]), a2 = fast_silu(a.in[I_CCTX][k]);
                s0 += wv * a0; s1 += wv * a1; s2 += wv * a2; }
            float* p = part + ((size_t)(l * 32 + kc) * 3) * 3072 + col;
            *(f32x4*)(p) = s0; *(f32x4*)(p + 3072) = s1; *(f32x4*)(p + 2 * 3072) = s2;
        }
    }
}

__device__ __forceinline__ void prepass(const Args& a, int l, LAS unsigned char* lds, int tid, int lane, int wave, int vcu) {
    unsigned char* ws = a.ws;
    const float* part = (const float*)(ws + WS_MODP); float* modf = (float*)(ws + WS_MODF);
    if (l == 0) {
        if (tid < 72) { const int o = vcu * 72 + tid; const int ll = o / 9216, rj = o % 9216, r = rj / 3072, j = rj % 3072; float s = a.in[I_BADA][ll * 3072 + j];
#pragma unroll 4
            for (int kc = 0; kc < 32; ++kc) s += part[((size_t)(ll * 32 + kc) * 3 + r) * 3072 + j];
            modf[o] = s; }
    }
    const int row0 = vcu * 66, row1 = row0 + 66;
    LAS float* coef = (LAS float*)lds;
    for (int r = 0; r < 3; ++r) {
        const int lo = r == 0 ? 0 : (r == 1 ? SEQ : MLAT), hi = r == 0 ? SEQ : (r == 1 ? MLAT : MT);
        if (row1 <= lo || row0 >= hi) continue;
        for (int k = tid; k < DM; k += NTHREADS) {
            float sh, sc;
            if (l == 0) { sh = a.in[I_BADA][k]; sc = a.in[I_BADA][DM + k];
#pragma unroll 4
                for (int kc = 0; kc < 32; ++kc) { const float* p = part + ((size_t)(kc) * 3 + r) * 3072; sh += p[k]; sc += p[DM + k]; } }
            else { sh = modf[(size_t)(l * 3 + r) * 3072 + k]; sc = modf[(size_t)(l * 3 + r) * 3072 + DM + k]; }
            coef[(r * 2) * DM + k] = a.in[I_GNORM][l * DM + k] * (1.0f + sc); coef[(r * 2 + 1) * DM + k] = sh;
        }
    }
    __syncthreads();
    const float* xlat = l == 0 ? a.in[I_X] : a.out; const float* xctx = l == 0 ? a.in[I_CTX] : (const float*)(ws + WS_CTX1);
    bf16_t* H = (bf16_t*)(ws + WS_H);
    for (int m = row0 + wave; m < row1; m += NWAVES) {
        const int r = m < SEQ ? 0 : (m < MLAT ? 1 : 2);
        const float* xrow = m < MLAT ? xlat + (size_t)m * DM : xctx + (size_t)(m - MLAT) * DM;
        const GAS f32x4* xr = (const GAS f32x4*)xrow + lane;
        f32x4 v[4]; float s2 = 0.f;
#pragma unroll
        for (int j = 0; j < 4; ++j) { v[j] = xr[64 * j]; s2 += (v[j].x * v[j].x + v[j].y * v[j].y) + (v[j].z * v[j].z + v[j].w * v[j].w); }
#pragma unroll
        for (int o = 1; o < 64; o <<= 1) s2 += __shfl_xor(s2, o);
        const float rstd = rsqrtf(s2 * (1.0f / DM) + EPS);
        GAS u32x2* o8 = (GAS u32x2*)(H + (size_t)m * DM) + lane;
#pragma unroll
        for (int j = 0; j < 4; ++j) { const f32x4 ga = *(const LAS f32x4*)(coef + (r * 2) * DM + 256 * j + 4 * lane), sh = *(const LAS f32x4*)(coef + (r * 2 + 1) * DM + 256 * j + 4 * lane);
            const f32x4 h = v[j] * rstd * ga + sh; u32x2 w; w.x = pk2(h.x, h.y); w.y = pk2(h.z, h.w); o8[64 * j] = w; }
    }
    __syncthreads();
}

struct TileSched {
    int x, c, pn0, npn, nseg, nctx, cpn0, cnpn;
    __device__ __forceinline__ bool next(int i, pg8::Unit& u) const {
        const int ti = i / nseg; u.seg = i - ti * nseg;
        const int j = ti * 32 + c;
        if (j < 8 * npn) { u.pm = 8 * x + (j & 7); u.pn = pn0 + (j >> 3); return true; }
        const int id = (j - 8 * npn) * 8 + x;
        if (id < nctx) { u.pm = 64 + (id & 1); u.pn = cpn0 + (id >> 1); return true; }
        return false;
    }
};

struct EpiIn {
    unsigned char* ws; const float* gq; const float* gk; const float* ropec; const float* ropes;
    __device__ __forceinline__ void operator()(const f32x4 (&acc)[2][2][4][2], const pg8::Unit& u, int wr, int wc, int fr, int fq) const {
        const bool ctx = u.pm >= 64; const int b = ctx ? u.pm - 64 : (u.pm >> 5);
        const int rbase = u.pm * 256 + wr * 64 + fr;
        const int pn = u.pn;
        if (pn < 4) {
            const bool isK = pn >= 2; const int gi = 4 * (pn & 1) + wc, h = gi >> 1, comp = gi & 1;
            const float* gsrc = isK ? gk : gq;
            f32x4 gv[2][2];
#pragma unroll
            for (int bj = 0; bj < 2; ++bj)
#pragma unroll
                for (int n = 0; n < 2; ++n) gv[bj][n] = *(const f32x4*)(gsrc + 32 * bj + 16 * n + 4 * fq);
#pragma unroll
            for (int ai = 0; ai < 2; ++ai)
#pragma unroll
                for (int m = 0; m < 4; ++m) {
                    const int row = rbase + ai * 128 + m * 16;
                    f32x4 v[2][2]; float ss = 0.f;
#pragma unroll
                    for (int bj = 0; bj < 2; ++bj)
#pragma unroll
                        for (int n = 0; n < 2; ++n) { v[bj][n] = acc[ai][bj][m][n]; ss += (v[bj][n].x * v[bj][n].x + v[bj][n].y * v[bj][n].y) + (v[bj][n].z * v[bj][n].z + v[bj][n].w * v[bj][n].w); }
                    ss += __shfl_xor(ss, 16); ss += __shfl_xor(ss, 32);
                    const float rstd = rsqrtf(ss * (1.0f / 64.0f) + EPS);
#pragma unroll
                    for (int bj = 0; bj < 2; ++bj)
#pragma unroll
                        for (int n = 0; n < 2; ++n) v[bj][n] = v[bj][n] * rstd * gv[bj][n];
                    int kx;
                    if (!ctx) { const int ntok = row - b * SEQ; kx = ntok;
#pragma unroll
                        for (int bj = 0; bj < 2; ++bj) { const int pos = bj == 0 ? (ntok >> 6) : (ntok & 63);
                            const f32x4 c4 = *(const f32x4*)(ropec + pos * 16 + 4 * fq), s4 = *(const f32x4*)(ropes + pos * 16 + 4 * fq);
                            const f32x4 x1 = v[bj][0], x2 = v[bj][1]; v[bj][0] = x1 * c4 - x2 * s4; v[bj][1] = x2 * c4 + x1 * s4; } }
                    else kx = SEQ + (row - MLAT - b * NCTX);
#pragma unroll
                    for (int bj = 0; bj < 2; ++bj) {
                        f32x4 p0 = v[bj][0], p1 = v[bj][1];
                        if (!isK) { p0 = p0 * QSCALE; p1 = p1 * QSCALE; }
                        u32x4 w; w.x = cvt_pk_bf16(p0.x, p0.y); w.y = cvt_pk_bf16(p0.z, p0.w); w.z = cvt_pk_bf16(p1.x, p1.y); w.w = cvt_pk_bf16(p1.z, p1.w);
                        if (!isK) *(u32x4*)((bf16_t*)(ws + WS_QG) + ((size_t)row * 4 + h) * 128 + comp * 64 + (bj * 4 + fq) * 8) = w;
                        else *(u32x4*)(ws + WS_KIMG + ((size_t)((b * 4 + h) * NKT + (kx >> 6)) * 16 + comp * 8 + bj * 4 + fq) * 1024 + (kx & 63) * 16) = w;
                    }
                }
            return;
        }
#pragma unroll
        for (int ai = 0; ai < 2; ++ai)
#pragma unroll
            for (int m = 0; m < 4; ++m) {
                const int row = rbase + ai * 128 + m * 16;
                if (pn == 8 || pn == 9) {
                    f32x4 p0, p1;
#pragma unroll
                    for (int e = 0; e < 4; ++e) { p0[e] = acc[ai][0][m][0][e] * fast_silu(acc[ai][1][m][0][e]); p1[e] = acc[ai][0][m][1][e] * fast_silu(acc[ai][1][m][1][e]); }
                    u32x4 w; w.x = cvt_pk_bf16(p0.x, p0.y); w.y = cvt_pk_bf16(p0.z, p0.w); w.z = cvt_pk_bf16(p1.x, p1.y); w.w = cvt_pk_bf16(p1.z, p1.w);
                    *(u32x4*)((bf16_t*)(ws + WS_UG) + (size_t)row * 256 + 128 * (pn - 8) + 32 * wc + 8 * fq) = w;
                    continue;
                }
#pragma unroll
                for (int bj = 0; bj < 2; ++bj) {
                    f32x4 p0 = acc[ai][bj][m][0], p1 = acc[ai][bj][m][1];
                    const int lc = 128 * bj + 32 * wc + 8 * fq;
                    unsigned char* dst;
                    if (pn < 6) { const int kx = ctx ? SEQ + (row - MLAT - b * NCTX) : row - b * SEQ; const int h = 2 * (pn - 4) + bj;
                        dst = ws + WS_VIMG + ((size_t)((b * 4 + h) * NKT + (kx >> 6)) * 16 + wc * 4 + ((kx & 63) >> 4)) * 1024 + (kx & 15) * 64 + fq * 16; }
                    else if (pn < 8) dst = ws + WS_Z2 + ((size_t)row * 512 + 256 * (pn - 6) + lc) * 2;
                    else if (pn == 10) dst = ws + WS_VC + ((size_t)row * 256 + lc) * 2;
                    else if (pn < 14) {
#pragma unroll
                        for (int e = 0; e < 4; ++e) { p0[e] = fast_silu(p0[e]); p1[e] = fast_silu(p1[e]); }
                        dst = ws + WS_GS + ((size_t)row * 768 + 256 * (pn - 11) + lc) * 2; }
                    else {
#pragma unroll
                        for (int e = 0; e < 4; ++e) { p0[e] = fast_sigmoid(p0[e]); p1[e] = fast_sigmoid(p1[e]); }
                        dst = ws + WS_MS + ((size_t)row * 3072 + 256 * (pn - 14) + lc) * 2; }
                    u32x4 w; w.x = cvt_pk_bf16(p0.x, p0.y); w.y = cvt_pk_bf16(p0.z, p0.w); w.z = cvt_pk_bf16(p1.x, p1.y); w.w = cvt_pk_bf16(p1.z, p1.w);
                    *(u32x4*)dst = w;
                }
            }
    }
};

struct EpiY {
    const bf16_t* MS; bf16_t* Y;
    __device__ __forceinline__ void operator()(const f32x4 (&acc)[2][2][4][2], const pg8::Unit& u, int wr, int wc, int fr, int fq) const {
        const int rbase = u.pm * 256 + wr * 64 + fr;
#pragma unroll
        for (int ai = 0; ai < 2; ++ai)
#pragma unroll
            for (int m = 0; m < 4; ++m) {
                const int row = rbase + ai * 128 + m * 16;
#pragma unroll
                for (int bj = 0; bj < 2; ++bj) {
                    const int col = 256 * u.pn + 128 * bj + 32 * wc + 8 * fq;
                    const u32x4 mg = *(const u32x4*)(MS + (size_t)row * 3072 + u.seg * 1024 + col);
                    f32x4 p0 = acc[ai][bj][m][0], p1 = acc[ai][bj][m][1];
                    p0.x *= bflo(mg.x); p0.y *= bfhi(mg.x); p0.z *= bflo(mg.y); p0.w *= bfhi(mg.y); p1.x *= bflo(mg.z); p1.y *= bfhi(mg.z); p1.z *= bflo(mg.w); p1.w *= bfhi(mg.w);
                    bf16_t* yp = Y + (size_t)row * DM + col;
                    if (u.seg != 0) { const u32x4 yo = *(const u32x4*)yp;
                        p0.x += bflo(yo.x); p0.y += bfhi(yo.x); p0.z += bflo(yo.y); p0.w += bfhi(yo.y); p1.x += bflo(yo.z); p1.y += bfhi(yo.z); p1.z += bflo(yo.w); p1.w += bfhi(yo.w); }
                    u32x4 w; w.x = cvt_pk_bf16(p0.x, p0.y); w.y = cvt_pk_bf16(p0.z, p0.w); w.z = cvt_pk_bf16(p1.x, p1.y); w.w = cvt_pk_bf16(p1.z, p1.w);
                    *(u32x4*)yp = w;
                }
            }
    }
};

struct EpiOut {
    const float* xlat; float* olat; const float* xctx; float* octx; const float* gate;
    __device__ __forceinline__ void operator()(const f32x4 (&acc)[2][2][4][2], const pg8::Unit& u, int wr, int wc, int fr, int fq) const {
        const bool ctx = u.pm >= 64; const int r = ctx ? 2 : (u.pm >> 5);
        const int rbase = u.pm * 256 + wr * 64 + fr;
        const float* src = ctx ? xctx - (size_t)MLAT * DM : xlat; float* dst = ctx ? octx - (size_t)MLAT * DM : olat;
#pragma unroll
        for (int bj = 0; bj < 2; ++bj)
#pragma unroll
            for (int n = 0; n < 2; ++n) {
                const int col = 256 * u.pn + 128 * bj + 32 * wc + 16 * n + 4 * fq;
                const f32x4 gv = *(const f32x4*)(gate + (size_t)r * 3072 + col);
#pragma unroll
                for (int ai = 0; ai < 2; ++ai)
#pragma unroll
                    for (int m = 0; m < 4; ++m) { const size_t off = (size_t)(rbase + ai * 128 + m * 16) * DM + col;
                        const f32x4 xo = *(const f32x4*)(src + off); *(f32x4*)(dst + off) = xo + gv * acc[ai][bj][m][n]; }
            }
    }
};

typedef short v4i16_t __attribute__((ext_vector_type(4)));
__device__ __forceinline__ s16x4 vtr(LAS const unsigned char* p) { return __builtin_bit_cast(s16x4, __builtin_amdgcn_ds_read_tr16_b64_v4i16((LAS v4i16_t*)p)); }
__device__ __forceinline__ int tr_lane_off(int lane) { return ((lane >> 4) & 1) * 32 + (lane & 3) * 8 + (4 * (lane >> 5) + ((lane & 15) >> 2)) * 64; }
__device__ __forceinline__ bf16x8 bfrag(LAS const unsigned char* piece_plus_laneoff) {
    const s16x4 lo = vtr(piece_plus_laneoff), hi = vtr(piece_plus_laneoff + 512);
    return (bf16x8){lo[0], lo[1], lo[2], lo[3], hi[0], hi[1], hi[2], hi[3]};
}
template <class RP> __device__ __forceinline__ void stage_pieces(LAS unsigned char* dst, int nrows, int ncols, RP rp, int tid) {
    const int cpr = ncols >> 3, total = nrows * cpr, pcs = ncols >> 5;
    for (int c = tid; c < total; c += NTHREADS) { const int row = c / cpr, cc = c - row * cpr;
        const u32x4 v = *(const u32x4*)(rp(row) + cc * 8);
        *(LAS u32x4*)(dst + ((row >> 4) * pcs + (cc >> 2)) * 1024 + (row & 15) * 64 + (cc & 3) * 16) = v; }
}
#define MFMA32(a, b, c) __builtin_amdgcn_mfma_f32_32x32x16_bf16(a, b, c, 0, 0, 0)
__device__ __forceinline__ bf16x8 afrag_img(const bf16_t* img, int KS, int mb, int s, int lane) { return *(const bf16x8*)(img + ((size_t)(mb * KS + s) * 64 + lane) * 8); }

__device__ __forceinline__ void f1_unit(unsigned char* ws, LAS unsigned char* lds, int unit, int tid, int lane, int wave) {
    const int b = unit >> 7, c = (unit >> 1) & 63, chh = unit & 1;
    bf16_t* Z2 = (bf16_t*)(ws + WS_Z2);
    const bf16_t* base = Z2 + ((size_t)(b * SEQ + c)) * 512 + chh * 128;
    stage_pieces(lds, 128, 128, [&](int r) { return base + (size_t)r * 64 * 512; }, tid);
    stage_pieces(lds + 32768, 128, 128, [&](int r) { return base + (size_t)r * 64 * 512 + 256; }, tid);
    __syncthreads();
    const int mb = wave & 3, cbp = wave >> 2, hi = lane >> 5, r32 = lane & 31, lo = tr_lane_off(lane);
    const bf16_t* c128 = (const bf16_t*)(ws + WS_C128); const bf16_t* s128 = (const bf16_t*)(ws + WS_S128);
    f32x16 outr[2], t1[2], t2[2];
#pragma unroll
    for (int e = 0; e < 2; ++e) { outr[e] = f32x16{}; t1[e] = f32x16{}; t2[e] = f32x16{}; }
#pragma unroll 1
    for (int s = 0; s < 8; ++s) {
        const bf16x8 cf = afrag_img(c128, 8, mb, s, lane), sf = afrag_img(s128, 8, mb, s, lane);
#pragma unroll
        for (int e = 0; e < 2; ++e) {
            const bf16x8 xr = bfrag(lds + (s * 4 + 2 * cbp + e) * 1024 + lo), xi = bfrag(lds + 32768 + (s * 4 + 2 * cbp + e) * 1024 + lo);
            outr[e] = MFMA32(cf, xr, outr[e]); outr[e] = MFMA32(sf, xi, outr[e]); t1[e] = MFMA32(cf, xi, t1[e]); t2[e] = MFMA32(sf, xr, t2[e]);
        }
    }
    const f32x2* tw = (const f32x2*)(ws + WS_TW);
#pragma unroll
    for (int e = 0; e < 2; ++e)
#pragma unroll
        for (int r = 0; r < 16; ++r) {
            const int k1 = 32 * mb + crow(r, hi), ch = chh * 128 + 32 * (2 * cbp + e) + r32;
            const float yr = outr[e][r], yi = t1[e][r] - t2[e][r];
            const f32x2 t = tw[(c * k1) & 8191];
            bf16_t* o = Z2 + ((size_t)(b * SEQ + 64 * k1 + c)) * 512 + ch;
            o[0] = (bf16_t)f2bf(yr * t.x + yi * t.y); o[256] = (bf16_t)f2bf(yi * t.x - yr * t.y);
            if ((r & 3) == 3) __builtin_amdgcn_sched_barrier(0);
        }
    __syncthreads();
}

__device__ __forceinline__ void sgu_unit(const Args& a, int l, LAS unsigned char* lds, int cu, int tid, int lane, int wave) {
    unsigned char* ws = a.ws;
    const int row0 = cu < 128 ? cu * 128 : MLAT + (cu - 128) * 128;
    const bf16_t* VC = (const bf16_t*)(ws + WS_VC);
    {
        const int tok = tid >> 2, qt = tid & 3;
        const u32x4* src = (const u32x4*)(VC + (size_t)(row0 + tok) * 256 + qt * 64);
        u32x4 raw[8]; float s = 0.f;
#pragma unroll
        for (int i = 0; i < 8; ++i) { raw[i] = src[i]; s += (bflo(raw[i].x) + bfhi(raw[i].x)) + (bflo(raw[i].y) + bfhi(raw[i].y)) + (bflo(raw[i].z) + bfhi(raw[i].z)) + (bflo(raw[i].w) + bfhi(raw[i].w)); }
        s += __shfl_xor(s, 1); s += __shfl_xor(s, 2);
        const float mu = s * (1.0f / 256.0f); float q = 0.f;
#pragma unroll
        for (int i = 0; i < 8; ++i) {
#pragma unroll
            for (int e = 0; e < 4; ++e) { const float d0 = bflo(raw[i][e]) - mu, d1 = bfhi(raw[i][e]) - mu; q += d0 * d0 + d1 * d1; } }
        q += __shfl_xor(q, 1); q += __shfl_xor(q, 2);
        const float rstd = rsqrtf(q * (1.0f / 256.0f) + EPS);
        const float* lg = a.in[I_LNG] + l * 256 + qt * 64; const float* lb = a.in[I_LNB] + l * 256 + qt * 64;
#pragma unroll
        for (int i = 0; i < 8; ++i) { u32x4 w;
#pragma unroll
            for (int e = 0; e < 4; ++e) { const int ch = 8 * i + 2 * e; w[e] = pk2((bflo(raw[i][e]) - mu) * rstd * lg[ch] + lb[ch], (bfhi(raw[i][e]) - mu) * rstd * lg[ch + 1] + lb[ch + 1]); }
            const int cc = qt * 8 + i;
            *(LAS u32x4*)(lds + ((tok >> 4) * 8 + (cc >> 2)) * 1024 + (tok & 15) * 64 + (cc & 3) * 16) = w; __builtin_amdgcn_sched_barrier(0); }
    }
    __syncthreads();
    const int g = wave >> 1, ph = wave & 1, hi = lane >> 5, r32 = lane & 31, lo = tr_lane_off(lane);
    const bf16_t* img = (const bf16_t*)(ws + WS_WSIMG) + (size_t)(l * 4 + g) * 16384;
    f32x16 acc[2][2];
#pragma unroll
    for (int i = 0; i < 2; ++i) { acc[i][0] = f32x16{}; acc[i][1] = f32x16{}; }
#pragma unroll 1
    for (int s = 0; s < 8; ++s) {
        const bf16x8 a0 = afrag_img(img, 8, 2 * ph, s, lane), a1 = afrag_img(img, 8, 2 * ph + 1, s, lane);
        const bf16x8 b0 = bfrag(lds + (s * 8 + 2 * g) * 1024 + lo), b1 = bfrag(lds + (s * 8 + 2 * g + 1) * 1024 + lo);
        acc[0][0] = MFMA32(a0, b0, acc[0][0]); acc[0][1] = MFMA32(a0, b1, acc[0][1]); acc[1][0] = MFMA32(a1, b0, acc[1][0]); acc[1][1] = MFMA32(a1, b1, acc[1][1]);
    }
    const bf16_t* UG = (const bf16_t*)(ws + WS_UG); bf16_t* A = (bf16_t*)(ws + WS_A);
    const float* bs = a.in[I_BS] + (size_t)(l * 4 + g) * 128;
#pragma unroll
    for (int i = 0; i < 2; ++i)
#pragma unroll
        for (int e = 0; e < 2; ++e)
#pragma unroll
            for (int r = 0; r < 16; ++r) { const int p = 32 * (2 * ph + i) + crow(r, hi), ch = 64 * g + 32 * e + r32;
                const float sv = acc[i][e][r] + bs[p]; const float ug = bf2f(UG[(size_t)(row0 + p) * 256 + ch]);
                A[(size_t)(row0 + p) * DM + 768 + ch] = (bf16_t)f2bf(ug * sv); if ((r & 3) == 3) __builtin_amdgcn_sched_barrier(0); }
    __syncthreads();
}

__device__ __forceinline__ void ctxf_unit(const Args& a, int l, LAS unsigned char* lds, int unit, int tid, int lane, int wave) {
    unsigned char* ws = a.ws;
    const int b = unit >> 2, chq = unit & 3;
    const bf16_t* Z2 = (const bf16_t*)(ws + WS_Z2);
    stage_pieces(lds, 512, 64, [&](int k) { return Z2 + (size_t)(MLAT + b * NCTX + (k & 255)) * 512 + (k >> 8) * 256 + chq * 64; }, tid);
    __syncthreads();
    const int mb = wave, hi = lane >> 5, r32 = lane & 31, lo = tr_lane_off(lane);
    const bf16_t* img = (const bf16_t*)(ws + WS_TC256);
    f32x16 acc[2]; acc[0] = f32x16{}; acc[1] = f32x16{};
#pragma unroll 4
    for (int s = 0; s < 32; ++s) { const bf16x8 af = afrag_img(img, 32, mb, s, lane);
        acc[0] = MFMA32(af, bfrag(lds + (s * 2) * 1024 + lo), acc[0]); acc[1] = MFMA32(af, bfrag(lds + (s * 2 + 1) * 1024 + lo), acc[1]); }
    const bf16_t* GS = (const bf16_t*)(ws + WS_GS); bf16_t* A = (bf16_t*)(ws + WS_A);
#pragma unroll
    for (int e = 0; e < 2; ++e)
#pragma unroll
        for (int r = 0; r < 16; ++r) { const int np = 32 * mb + crow(r, hi), ch = 64 * chq + 32 * e + r32; const size_t row = MLAT + b * NCTX + np;
            const float v = acc[e][r] * (1.0f / 128.0f) + a.in[I_BF][l * 256 + ch];
            A[row * DM + 512 + ch] = (bf16_t)f2bf(v * bf2f(GS[row * 768 + 512 + ch])); if ((r & 3) == 3) __builtin_amdgcn_sched_barrier(0); }
    __syncthreads();
}

__device__ __forceinline__ void f2_unit(const Args& a, int l, LAS unsigned char* lds, int unit, int tid, int lane, int wave) {
    unsigned char* ws = a.ws;
    const int b = unit >> 7, k1 = unit & 127;
    const bf16_t* Z2 = (const bf16_t*)(ws + WS_Z2);
    stage_pieces(lds, 128, 256, [&](int k) { return Z2 + (size_t)(b * SEQ + 64 * k1 + (k & 63)) * 512 + (k >> 6) * 256; }, tid);
    __syncthreads();
    const int cb = wave, hi = lane >> 5, r32 = lane & 31, lo = tr_lane_off(lane);
    const bf16_t* img = (const bf16_t*)(ws + WS_T64);
    f32x16 acc[2]; acc[0] = f32x16{}; acc[1] = f32x16{};
#pragma unroll 4
    for (int s = 0; s < 8; ++s) { const bf16x8 bf = bfrag(lds + (s * 8 + cb) * 1024 + lo);
        acc[0] = MFMA32(afrag_img(img, 8, 0, s, lane), bf, acc[0]); acc[1] = MFMA32(afrag_img(img, 8, 1, s, lane), bf, acc[1]); }
    const bf16_t* GS = (const bf16_t*)(ws + WS_GS); bf16_t* A = (bf16_t*)(ws + WS_A);
    const float nrm = 0.0013810679320049757f;
#pragma unroll
    for (int mb = 0; mb < 2; ++mb)
#pragma unroll
        for (int r = 0; r < 16; ++r) { const int k2 = 32 * mb + crow(r, hi), ch = 32 * cb + r32; const size_t row = (size_t)b * SEQ + k1 + 128 * k2;
            const float v = acc[mb][r] * nrm + a.in[I_BF][l * 256 + ch];
            A[row * DM + 512 + ch] = (bf16_t)f2bf(v * bf2f(GS[row * 768 + 512 + ch])); if ((r & 3) == 3) __builtin_amdgcn_sched_barrier(0); }
    __syncthreads();
}

__device__ __forceinline__ void attn_unit(const Args& a, int l, LAS unsigned char* lds, int b, int h, int qrow0, int t0, int nt, int tid, int lane, int wave) {
    unsigned char* ws = a.ws;
    const int comp = wave >> 2, qg = wave & 3, hi = lane >> 5, r32 = lane & 31;
    const bf16_t* Qg = (const bf16_t*)(ws + WS_QG);
    const unsigned char* kimg = ws + WS_KIMG + (size_t)(b * 4 + h) * NKT * 16384;
    const unsigned char* vimg = ws + WS_VIMG + (size_t)(b * 4 + h) * NKT * 16384;
    bf16x8 qr[4];
    { const bf16_t* qp = Qg + ((size_t)(qrow0 + 32 * qg + r32) * 4 + h) * 128 + comp * 64 + 8 * hi;
#pragma unroll
      for (int d0 = 0; d0 < 4; ++d0) qr[d0] = *(const bf16x8*)(qp + 16 * d0); }
    f32x16 o[4];
#pragma unroll
    for (int d = 0; d < 4; ++d) o[d] = f32x16{};
    float lsum = 0.f;
    const int lo = tr_lane_off(lane);
#define ATT_DMA(t, buf) do { const unsigned char* ks_ = kimg + (size_t)(t) * 16384 + wave * 2048 + lane * 16; const unsigned char* vs_ = vimg + (size_t)(t) * 16384 + wave * 2048 + lane * 16; \
        LAS unsigned char* kd_ = lds + (buf) * 32768 + wave * 2048; \
        __builtin_amdgcn_global_load_lds((const unsigned*)ks_, (LAS unsigned*)kd_, 16, 0, 0); __builtin_amdgcn_global_load_lds((const unsigned*)(ks_ + 1024), (LAS unsigned*)(kd_ + 1024), 16, 0, 0); \
        __builtin_amdgcn_global_load_lds((const unsigned*)vs_, (LAS unsigned*)(kd_ + 16384), 16, 0, 0); __builtin_amdgcn_global_load_lds((const unsigned*)(vs_ + 1024), (LAS unsigned*)(kd_ + 16384 + 1024), 16, 0, 0); } while (0)
    ATT_DMA(t0, 0);
    VM_WAIT(); __syncthreads();
    for (int t = 0; t < nt; ++t) {
        const int buf = t & 1;
        if (t + 1 < nt) ATT_DMA(t0 + t + 1, buf ^ 1);
        LAS const unsigned char* kb = lds + buf * 32768 + comp * 8192 + hi * 1024 + r32 * 16;
        LAS const unsigned char* vb = lds + buf * 32768 + 16384 + lo;
        f32x16 c0 = f32x16{}, c1 = f32x16{};
#pragma unroll
        for (int d0 = 0; d0 < 4; ++d0) {
            const bf16x8 k0 = *(const LAS bf16x8*)(kb + d0 * 2048), k1 = *(const LAS bf16x8*)(kb + d0 * 2048 + 512);
            c0 = MFMA32(k0, qr[d0], c0); c1 = MFMA32(k1, qr[d0], c1);
        }
        float ps = 0.f;
#pragma unroll
        for (int r = 0; r < 16; ++r) { c0[r] = __builtin_amdgcn_exp2f(c0[r]); c1[r] = __builtin_amdgcn_exp2f(c1[r]); ps += c0[r] + c1[r]; }
        lsum += ps;
        u32x4 pw[4];
#pragma unroll
        for (int e = 0; e < 4; ++e) { pw[0][e] = cvt_pk_bf16(c0[2 * e], c0[2 * e + 1]); pw[1][e] = cvt_pk_bf16(c0[8 + 2 * e], c0[9 + 2 * e]); pw[2][e] = cvt_pk_bf16(c1[2 * e], c1[2 * e + 1]); pw[3][e] = cvt_pk_bf16(c1[8 + 2 * e], c1[9 + 2 * e]); }
#pragma unroll
        for (int d = 0; d < 4; ++d)
#pragma unroll
            for (int s = 0; s < 4; ++s) o[d] = MFMA32(__builtin_bit_cast(bf16x8, pw[s]), bfrag(vb + (d * 4 + s) * 1024), o[d]);
        VM_WAIT(); __syncthreads();
    }
#undef ATT_DMA
    LAS float* ost = (LAS float*)lds;
    LAS float* lw = (LAS float*)(lds + 72 * 1024);
    lsum += __shfl_xor(lsum, 32);
    if (hi == 0) lw[wave * 32 + r32] = lsum;
    LDS_WAIT(); asm volatile("" ::: "memory");
    const float* lamp = (const float*)(ws + WS_LAM) + 2 * l;
    const float lam = lamp[0], oscale = lamp[1];
    float rl[16];
#pragma unroll
    for (int r = 0; r < 16; ++r) rl[r] = __builtin_amdgcn_rcpf(lw[wave * 32 + crow(r, hi)]);
    if (comp == 0) {
#pragma unroll
        for (int d = 0; d < 4; ++d)
#pragma unroll
            for (int r = 0; r < 16; ++r) ost[(32 * qg + crow(r, hi)) * 132 + 32 * d + r32] = o[d][r] * rl[r];
    }
    __syncthreads();
    if (comp == 1) {
#pragma unroll
        for (int d = 0; d < 4; ++d)
#pragma unroll
            for (int r = 0; r < 16; ++r) ost[(32 * qg + crow(r, hi)) * 132 + 32 * d + r32] -= lam * o[d][r] * rl[r];
    }
    __syncthreads();
    {
        const int row = tid >> 2, qt = tid & 3; const LAS float* src = ost + row * 132 + 32 * qt;
        float v[32]; float ss = 0.f;
#pragma unroll
        for (int i = 0; i < 32; ++i) { v[i] = src[i]; ss += v[i] * v[i]; }
        ss += __shfl_xor(ss, 1); ss += __shfl_xor(ss, 2);
        const float rstd = rsqrtf(ss * (1.0f / 128.0f) + EPS) * oscale;
        const size_t grow = (size_t)qrow0 + row;
        const bf16_t* gs = (const bf16_t*)(ws + WS_GS) + grow * 768 + h * 128 + 32 * qt;
        bf16_t* dst = (bf16_t*)(ws + WS_A) + grow * DM + h * 128 + 32 * qt;
        const float* gsub = a.in[I_GSUB] + l * 128 + 32 * qt;
#pragma unroll
        for (int i = 0; i < 4; ++i) { const u32x4 gw = *(const u32x4*)(gs + 8 * i); u32x4 w;
#pragma unroll
            for (int e = 0; e < 4; ++e) { const int j = 8 * i + 2 * e; w[e] = pk2(v[j] * rstd * gsub[j] * bflo(gw[e]), v[j + 1] * rstd * gsub[j + 1] * bfhi(gw[e])); }
            *(u32x4*)(dst + 8 * i) = w; }
    }
    __syncthreads();
}

constexpr int N_PHASES = 15;
__global__ void __launch_bounds__(NTHREADS, 2) fwd_kernel(Args args) {
    extern __shared__ __attribute__((aligned(16))) unsigned char lds_raw[];
    LAS unsigned char* lds = (LAS unsigned char*)lds_raw;
    const int tid = threadIdx.x, lane = tid & 63, wave = __builtin_amdgcn_readfirstlane(tid >> 6);
    const int bx = blockIdx.x, vcu = (bx % 8) * (GRID / 8) + bx / 8;
    unsigned char* ws = args.ws;
    volatile LAS unsigned* MISC = (volatile LAS unsigned*)(lds + MISC_OFF);
    for (int u = tid; u < 32; u += NTHREADS) MISC[u] = 0u;
    __syncthreads();
    XcdBarrier bar; bar.bar = (unsigned*)(ws + WS_CTL) + CW_BAR; bar.x = 0; bar.st = nullptr;
    const bool one_launch = (args.ph_hi - args.ph_lo) > 1;
    if (one_launch) bar = xcd_barrier_post((unsigned*)(ws + WS_CTL) + CW_BAR, MISC + 8);
    const int lo = args.ph_lo, hi = args.ph_hi;
#ifndef PHMASK
#define PHMASK 0xffff
#endif
#define EN(b) (((PHMASK) >> (b)) & 1)
#define IN(k) (lo <= (k) && (k) < hi)
#define LAUNDER() int tid_ = tid, vcu_ = vcu; asm volatile("" : "+v"(tid_)); asm volatile("" : "+s"(vcu_)); const int lane_ = tid_ & 63, wave_ = __builtin_amdgcn_readfirstlane(tid_ >> 6); (void)lane_; (void)wave_
#define SEAM(k) do { if (IN(k) && IN((k) + 1)) { XcdBarrier b2_ = bar; asm volatile("" : "+s"(b2_.bar)); xcd_barrier(b2_); } } while (0)

    if (EN(0) && IN(0)) { LAUNDER(); ph0_prologue(args, lds, tid_, lane_, wave_, vcu_); SEAM(0); }
    if (EN(1) && IN(1)) { LAUNDER(); prepass(args, 0, lds, tid_, lane_, wave_, vcu_); SEAM(1); }
#pragma unroll 1
    for (int l = 0; l < DEPTH; ++l) {
        const int pb = l == 0 ? 2 : 9;
        const bf16_t* Wl = (const bf16_t*)(ws + WS_WIN) + (size_t)l * NPHYS * DM;
        if (EN(2) && IN(pb)) {
            LAUNDER();
            pg8::Gemm g{(const bf16_t*)(ws + WS_H), Wl, DM, DM, 0, 0, 0, 16, 16, 16};
            TileSched S{vcu_ >> 5, vcu_ & 31, 0, 14, 1, l == 0 ? 28 : 8, l == 0 ? 0 : 2, l == 0 ? 14 : 4};
            EpiIn E{ws, args.in[I_GQ] + l * 64, args.in[I_GK] + l * 64, (const float*)(ws + WS_ROPE), (const float*)(ws + WS_ROPE) + 2048};
            pg8::gemm_phase<EpiIn, TileSched, true, true>(lds, g, S, E, tid_);
            SEAM(pb);
        }
        if (EN(3) && IN(pb + 1)) {
            LAUNDER();
            if (EN(8)) f1_unit(ws, lds, vcu_, tid_, lane_, wave_);
            const int nsgu = l == 0 ? 132 : 128;
            if (EN(9)) for (int cu = vcu_; cu < nsgu; cu += GRID) sgu_unit(args, l, lds, cu, tid_, lane_, wave_);
            if (EN(10) && l == 0 && vcu_ >= 248) ctxf_unit(args, l, lds, vcu_ - 248, tid_, lane_, wave_);
            SEAM(pb + 1);
        }
        if (EN(4) && IN(pb + 2)) {
            LAUNDER();
            if (EN(11)) f2_unit(args, l, lds, vcu_, tid_, lane_, wave_);
            const int bh = vcu_ >> 5, qb = vcu_ & 31;
            if (EN(12)) {
                const int nun = (l == 0 && qb < 2) ? 3 : 2;
#pragma unroll 1
                for (int ui = 0; ui < nun; ++ui) {
                    const int qrow0 = ui < 2 ? (bh >> 2) * SEQ + 256 * qb + 128 * ui : MLAT + (bh >> 2) * NCTX + 128 * qb;
                    attn_unit(args, l, lds, bh >> 2, bh & 3, qrow0, ui < 2 ? 0 : SEQ / 64, ui < 2 ? NKT : NCTX / 64, tid_, lane_, wave_);
                }
            }
            SEAM(pb + 2);
        }
        if (EN(5) && IN(pb + 3)) {
            LAUNDER();
            pg8::Gemm g{(const bf16_t*)(ws + WS_H), Wl, DM, DM, 0, 0, 0, 16, 16, 16};
            TileSched S{vcu_ >> 5, vcu_ & 31, 14, 12, 1, l == 0 ? 24 : 0, 14, 12};
            EpiIn E{ws, nullptr, nullptr, nullptr, nullptr};
            pg8::gemm_phase<EpiIn, TileSched, true, true>(lds, g, S, E, tid_);
            SEAM(pb + 3);
        }
        if (EN(6) && IN(pb + 4)) {
            LAUNDER();
            pg8::Gemm g{(const bf16_t*)(ws + WS_A), (const bf16_t*)(ws + WS_WBR) + (size_t)l * DM * DM, DM, DM, 0, 512, 768, 8, 4, 4};
            TileSched S{vcu_ >> 5, vcu_ & 31, 0, 4, 3, l == 0 ? 8 : 0, 0, 4};
            EpiY E{(const bf16_t*)(ws + WS_MS), (bf16_t*)(ws + WS_H)};
            pg8::gemm_phase<EpiY, TileSched, true, true>(lds, g, S, E, tid_);
            SEAM(pb + 4);
        }
        if (EN(7) && IN(pb + 5)) {
            LAUNDER();
            pg8::Gemm g{(const bf16_t*)(ws + WS_H), (const bf16_t*)(ws + WS_WOUT) + (size_t)l * DM * DM, DM, DM, 0, 0, 0, 16, 16, 16};
            TileSched S{vcu_ >> 5, vcu_ & 31, 0, 4, 1, l == 0 ? 8 : 0, 0, 4};
            EpiOut E{l == 0 ? args.in[I_X] : args.out, args.out, args.in[I_CTX], (float*)(ws + WS_CTX1), (const float*)(ws + WS_MODF) + (size_t)(l * 3) * 3072 + 2048};
            pg8::gemm_phase<EpiOut, TileSched, true, true>(lds, g, S, E, tid_);
            SEAM(pb + 5);
        }
        if (EN(1) && l == 0 && IN(8)) { LAUNDER(); prepass(args, 1, lds, tid_, lane_, wave_, vcu_); SEAM(8); }
    }
#undef IN
#undef SEAM
}

extern "C" void kernel_launch(void* const* d_in, const int* in_sizes, int n_in, void* d_out, int out_size, void* d_ws, size_t ws_size, hipStream_t stream) {
    static int ready = 0;
    if (ready == 0) {
        if (n_in != 25 || out_size != MLAT * DM || ws_size < 256 * MiB) { fprintf(stderr, "kernel_launch: unexpected shapes (n_in %d out %d ws %zu)\n", n_in, out_size, ws_size); ready = -1; return; }
        int dev = 0, cus = 0, per_cu = 0;
        hipGetDevice(&dev); hipDeviceGetAttribute(&cus, hipDeviceAttributeMultiprocessorCount, dev);
        if (hipFuncSetAttribute((const void*)fwd_kernel, hipFuncAttributeMaxDynamicSharedMemorySize, LDS_BYTES) != hipSuccess) { fprintf(stderr, "kernel_launch: hipFuncSetAttribute failed\n"); ready = -1; return; }
        hipOccupancyMaxActiveBlocksPerMultiprocessor(&per_cu, (const void*)fwd_kernel, NTHREADS, LDS_BYTES);
        (void)hipGetLastError();
        if (cus != GRID || per_cu < 1) fprintf(stderr, "kernel_launch: note: %d CUs, occupancy %d blocks/CU (built for 256 CUs, 1 block/CU)\n", cus, per_cu);
        ready = (cus >= GRID) ? 1 : -1;
    }
    if (ready < 0) return;
    hipMemsetAsync((char*)d_ws + WS_CTL, 0, CTL_ZERO_BYTES, stream);
    Args a{};
    for (int i = 0; i < 25; ++i) a.in[i] = (const float*)d_in[i];
    a.out = (float*)d_out; a.ws = (unsigned char*)d_ws;
#if MK_N_LAUNCHES == 1
    a.ph_lo = 0; a.ph_hi = N_PHASES;
    hipLaunchKernelGGL(fwd_kernel, dim3(GRID), dim3(NTHREADS), LDS_BYTES, stream, a);
#else
    for (int p = 0; p < N_PHASES; ++p) { a.ph_lo = p; a.ph_hi = p + 1; hipLaunchKernelGGL(fwd_kernel, dim3(GRID), dim3(NTHREADS), LDS_BYTES, stream, a); }
#endif
}
```

```cpp
#include <hip/hip_runtime.h>
#include <cstdio>
#include <cstdint>

#ifndef MK_N_LAUNCHES
#define MK_N_LAUNCHES 1
#endif

#define LAS __attribute__((address_space(3)))
#define GAS __attribute__((address_space(1)))
typedef unsigned short bf16_t;
typedef short bf16x8 __attribute__((ext_vector_type(8)));
typedef short s16x4 __attribute__((ext_vector_type(4)));
typedef float f32x4 __attribute__((ext_vector_type(4)));
typedef float f32x2 __attribute__((ext_vector_type(2)));
typedef float f32x16 __attribute__((ext_vector_type(16)));
typedef unsigned u32x4 __attribute__((ext_vector_type(4)));
typedef unsigned u32x2 __attribute__((ext_vector_type(2)));

constexpr int DM = 1024, BATCH = 2, SEQ = 8192, NCTX = 256, DEPTH = 2;
constexpr int MLAT = BATCH * SEQ, MCTX = BATCH * NCTX, MT = MLAT + MCTX;
constexpr int NKEY = SEQ + NCTX, NKT = NKEY / 64;
constexpr int INW = 6400;
constexpr int OFF_Q = 0, OFF_K = 512, OFF_V = 1024, OFF_F = 1536, OFF_U = 1792, OFF_VC = 2048, OFF_GATE = 2304, OFF_MERGE = 3328;
constexpr int NPHYS = 6656;
constexpr float EPS = 1e-6f;
constexpr float QSCALE = 0.125f * 1.4426950408889634f;

constexpr size_t KiB = 1024, MiB = 1u << 20;
constexpr size_t WS_CTL = 0, CTL_ZERO_BYTES = 64 * KiB;
constexpr size_t WS_MODP = 1 * MiB;
constexpr size_t WS_MODF = WS_MODP + 2304 * KiB;
constexpr size_t WS_ROPE = WS_MODF + 72 * KiB;
constexpr size_t WS_TW = WS_ROPE + 16 * KiB;
constexpr size_t WS_LAM = WS_TW + 64 * KiB;
constexpr size_t WS_C128 = WS_LAM + 1 * KiB;
constexpr size_t WS_S128 = WS_C128 + 32 * KiB;
constexpr size_t WS_T64 = WS_S128 + 32 * KiB;
constexpr size_t WS_TC256 = WS_T64 + 16 * KiB;
constexpr size_t WS_WSIMG = WS_TC256 + 256 * KiB;
constexpr size_t WS_SMALL_END = WS_WSIMG + 256 * KiB;
static_assert(WS_SMALL_END <= 5 * MiB, "small tables");
constexpr size_t WS_WIN = 5 * MiB;
constexpr size_t WS_WBR = 31 * MiB;
constexpr size_t WS_WOUT = 35 * MiB;
constexpr size_t WS_CTX1 = 39 * MiB;
constexpr size_t WS_H = 41 * MiB;
constexpr size_t WS_A = 74 * MiB;
constexpr size_t WS_R = 107 * MiB;
constexpr size_t SZ_QG = (size_t)MT * 512 * 2, SZ_KIMG = (size_t)BATCH * 4 * NKT * 16384, SZ_Z2 = (size_t)MT * 512 * 2, SZ_UG = (size_t)MT * 256 * 2, SZ_GS = (size_t)MT * 768 * 2;
constexpr size_t WS_QG = WS_R, WS_KIMG = WS_QG + SZ_QG, WS_VIMG = WS_KIMG + SZ_KIMG, WS_Z2 = WS_VIMG + SZ_KIMG, WS_UG = WS_Z2 + SZ_Z2, WS_VC = WS_UG + SZ_UG, WS_GS = WS_VC + SZ_UG;
constexpr size_t WS_MS = WS_R;
constexpr size_t WS_END = WS_GS + SZ_GS;
constexpr size_t WS_MSC = 224 * MiB;
static_assert(WS_R + (size_t)MT * 3072 * 2 <= 256 * MiB && WS_END <= WS_MSC && WS_MSC + (size_t)MCTX * 3072 * 2 <= 256 * MiB, "d_ws map");

__device__ __forceinline__ unsigned f2bf(float f) { unsigned u = __builtin_bit_cast(unsigned, f); return (u + 0x7fffu + ((u >> 16) & 1u)) >> 16; }
__device__ __forceinline__ unsigned pk2(float lo, float hi) { return f2bf(lo) | (f2bf(hi) << 16); }
__device__ __forceinline__ unsigned cvt_pk_bf16(float lo, float hi) { unsigned r; asm volatile("v_cvt_pk_bf16_f32 %0, %1, %2" : "=v"(r) : "v"(lo), "v"(hi)); return r; }
__device__ __forceinline__ float bf2f(unsigned short v) { return __builtin_bit_cast(float, (unsigned)v << 16); }
__device__ __forceinline__ float bflo(unsigned w) { return __builtin_bit_cast(float, w << 16); }
__device__ __forceinline__ float bfhi(unsigned w) { return __builtin_bit_cast(float, w & 0xffff0000u); }
__device__ __forceinline__ float fast_sigmoid(float x) { return __builtin_amdgcn_rcpf(1.0f + __builtin_amdgcn_exp2f(-1.4426950408889634f * x)); }
__device__ __forceinline__ float fast_silu(float x) { return x * fast_sigmoid(x); }
__device__ __forceinline__ int crow(int r, int hi) { return (r & 3) + 8 * (r >> 2) + 4 * hi; }
__host__ __device__ __forceinline__ int perm32(int rho) { const int n = rho >> 4, i = rho & 15; return 8 * (i >> 2) + 4 * n + (i & 3); }
__host__ __device__ __forceinline__ int invperm32(int c) { return 16 * ((c >> 2) & 1) + 4 * (c >> 3) + (c & 3); }
#define LDS_WAIT() asm volatile("s_waitcnt lgkmcnt(0)" ::: "memory")
#define VM_WAIT() asm volatile("s_waitcnt vmcnt(0)" ::: "memory")

namespace pg8 {
constexpr int BM = 256, BK = 64, HALF = 128, HTB = HALF * BK * 2  , STAGE_BYTES = 8 * HTB;
__host__ __device__ __forceinline__ int lds_byte(int r, int c) { const int st = (r >> 4) * 2 + (c >> 5), rr = r & 15, cc = c & 31, ob = rr * 64 + cc * 2; return st * 1024 + (ob ^ (((ob >> 9) & 1) << 5)); }
__host__ __device__ __forceinline__ void stage_rc(int b, int& R, int& C) { const int st = b / 1024, sb = b % 1024, swz = sb ^ (((sb >> 9) & 1) << 5); R = (st >> 1) * 16 + swz / 64; C = (st & 1) * 32 + (swz % 64) / 2; }

struct Unit { int pm, pn, seg; };
struct Gemm { const bf16_t* A; const bf16_t* Bt; int lda, ldb; int k0_0, k0_1, k0_2; int nt_0, nt_1, nt_2; };

template <class Epi, class Sched, bool ALIGN_EPI = false, bool SP2 = false>
__device__ __forceinline__ void gemm_phase(LAS unsigned char* lds, const Gemm g, const Sched& S, const Epi& E, const int tid) {
    const int wid = __builtin_amdgcn_readfirstlane(tid >> 6), lane = tid & 63, wr = wid >> 2, wc = wid & 3, fr = lane & 15, fq = lane >> 4;
    unsigned voffA[2], voffB[2];
#pragma unroll
    for (int i = 0; i < 2; ++i) { int R, C; stage_rc(tid * 16 + i * 8192, R, C); voffA[i] = (unsigned)(R * g.lda + C) * 2u; voffB[i] = (unsigned)(R * g.ldb + C) * 2u; }
    const size_t kstep = (size_t)(BK * 2);
    const size_t hstepA = (size_t)HALF * g.lda * 2, hstepB = (size_t)HALF * g.ldb * 2;
    const size_t tstepA = 2 * hstepA, tstepB = 2 * hstepB;
    const unsigned ldsw = (unsigned)wid * 1024u;
    const int aoff = lds_byte(wr * 64 + fr, fq * 8), boff = lds_byte(wc * 32 + fr, fq * 8);
#define PG8_SA(b, h) (((b) * 2 + (h)) * HTB)
#define PG8_SB(b, h) ((4 + (b) * 2 + (h)) * HTB)
#define PG8_STAGE(bufoff, gbase, voff) do { _Pragma("unroll") for (int _i = 0; _i < 2; ++_i) \
        __builtin_amdgcn_global_load_lds((const unsigned*)((const char*)(gbase) + (voff)[_i]), (LAS unsigned*)(lds + (bufoff) + ldsw + _i * 8192), 16, 0, 0); } while (0)
#define PG8_LDA(dst, b, h) do { _Pragma("unroll") for (int m = 0; m < 4; ++m) _Pragma("unroll") for (int k = 0; k < 2; ++k) dst[m][k] = *(const LAS bf16x8*)(lds + PG8_SA(b, h) + aoff + m * 2048 + k * 1024); } while (0)
#define PG8_LDB(dst, b, h) do { _Pragma("unroll") for (int n = 0; n < 2; ++n) _Pragma("unroll") for (int k = 0; k < 2; ++k) dst[n][k] = *(const LAS bf16x8*)(lds + PG8_SB(b, h) + boff + n * 2048 + k * 1024); } while (0)
#define PG8_MMA(ai, bj, At, Bt) do { __builtin_amdgcn_s_setprio(1); _Pragma("unroll") for (int m = 0; m < 4; ++m) _Pragma("unroll") for (int n = 0; n < 2; ++n) _Pragma("unroll") for (int k = 0; k < 2; ++k) \
        acc[ai][bj][m][n] = __builtin_amdgcn_mfma_f32_16x16x32_bf16(Bt[n][k], At[m][k], acc[ai][bj][m][n], 0, 0, 0); __builtin_amdgcn_s_setprio(0); } while (0)
#define PG8_WAIT_V(n) asm volatile("s_waitcnt vmcnt(" #n ")" ::: "memory")
#define PG8_WAIT_L(n) asm volatile("s_waitcnt lgkmcnt(" #n ")" ::: "memory")
#define PG8_BAR __builtin_amdgcn_s_barrier()
#define PG8_SCHED __builtin_amdgcn_sched_barrier(0)
#define PG8_K0(u) ((u).seg == 0 ? g.k0_0 : ((u).seg == 1 ? g.k0_1 : g.k0_2))
#define PG8_NT(u) ((u).seg == 0 ? g.nt_0 : ((u).seg == 1 ? g.nt_1 : g.nt_2))
#define PG8_UA(u) ((const char*)g.A + (size_t)(u).pm * tstepA + (size_t)PG8_K0(u) * 2)
#define PG8_UB(u) ((const char*)g.Bt + (size_t)(u).pn * tstepB + (size_t)PG8_K0(u) * 2)
    Unit cur, nxt; int ui = 0;
    if (!S.next(0, cur)) return;
    f32x4 acc[2][2][4][2];
#pragma unroll
    for (int a = 0; a < 2; ++a)
#pragma unroll
        for (int b = 0; b < 2; ++b)
#pragma unroll
            for (int m = 0; m < 4; ++m)
#pragma unroll
                for (int n = 0; n < 2; ++n) acc[a][b][m][n] = (f32x4){0.f, 0.f, 0.f, 0.f};
    bf16x8 At[4][2], B0[2][2], B1[2][2];
    const char* cA = PG8_UA(cur); const char* cB = PG8_UB(cur); int nt = PG8_NT(cur);
    if constexpr (SP2) {
        PG8_STAGE(PG8_SB(0, 0), cB, voffB); PG8_STAGE(PG8_SB(0, 1), cB + hstepB, voffB); PG8_STAGE(PG8_SA(0, 0), cA, voffA); PG8_STAGE(PG8_SA(0, 1), cA + hstepA, voffA);
        if (wr == 1) PG8_BAR;
        PG8_WAIT_V(2); PG8_BAR;
        PG8_STAGE(PG8_SB(1, 0), cB + kstep, voffB); PG8_STAGE(PG8_SA(1, 0), cA + kstep, voffA); PG8_STAGE(PG8_SB(1, 1), cB + hstepB + kstep, voffB);
        PG8_WAIT_V(6); PG8_BAR;
    } else {
        PG8_STAGE(PG8_SB(0, 0), cB, voffB); PG8_STAGE(PG8_SA(0, 0), cA, voffA); PG8_STAGE(PG8_SB(0, 1), cB + hstepB, voffB); PG8_STAGE(PG8_SA(0, 1), cA + hstepA, voffA);
        if (wr == 1) PG8_BAR;
        PG8_WAIT_V(4); PG8_BAR;
        PG8_STAGE(PG8_SB(1, 0), cB + kstep, voffB); PG8_STAGE(PG8_SA(1, 0), cA + kstep, voffA); PG8_STAGE(PG8_SB(1, 1), cB + hstepB + kstep, voffB);
        PG8_WAIT_V(6); PG8_BAR;
    }
    for (;;) {
        const bool has_next = S.next(ui + 1, nxt);
        const char* nA = has_next ? PG8_UA(nxt) : cA; const char* nB = has_next ? PG8_UB(nxt) : cB;
        for (int t = 0; t < nt; t += 2) {
            const bool last = (t == nt - 2);
            const char* a1 = cA + (size_t)(t + 1) * kstep;
            const char* a2 = last ? nA : cA + (size_t)(t + 2) * kstep; const char* b2 = last ? nB : cB + (size_t)(t + 2) * kstep;
            const char* a3 = a2 + kstep; const char* b3 = b2 + kstep;
            if constexpr (SP2) {
            PG8_LDB(B0, 0, 0); PG8_LDB(B1, 0, 1); PG8_SCHED; PG8_LDA(At, 0, 0); PG8_STAGE(PG8_SA(1, 1), a1 + hstepA, voffA);
            PG8_WAIT_V(8); PG8_WAIT_L(0); PG8_BAR; PG8_MMA(0, 0, At, B0); PG8_MMA(0, 1, At, B1); PG8_BAR; PG8_SCHED;
            PG8_LDA(At, 0, 1); PG8_STAGE(PG8_SB(0, 0), b2, voffB); PG8_STAGE(PG8_SB(0, 1), b2 + hstepB, voffB); PG8_STAGE(PG8_SA(0, 0), a2, voffA);
            PG8_WAIT_V(8); PG8_WAIT_L(0); PG8_BAR; PG8_MMA(1, 0, At, B0); PG8_MMA(1, 1, At, B1); PG8_BAR; PG8_SCHED;
            PG8_LDB(B0, 1, 0); PG8_LDB(B1, 1, 1); PG8_SCHED; PG8_LDA(At, 1, 0); PG8_STAGE(PG8_SA(0, 1), a2 + hstepA, voffA);
            PG8_WAIT_V(8); PG8_WAIT_L(0); PG8_BAR; PG8_MMA(0, 0, At, B0); PG8_MMA(0, 1, At, B1); PG8_BAR; PG8_SCHED;
            PG8_LDA(At, 1, 1); PG8_STAGE(PG8_SB(1, 0), b3, voffB); PG8_STAGE(PG8_SB(1, 1), b3 + hstepB, voffB); PG8_STAGE(PG8_SA(1, 0), a3, voffA);
            PG8_WAIT_V(8); PG8_WAIT_L(0); PG8_BAR; PG8_MMA(1, 0, At, B0); PG8_MMA(1, 1, At, B1); PG8_BAR; PG8_SCHED;
            } else {
            PG8_LDB(B0, 0, 0); PG8_SCHED; PG8_LDA(At, 0, 0); PG8_STAGE(PG8_SA(1, 1), a1 + hstepA, voffA);
            PG8_WAIT_L(8); PG8_BAR; PG8_WAIT_L(0); PG8_MMA(0, 0, At, B0); PG8_BAR; PG8_SCHED;
            PG8_LDB(B1, 0, 1); PG8_STAGE(PG8_SB(0, 0), b2, voffB);
            PG8_BAR; PG8_WAIT_L(0); PG8_MMA(0, 1, At, B1); PG8_BAR;
            PG8_LDA(At, 0, 1); PG8_STAGE(PG8_SA(0, 0), a2, voffA);
            PG8_BAR; PG8_WAIT_L(0); PG8_MMA(1, 0, At, B0); PG8_BAR; PG8_SCHED;
            PG8_STAGE(PG8_SB(0, 1), b2 + hstepB, voffB);
            PG8_WAIT_V(6); PG8_BAR; PG8_MMA(1, 1, At, B1); PG8_BAR;
            PG8_LDB(B0, 1, 0); PG8_SCHED; PG8_LDA(At, 1, 0); PG8_STAGE(PG8_SA(0, 1), a2 + hstepA, voffA);
            PG8_WAIT_L(8); PG8_BAR; PG8_WAIT_L(0); PG8_MMA(0, 0, At, B0); PG8_BAR; PG8_SCHED;
            PG8_LDB(B1, 1, 1); PG8_STAGE(PG8_SB(1, 0), b3, voffB);
            PG8_BAR; PG8_WAIT_L(0); PG8_MMA(0, 1, At, B1); PG8_BAR;
            PG8_LDA(At, 1, 1); PG8_STAGE(PG8_SA(1, 0), a3, voffA);
            PG8_BAR; PG8_WAIT_L(0); PG8_MMA(1, 0, At, B0); PG8_BAR; PG8_SCHED;
            PG8_STAGE(PG8_SB(1, 1), b3 + hstepB, voffB);
            PG8_WAIT_V(6); PG8_BAR; PG8_MMA(1, 1, At, B1); PG8_BAR;
            }
        }
        if constexpr (ALIGN_EPI) { if (wr == 0) PG8_BAR; }
        E(acc, cur, wr, wc, fr, fq);
        if (!has_next) break;
#pragma unroll
        for (int a = 0; a < 2; ++a)
#pragma unroll
            for (int b = 0; b < 2; ++b)
#pragma unroll
                for (int m = 0; m < 4; ++m)
#pragma unroll
                    for (int n = 0; n < 2; ++n) acc[a][b][m][n] = (f32x4){0.f, 0.f, 0.f, 0.f};
        cur = nxt; cA = nA; cB = nB; nt = PG8_NT(cur); ++ui;
        if constexpr (ALIGN_EPI) { if (wr == 1) PG8_BAR; }
    }
    PG8_WAIT_V(0);
    if constexpr (!ALIGN_EPI) { if (wr == 0) PG8_BAR; }
    PG8_BAR;
#undef PG8_SA
#undef PG8_SB
#undef PG8_STAGE
#undef PG8_LDA
#undef PG8_LDB
#undef PG8_MMA
#undef PG8_WAIT_V
#undef PG8_WAIT_L
#undef PG8_BAR
#undef PG8_SCHED
#undef PG8_K0
#undef PG8_NT
#undef PG8_UA
#undef PG8_UB
}
}

#define XB_TMO      128
#define XB_XCNT(j)  (256  + 64 * (j))
#define XB_XSUB(j)  (1280 + 64 * (j))
#define XB_XGEN(j)  (2304 + 64 * (j))
#define XB_TOP      3328
#define XB_TOPGEN   3392
#define XCD_BAR_WORDS 3456
#define XB_SPIN_CAP (1u << 18)
__device__ __forceinline__ unsigned xb_ld(unsigned* p)              { return __hip_atomic_load(p, __ATOMIC_RELAXED, __HIP_MEMORY_SCOPE_AGENT); }
__device__ __forceinline__ unsigned xb_add(unsigned* p, unsigned v) { return __hip_atomic_fetch_add(p, v, __ATOMIC_RELAXED, __HIP_MEMORY_SCOPE_AGENT); }
__device__ __forceinline__ unsigned xb_xcc_id() { return (unsigned)__builtin_amdgcn_s_getreg((3 << 11) | 20) & 0xFu; }
#define XB_SPIN(cond, bar) do { unsigned _sp = 0; while (cond) { __builtin_amdgcn_s_sleep(1); \
    if ((++_sp & 255u) == 0u) { if (xb_ld(&(bar)[XB_TMO])) break; if (_sp > XB_SPIN_CAP) { atomicAdd(&(bar)[XB_TMO], 1u); break; } } } } while (0)
struct XcdBarrier { unsigned* bar; unsigned x; volatile LAS unsigned* st; };
__device__ __forceinline__ XcdBarrier xcd_barrier_post(unsigned* bar, volatile LAS unsigned* st) {
    XcdBarrier b; b.bar = bar; b.x = xb_xcc_id(); b.st = st;
    if (threadIdx.x == 0) (void)xb_add(&bar[XB_XCNT(b.x)], 1u);
    return b;
}
__device__ __forceinline__ void xcd_barrier_complete(unsigned* bar, unsigned x, unsigned& nloc, unsigned& nx) {
    const unsigned G = gridDim.x * gridDim.y * gridDim.z;
    unsigned sum, cnt, mine, sp = 0u;
    for (;;) {
        sum = 0u; cnt = 0u; mine = 0u;
#pragma unroll
        for (unsigned j = 0; j < 16; ++j) { const unsigned c = xb_ld(&bar[XB_XCNT(j)]); sum += c; cnt += (c > 0u) ? 1u : 0u; mine = (j == x) ? c : mine; }
        if (sum == G) break;
        __builtin_amdgcn_s_sleep(1);
        if ((++sp & 255u) == 0u) { if (xb_ld(&bar[XB_TMO])) break; if (sp > XB_SPIN_CAP) { atomicAdd(&bar[XB_TMO], 1u); break; } }
    }
    nloc = mine > 0u ? mine : 1u; nx = cnt > 0u ? cnt : 1u;
}
__device__ __forceinline__ void xcd_barrier(const XcdBarrier& b) {
    asm volatile("s_waitcnt vmcnt(0)" ::: "memory");
    __syncthreads();
    if (threadIdx.x == 0) {
        unsigned* bar = b.bar;
        __builtin_amdgcn_s_waitcnt(0);
        unsigned nloc = b.st[0], nx = b.st[1];
        if (nloc == 0u) { xcd_barrier_complete(bar, b.x, nloc, nx); b.st[0] = nloc; b.st[1] = nx; }
        const unsigned old = xb_add(&bar[XB_XSUB(b.x)], 1u);
        const unsigned gen = old / nloc;
        if (old + 1u == (gen + 1u) * nloc) {
            __builtin_amdgcn_fence(__ATOMIC_RELEASE, "agent");
            asm volatile("s_waitcnt vmcnt(0)" ::: "memory");
            const unsigned og = xb_add(&bar[XB_TOP], 1u);
            const unsigned tg = og / nx;
            if (og + 1u == (tg + 1u) * nx) xb_add(&bar[XB_TOPGEN], 1u);
            else XB_SPIN(xb_ld(&bar[XB_TOPGEN]) == tg, bar);
            __builtin_amdgcn_fence(__ATOMIC_ACQUIRE, "agent");
            xb_add(&bar[XB_XGEN(b.x)], 1u);
            asm volatile("s_waitcnt vmcnt(0)" ::: "memory");
        } else {
            XB_SPIN(xb_ld(&bar[XB_XGEN(b.x)]) == gen, bar);
            __builtin_amdgcn_fence(__ATOMIC_ACQUIRE, "agent");
            asm volatile("s_waitcnt vmcnt(0)" ::: "memory");
        }
    }
    __syncthreads();
}

constexpr int NWAVES = 8, NTHREADS = 512, GRID = 256;
constexpr int LDS_BYTES = 147456;
constexpr int MISC_OFF = 131072 + 320;
constexpr int CW_BAR = 4096;

struct Args {
    const float* in[25];
    float* out; unsigned char* ws;
    int ph_lo, ph_hi;
};

struct Frame {
    LAS unsigned char* lds;
    int tid, lane, wave, vcu;
    const float* const* in;
    float* out; unsigned char* ws;
};
enum { I_X = 0, I_C, I_CTX, I_CCTX, I_WADA, I_BADA, I_GNORM, I_WIN, I_GQ, I_GK, I_LQ1, I_LK1, I_LQ2, I_LK2, I_GSUB, I_WF, I_BF, I_LNG, I_LNB, I_WS, I_BS, I_WBRA, I_WBRB, I_WBRC, I_WOUT };

__device__ __forceinline__ void transpose_item(const float* W, int ldw, int k0, int lcol0, bool perm, bf16_t* dst, int ldd, int prow0, int dcol0, LAS float* scr, int lane) {
#pragma unroll 8
    for (int i = 0; i < 32; ++i) { const int kk = 2 * i + (lane >> 5); scr[kk * 33 + (lane & 31)] = W[(size_t)(k0 + kk) * ldw + lcol0 + (lane & 31)]; }
    LDS_WAIT(); asm volatile("" ::: "memory");
    const int c = lane & 7;
#pragma unroll
    for (int j = 0; j < 4; ++j) { const int n = (lane >> 3) + 8 * j; const int jn = perm ? perm32(n) : n; const LAS float* s = scr + (8 * c) * 33 + jn;
        u32x4 o; o.x = pk2(s[0 * 33], s[1 * 33]); o.y = pk2(s[2 * 33], s[3 * 33]); o.z = pk2(s[4 * 33], s[5 * 33]); o.w = pk2(s[6 * 33], s[7 * 33]);
        *(GAS u32x4*)(dst + (size_t)(prow0 + n) * ldd + dcol0 + k0 + 8 * c) = o; }
    LDS_WAIT(); asm volatile("" ::: "memory");
}
__device__ __forceinline__ bool win_block_map(int pb, int& lcol, bool& perm) {
    const int tile = pb >> 3, w = pb & 7, bj = w >> 2, wc = w & 3;
    if (tile < 2) { lcol = OFF_Q + (4 * (tile & 1) + wc) * 64 + 32 * bj; perm = false; return true; }
    if (tile < 4) { lcol = OFF_K + (4 * (tile & 1) + wc) * 64 + 32 * bj; perm = false; return true; }
    perm = true;
    if (tile < 6) { lcol = OFF_V + 256 * (tile - 4) + 32 * w; return true; }
    if (tile < 8) return false;
    if (tile < 10) { lcol = (bj == 0 ? OFF_U : OFF_GATE + 768) + 128 * (tile - 8) + 32 * wc; return true; }
    if (tile == 10) { lcol = OFF_VC + 32 * w; return true; }
    if (tile < 14) { lcol = OFF_GATE + 256 * (tile - 11) + 32 * w; return true; }
    lcol = OFF_MERGE + 256 * (tile - 14) + 32 * w; return true;
}
__device__ __forceinline__ float cos2pi(int a, int n) { return cospif(2.0f * (float)a / (float)n); }
__device__ __forceinline__ float sin2pi(int a, int n) { return sinpif(2.0f * (float)a / (float)n); }

__device__ __forceinline__ void ph0_prologue(const Args& a, LAS unsigned char* lds, int tid, int lane, int wave, int vcu, int pmask) {
    unsigned char* ws = a.ws;
    const int gw = vcu * NWAVES + wave, NGW = GRID * NWAVES;
    const int gt = vcu * NTHREADS + tid, NGT = GRID * NTHREADS;
    if (pmask & 1) {
        LAS float* scr = (LAS float*)(lds + wave * 16384);
        constexpr int I_WIN_N = DEPTH * 208 * 16;
        constexpr int I_BR_N = DEPTH * 32 * 16;
        constexpr int I_OUT_N = DEPTH * 32 * 16;
        for (int it = gw; it < I_WIN_N + I_BR_N + I_OUT_N; it += NGW) {
            int r = it;
            if (r < I_WIN_N) {
                const int l = r / (208 * 16), q = r % (208 * 16), pb = q >> 4, kb = q & 15; int lcol; bool perm;
                if (!win_block_map(pb, lcol, perm)) continue;
                transpose_item(a.in[I_WIN] + (size_t)l * DM * INW, INW, 64 * kb, lcol, perm, (bf16_t*)(ws + WS_WIN) + (size_t)l * NPHYS * DM, DM, 32 * pb, 0, scr, lane);
                continue;
            }
            r -= I_WIN_N;
            if (r < I_BR_N) {
                const int l = r / 512, q = r % 512, pb = q >> 4, kb = q & 15;
                const float* W; int ksrc;
                if (kb < 8) { W = a.in[I_WBRA] + (size_t)l * 512 * DM; ksrc = 64 * kb; } else if (kb < 12) { W = a.in[I_WBRB] + (size_t)l * 256 * DM; ksrc = 64 * (kb - 8); } else { W = a.in[I_WBRC] + (size_t)l * 256 * DM; ksrc = 64 * (kb - 12); }
                transpose_item(W, DM, ksrc, 32 * pb, true, (bf16_t*)(ws + WS_WBR) + (size_t)l * DM * DM, DM, 32 * pb, 64 * kb - ksrc, scr, lane);
                continue;
            }
            r -= I_BR_N;
            { const int l = r / 512, q = r % 512, pb = q >> 4, kb = q & 15;
              transpose_item(a.in[I_WOUT] + (size_t)l * DM * DM, DM, 64 * kb, 32 * pb, false, (bf16_t*)(ws + WS_WOUT) + (size_t)l * DM * DM, DM, 32 * pb, 0, scr, lane); }
        }
    }
    __syncthreads();
    if (pmask & 2) {
        LAS float* Wb = (LAS float*)lds;
        LAS float* TR = Wb + 64 * 65;
        LAS float* Tt = TR + 64 * 128;
        LAS float* Wf = Tt + 64 * 132;
        for (int it = vcu; it < DEPTH * 4 * 16; it += GRID) {
            const int l = it / 64, g = (it >> 4) & 3, kb = it & 15;
            const float* win = a.in[I_WIN] + (size_t)l * DM * INW; const float* wf = a.in[I_WF] + (size_t)(l * 4 + g) * 64 * 64;
            for (int e = tid; e < 4096; e += NTHREADS) { const int r = e >> 6, c = e & 63; Wb[r * 65 + c] = win[(size_t)(64 * kb + r) * INW + OFF_F + 64 * g + c]; Wf[e] = wf[e]; }
            for (int e = tid; e < 64 * 128; e += NTHREADS) { const int c = e >> 7, ri = (e >> 6) & 1, cp = e & 63; const int ph = (c * cp) & 63; TR[e] = ri ? -sin2pi(ph, 64) : cos2pi(ph, 64); }
            __syncthreads();
            const int tk = tid >> 5, tn = tid & 31;
            { f32x4 acc[4];
#pragma unroll
              for (int i = 0; i < 4; ++i) acc[i] = (f32x4){0.f, 0.f, 0.f, 0.f};
#pragma unroll 4
              for (int c = 0; c < 64; ++c) { const f32x4 bv = *(const LAS f32x4*)(TR + c * 128 + 4 * tn);
#pragma unroll
                  for (int i = 0; i < 4; ++i) acc[i] += bv * Wb[(4 * tk + i) * 65 + c]; }
#pragma unroll
              for (int i = 0; i < 4; ++i) *(LAS f32x4*)(Tt + (4 * tk + i) * 132 + 4 * tn) = acc[i]; }
            __syncthreads();
            { const int ri = tn >> 4, td = tn & 15;
              f32x4 acc[4];
#pragma unroll
              for (int i = 0; i < 4; ++i) acc[i] = (f32x4){0.f, 0.f, 0.f, 0.f};
#pragma unroll 4
              for (int cp = 0; cp < 64; ++cp) { const f32x4 bv = *(const LAS f32x4*)(Wf + cp * 64 + 4 * td);
#pragma unroll
                  for (int i = 0; i < 4; ++i) acc[i] += bv * Tt[(4 * tk + i) * 132 + ri * 64 + cp]; }
              bf16_t* dst = (bf16_t*)(ws + WS_WIN) + (size_t)l * NPHYS * DM;
#pragma unroll
              for (int e = 0; e < 4; ++e) { const int ch = 64 * g + 4 * td + e, prow = 6 * 256 + ri * 256 + (ch & ~31) + invperm32(ch & 31);
                  u32x2 w; w.x = pk2(acc[0][e], acc[1][e]); w.y = pk2(acc[2][e], acc[3][e]);
                  *(u32x2*)(dst + (size_t)prow * DM + 64 * kb + 4 * tk) = w; } }
            __syncthreads();
        }
    }
    if (pmask & 4) {
        float* ropec = (float*)(ws + WS_ROPE); float* ropes = ropec + 2048;
        for (int e = gt; e < 2048; e += NGT) { const int pos = e >> 4, f = e & 15; const float freq = powf(10000.0f, -(float)(2 * f) / 32.0f); const float ang = (float)pos * freq; ropec[e] = cosf(ang); ropes[e] = sinf(ang); }
        f32x2* tw = (f32x2*)(ws + WS_TW);
        for (int e = gt; e < 8192; e += NGT) tw[e] = (f32x2){cos2pi(e, 8192), sin2pi(e, 8192)};
        bf16_t* c128 = (bf16_t*)(ws + WS_C128); bf16_t* s128 = (bf16_t*)(ws + WS_S128);
        for (int e = gt; e < 4 * 8 * 64 * 8; e += NGT) { const int j = e & 7, ln = (e >> 3) & 63, s = (e >> 9) & 7, mb = e >> 12; const int row = 32 * mb + (ln & 31), k = 16 * s + 8 * (j >> 2) + 4 * (ln >> 5) + (j & 3);
            const int ph = (row * k) & 127; c128[e] = (bf16_t)f2bf(cos2pi(ph, 128)); s128[e] = (bf16_t)f2bf(sin2pi(ph, 128)); }
        bf16_t* t64 = (bf16_t*)(ws + WS_T64);
        for (int e = gt; e < 2 * 8 * 64 * 8; e += NGT) { const int j = e & 7, ln = (e >> 3) & 63, s = (e >> 9) & 7, mb = e >> 12; const int row = 32 * mb + (ln & 31), k = 16 * s + 8 * (j >> 2) + 4 * (ln >> 5) + (j & 3);
            const int ri = k >> 6, c = k & 63, ph = (row * c) & 63; t64[e] = (bf16_t)f2bf(ri ? sin2pi(ph, 64) : cos2pi(ph, 64)); }
        bf16_t* tc256 = (bf16_t*)(ws + WS_TC256);
        for (int e = gt; e < 8 * 32 * 64 * 8; e += NGT) { const int j = e & 7, ln = (e >> 3) & 63, s = (e >> 9) & 31, mb = e >> 14; const int row = 32 * mb + (ln & 31), k = 16 * s + 8 * (j >> 2) + 4 * (ln >> 5) + (j & 3);
            const int ri = k >> 8, n = k & 255, ph = (row * n) & 255; tc256[e] = (bf16_t)f2bf(ri ? sin2pi(ph, 256) : cos2pi(ph, 256)); }
        bf16_t* wsimg = (bf16_t*)(ws + WS_WSIMG);
        for (int e = gt; e < DEPTH * 4 * 4 * 8 * 64 * 8; e += NGT) { const int j = e & 7, ln = (e >> 3) & 63, s = (e >> 9) & 7, mb = (e >> 12) & 3, lg = e >> 14; const int row = 32 * mb + (ln & 31), k = 16 * s + 8 * (j >> 2) + 4 * (ln >> 5) + (j & 3);
            wsimg[e] = (bf16_t)f2bf(a.in[I_WS][(size_t)lg * 128 * 128 + row * 128 + k]); }
        if (gt < DEPTH) { const int l = gt; float s1 = 0.f, s2 = 0.f;
            for (int i = 0; i < 64; ++i) { s1 += a.in[I_LQ1][l * 64 + i] * a.in[I_LK1][l * 64 + i]; s2 += a.in[I_LQ2][l * 64 + i] * a.in[I_LK2][l * 64 + i]; }
            const float lam_init = 0.8f - 0.6f * expf(-0.3f * (float)l);
            float* lam = (float*)(ws + WS_LAM); lam[2 * l] = expf(s1) - expf(s2) + lam_init; lam[2 * l + 1] = 1.0f - lam_init; }
    }
    if (pmask & 8) {
        float* part = (float*)(ws + WS_MODP);
        for (int it = gw; it < DEPTH * 12 * 32; it += NGW) {
            const int l = it / 384, q = it % 384, cc = q >> 5, kc = q & 31; const int col = 256 * cc + 4 * lane;
            const float* w = a.in[I_WADA] + (size_t)l * DM * 3072 + col;
            f32x4 s0 = {0.f, 0.f, 0.f, 0.f}, s1 = s0, s2 = s0;
#pragma unroll 8
            for (int kk = 0; kk < 32; ++kk) { const int k = 32 * kc + kk; const f32x4 wv = *(const f32x4*)(w + (size_t)k * 3072);
                const float a0 = fast_silu(a.in[I_C][k]), a1 = fast_silu(a.in[I_C][DM + k]), a2 = fast_silu(a.in[I_CCTX][k]);
                s0 += wv * a0; s1 += wv * a1; s2 += wv * a2; }
            float* p = part + ((size_t)(l * 32 + kc) * 3) * 3072 + col;
            *(f32x4*)(p) = s0; *(f32x4*)(p + 3072) = s1; *(f32x4*)(p + 2 * 3072) = s2;
        }
    }
}

__device__ __forceinline__ void prepass(const Args& a, int l, LAS unsigned char* lds, int tid, int lane, int wave, int vcu) {
    unsigned char* ws = a.ws;
    const float* part = (const float*)(ws + WS_MODP); float* modf = (float*)(ws + WS_MODF);
    if (l == 0) {
        if (tid < 72) { const int o = vcu * 72 + tid; const int ll = o / 9216, rj = o % 9216, r = rj / 3072, j = rj % 3072; float s = a.in[I_BADA][ll * 3072 + j];
#pragma unroll 4
            for (int kc = 0; kc < 32; ++kc) s += part[((size_t)(ll * 32 + kc) * 3 + r) * 3072 + j];
            modf[o] = s; }
    }
    const int row0 = vcu * 66, row1 = row0 + 66;
    LAS float* coef = (LAS float*)lds;
    for (int r = 0; r < 3; ++r) {
        const int lo = r == 0 ? 0 : (r == 1 ? SEQ : MLAT), hi = r == 0 ? SEQ : (r == 1 ? MLAT : MT);
        if (row1 <= lo || row0 >= hi) continue;
        for (int k = tid; k < DM; k += NTHREADS) {
            float sh, sc;
            if (l == 0) { sh = a.in[I_BADA][k]; sc = a.in[I_BADA][DM + k];
#pragma unroll 4
                for (int kc = 0; kc < 32; ++kc) { const float* p = part + ((size_t)(kc) * 3 + r) * 3072; sh += p[k]; sc += p[DM + k]; } }
            else { sh = modf[(size_t)(l * 3 + r) * 3072 + k]; sc = modf[(size_t)(l * 3 + r) * 3072 + DM + k]; }
            coef[(r * 2) * DM + k] = a.in[I_GNORM][l * DM + k] * (1.0f + sc); coef[(r * 2 + 1) * DM + k] = sh;
        }
    }
    __syncthreads();
    const float* xlat = l == 0 ? a.in[I_X] : a.out; const float* xctx = l == 0 ? a.in[I_CTX] : (const float*)(ws + WS_CTX1);
    bf16_t* H = (bf16_t*)(ws + WS_H);
    for (int m = row0 + wave; m < row1; m += NWAVES) {
        const int r = m < SEQ ? 0 : (m < MLAT ? 1 : 2);
        const float* xrow = m < MLAT ? xlat + (size_t)m * DM : xctx + (size_t)(m - MLAT) * DM;
        const GAS f32x4* xr = (const GAS f32x4*)xrow + lane;
        f32x4 v[4]; float s2 = 0.f;
#pragma unroll
        for (int j = 0; j < 4; ++j) { v[j] = xr[64 * j]; s2 += (v[j].x * v[j].x + v[j].y * v[j].y) + (v[j].z * v[j].z + v[j].w * v[j].w); }
#pragma unroll
        for (int o = 1; o < 64; o <<= 1) s2 += __shfl_xor(s2, o);
        const float rstd = rsqrtf(s2 * (1.0f / DM) + EPS);
        GAS u32x2* o8 = (GAS u32x2*)(H + (size_t)m * DM) + lane;
#pragma unroll
        for (int j = 0; j < 4; ++j) { const f32x4 ga = *(const LAS f32x4*)(coef + (r * 2) * DM + 256 * j + 4 * lane), sh = *(const LAS f32x4*)(coef + (r * 2 + 1) * DM + 256 * j + 4 * lane);
            const f32x4 h = v[j] * rstd * ga + sh; u32x2 w; w.x = pk2(h.x, h.y); w.y = pk2(h.z, h.w); o8[64 * j] = w; }
    }
    __syncthreads();
}

struct TileSched {
    int x, c, pn0, npn, nseg, nctx, cpn0, cnpn;
    __device__ __forceinline__ bool next(int i, pg8::Unit& u) const {
        const int ti = i / nseg; u.seg = i - ti * nseg;
        const int j = ti * 32 + c;
        if (j < 8 * npn) { u.pm = 8 * x + (j & 7); u.pn = pn0 + (j >> 3); return true; }
        const int id = (j - 8 * npn) * 8 + x;
        if (id < nctx) { u.pm = 64 + (id & 1); u.pn = cpn0 + (id >> 1); return true; }
        return false;
    }
};

struct EpiIn {
    unsigned char* ws; const float* gq; const float* gk; const float* ropec; const float* ropes;
    __device__ __forceinline__ void operator()(const f32x4 (&acc)[2][2][4][2], const pg8::Unit& u, int wr, int wc, int fr, int fq) const {
        const bool ctx = u.pm >= 64; const int b = ctx ? u.pm - 64 : (u.pm >> 5);
        const int rbase = u.pm * 256 + wr * 64 + fr;
        const int pn = u.pn;
        if (pn < 4) {
            const bool isK = pn >= 2; const int gi = 4 * (pn & 1) + wc, h = gi >> 1, comp = gi & 1;
            const float* gsrc = isK ? gk : gq;
            f32x4 gv[2][2];
#pragma unroll
            for (int bj = 0; bj < 2; ++bj)
#pragma unroll
                for (int n = 0; n < 2; ++n) gv[bj][n] = *(const f32x4*)(gsrc + 32 * bj + 16 * n + 4 * fq);
#pragma unroll
            for (int ai = 0; ai < 2; ++ai)
#pragma unroll
                for (int m = 0; m < 4; ++m) {
                    const int row = rbase + ai * 128 + m * 16;
                    f32x4 v[2][2]; float ss = 0.f;
#pragma unroll
                    for (int bj = 0; bj < 2; ++bj)
#pragma unroll
                        for (int n = 0; n < 2; ++n) { v[bj][n] = acc[ai][bj][m][n]; ss += (v[bj][n].x * v[bj][n].x + v[bj][n].y * v[bj][n].y) + (v[bj][n].z * v[bj][n].z + v[bj][n].w * v[bj][n].w); }
                    ss += __shfl_xor(ss, 16); ss += __shfl_xor(ss, 32);
                    const float rstd = rsqrtf(ss * (1.0f / 64.0f) + EPS);
#pragma unroll
                    for (int bj = 0; bj < 2; ++bj)
#pragma unroll
                        for (int n = 0; n < 2; ++n) v[bj][n] = v[bj][n] * rstd * gv[bj][n];
                    int kx;
                    if (!ctx) { const int ntok = row - b * SEQ; kx = ntok;
#pragma unroll
                        for (int bj = 0; bj < 2; ++bj) { const int pos = bj == 0 ? (ntok >> 6) : (ntok & 63);
                            const f32x4 c4 = *(const f32x4*)(ropec + pos * 16 + 4 * fq), s4 = *(const f32x4*)(ropes + pos * 16 + 4 * fq);
                            const f32x4 x1 = v[bj][0], x2 = v[bj][1]; v[bj][0] = x1 * c4 - x2 * s4; v[bj][1] = x2 * c4 + x1 * s4; } }
                    else kx = SEQ + (row - MLAT - b * NCTX);
#pragma unroll
                    for (int bj = 0; bj < 2; ++bj) {
                        f32x4 p0 = v[bj][0], p1 = v[bj][1];
                        if (!isK) { p0 = p0 * QSCALE; p1 = p1 * QSCALE; }
                        u32x4 w; w.x = cvt_pk_bf16(p0.x, p0.y); w.y = cvt_pk_bf16(p0.z, p0.w); w.z = cvt_pk_bf16(p1.x, p1.y); w.w = cvt_pk_bf16(p1.z, p1.w);
                        if (!isK) *(u32x4*)((bf16_t*)(ws + WS_QG) + ((size_t)row * 4 + h) * 128 + comp * 64 + (bj * 4 + fq) * 8) = w;
                        else *(u32x4*)(ws + WS_KIMG + ((size_t)((b * 4 + h) * NKT + (kx >> 6)) * 16 + comp * 8 + bj * 4 + fq) * 1024 + (kx & 63) * 16) = w;
                    }
                }
            return;
        }
#pragma unroll
        for (int ai = 0; ai < 2; ++ai)
#pragma unroll
            for (int m = 0; m < 4; ++m) {
                const int row = rbase + ai * 128 + m * 16;
                if (pn == 8 || pn == 9) {
                    f32x4 p0, p1;
#pragma unroll
                    for (int e = 0; e < 4; ++e) { p0[e] = acc[ai][0][m][0][e] * fast_silu(acc[ai][1][m][0][e]); p1[e] = acc[ai][0][m][1][e] * fast_silu(acc[ai][1][m][1][e]); }
                    u32x4 w; w.x = cvt_pk_bf16(p0.x, p0.y); w.y = cvt_pk_bf16(p0.z, p0.w); w.z = cvt_pk_bf16(p1.x, p1.y); w.w = cvt_pk_bf16(p1.z, p1.w);
                    *(u32x4*)((bf16_t*)(ws + WS_UG) + (size_t)row * 256 + 128 * (pn - 8) + 32 * wc + 8 * fq) = w;
                    continue;
                }
#pragma unroll
                for (int bj = 0; bj < 2; ++bj) {
                    f32x4 p0 = acc[ai][bj][m][0], p1 = acc[ai][bj][m][1];
                    const int lc = 128 * bj + 32 * wc + 8 * fq;
                    unsigned char* dst;
                    if (pn < 6) { const int kx = ctx ? SEQ + (row - MLAT - b * NCTX) : row - b * SEQ; const int h = 2 * (pn - 4) + bj;
                        dst = ws + WS_VIMG + ((size_t)((b * 4 + h) * NKT + (kx >> 6)) * 16 + wc * 4 + ((kx & 63) >> 4)) * 1024 + (kx & 15) * 64 + fq * 16; }
                    else if (pn < 8) dst = ws + WS_Z2 + ((size_t)row * 512 + 256 * (pn - 6) + lc) * 2;
                    else if (pn == 10) dst = ws + WS_VC + ((size_t)row * 256 + lc) * 2;
                    else if (pn < 14) {
#pragma unroll
                        for (int e = 0; e < 4; ++e) { p0[e] = fast_silu(p0[e]); p1[e] = fast_silu(p1[e]); }
                        dst = ws + WS_GS + ((size_t)row * 768 + 256 * (pn - 11) + lc) * 2; }
                    else {
#pragma unroll
                        for (int e = 0; e < 4; ++e) { p0[e] = fast_sigmoid(p0[e]); p1[e] = fast_sigmoid(p1[e]); }
                        dst = ctx ? ws + WS_MSC + ((size_t)(row - MLAT) * 3072 + 256 * (pn - 14) + lc) * 2 : ws + WS_MS + ((size_t)row * 3072 + 256 * (pn - 14) + lc) * 2; }
                    u32x4 w; w.x = cvt_pk_bf16(p0.x, p0.y); w.y = cvt_pk_bf16(p0.z, p0.w); w.z = cvt_pk_bf16(p1.x, p1.y); w.w = cvt_pk_bf16(p1.z, p1.w);
                    *(u32x4*)dst = w;
                }
            }
    }
};

struct EpiY {
    const bf16_t* MS; bf16_t* Y;
    __device__ __forceinline__ void operator()(const f32x4 (&acc)[2][2][4][2], const pg8::Unit& u, int wr, int wc, int fr, int fq) const {
        const int rbase = u.pm * 256 + wr * 64 + fr;
#pragma unroll
        for (int ai = 0; ai < 2; ++ai)
#pragma unroll
            for (int m = 0; m < 4; ++m) {
                const int row = rbase + ai * 128 + m * 16;
#pragma unroll
                for (int bj = 0; bj < 2; ++bj) {
                    const int col = 256 * u.pn + 128 * bj + 32 * wc + 8 * fq;
                    const u32x4 mg = *(const u32x4*)(MS + (size_t)row * 3072 + u.seg * 1024 + col);
                    f32x4 p0 = acc[ai][bj][m][0], p1 = acc[ai][bj][m][1];
                    p0.x *= bflo(mg.x); p0.y *= bfhi(mg.x); p0.z *= bflo(mg.y); p0.w *= bfhi(mg.y); p1.x *= bflo(mg.z); p1.y *= bfhi(mg.z); p1.z *= bflo(mg.w); p1.w *= bfhi(mg.w);
                    bf16_t* yp = Y + (size_t)row * DM + col;
                    if (u.seg != 0) { const u32x4 yo = *(const u32x4*)yp;
                        p0.x += bflo(yo.x); p0.y += bfhi(yo.x); p0.z += bflo(yo.y); p0.w += bfhi(yo.y); p1.x += bflo(yo.z); p1.y += bfhi(yo.z); p1.z += bflo(yo.w); p1.w += bfhi(yo.w); }
                    u32x4 w; w.x = cvt_pk_bf16(p0.x, p0.y); w.y = cvt_pk_bf16(p0.z, p0.w); w.z = cvt_pk_bf16(p1.x, p1.y); w.w = cvt_pk_bf16(p1.z, p1.w);
                    *(u32x4*)yp = w;
                }
            }
    }
};

struct EpiOut {
    const float* xlat; float* olat; const float* xctx; float* octx; const float* gate;
    __device__ __forceinline__ void operator()(const f32x4 (&acc)[2][2][4][2], const pg8::Unit& u, int wr, int wc, int fr, int fq) const {
        const bool ctx = u.pm >= 64; const int r = ctx ? 2 : (u.pm >> 5);
        const int rbase = u.pm * 256 + wr * 64 + fr;
        const float* src = ctx ? xctx - (size_t)MLAT * DM : xlat; float* dst = ctx ? octx - (size_t)MLAT * DM : olat;
#pragma unroll
        for (int bj = 0; bj < 2; ++bj)
#pragma unroll
            for (int n = 0; n < 2; ++n) {
                const int col = 256 * u.pn + 128 * bj + 32 * wc + 16 * n + 4 * fq;
                const f32x4 gv = *(const f32x4*)(gate + (size_t)r * 3072 + col);
#pragma unroll
                for (int ai = 0; ai < 2; ++ai)
#pragma unroll
                    for (int m = 0; m < 4; ++m) { const size_t off = (size_t)(rbase + ai * 128 + m * 16) * DM + col;
                        const f32x4 xo = *(const f32x4*)(src + off); *(f32x4*)(dst + off) = xo + gv * acc[ai][bj][m][n]; }
            }
    }
};


__device__ __forceinline__ f32x4 mini_block(const bf16_t* A, int lda, const bf16_t* Bt, int ldb, int m0, int n0, int k0, int nk, int fr, int fq, f32x4 acc) {
    const bf16_t* ap = A + (size_t)(m0 + fr) * lda + k0 + 8 * fq; const bf16_t* bp = Bt + (size_t)(n0 + fr) * ldb + k0 + 8 * fq;
#pragma unroll 8
    for (int s = 0; s < nk; s += 32) acc = __builtin_amdgcn_mfma_f32_16x16x32_bf16(*(const bf16x8*)(bp + s), *(const bf16x8*)(ap + s), acc, 0, 0, 0);
    return acc;
}
__device__ __forceinline__ int mini_lcol(int n0, int fq) { return (n0 & ~31) + 8 * fq + 4 * ((n0 >> 4) & 1); }
__device__ __forceinline__ void ctx_merge_gates(unsigned char* ws, const bf16_t* Wl, int gw, int lane) {
    const int fr = lane & 15, fq = lane >> 4; const bf16_t* H = (const bf16_t*)(ws + WS_H); bf16_t* MS = (bf16_t*)(ws + WS_MS);
    for (int blk = gw; blk < 32 * 192; blk += GRID * NWAVES) { const int m0 = MLAT + 16 * (blk & 31), n0 = 16 * (blk >> 5);
        const f32x4 acc = mini_block(H, DM, Wl + (size_t)(14 * 256) * DM, DM, m0, n0, 0, DM, fr, fq, (f32x4){0.f, 0.f, 0.f, 0.f});
        u32x2 w; w.x = cvt_pk_bf16(fast_sigmoid(acc[0]), fast_sigmoid(acc[1])); w.y = cvt_pk_bf16(fast_sigmoid(acc[2]), fast_sigmoid(acc[3]));
        *(u32x2*)(MS + (size_t)(m0 + fr) * 3072 + mini_lcol(n0, fq)) = w; }
}
__device__ __forceinline__ void ctx_branch_proj(unsigned char* ws, const bf16_t* Wbr, int gw, int lane) {
    const int fr = lane & 15, fq = lane >> 4; const bf16_t* A = (const bf16_t*)(ws + WS_A); const bf16_t* MS = (const bf16_t*)(ws + WS_MSC) - (size_t)MLAT * 3072; bf16_t* Y = (bf16_t*)(ws + WS_H);
    for (int blk = gw; blk < 32 * 64; blk += GRID * NWAVES) { const int m0 = MLAT + 16 * (blk & 31), n0 = 16 * (blk >> 5); const int lc = mini_lcol(n0, fq);
        f32x4 y = {0.f, 0.f, 0.f, 0.f};
#pragma unroll
        for (int seg = 0; seg < 3; ++seg) { const int k0 = seg == 0 ? 0 : (seg == 1 ? 512 : 768), nk = seg == 0 ? 512 : 256;
            const f32x4 acc = mini_block(A, DM, Wbr, DM, m0, n0, k0, nk, fr, fq, (f32x4){0.f, 0.f, 0.f, 0.f});
            const u32x2 mg = *(const u32x2*)(MS + (size_t)(m0 + fr) * 3072 + seg * 1024 + lc);
            y[0] += acc[0] * bflo(mg.x); y[1] += acc[1] * bfhi(mg.x); y[2] += acc[2] * bflo(mg.y); y[3] += acc[3] * bfhi(mg.y); }
        u32x2 w; w.x = cvt_pk_bf16(y[0], y[1]); w.y = cvt_pk_bf16(y[2], y[3]);
        *(u32x2*)(Y + (size_t)(m0 + fr) * DM + lc) = w; }
}
__device__ __forceinline__ void ctx_out_proj(unsigned char* ws, const bf16_t* Wout, const float* ctx_in, const float* gate_ctx, int gw, int lane) {
    const int fr = lane & 15, fq = lane >> 4; const bf16_t* Y = (const bf16_t*)(ws + WS_H); float* C1 = (float*)(ws + WS_CTX1);
    for (int blk = gw; blk < 32 * 64; blk += GRID * NWAVES) { const int m0 = MLAT + 16 * (blk & 31), n0 = 16 * (blk >> 5);
        const f32x4 acc = mini_block(Y, DM, Wout, DM, m0, n0, 0, DM, fr, fq, (f32x4){0.f, 0.f, 0.f, 0.f});
        const size_t off = (size_t)(m0 - MLAT + fr) * DM + n0 + 4 * fq;
        const f32x4 g = *(const f32x4*)(gate_ctx + n0 + 4 * fq), x = *(const f32x4*)(ctx_in + off);
        *(f32x4*)(C1 + off) = x + g * acc; }
}

typedef short v4i16_t __attribute__((ext_vector_type(4)));
__device__ __forceinline__ s16x4 vtr(LAS const unsigned char* p) { return __builtin_bit_cast(s16x4, __builtin_amdgcn_ds_read_tr16_b64_v4i16((LAS v4i16_t*)p)); }
__device__ __forceinline__ int tr_lane_off(int lane) { return ((lane >> 4) & 1) * 32 + (lane & 3) * 8 + (4 * (lane >> 5) + ((lane & 15) >> 2)) * 64; }
__device__ __forceinline__ bf16x8 bfrag(LAS const unsigned char* piece_plus_laneoff) {
    const s16x4 lo = vtr(piece_plus_laneoff), hi = vtr(piece_plus_laneoff + 512);
    return (bf16x8){lo[0], lo[1], lo[2], lo[3], hi[0], hi[1], hi[2], hi[3]};
}
template <class RP> __device__ __forceinline__ void stage_pieces(LAS unsigned char* dst, int nrows, int ncols, RP rp, int tid) {
    const int cpr = ncols >> 3, total = nrows * cpr, pcs = ncols >> 5;
    for (int c = tid; c < total; c += NTHREADS) { const int row = c / cpr, cc = c - row * cpr;
        const u32x4 v = *(const u32x4*)(rp(row) + cc * 8);
        *(LAS u32x4*)(dst + ((row >> 4) * pcs + (cc >> 2)) * 1024 + (row & 15) * 64 + (cc & 3) * 16) = v; }
}
#define MFMA32(a, b, c) __builtin_amdgcn_mfma_f32_32x32x16_bf16(a, b, c, 0, 0, 0)
__device__ __forceinline__ bf16x8 afrag_img(const bf16_t* img, int KS, int mb, int s, int lane) { return *(const bf16x8*)(img + ((size_t)(mb * KS + s) * 64 + lane) * 8); }

__device__ __forceinline__ void f1_unit(unsigned char* ws, LAS unsigned char* lds, int unit, int tid, int lane, int wave) {
    const int b = unit >> 7, c = (unit >> 1) & 63, chh = unit & 1;
    bf16_t* Z2 = (bf16_t*)(ws + WS_Z2);
    const bf16_t* base = Z2 + ((size_t)(b * SEQ + c)) * 512 + chh * 128;
    stage_pieces(lds, 128, 128, [&](int r) { return base + (size_t)r * 64 * 512; }, tid);
    stage_pieces(lds + 32768, 128, 128, [&](int r) { return base + (size_t)r * 64 * 512 + 256; }, tid);
    __syncthreads();
    const int mb = wave & 3, cbp = wave >> 2, hi = lane >> 5, r32 = lane & 31, lo = tr_lane_off(lane);
    const bf16_t* c128 = (const bf16_t*)(ws + WS_C128); const bf16_t* s128 = (const bf16_t*)(ws + WS_S128);
    f32x16 outr[2], t1[2], t2[2];
#pragma unroll
    for (int e = 0; e < 2; ++e) { outr[e] = f32x16{}; t1[e] = f32x16{}; t2[e] = f32x16{}; }
#pragma unroll 1
    for (int s = 0; s < 8; ++s) {
        const bf16x8 cf = afrag_img(c128, 8, mb, s, lane), sf = afrag_img(s128, 8, mb, s, lane);
#pragma unroll
        for (int e = 0; e < 2; ++e) {
            const bf16x8 xr = bfrag(lds + (s * 4 + 2 * cbp + e) * 1024 + lo), xi = bfrag(lds + 32768 + (s * 4 + 2 * cbp + e) * 1024 + lo);
            outr[e] = MFMA32(cf, xr, outr[e]); outr[e] = MFMA32(sf, xi, outr[e]); t1[e] = MFMA32(cf, xi, t1[e]); t2[e] = MFMA32(sf, xr, t2[e]);
        }
    }
    const f32x2* tw = (const f32x2*)(ws + WS_TW);
#pragma unroll
    for (int e = 0; e < 2; ++e)
#pragma unroll
        for (int r = 0; r < 16; ++r) {
            const int k1 = 32 * mb + crow(r, hi), ch = chh * 128 + 32 * (2 * cbp + e) + r32;
            const float yr = outr[e][r], yi = t1[e][r] - t2[e][r];
            const f32x2 t = tw[(c * k1) & 8191];
            bf16_t* o = Z2 + ((size_t)(b * SEQ + 64 * k1 + c)) * 512 + ch;
            o[0] = (bf16_t)f2bf(yr * t.x + yi * t.y); o[256] = (bf16_t)f2bf(yi * t.x - yr * t.y);
            if ((r & 3) == 3) __builtin_amdgcn_sched_barrier(0);
        }
    __syncthreads();
}

__device__ __forceinline__ void sgu_unit(const Args& a, int l, LAS unsigned char* lds, int cu, int tid, int lane, int wave) {
    unsigned char* ws = a.ws;
    const int row0 = cu < 128 ? cu * 128 : MLAT + (cu - 128) * 128;
    const bf16_t* VC = (const bf16_t*)(ws + WS_VC);
    {
        const int tok = tid >> 2, qt = tid & 3;
        const u32x4* src = (const u32x4*)(VC + (size_t)(row0 + tok) * 256 + qt * 64);
        u32x4 raw[8]; float s = 0.f;
#pragma unroll
        for (int i = 0; i < 8; ++i) { raw[i] = src[i]; s += (bflo(raw[i].x) + bfhi(raw[i].x)) + (bflo(raw[i].y) + bfhi(raw[i].y)) + (bflo(raw[i].z) + bfhi(raw[i].z)) + (bflo(raw[i].w) + bfhi(raw[i].w)); }
        s += __shfl_xor(s, 1); s += __shfl_xor(s, 2);
        const float mu = s * (1.0f / 256.0f); float q = 0.f;
#pragma unroll
        for (int i = 0; i < 8; ++i) {
#pragma unroll
            for (int e = 0; e < 4; ++e) { const float d0 = bflo(raw[i][e]) - mu, d1 = bfhi(raw[i][e]) - mu; q += d0 * d0 + d1 * d1; } }
        q += __shfl_xor(q, 1); q += __shfl_xor(q, 2);
        const float rstd = rsqrtf(q * (1.0f / 256.0f) + EPS);
        const float* lg = a.in[I_LNG] + l * 256 + qt * 64; const float* lb = a.in[I_LNB] + l * 256 + qt * 64;
#pragma unroll
        for (int i = 0; i < 8; ++i) { u32x4 w;
#pragma unroll
            for (int e = 0; e < 4; ++e) { const int ch = 8 * i + 2 * e; w[e] = pk2((bflo(raw[i][e]) - mu) * rstd * lg[ch] + lb[ch], (bfhi(raw[i][e]) - mu) * rstd * lg[ch + 1] + lb[ch + 1]); }
            const int cc = qt * 8 + i;
            *(LAS u32x4*)(lds + ((tok >> 4) * 8 + (cc >> 2)) * 1024 + (tok & 15) * 64 + (cc & 3) * 16) = w; __builtin_amdgcn_sched_barrier(0); }
    }
    __syncthreads();
    const int g = wave >> 1, ph = wave & 1, hi = lane >> 5, r32 = lane & 31, lo = tr_lane_off(lane);
    const bf16_t* img = (const bf16_t*)(ws + WS_WSIMG) + (size_t)(l * 4 + g) * 16384;
    f32x16 acc[2][2];
#pragma unroll
    for (int i = 0; i < 2; ++i) { acc[i][0] = f32x16{}; acc[i][1] = f32x16{}; }
#pragma unroll 1
    for (int s = 0; s < 8; ++s) {
        const bf16x8 a0 = afrag_img(img, 8, 2 * ph, s, lane), a1 = afrag_img(img, 8, 2 * ph + 1, s, lane);
        const bf16x8 b0 = bfrag(lds + (s * 8 + 2 * g) * 1024 + lo), b1 = bfrag(lds + (s * 8 + 2 * g + 1) * 1024 + lo);
        acc[0][0] = MFMA32(a0, b0, acc[0][0]); acc[0][1] = MFMA32(a0, b1, acc[0][1]); acc[1][0] = MFMA32(a1, b0, acc[1][0]); acc[1][1] = MFMA32(a1, b1, acc[1][1]);
    }
    const bf16_t* UG = (const bf16_t*)(ws + WS_UG); bf16_t* A = (bf16_t*)(ws + WS_A);
    const float* bs = a.in[I_BS] + (size_t)(l * 4 + g) * 128;
#pragma unroll
    for (int i = 0; i < 2; ++i)
#pragma unroll
        for (int e = 0; e < 2; ++e)
#pragma unroll
            for (int r = 0; r < 16; ++r) { const int p = 32 * (2 * ph + i) + crow(r, hi), ch = 64 * g + 32 * e + r32;
                const float sv = acc[i][e][r] + bs[p]; const float ug = bf2f(UG[(size_t)(row0 + p) * 256 + ch]);
                A[(size_t)(row0 + p) * DM + 768 + ch] = (bf16_t)f2bf(ug * sv); if ((r & 3) == 3) __builtin_amdgcn_sched_barrier(0); }
    __syncthreads();
}

__device__ __forceinline__ void ctxf_unit(const Args& a, int l, LAS unsigned char* lds, int unit, int tid, int lane, int wave) {
    unsigned char* ws = a.ws;
    const int b = unit >> 2, chq = unit & 3;
    const bf16_t* Z2 = (const bf16_t*)(ws + WS_Z2);
    stage_pieces(lds, 512, 64, [&](int k) { return Z2 + (size_t)(MLAT + b * NCTX + (k & 255)) * 512 + (k >> 8) * 256 + chq * 64; }, tid);
    __syncthreads();
    const int mb = wave, hi = lane >> 5, r32 = lane & 31, lo = tr_lane_off(lane);
    const bf16_t* img = (const bf16_t*)(ws + WS_TC256);
    f32x16 acc[2]; acc[0] = f32x16{}; acc[1] = f32x16{};
#pragma unroll 4
    for (int s = 0; s < 32; ++s) { const bf16x8 af = afrag_img(img, 32, mb, s, lane);
        acc[0] = MFMA32(af, bfrag(lds + (s * 2) * 1024 + lo), acc[0]); acc[1] = MFMA32(af, bfrag(lds + (s * 2 + 1) * 1024 + lo), acc[1]); }
    const bf16_t* GS = (const bf16_t*)(ws + WS_GS); bf16_t* A = (bf16_t*)(ws + WS_A);
#pragma unroll
    for (int e = 0; e < 2; ++e)
#pragma unroll
        for (int r = 0; r < 16; ++r) { const int np = 32 * mb + crow(r, hi), ch = 64 * chq + 32 * e + r32; const size_t row = MLAT + b * NCTX + np;
            const float v = acc[e][r] * (1.0f / 128.0f) + a.in[I_BF][l * 256 + ch];
            A[row * DM + 512 + ch] = (bf16_t)f2bf(v * bf2f(GS[row * 768 + 512 + ch])); if ((r & 3) == 3) __builtin_amdgcn_sched_barrier(0); }
    __syncthreads();
}

__device__ __forceinline__ void f2_unit(const Args& a, int l, LAS unsigned char* lds, int unit, int tid, int lane, int wave) {
    unsigned char* ws = a.ws;
    const int b = unit >> 7, k1 = unit & 127;
    const bf16_t* Z2 = (const bf16_t*)(ws + WS_Z2);
    stage_pieces(lds, 128, 256, [&](int k) { return Z2 + (size_t)(b * SEQ + 64 * k1 + (k & 63)) * 512 + (k >> 6) * 256; }, tid);
    __syncthreads();
    const int cb = wave, hi = lane >> 5, r32 = lane & 31, lo = tr_lane_off(lane);
    const bf16_t* img = (const bf16_t*)(ws + WS_T64);
    f32x16 acc[2]; acc[0] = f32x16{}; acc[1] = f32x16{};
#pragma unroll 4
    for (int s = 0; s < 8; ++s) { const bf16x8 bf = bfrag(lds + (s * 8 + cb) * 1024 + lo);
        acc[0] = MFMA32(afrag_img(img, 8, 0, s, lane), bf, acc[0]); acc[1] = MFMA32(afrag_img(img, 8, 1, s, lane), bf, acc[1]); }
    const bf16_t* GS = (const bf16_t*)(ws + WS_GS); bf16_t* A = (bf16_t*)(ws + WS_A);
    const float nrm = 0.0013810679320049757f;
#pragma unroll
    for (int mb = 0; mb < 2; ++mb)
#pragma unroll
        for (int r = 0; r < 16; ++r) { const int k2 = 32 * mb + crow(r, hi), ch = 32 * cb + r32; const size_t row = (size_t)b * SEQ + k1 + 128 * k2;
            const float v = acc[mb][r] * nrm + a.in[I_BF][l * 256 + ch];
            A[row * DM + 512 + ch] = (bf16_t)f2bf(v * bf2f(GS[row * 768 + 512 + ch])); if ((r & 3) == 3) __builtin_amdgcn_sched_barrier(0); }
    __syncthreads();
}

__device__ __forceinline__ void glds16(const void* gsrc, unsigned lds_dst) { unsigned keep;
    asm volatile("s_mov_b32 %0, m0\n\ts_mov_b32 m0, %2\n\ts_nop 0\n\tglobal_load_lds_dwordx4 %1, off\n\ts_mov_b32 m0, %0" : "=&s"(keep) : "v"(gsrc), "s"(lds_dst) : "memory"); }
__device__ __forceinline__ void attn_unit(const Args& a, int l, LAS unsigned char* lds, int b, int h, int qrow0, int t0, int nt, int tid, int lane, int wave, bool dry) {
    unsigned char* ws = a.ws;
    const int comp = wave >> 2, qg = wave & 3, hi = lane >> 5, r32 = lane & 31;
    const bf16_t* Qg = (const bf16_t*)(ws + WS_QG);
    const unsigned char* kimg = ws + WS_KIMG + (size_t)(b * 4 + h) * NKT * 16384;
    const unsigned char* vimg = ws + WS_VIMG + (size_t)(b * 4 + h) * NKT * 16384;
    bf16x8 qr[4];
    { const bf16_t* qp = Qg + ((size_t)(qrow0 + 32 * qg + r32) * 4 + h) * 128 + comp * 64 + 8 * hi;
#pragma unroll
      for (int d0 = 0; d0 < 4; ++d0) qr[d0] = *(const bf16x8*)(qp + 16 * d0); }
    asm volatile("" : "+v"(qr[0]), "+v"(qr[1]), "+v"(qr[2]), "+v"(qr[3]));
    f32x16 o[4];
#pragma unroll
    for (int d = 0; d < 4; ++d) o[d] = f32x16{};
    float lsum = 0.f;
    const int lo = tr_lane_off(lane);
    const unsigned lds0 = (unsigned)(uintptr_t)lds;
    constexpr int KSL = 16384, VBASE = 3 * KSL;
#define ATT_DMA_K(t, slotb) do { const unsigned char* s_ = kimg + (size_t)(t) * 16384 + wave * 2048 + lane * 16; const unsigned d_ = (unsigned)__builtin_amdgcn_readfirstlane((int)(lds0 + (slotb) + wave * 2048)); \
        glds16(s_, d_); glds16(s_ + 1024, d_ + 1024); } while (0)
#define ATT_DMA_V(t, slotb) do { const unsigned char* s_ = vimg + (size_t)(t) * 16384 + wave * 2048 + lane * 16; const unsigned d_ = (unsigned)__builtin_amdgcn_readfirstlane((int)(lds0 + VBASE + (slotb) + wave * 2048)); \
        glds16(s_, d_); glds16(s_ + 1024, d_ + 1024); } while (0)
#define ATT_WAIT_BAR(N) asm volatile("s_waitcnt vmcnt(" #N ") lgkmcnt(0)\n\ts_barrier" ::: "memory")
#define SBAR() __builtin_amdgcn_sched_barrier(0)
#define PIN(x) asm volatile("" : "+v"(x))
    LAS const unsigned char* kp0 = lds + comp * 8192 + hi * 1024 + r32 * 16;
    LAS const unsigned char* vp0 = lds + VBASE + lo;
    bf16x8 kf[8];
#define KRD(j, slotb) do { kf[j] = *(const LAS bf16x8*)(kp0 + (slotb) + ((j) >> 1) * 2048 + ((j) & 1) * 512); } while (0)
    f32x16 pA0 = f32x16{}, pA1 = f32x16{}, pB0, pB1;
    u32x4 pw0, pw1, pw2, pw3;
    bf16x8 vA[8], vB[8];
    int sl_prev = 0, sl_cur = 0, sl_next = KSL;
#define ROT() do { sl_prev = sl_cur; sl_cur = sl_next; sl_next = (sl_next == 2 * KSL) ? 0 : sl_next + KSL; } while (0)
    ATT_DMA_K(t0, 0); ATT_DMA_V(t0, 0); ATT_DMA_K(t0 + 1, KSL); ATT_DMA_K(t0 + 2, 2 * KSL);
    ATT_WAIT_BAR(0);
#pragma unroll
    for (int j = 0; j < 8; ++j) KRD(j, 0);
    ATT_WAIT_BAR(0);
#define PKW(P, B) cvt_pk_bf16(P[B], P[B + 1])
#define EX(v) __builtin_amdgcn_exp2f(v)
#define GAPA(i, C, CIN, a0, a1, a2, a3, W0, W1, PWV) do { vA[i] = bfrag(vpp_ + (i) * 1024); SBAR(); \
        C = MFMA32(kf[i], qr[(i) >> 1], CIN); sacc += a0; sacc += a1; sacc += a2; sacc += a3; PIN(sacc); W0; W1; PIN(PWV); SBAR(); } while (0)
#define GAPB_V(j, d, PWV, X, B) do { o[d] = MFMA32(__builtin_bit_cast(bf16x8, PWV), vA[j], o[d]); X[B] = EX(X[B]); X[B + 1] = EX(X[B + 1]); PIN(X); vB[j] = bfrag(vpp_ + (8 + (j)) * 1024); SBAR(); } while (0)
#define GAPB_K(j, d, PWV, X, B) do { o[d] = MFMA32(__builtin_bit_cast(bf16x8, PWV), vB[(j) - 8], o[d]); X[B] = EX(X[B]); X[B + 1] = EX(X[B + 1]); PIN(X); KRD((j) - 8, sl_next); SBAR(); } while (0)
    const f32x16 zero16 = f32x16{};
#define STEP(C0, C1, P0, P1, t) do { SBAR(); \
        LAS const unsigned char* vpp_ = vp0 + sl_prev; float sacc = 0.f; \
        GAPA(0, C0, zero16, P0[0], P0[1], P0[2], P0[3],     pw0[0] = PKW(P0, 0),  pw0[1] = PKW(P0, 2),  pw0); \
        GAPA(1, C1, zero16, P0[4], P0[5], P0[6], P0[7],     pw0[2] = PKW(P0, 4),  pw0[3] = PKW(P0, 6),  pw0); \
        GAPA(2, C0, C0,     P0[8], P0[9], P0[10], P0[11],   pw1[0] = PKW(P0, 8),  pw1[1] = PKW(P0, 10), pw1); \
        GAPA(3, C1, C1,     P0[12], P0[13], P0[14], P0[15], pw1[2] = PKW(P0, 12), pw1[3] = PKW(P0, 14), pw1); \
        GAPA(4, C0, C0,     P1[0], P1[1], P1[2], P1[3],     pw2[0] = PKW(P1, 0),  pw2[1] = PKW(P1, 2),  pw2); \
        GAPA(5, C1, C1,     P1[4], P1[5], P1[6], P1[7],     pw2[2] = PKW(P1, 4),  pw2[3] = PKW(P1, 6),  pw2); \
        GAPA(6, C0, C0,     P1[8], P1[9], P1[10], P1[11],   pw3[0] = PKW(P1, 8),  pw3[1] = PKW(P1, 10), pw3); \
        GAPA(7, C1, C1,     P1[12], P1[13], P1[14], P1[15], pw3[2] = PKW(P1, 12), pw3[3] = PKW(P1, 14), pw3); \
        lsum += sacc; \
        if ((t) + 3 < nt) ATT_DMA_K(t0 + (t) + 3, sl_cur); \
        if ((t) + 1 < nt) ATT_DMA_V(t0 + (t) + 1, sl_next); \
        SBAR(); \
        GAPB_V(0, 0, pw0, C0, 0);  GAPB_V(1, 0, pw1, C0, 2);  GAPB_V(2, 0, pw2, C0, 4);  GAPB_V(3, 0, pw3, C0, 6); \
        GAPB_V(4, 1, pw0, C0, 8);  GAPB_V(5, 1, pw1, C0, 10); GAPB_V(6, 1, pw2, C0, 12); GAPB_V(7, 1, pw3, C0, 14); \
        GAPB_K(8, 2, pw0, C1, 0);  GAPB_K(9, 2, pw1, C1, 2);  GAPB_K(10, 2, pw2, C1, 4); GAPB_K(11, 2, pw3, C1, 6); \
        GAPB_K(12, 3, pw0, C1, 8); GAPB_K(13, 3, pw1, C1, 10); GAPB_K(14, 3, pw2, C1, 12); GAPB_K(15, 3, pw3, C1, 14); \
        if ((t) + 3 < nt) ATT_WAIT_BAR(4); else ATT_WAIT_BAR(0); \
        ROT(); } while (0)
#pragma unroll 1
    for (int t = 0; t < nt; t += 2) {
        STEP(pB0, pB1, pA0, pA1, t);
        STEP(pA0, pA1, pB0, pB1, t + 1);
    }
    {
        float sacc = 0.f;
#pragma unroll
        for (int r = 0; r < 16; ++r) sacc += pA0[r] + pA1[r];
        lsum += sacc;
        pw0 = (u32x4){PKW(pA0, 0), PKW(pA0, 2), PKW(pA0, 4), PKW(pA0, 6)}; pw1 = (u32x4){PKW(pA0, 8), PKW(pA0, 10), PKW(pA0, 12), PKW(pA0, 14)};
        pw2 = (u32x4){PKW(pA1, 0), PKW(pA1, 2), PKW(pA1, 4), PKW(pA1, 6)}; pw3 = (u32x4){PKW(pA1, 8), PKW(pA1, 10), PKW(pA1, 12), PKW(pA1, 14)};
        LAS const unsigned char* vpp_ = vp0 + sl_prev;
#pragma unroll
        for (int d = 0; d < 4; ++d) {
            const bf16x8 f0 = bfrag(vpp_ + (d * 4 + 0) * 1024), f1 = bfrag(vpp_ + (d * 4 + 1) * 1024), f2 = bfrag(vpp_ + (d * 4 + 2) * 1024), f3 = bfrag(vpp_ + (d * 4 + 3) * 1024);
            o[d] = MFMA32(__builtin_bit_cast(bf16x8, pw0), f0, o[d]); o[d] = MFMA32(__builtin_bit_cast(bf16x8, pw1), f1, o[d]);
            o[d] = MFMA32(__builtin_bit_cast(bf16x8, pw2), f2, o[d]); o[d] = MFMA32(__builtin_bit_cast(bf16x8, pw3), f3, o[d]);
        }
    }
    ATT_WAIT_BAR(0);
#undef ATT_DMA_K
#undef ATT_DMA_V
#undef ATT_WAIT_BAR
#undef SBAR
#undef PIN
#undef KRD
#undef ROT
#undef PKW
#undef EX
#undef GAPA
#undef GAPB_V
#undef GAPB_K
#undef STEP
    if (dry) return;
    LAS float* ost = (LAS float*)lds;
    LAS float* lw = (LAS float*)(lds + 72 * 1024);
    lsum += __shfl_xor(lsum, 32);
    if (hi == 0) lw[wave * 32 + r32] = lsum;
    LDS_WAIT(); asm volatile("" ::: "memory");
    const float* lamp = (const float*)(ws + WS_LAM) + 2 * l;
    const float lam = lamp[0], oscale = lamp[1];
    float rl[16];
#pragma unroll
    for (int r = 0; r < 16; ++r) rl[r] = __builtin_amdgcn_rcpf(lw[wave * 32 + crow(r, hi)]);
    if (comp == 0) {
#pragma unroll
        for (int d = 0; d < 4; ++d)
#pragma unroll
            for (int r = 0; r < 16; ++r) ost[(32 * qg + crow(r, hi)) * 132 + 32 * d + r32] = o[d][r] * rl[r];
    }
    __syncthreads();
    if (comp == 1) {
#pragma unroll
        for (int d = 0; d < 4; ++d)
#pragma unroll
            for (int r = 0; r < 16; ++r) ost[(32 * qg + crow(r, hi)) * 132 + 32 * d + r32] -= lam * o[d][r] * rl[r];
    }
    __syncthreads();
    {
        const int row = tid >> 2, qt = tid & 3; const LAS float* src = ost + row * 132 + 32 * qt;
        float v[32]; float ss = 0.f;
#pragma unroll
        for (int i = 0; i < 32; ++i) { v[i] = src[i]; ss += v[i] * v[i]; }
        ss += __shfl_xor(ss, 1); ss += __shfl_xor(ss, 2);
        const float rstd = rsqrtf(ss * (1.0f / 128.0f) + EPS) * oscale;
        const size_t grow = (size_t)qrow0 + row;
        const bf16_t* gs = (const bf16_t*)(ws + WS_GS) + grow * 768 + h * 128 + 32 * qt;
        bf16_t* dst = (bf16_t*)(ws + WS_A) + grow * DM + h * 128 + 32 * qt;
        const float* gsub = a.in[I_GSUB] + l * 128 + 32 * qt;
#pragma unroll
        for (int i = 0; i < 4; ++i) { const u32x4 gw = *(const u32x4*)(gs + 8 * i); u32x4 w;
#pragma unroll
            for (int e = 0; e < 4; ++e) { const int j = 8 * i + 2 * e; w[e] = pk2(v[j] * rstd * gsub[j] * bflo(gw[e]), v[j + 1] * rstd * gsub[j + 1] * bfhi(gw[e])); }
            *(u32x4*)(dst + 8 * i) = w; }
    }
    __syncthreads();
}

#ifndef REPEAT_PHASE
#define REPEAT_PHASE (-1)
#endif
constexpr int N_PHASES = 15 + (REPEAT_PHASE >= 0 ? 1 : 0);
__global__ void __launch_bounds__(NTHREADS, 2) fwd_kernel(Args args) {
    extern __shared__ __attribute__((aligned(16))) unsigned char lds_raw[];
    LAS unsigned char* lds = (LAS unsigned char*)lds_raw;
    const int tid = threadIdx.x, lane = tid & 63, wave = __builtin_amdgcn_readfirstlane(tid >> 6);
    const int bx = blockIdx.x, vcu = (bx % 8) * (GRID / 8) + bx / 8;
    unsigned char* ws = args.ws;
    volatile LAS unsigned* MISC = (volatile LAS unsigned*)(lds + MISC_OFF);
    for (int u = tid; u < 32; u += NTHREADS) MISC[u] = 0u;
    __syncthreads();
    XcdBarrier bar; bar.bar = (unsigned*)(ws + WS_CTL) + CW_BAR; bar.x = 0; bar.st = nullptr;
    const bool one_launch = (args.ph_hi - args.ph_lo) > 1;
    if (one_launch) bar = xcd_barrier_post((unsigned*)(ws + WS_CTL) + CW_BAR, MISC + 8);
#ifndef REPEAT_PHASE
#define REPEAT_PHASE (-1)
#endif
#ifndef PRO_PROBE
#define PRO_PROBE 15
#endif
#ifndef PHMASK
#define PHMASK 0xffff
#endif
#define EN(b) (((PHMASK) >> (b)) & 1)
#define LAUNDER() int tid_ = tid, vcu_ = vcu; asm volatile("" : "+v"(tid_)); asm volatile("" : "+s"(vcu_)); const int lane_ = tid_ & 63, wave_ = __builtin_amdgcn_readfirstlane(tid_ >> 6); (void)lane_; (void)wave_
#pragma unroll 1
    for (int pc = args.ph_lo; pc < args.ph_hi; ++pc) {
        const int ph = (REPEAT_PHASE >= 0 && pc > REPEAT_PHASE) ? pc - 1 : pc;
        const int l = ph >= 8 ? 1 : 0;
        const bool second = (REPEAT_PHASE >= 0 && pc == REPEAT_PHASE + 1); (void)second;
        const int kind = ph == 0 ? 6 : ((ph == 1 || ph == 8) ? 7 : (ph < 8 ? ph - 2 : ph - 9));
        const bf16_t* Wl = (const bf16_t*)(ws + WS_WIN) + (size_t)l * NPHYS * DM;
        LAUNDER();
        if (kind == 6) { if (EN(0)) ph0_prologue(args, lds, tid_, lane_, wave_, vcu_, second ? PRO_PROBE : 15); }
        else if (kind == 7) { if (EN(1)) prepass(args, ph == 1 ? 0 : 1, lds, tid_, lane_, wave_, vcu_); }
        else if (kind == 0) { if (EN(2)) {
            pg8::Gemm g{(const bf16_t*)(ws + WS_H), Wl, DM, DM, 0, 0, 0, 16, 16, 16};
            TileSched S{vcu_ >> 5, vcu_ & 31, 0, 14, 1, l == 0 ? 52 : 8, l == 0 ? 0 : 2, l == 0 ? 26 : 4};
            EpiIn E{ws, args.in[I_GQ] + l * 64, args.in[I_GK] + l * 64, (const float*)(ws + WS_ROPE), (const float*)(ws + WS_ROPE) + 2048};
            pg8::gemm_phase<EpiIn, TileSched, true, true>(lds, g, S, E, tid_); } }
        else if (kind == 1) { if (EN(3)) {
            if (EN(8)) f1_unit(ws, lds, vcu_, tid_, lane_, wave_);
            const int nsgu = l == 0 ? 132 : 128;
            if (EN(9)) for (int cu = vcu_; cu < nsgu; cu += GRID) sgu_unit(args, l, lds, cu, tid_, lane_, wave_);
            if (EN(10) && l == 0 && vcu_ >= 248) ctxf_unit(args, l, lds, vcu_ - 248, tid_, lane_, wave_); } }
        else if (kind == 2) { if (EN(4)) {
            if (EN(11) && !second) f2_unit(args, l, lds, vcu_, tid_, lane_, wave_);
            const int bh = vcu_ >> 5, qb = vcu_ & 31;
            if (EN(12)) {
                const int nun = (l == 0 && qb < 2) ? 3 : 2;
#pragma unroll 1
                for (int ui = 0; ui < nun; ++ui) {
                    const int qrow0 = ui < 2 ? (bh >> 2) * SEQ + 256 * qb + 128 * ui : MLAT + (bh >> 2) * NCTX + 128 * qb;
                    attn_unit(args, l, lds, bh >> 2, bh & 3, qrow0, ui < 2 ? 0 : SEQ / 64, ui < 2 ? NKT : NCTX / 64, tid_, lane_, wave_, second);
                }
            } } }
        else if (kind == 3) { if (EN(5)) {
            pg8::Gemm g{(const bf16_t*)(ws + WS_H), Wl, DM, DM, 0, 0, 0, 16, 16, 16};
            TileSched S{vcu_ >> 5, vcu_ & 31, 14, 12, 1, 0, 14, 12};
            EpiIn E{ws, nullptr, nullptr, nullptr, nullptr};
            pg8::gemm_phase<EpiIn, TileSched, true, true>(lds, g, S, E, tid_); } }
        else if (kind == 4) { if (EN(6)) {
            pg8::Gemm g{(const bf16_t*)(ws + WS_A), (const bf16_t*)(ws + WS_WBR) + (size_t)l * DM * DM, DM, DM, 0, 512, 768, 8, 4, 4};
            TileSched S{vcu_ >> 5, vcu_ & 31, 0, 4, 3, 0, 0, 4};
            if (l == 0) ctx_branch_proj(ws, (const bf16_t*)(ws + WS_WBR), vcu_ * NWAVES + wave_, lane_);
            EpiY E{(const bf16_t*)(ws + WS_MS), (bf16_t*)(ws + WS_H)};
            pg8::gemm_phase<EpiY, TileSched, true, true>(lds, g, S, E, tid_); } }
        else { if (EN(7)) {
            pg8::Gemm g{(const bf16_t*)(ws + WS_H), (const bf16_t*)(ws + WS_WOUT) + (size_t)l * DM * DM, DM, DM, 0, 0, 0, 16, 16, 16};
            TileSched S{vcu_ >> 5, vcu_ & 31, 0, 4, 1, 0, 0, 4};
            if (l == 0) ctx_out_proj(ws, (const bf16_t*)(ws + WS_WOUT), args.in[I_CTX], (const float*)(ws + WS_MODF) + 2 * 3072 + 2048, vcu_ * NWAVES + wave_, lane_);
            EpiOut E{l == 0 ? args.in[I_X] : args.out, args.out, args.in[I_CTX], (float*)(ws + WS_CTX1), (const float*)(ws + WS_MODF) + (size_t)(l * 3) * 3072 + 2048};
            pg8::gemm_phase<EpiOut, TileSched, true, true>(lds, g, S, E, tid_); } }
        if (pc + 1 < args.ph_hi) { XcdBarrier b2_ = bar; asm volatile("" : "+s"(b2_.bar)); xcd_barrier(b2_); }
    }
}

extern "C" void kernel_launch(void* const* d_in, const int* in_sizes, int n_in, void* d_out, int out_size, void* d_ws, size_t ws_size, hipStream_t stream) {
    static int ready = 0;
    if (ready == 0) {
        if (n_in != 25 || out_size != MLAT * DM || ws_size < 256 * MiB) { fprintf(stderr, "kernel_launch: unexpected shapes (n_in %d out %d ws %zu)\n", n_in, out_size, ws_size); ready = -1; return; }
        int dev = 0, cus = 0, per_cu = 0;
        hipGetDevice(&dev); hipDeviceGetAttribute(&cus, hipDeviceAttributeMultiprocessorCount, dev);
        if (hipFuncSetAttribute((const void*)fwd_kernel, hipFuncAttributeMaxDynamicSharedMemorySize, LDS_BYTES) != hipSuccess) { fprintf(stderr, "kernel_launch: hipFuncSetAttribute failed\n"); ready = -1; return; }
        hipOccupancyMaxActiveBlocksPerMultiprocessor(&per_cu, (const void*)fwd_kernel, NTHREADS, LDS_BYTES);
        (void)hipGetLastError();
        if (cus != GRID || per_cu < 1) fprintf(stderr, "kernel_launch: note: %d CUs, occupancy %d blocks/CU (built for 256 CUs, 1 block/CU)\n", cus, per_cu);
        ready = (cus >= GRID) ? 1 : -1;
    }
    if (ready < 0) return;
    hipMemsetAsync((char*)d_ws + WS_CTL, 0, CTL_ZERO_BYTES, stream);
    Args a{};
    for (int i = 0; i < 25; ++i) a.in[i] = (const float*)d_in[i];
    a.out = (float*)d_out; a.ws = (unsigned char*)d_ws;
#if MK_N_LAUNCHES == 1
    a.ph_lo = 0; a.ph_hi = N_PHASES;
    hipLaunchKernelGGL(fwd_kernel, dim3(GRID), dim3(NTHREADS), LDS_BYTES, stream, a);
#else
    for (int p = 0; p < N_PHASES; ++p) { a.ph_lo = p; a.ph_hi = p + 1; hipLaunchKernelGGL(fwd_kernel, dim3(GRID), dim3(NTHREADS), LDS_BYTES, stream, a); }
#endif
}
```

```cpp
#include <hip/hip_runtime.h>
#include <cstdio>
#include <cstdint>

#ifndef MK_N_LAUNCHES
#define MK_N_LAUNCHES 1
#endif

#define LAS __attribute__((address_space(3)))
#define GAS __attribute__((address_space(1)))
typedef unsigned short bf16_t;
typedef short bf16x8 __attribute__((ext_vector_type(8)));
typedef short s16x4 __attribute__((ext_vector_type(4)));
typedef float f32x4 __attribute__((ext_vector_type(4)));
typedef float f32x2 __attribute__((ext_vector_type(2)));
typedef float f32x16 __attribute__((ext_vector_type(16)));
typedef unsigned u32x4 __attribute__((ext_vector_type(4)));
typedef unsigned u32x2 __attribute__((ext_vector_type(2)));

constexpr int DM = 1024, BATCH = 2, SEQ = 8192, NCTX = 256, DEPTH = 2;
constexpr int MLAT = BATCH * SEQ, MCTX = BATCH * NCTX, MT = MLAT + MCTX;
constexpr int NKEY = SEQ + NCTX, NKT = NKEY / 64;
constexpr int INW = 6400;
constexpr int OFF_Q = 0, OFF_K = 512, OFF_V = 1024, OFF_F = 1536, OFF_U = 1792, OFF_VC = 2048, OFF_GATE = 2304, OFF_MERGE = 3328;
constexpr int NPHYS = 6656;
constexpr float EPS = 1e-6f;
constexpr float QSCALE = 0.125f * 1.4426950408889634f;

constexpr size_t KiB = 1024, MiB = 1u << 20;
constexpr size_t WS_CTL = 0, CTL_ZERO_BYTES = 64 * KiB;
constexpr size_t WS_MODP = 1 * MiB;
constexpr size_t WS_MODF = WS_MODP + 2304 * KiB;
constexpr size_t WS_ROPE = WS_MODF + 72 * KiB;
constexpr size_t WS_TW = WS_ROPE + 16 * KiB;
constexpr size_t WS_LAM = WS_TW + 64 * KiB;
constexpr size_t WS_C128 = WS_LAM + 1 * KiB;
constexpr size_t WS_S128 = WS_C128 + 32 * KiB;
constexpr size_t WS_T64 = WS_S128 + 32 * KiB;
constexpr size_t WS_TC256 = WS_T64 + 16 * KiB;
constexpr size_t WS_WSIMG = WS_TC256 + 256 * KiB;
constexpr size_t WS_SMALL_END = WS_WSIMG + 256 * KiB;
static_assert(WS_SMALL_END <= 5 * MiB, "small tables");
constexpr size_t WS_WIN = 5 * MiB;
constexpr size_t WS_WBR = 31 * MiB;
constexpr size_t WS_WOUT = 35 * MiB;
constexpr size_t WS_CTX1 = 39 * MiB;
constexpr size_t WS_H = 41 * MiB;
constexpr size_t WS_A = 74 * MiB;
constexpr size_t WS_R = 107 * MiB;
constexpr size_t SZ_QG = (size_t)MT * 512 * 2, SZ_KIMG = (size_t)BATCH * 4 * NKT * 16384, SZ_Z2 = (size_t)MT * 512 * 2, SZ_UG = (size_t)MT * 256 * 2, SZ_GS = (size_t)MT * 768 * 2;
constexpr size_t WS_QG = WS_R, WS_KIMG = WS_QG + SZ_QG, WS_VIMG = WS_KIMG + SZ_KIMG, WS_Z2 = WS_VIMG + SZ_KIMG, WS_UG = WS_Z2 + SZ_Z2, WS_VC = WS_UG + SZ_UG, WS_GS = WS_VC + SZ_UG;
constexpr size_t WS_MS = WS_R;
constexpr size_t WS_END = WS_GS + SZ_GS;
constexpr size_t WS_MSC = 224 * MiB;
static_assert(WS_MS + (size_t)MT * 3072 <= WS_Z2 && WS_END <= WS_MSC && WS_MSC + (size_t)MCTX * 3072 * 2 <= 256 * MiB, "d_ws map");

__device__ __forceinline__ unsigned f2bf(float f) { unsigned u = __builtin_bit_cast(unsigned, f); return (u + 0x7fffu + ((u >> 16) & 1u)) >> 16; }
__device__ __forceinline__ unsigned pk2(float lo, float hi) { return f2bf(lo) | (f2bf(hi) << 16); }
__device__ __forceinline__ unsigned cvt_pk_bf16(float lo, float hi) { unsigned r; asm volatile("v_cvt_pk_bf16_f32 %0, %1, %2" : "=v"(r) : "v"(lo), "v"(hi)); return r; }
__device__ __forceinline__ float bf2f(unsigned short v) { return __builtin_bit_cast(float, (unsigned)v << 16); }
__device__ __forceinline__ float bflo(unsigned w) { return __builtin_bit_cast(float, w << 16); }
__device__ __forceinline__ float bfhi(unsigned w) { return __builtin_bit_cast(float, w & 0xffff0000u); }
__device__ __forceinline__ float fast_sigmoid(float x) { return __builtin_amdgcn_rcpf(1.0f + __builtin_amdgcn_exp2f(-1.4426950408889634f * x)); }
__device__ __forceinline__ unsigned ms_quant_pk(float x, unsigned sel, unsigned old) { const float q = __builtin_amdgcn_rcpf((1.0f / 255.0f) + __builtin_amdgcn_exp2f(__builtin_fmaf(x, -1.4426950408889634f, -7.994353436858858f)));
    return __builtin_amdgcn_cvt_pk_u8_f32(__builtin_fmaxf(q, 1.0f), sel, old); }
__device__ __forceinline__ float ub(unsigned w, int i) { return (float)((w >> (8 * i)) & 0xffu); }
__device__ __forceinline__ float fast_silu(float x) { return x * fast_sigmoid(x); }
__device__ __forceinline__ int crow(int r, int hi) { return (r & 3) + 8 * (r >> 2) + 4 * hi; }
__host__ __device__ __forceinline__ int perm32(int rho) { const int n = rho >> 4, i = rho & 15; return 8 * (i >> 2) + 4 * n + (i & 3); }
__host__ __device__ __forceinline__ int invperm32(int c) { return 16 * ((c >> 2) & 1) + 4 * (c >> 3) + (c & 3); }
#define LDS_WAIT() asm volatile("s_waitcnt lgkmcnt(0)" ::: "memory")
#define VM_WAIT() asm volatile("s_waitcnt vmcnt(0)" ::: "memory")

namespace pg8 {
constexpr int BM = 256, BK = 64, HALF = 128, HTB = HALF * BK * 2  , STAGE_BYTES = 8 * HTB;
__host__ __device__ __forceinline__ int lds_byte(int r, int c) { const int st = (r >> 4) * 2 + (c >> 5), rr = r & 15, cc = c & 31, ob = rr * 64 + cc * 2; return st * 1024 + (ob ^ (((ob >> 9) & 1) << 5)); }
__host__ __device__ __forceinline__ void stage_rc(int b, int& R, int& C) { const int st = b / 1024, sb = b % 1024, swz = sb ^ (((sb >> 9) & 1) << 5); R = (st >> 1) * 16 + swz / 64; C = (st & 1) * 32 + (swz % 64) / 2; }

struct Unit { int pm, pn, seg; };
struct Gemm { const bf16_t* A; const bf16_t* Bt; int lda, ldb; int k0_0, k0_1, k0_2; int nt_0, nt_1, nt_2; };

template <class Epi, class Sched, bool ALIGN_EPI = false, bool SP2 = false>
__device__ __forceinline__ void gemm_phase(LAS unsigned char* lds, const Gemm g, const Sched& S, const Epi& E, const int tid) {
    const int wid = __builtin_amdgcn_readfirstlane(tid >> 6), lane = tid & 63, wr = wid >> 2, wc = wid & 3, fr = lane & 15, fq = lane >> 4;
    unsigned voffA[2], voffB[2];
#pragma unroll
    for (int i = 0; i < 2; ++i) { int R, C; stage_rc(tid * 16 + i * 8192, R, C); voffA[i] = (unsigned)(R * g.lda + C) * 2u; voffB[i] = (unsigned)(R * g.ldb + C) * 2u; }
    const size_t kstep = (size_t)(BK * 2);
    const size_t hstepA = (size_t)HALF * g.lda * 2, hstepB = (size_t)HALF * g.ldb * 2;
    const size_t tstepA = 2 * hstepA, tstepB = 2 * hstepB;
    const unsigned ldsw = (unsigned)wid * 1024u;
    const int aoff = lds_byte(wr * 64 + fr, fq * 8), boff = lds_byte(wc * 32 + fr, fq * 8);
#define PG8_SA(b, h) (((b) * 2 + (h)) * HTB)
#define PG8_SB(b, h) ((4 + (b) * 2 + (h)) * HTB)
#define PG8_STAGE(bufoff, gbase, voff) do { _Pragma("unroll") for (int _i = 0; _i < 2; ++_i) \
        __builtin_amdgcn_global_load_lds((const unsigned*)((const char*)(gbase) + (voff)[_i]), (LAS unsigned*)(lds + (bufoff) + ldsw + _i * 8192), 16, 0, 0); } while (0)
#define PG8_LDA(dst, b, h) do { _Pragma("unroll") for (int m = 0; m < 4; ++m) _Pragma("unroll") for (int k = 0; k < 2; ++k) dst[m][k] = *(const LAS bf16x8*)(lds + PG8_SA(b, h) + aoff + m * 2048 + k * 1024); } while (0)
#define PG8_LDB(dst, b, h) do { _Pragma("unroll") for (int n = 0; n < 2; ++n) _Pragma("unroll") for (int k = 0; k < 2; ++k) dst[n][k] = *(const LAS bf16x8*)(lds + PG8_SB(b, h) + boff + n * 2048 + k * 1024); } while (0)
#define PG8_MMA(ai, bj, At, Bt) do { __builtin_amdgcn_s_setprio(1); _Pragma("unroll") for (int m = 0; m < 4; ++m) _Pragma("unroll") for (int n = 0; n < 2; ++n) _Pragma("unroll") for (int k = 0; k < 2; ++k) \
        acc[ai][bj][m][n] = __builtin_amdgcn_mfma_f32_16x16x32_bf16(Bt[n][k], At[m][k], acc[ai][bj][m][n], 0, 0, 0); __builtin_amdgcn_s_setprio(0); } while (0)
#define PG8_WAIT_V(n) asm volatile("s_waitcnt vmcnt(" #n ")" ::: "memory")
#define PG8_WAIT_L(n) asm volatile("s_waitcnt lgkmcnt(" #n ")" ::: "memory")
#define PG8_BAR __builtin_amdgcn_s_barrier()
#define PG8_SCHED __builtin_amdgcn_sched_barrier(0)
#define PG8_K0(u) ((u).seg == 0 ? g.k0_0 : ((u).seg == 1 ? g.k0_1 : g.k0_2))
#define PG8_NT(u) ((u).seg == 0 ? g.nt_0 : ((u).seg == 1 ? g.nt_1 : g.nt_2))
#define PG8_UA(u) ((const char*)g.A + (size_t)(u).pm * tstepA + (size_t)PG8_K0(u) * 2)
#define PG8_UB(u) ((const char*)g.Bt + (size_t)(u).pn * tstepB + (size_t)PG8_K0(u) * 2)
    Unit cur, nxt; int ui = 0;
    if (!S.next(0, cur)) return;
    f32x4 acc[2][2][4][2];
#pragma unroll
    for (int a = 0; a < 2; ++a)
#pragma unroll
        for (int b = 0; b < 2; ++b)
#pragma unroll
            for (int m = 0; m < 4; ++m)
#pragma unroll
                for (int n = 0; n < 2; ++n) acc[a][b][m][n] = (f32x4){0.f, 0.f, 0.f, 0.f};
    bf16x8 At[4][2], B0[2][2], B1[2][2];
    const char* cA = PG8_UA(cur); const char* cB = PG8_UB(cur); int nt = PG8_NT(cur);
    if constexpr (SP2) {
        PG8_STAGE(PG8_SB(0, 0), cB, voffB); PG8_STAGE(PG8_SB(0, 1), cB + hstepB, voffB); PG8_STAGE(PG8_SA(0, 0), cA, voffA); PG8_STAGE(PG8_SA(0, 1), cA + hstepA, voffA);
        if (wr == 1) PG8_BAR;
        PG8_WAIT_V(2); PG8_BAR;
        PG8_STAGE(PG8_SB(1, 0), cB + kstep, voffB); PG8_STAGE(PG8_SA(1, 0), cA + kstep, voffA); PG8_STAGE(PG8_SB(1, 1), cB + hstepB + kstep, voffB);
        PG8_WAIT_V(6); PG8_BAR;
    } else {
        PG8_STAGE(PG8_SB(0, 0), cB, voffB); PG8_STAGE(PG8_SA(0, 0), cA, voffA); PG8_STAGE(PG8_SB(0, 1), cB + hstepB, voffB); PG8_STAGE(PG8_SA(0, 1), cA + hstepA, voffA);
        if (wr == 1) PG8_BAR;
        PG8_WAIT_V(4); PG8_BAR;
        PG8_STAGE(PG8_SB(1, 0), cB + kstep, voffB); PG8_STAGE(PG8_SA(1, 0), cA + kstep, voffA); PG8_STAGE(PG8_SB(1, 1), cB + hstepB + kstep, voffB);
        PG8_WAIT_V(6); PG8_BAR;
    }
    for (;;) {
        const bool has_next = S.next(ui + 1, nxt);
        const char* nA = has_next ? PG8_UA(nxt) : cA; const char* nB = has_next ? PG8_UB(nxt) : cB;
        for (int t = 0; t < nt; t += 2) {
            const bool last = (t == nt - 2);
            const char* a1 = cA + (size_t)(t + 1) * kstep;
            const char* a2 = last ? nA : cA + (size_t)(t + 2) * kstep; const char* b2 = last ? nB : cB + (size_t)(t + 2) * kstep;
            const char* a3 = a2 + kstep; const char* b3 = b2 + kstep;
            if constexpr (SP2) {
            PG8_LDB(B0, 0, 0); PG8_LDB(B1, 0, 1); PG8_SCHED; PG8_LDA(At, 0, 0); PG8_STAGE(PG8_SA(1, 1), a1 + hstepA, voffA);
            PG8_WAIT_V(8); PG8_WAIT_L(0); PG8_BAR; PG8_MMA(0, 0, At, B0); PG8_MMA(0, 1, At, B1); PG8_BAR; PG8_SCHED;
            PG8_LDA(At, 0, 1); PG8_STAGE(PG8_SB(0, 0), b2, voffB); PG8_STAGE(PG8_SB(0, 1), b2 + hstepB, voffB); PG8_STAGE(PG8_SA(0, 0), a2, voffA);
            PG8_WAIT_V(8); PG8_WAIT_L(0); PG8_BAR; PG8_MMA(1, 0, At, B0); PG8_MMA(1, 1, At, B1); PG8_BAR; PG8_SCHED;
            PG8_LDB(B0, 1, 0); PG8_LDB(B1, 1, 1); PG8_SCHED; PG8_LDA(At, 1, 0); PG8_STAGE(PG8_SA(0, 1), a2 + hstepA, voffA);
            PG8_WAIT_V(8); PG8_WAIT_L(0); PG8_BAR; PG8_MMA(0, 0, At, B0); PG8_MMA(0, 1, At, B1); PG8_BAR; PG8_SCHED;
            PG8_LDA(At, 1, 1); PG8_STAGE(PG8_SB(1, 0), b3, voffB); PG8_STAGE(PG8_SB(1, 1), b3 + hstepB, voffB); PG8_STAGE(PG8_SA(1, 0), a3, voffA);
            PG8_WAIT_V(8); PG8_WAIT_L(0); PG8_BAR; PG8_MMA(1, 0, At, B0); PG8_MMA(1, 1, At, B1); PG8_BAR; PG8_SCHED;
            } else {
            PG8_LDB(B0, 0, 0); PG8_SCHED; PG8_LDA(At, 0, 0); PG8_STAGE(PG8_SA(1, 1), a1 + hstepA, voffA);
            PG8_WAIT_L(8); PG8_BAR; PG8_WAIT_L(0); PG8_MMA(0, 0, At, B0); PG8_BAR; PG8_SCHED;
            PG8_LDB(B1, 0, 1); PG8_STAGE(PG8_SB(0, 0), b2, voffB);
            PG8_BAR; PG8_WAIT_L(0); PG8_MMA(0, 1, At, B1); PG8_BAR;
            PG8_LDA(At, 0, 1); PG8_STAGE(PG8_SA(0, 0), a2, voffA);
            PG8_BAR; PG8_WAIT_L(0); PG8_MMA(1, 0, At, B0); PG8_BAR; PG8_SCHED;
            PG8_STAGE(PG8_SB(0, 1), b2 + hstepB, voffB);
            PG8_WAIT_V(6); PG8_BAR; PG8_MMA(1, 1, At, B1); PG8_BAR;
            PG8_LDB(B0, 1, 0); PG8_SCHED; PG8_LDA(At, 1, 0); PG8_STAGE(PG8_SA(0, 1), a2 + hstepA, voffA);
            PG8_WAIT_L(8); PG8_BAR; PG8_WAIT_L(0); PG8_MMA(0, 0, At, B0); PG8_BAR; PG8_SCHED;
            PG8_LDB(B1, 1, 1); PG8_STAGE(PG8_SB(1, 0), b3, voffB);
            PG8_BAR; PG8_WAIT_L(0); PG8_MMA(0, 1, At, B1); PG8_BAR;
            PG8_LDA(At, 1, 1); PG8_STAGE(PG8_SA(1, 0), a3, voffA);
            PG8_BAR; PG8_WAIT_L(0); PG8_MMA(1, 0, At, B0); PG8_BAR; PG8_SCHED;
            PG8_STAGE(PG8_SB(1, 1), b3 + hstepB, voffB);
            PG8_WAIT_V(6); PG8_BAR; PG8_MMA(1, 1, At, B1); PG8_BAR;
            }
        }
        if constexpr (ALIGN_EPI) { if (wr == 0) PG8_BAR; }
        const bool reset_acc = E(acc, cur, wr, wc, fr, fq);
        if (!has_next) break;
        if (reset_acc) {
#pragma unroll
        for (int a = 0; a < 2; ++a)
#pragma unroll
            for (int b = 0; b < 2; ++b)
#pragma unroll
                for (int m = 0; m < 4; ++m)
#pragma unroll
                    for (int n = 0; n < 2; ++n) acc[a][b][m][n] = (f32x4){0.f, 0.f, 0.f, 0.f};
        }
        cur = nxt; cA = nA; cB = nB; nt = PG8_NT(cur); ++ui;
        if constexpr (ALIGN_EPI) { if (wr == 1) PG8_BAR; }
    }
    PG8_WAIT_V(0);
    if constexpr (!ALIGN_EPI) { if (wr == 0) PG8_BAR; }
    PG8_BAR;
#undef PG8_SA
#undef PG8_SB
#undef PG8_STAGE
#undef PG8_LDA
#undef PG8_LDB
#undef PG8_MMA
#undef PG8_WAIT_V
#undef PG8_WAIT_L
#undef PG8_BAR
#undef PG8_SCHED
#undef PG8_K0
#undef PG8_NT
#undef PG8_UA
#undef PG8_UB
}
}

#define XB_TMO      128
#define XB_XCNT(j)  (256  + 64 * (j))
#define XB_XSUB(j)  (1280 + 64 * (j))
#define XB_XGEN(j)  (2304 + 64 * (j))
#define XB_TOP      3328
#define XB_TOPGEN   3392
#define XCD_BAR_WORDS 3456
#define XB_SPIN_CAP (1u << 18)
__device__ __forceinline__ unsigned xb_ld(unsigned* p)              { return __hip_atomic_load(p, __ATOMIC_RELAXED, __HIP_MEMORY_SCOPE_AGENT); }
__device__ __forceinline__ unsigned xb_add(unsigned* p, unsigned v) { return __hip_atomic_fetch_add(p, v, __ATOMIC_RELAXED, __HIP_MEMORY_SCOPE_AGENT); }
__device__ __forceinline__ unsigned xb_xcc_id() { return (unsigned)__builtin_amdgcn_s_getreg((3 << 11) | 20) & 0xFu; }
#define XB_SPIN(cond, bar) do { unsigned _sp = 0; while (cond) { __builtin_amdgcn_s_sleep(1); \
    if ((++_sp & 255u) == 0u) { if (xb_ld(&(bar)[XB_TMO])) break; if (_sp > XB_SPIN_CAP) { atomicAdd(&(bar)[XB_TMO], 1u); break; } } } } while (0)
struct XcdBarrier { unsigned* bar; unsigned x; volatile LAS unsigned* st; };
__device__ __forceinline__ XcdBarrier xcd_barrier_post(unsigned* bar, volatile LAS unsigned* st) {
    XcdBarrier b; b.bar = bar; b.x = xb_xcc_id(); b.st = st;
    if (threadIdx.x == 0) (void)xb_add(&bar[XB_XCNT(b.x)], 1u);
    return b;
}
__device__ __forceinline__ void xcd_barrier_complete(unsigned* bar, unsigned x, unsigned& nloc, unsigned& nx) {
    const unsigned G = gridDim.x * gridDim.y * gridDim.z;
    unsigned sum, cnt, mine, sp = 0u;
    for (;;) {
        sum = 0u; cnt = 0u; mine = 0u;
#pragma unroll
        for (unsigned j = 0; j < 16; ++j) { const unsigned c = xb_ld(&bar[XB_XCNT(j)]); sum += c; cnt += (c > 0u) ? 1u : 0u; mine = (j == x) ? c : mine; }
        if (sum == G) break;
        __builtin_amdgcn_s_sleep(1);
        if ((++sp & 255u) == 0u) { if (xb_ld(&bar[XB_TMO])) break; if (sp > XB_SPIN_CAP) { atomicAdd(&bar[XB_TMO], 1u); break; } }
    }
    nloc = mine > 0u ? mine : 1u; nx = cnt > 0u ? cnt : 1u;
}
__device__ __forceinline__ void xcd_barrier(const XcdBarrier& b) {
    asm volatile("s_waitcnt vmcnt(0)" ::: "memory");
    __syncthreads();
    if (threadIdx.x == 0) {
        unsigned* bar = b.bar;
        __builtin_amdgcn_s_waitcnt(0);
        unsigned nloc = b.st[0], nx = b.st[1];
        if (nloc == 0u) { xcd_barrier_complete(bar, b.x, nloc, nx); b.st[0] = nloc; b.st[1] = nx; }
        const unsigned old = xb_add(&bar[XB_XSUB(b.x)], 1u);
        const unsigned gen = old / nloc;
        if (old + 1u == (gen + 1u) * nloc) {
            __builtin_amdgcn_fence(__ATOMIC_RELEASE, "agent");
            asm volatile("s_waitcnt vmcnt(0)" ::: "memory");
            const unsigned og = xb_add(&bar[XB_TOP], 1u);
            const unsigned tg = og / nx;
            if (og + 1u == (tg + 1u) * nx) xb_add(&bar[XB_TOPGEN], 1u);
            else XB_SPIN(xb_ld(&bar[XB_TOPGEN]) == tg, bar);
            __builtin_amdgcn_fence(__ATOMIC_ACQUIRE, "agent");
            xb_add(&bar[XB_XGEN(b.x)], 1u);
            asm volatile("s_waitcnt vmcnt(0)" ::: "memory");
        } else {
            XB_SPIN(xb_ld(&bar[XB_XGEN(b.x)]) == gen, bar);
            __builtin_amdgcn_fence(__ATOMIC_ACQUIRE, "agent");
            asm volatile("s_waitcnt vmcnt(0)" ::: "memory");
        }
    }
    __syncthreads();
}

constexpr int NWAVES = 8, NTHREADS = 512, GRID = 256;
constexpr int LDS_BYTES = 147456;
constexpr int MISC_OFF = 131072 + 320;
constexpr int CW_BAR = 4096;

struct Args {
    const float* in[25];
    float* out; unsigned char* ws;
    int ph_lo, ph_hi;
};

struct Frame {
    LAS unsigned char* lds;
    int tid, lane, wave, vcu;
    const float* const* in;
    float* out; unsigned char* ws;
};
enum { I_X = 0, I_C, I_CTX, I_CCTX, I_WADA, I_BADA, I_GNORM, I_WIN, I_GQ, I_GK, I_LQ1, I_LK1, I_LQ2, I_LK2, I_GSUB, I_WF, I_BF, I_LNG, I_LNB, I_WS, I_BS, I_WBRA, I_WBRB, I_WBRC, I_WOUT };

__device__ __forceinline__ void transpose_item(const float* W, int ldw, int k0, int lcol0, bool perm, bf16_t* dst, int ldd, int prow0, int dcol0, LAS float* scr, int lane) {
#pragma unroll 8
    for (int i = 0; i < 32; ++i) { const int kk = 2 * i + (lane >> 5); scr[kk * 33 + (lane & 31)] = W[(size_t)(k0 + kk) * ldw + lcol0 + (lane & 31)]; }
    LDS_WAIT(); asm volatile("" ::: "memory");
    const int c = lane & 7;
#pragma unroll
    for (int j = 0; j < 4; ++j) { const int n = (lane >> 3) + 8 * j; const int jn = perm ? perm32(n) : n; const LAS float* s = scr + (8 * c) * 33 + jn;
        u32x4 o; o.x = pk2(s[0 * 33], s[1 * 33]); o.y = pk2(s[2 * 33], s[3 * 33]); o.z = pk2(s[4 * 33], s[5 * 33]); o.w = pk2(s[6 * 33], s[7 * 33]);
        *(GAS u32x4*)(dst + (size_t)(prow0 + n) * ldd + dcol0 + k0 + 8 * c) = o; }
    LDS_WAIT(); asm volatile("" ::: "memory");
}
__device__ __forceinline__ bool win_block_map(int pb, int& lcol, bool& perm) {
    const int tile = pb >> 3, w = pb & 7, bj = w >> 2, wc = w & 3;
    if (tile < 2) { lcol = OFF_Q + (4 * (tile & 1) + wc) * 64 + 32 * bj; perm = false; return true; }
    if (tile < 4) { lcol = OFF_K + (4 * (tile & 1) + wc) * 64 + 32 * bj; perm = false; return true; }
    perm = true;
    if (tile < 6) { lcol = OFF_V + 256 * (tile - 4) + 32 * w; return true; }
    if (tile < 8) return false;
    if (tile < 10) { lcol = (bj == 0 ? OFF_U : OFF_GATE + 768) + 128 * (tile - 8) + 32 * wc; return true; }
    if (tile == 10) { lcol = OFF_VC + 32 * w; return true; }
    if (tile < 14) { lcol = OFF_GATE + 256 * (tile - 11) + 32 * w; return true; }
    lcol = OFF_MERGE + 256 * (tile - 14) + 32 * w; return true;
}
__device__ __forceinline__ float cos2pi(int a, int n) { return cospif(2.0f * (float)a / (float)n); }
__device__ __forceinline__ float sin2pi(int a, int n) { return sinpif(2.0f * (float)a / (float)n); }

__device__ __forceinline__ void ph0_prologue(const Args& a, LAS unsigned char* lds, int tid, int lane, int wave, int vcu, int pmask) {
    unsigned char* ws = a.ws;
    const int gw = vcu * NWAVES + wave, NGW = GRID * NWAVES;
    const int gt = vcu * NTHREADS + tid, NGT = GRID * NTHREADS;
    if (pmask & 1) {
        LAS float* scr = (LAS float*)(lds + wave * 16384);
        constexpr int I_WIN_N = DEPTH * 208 * 16;
        constexpr int I_BR_N = DEPTH * 32 * 16;
        constexpr int I_OUT_N = DEPTH * 32 * 16;
        for (int it = gw; it < I_WIN_N + I_BR_N + I_OUT_N; it += NGW) {
            int r = it;
            if (r < I_WIN_N) {
                const int l = r / (208 * 16), q = r % (208 * 16), pb = q >> 4, kb = q & 15; int lcol; bool perm;
                if (!win_block_map(pb, lcol, perm)) continue;
                transpose_item(a.in[I_WIN] + (size_t)l * DM * INW, INW, 64 * kb, lcol, perm, (bf16_t*)(ws + WS_WIN) + (size_t)l * NPHYS * DM, DM, 32 * pb, 0, scr, lane);
                continue;
            }
            r -= I_WIN_N;
            if (r < I_BR_N) {
                const int l = r / 512, q = r % 512, pb = q >> 4, kb = q & 15;
                const float* W; int ksrc;
                if (kb < 8) { W = a.in[I_WBRA] + (size_t)l * 512 * DM; ksrc = 64 * kb; } else if (kb < 12) { W = a.in[I_WBRB] + (size_t)l * 256 * DM; ksrc = 64 * (kb - 8); } else { W = a.in[I_WBRC] + (size_t)l * 256 * DM; ksrc = 64 * (kb - 12); }
                transpose_item(W, DM, ksrc, 32 * pb, true, (bf16_t*)(ws + WS_WBR) + (size_t)l * DM * DM, DM, 32 * pb, 64 * kb - ksrc, scr, lane);
                continue;
            }
            r -= I_BR_N;
            { const int l = r / 512, q = r % 512, pb = q >> 4, kb = q & 15;
              transpose_item(a.in[I_WOUT] + (size_t)l * DM * DM, DM, 64 * kb, 32 * pb, false, (bf16_t*)(ws + WS_WOUT) + (size_t)l * DM * DM, DM, 32 * pb, 0, scr, lane); }
        }
    }
    __syncthreads();
    if (pmask & 2) {
        LAS float* Wb = (LAS float*)lds;
        LAS float* TR = Wb + 64 * 65;
        LAS float* Tt = TR + 64 * 128;
        LAS float* Wf = Tt + 64 * 132;
        for (int it = vcu; it < DEPTH * 4 * 16; it += GRID) {
            const int l = it / 64, g = (it >> 4) & 3, kb = it & 15;
            const float* win = a.in[I_WIN] + (size_t)l * DM * INW; const float* wf = a.in[I_WF] + (size_t)(l * 4 + g) * 64 * 64;
            for (int e = tid; e < 4096; e += NTHREADS) { const int r = e >> 6, c = e & 63; Wb[r * 65 + c] = win[(size_t)(64 * kb + r) * INW + OFF_F + 64 * g + c]; Wf[e] = wf[e]; }
            for (int e = tid; e < 64 * 128; e += NTHREADS) { const int c = e >> 7, ri = (e >> 6) & 1, cp = e & 63; const int ph = (c * cp) & 63; TR[e] = ri ? -sin2pi(ph, 64) : cos2pi(ph, 64); }
            __syncthreads();
            const int tk = tid >> 5, tn = tid & 31;
            { f32x4 acc[4];
#pragma unroll
              for (int i = 0; i < 4; ++i) acc[i] = (f32x4){0.f, 0.f, 0.f, 0.f};
#pragma unroll 4
              for (int c = 0; c < 64; ++c) { const f32x4 bv = *(const LAS f32x4*)(TR + c * 128 + 4 * tn);
#pragma unroll
                  for (int i = 0; i < 4; ++i) acc[i] += bv * Wb[(4 * tk + i) * 65 + c]; }
#pragma unroll
              for (int i = 0; i < 4; ++i) *(LAS f32x4*)(Tt + (4 * tk + i) * 132 + 4 * tn) = acc[i]; }
            __syncthreads();
            { const int ri = tn >> 4, td = tn & 15;
              f32x4 acc[4];
#pragma unroll
              for (int i = 0; i < 4; ++i) acc[i] = (f32x4){0.f, 0.f, 0.f, 0.f};
#pragma unroll 4
              for (int cp = 0; cp < 64; ++cp) { const f32x4 bv = *(const LAS f32x4*)(Wf + cp * 64 + 4 * td);
#pragma unroll
                  for (int i = 0; i < 4; ++i) acc[i] += bv * Tt[(4 * tk + i) * 132 + ri * 64 + cp]; }
              bf16_t* dst = (bf16_t*)(ws + WS_WIN) + (size_t)l * NPHYS * DM;
#pragma unroll
              for (int e = 0; e < 4; ++e) { const int ch = 64 * g + 4 * td + e, prow = 6 * 256 + ri * 256 + (ch & ~31) + invperm32(ch & 31);
                  u32x2 w; w.x = pk2(acc[0][e], acc[1][e]); w.y = pk2(acc[2][e], acc[3][e]);
                  *(u32x2*)(dst + (size_t)prow * DM + 64 * kb + 4 * tk) = w; } }
            __syncthreads();
        }
    }
    if (pmask & 4) {
        float* ropec = (float*)(ws + WS_ROPE); float* ropes = ropec + 2048;
        for (int e = gt; e < 2048; e += NGT) { const int pos = e >> 4, f = e & 15; const float freq = powf(10000.0f, -(float)(2 * f) / 32.0f); const float ang = (float)pos * freq; ropec[e] = cosf(ang); ropes[e] = sinf(ang); }
        f32x2* tw = (f32x2*)(ws + WS_TW);
        for (int e = gt; e < 8192; e += NGT) tw[e] = (f32x2){cos2pi(e, 8192), sin2pi(e, 8192)};
        bf16_t* c128 = (bf16_t*)(ws + WS_C128); bf16_t* s128 = (bf16_t*)(ws + WS_S128);
        for (int e = gt; e < 4 * 8 * 64 * 8; e += NGT) { const int j = e & 7, ln = (e >> 3) & 63, s = (e >> 9) & 7, mb = e >> 12; const int row = 32 * mb + (ln & 31), k = 16 * s + 8 * (j >> 2) + 4 * (ln >> 5) + (j & 3);
            const int ph = (row * k) & 127; c128[e] = (bf16_t)f2bf(cos2pi(ph, 128)); s128[e] = (bf16_t)f2bf(sin2pi(ph, 128)); }
        bf16_t* t64 = (bf16_t*)(ws + WS_T64);
        for (int e = gt; e < 2 * 8 * 64 * 8; e += NGT) { const int j = e & 7, ln = (e >> 3) & 63, s = (e >> 9) & 7, mb = e >> 12; const int row = 32 * mb + (ln & 31), k = 16 * s + 8 * (j >> 2) + 4 * (ln >> 5) + (j & 3);
            const int ri = k >> 6, c = k & 63, ph = (row * c) & 63; t64[e] = (bf16_t)f2bf(ri ? sin2pi(ph, 64) : cos2pi(ph, 64)); }
        bf16_t* tc256 = (bf16_t*)(ws + WS_TC256);
        for (int e = gt; e < 8 * 32 * 64 * 8; e += NGT) { const int j = e & 7, ln = (e >> 3) & 63, s = (e >> 9) & 31, mb = e >> 14; const int row = 32 * mb + (ln & 31), k = 16 * s + 8 * (j >> 2) + 4 * (ln >> 5) + (j & 3);
            const int ri = k >> 8, n = k & 255, ph = (row * n) & 255; tc256[e] = (bf16_t)f2bf(ri ? sin2pi(ph, 256) : cos2pi(ph, 256)); }
        bf16_t* wsimg = (bf16_t*)(ws + WS_WSIMG);
        for (int e = gt; e < DEPTH * 4 * 4 * 8 * 64 * 8; e += NGT) { const int j = e & 7, ln = (e >> 3) & 63, s = (e >> 9) & 7, mb = (e >> 12) & 3, lg = e >> 14; const int row = 32 * mb + (ln & 31), k = 16 * s + 8 * (j >> 2) + 4 * (ln >> 5) + (j & 3);
            wsimg[e] = (bf16_t)f2bf(a.in[I_WS][(size_t)lg * 128 * 128 + row * 128 + k]); }
        if (gt < DEPTH) { const int l = gt; float s1 = 0.f, s2 = 0.f;
            for (int i = 0; i < 64; ++i) { s1 += a.in[I_LQ1][l * 64 + i] * a.in[I_LK1][l * 64 + i]; s2 += a.in[I_LQ2][l * 64 + i] * a.in[I_LK2][l * 64 + i]; }
            const float lam_init = 0.8f - 0.6f * expf(-0.3f * (float)l);
            float* lam = (float*)(ws + WS_LAM); lam[2 * l] = expf(s1) - expf(s2) + lam_init; lam[2 * l + 1] = 1.0f - lam_init; }
    }
    if (pmask & 8) {
        float* part = (float*)(ws + WS_MODP);
        for (int it = gw; it < DEPTH * 12 * 32; it += NGW) {
            const int l = it / 384, q = it % 384, cc = q >> 5, kc = q & 31; const int col = 256 * cc + 4 * lane;
            const float* w = a.in[I_WADA] + (size_t)l * DM * 3072 + col;
            f32x4 s0 = {0.f, 0.f, 0.f, 0.f}, s1 = s0, s2 = s0;
#pragma unroll 8
            for (int kk = 0; kk < 32; ++kk) { const int k = 32 * kc + kk; const f32x4 wv = *(const f32x4*)(w + (size_t)k * 3072);
                const float a0 = fast_silu(a.in[I_C][k]), a1 = fast_silu(a.in[I_C][DM + k]), a2 = fast_silu(a.in[I_CCTX][k]);
                s0 += wv * a0; s1 += wv * a1; s2 += wv * a2; }
            float* p = part + ((size_t)(l * 32 + kc) * 3) * 3072 + col;
            *(f32x4*)(p) = s0; *(f32x4*)(p + 3072) = s1; *(f32x4*)(p + 2 * 3072) = s2;
        }
    }
}

__device__ __forceinline__ void prepass(const Args& a, int l, LAS unsigned char* lds, int tid, int lane, int wave, int vcu) {
    unsigned char* ws = a.ws;
    const float* part = (const float*)(ws + WS_MODP); float* modf = (float*)(ws + WS_MODF);
    if (l == 0) {
        if (tid < 72) { const int o = vcu * 72 + tid; const int ll = o / 9216, rj = o % 9216, r = rj / 3072, j = rj % 3072; float s = a.in[I_BADA][ll * 3072 + j];
#pragma unroll 4
            for (int kc = 0; kc < 32; ++kc) s += part[((size_t)(ll * 32 + kc) * 3 + r) * 3072 + j];
            modf[o] = s; }
    }
    const int row0 = vcu * 66, row1 = row0 + 66;
    LAS float* coef = (LAS float*)lds;
    for (int r = 0; r < 3; ++r) {
        const int lo = r == 0 ? 0 : (r == 1 ? SEQ : MLAT), hi = r == 0 ? SEQ : (r == 1 ? MLAT : MT);
        if (row1 <= lo || row0 >= hi) continue;
        for (int k = tid; k < DM; k += NTHREADS) {
            float sh, sc;
            if (l == 0) { sh = a.in[I_BADA][k]; sc = a.in[I_BADA][DM + k];
#pragma unroll 4
                for (int kc = 0; kc < 32; ++kc) { const float* p = part + ((size_t)(kc) * 3 + r) * 3072; sh += p[k]; sc += p[DM + k]; } }
            else { sh = modf[(size_t)(l * 3 + r) * 3072 + k]; sc = modf[(size_t)(l * 3 + r) * 3072 + DM + k]; }
            coef[(r * 2) * DM + k] = a.in[I_GNORM][l * DM + k] * (1.0f + sc); coef[(r * 2 + 1) * DM + k] = sh;
        }
    }
    __syncthreads();
    const float* xlat = l == 0 ? a.in[I_X] : a.out; const float* xctx = l == 0 ? a.in[I_CTX] : (const float*)(ws + WS_CTX1);
    bf16_t* H = (bf16_t*)(ws + WS_H);
    for (int m = row0 + wave; m < row1; m += NWAVES) {
        const int r = m < SEQ ? 0 : (m < MLAT ? 1 : 2);
        const float* xrow = m < MLAT ? xlat + (size_t)m * DM : xctx + (size_t)(m - MLAT) * DM;
        const GAS f32x4* xr = (const GAS f32x4*)xrow + lane;
        f32x4 v[4]; float s2 = 0.f;
#pragma unroll
        for (int j = 0; j < 4; ++j) { v[j] = xr[64 * j]; s2 += (v[j].x * v[j].x + v[j].y * v[j].y) + (v[j].z * v[j].z + v[j].w * v[j].w); }
#pragma unroll
        for (int o = 1; o < 64; o <<= 1) s2 += __shfl_xor(s2, o);
        const float rstd = rsqrtf(s2 * (1.0f / DM) + EPS);
        GAS u32x2* o8 = (GAS u32x2*)(H + (size_t)m * DM) + lane;
#pragma unroll
        for (int j = 0; j < 4; ++j) { const f32x4 ga = *(const LAS f32x4*)(coef + (r * 2) * DM + 256 * j + 4 * lane), sh = *(const LAS f32x4*)(coef + (r * 2 + 1) * DM + 256 * j + 4 * lane);
            const f32x4 h = v[j] * rstd * ga + sh; u32x2 w; w.x = pk2(h.x, h.y); w.y = pk2(h.z, h.w); o8[64 * j] = w; }
    }
    __syncthreads();
}

struct TileSched {
    int x, c, pn0, npn, nseg, nctx, cpn0, cnpn;
    __device__ __forceinline__ bool next(int i, pg8::Unit& u) const {
        const int ti = i / nseg; u.seg = i - ti * nseg;
        const int j = ti * 32 + c;
        if (j < 8 * npn) { u.pm = 8 * x + (j & 7); u.pn = pn0 + (j >> 3); return true; }
        const int id = (j - 8 * npn) * 8 + x;
        if (id < nctx) { u.pm = 64 + (id & 1); u.pn = cpn0 + (id >> 1); return true; }
        return false;
    }
};

struct EpiIn {
    unsigned char* ws; const float* gq; const float* gk; const float* ropec; const float* ropes;
    __device__ __forceinline__ bool operator()(f32x4 (&acc)[2][2][4][2], const pg8::Unit& u, int wr, int wc, int fr, int fq) const {
        const bool ctx = u.pm >= 64; const int b = ctx ? u.pm - 64 : (u.pm >> 5);
        const int rbase = u.pm * 256 + wr * 64 + fr;
        const int pn = u.pn;
        if (pn < 4) {
            const bool isK = pn >= 2; const int gi = 4 * (pn & 1) + wc, h = gi >> 1, comp = gi & 1;
            const float* gsrc = isK ? gk : gq;
            f32x4 gv[2][2];
#pragma unroll
            for (int bj = 0; bj < 2; ++bj)
#pragma unroll
                for (int n = 0; n < 2; ++n) gv[bj][n] = *(const f32x4*)(gsrc + 32 * bj + 16 * n + 4 * fq);
#pragma unroll
            for (int ai = 0; ai < 2; ++ai)
#pragma unroll
                for (int m = 0; m < 4; ++m) {
                    const int row = rbase + ai * 128 + m * 16;
                    f32x4 v[2][2]; float ss = 0.f;
#pragma unroll
                    for (int bj = 0; bj < 2; ++bj)
#pragma unroll
                        for (int n = 0; n < 2; ++n) { v[bj][n] = acc[ai][bj][m][n]; ss += (v[bj][n].x * v[bj][n].x + v[bj][n].y * v[bj][n].y) + (v[bj][n].z * v[bj][n].z + v[bj][n].w * v[bj][n].w); }
                    ss += __shfl_xor(ss, 16); ss += __shfl_xor(ss, 32);
                    const float rstd = rsqrtf(ss * (1.0f / 64.0f) + EPS);
#pragma unroll
                    for (int bj = 0; bj < 2; ++bj)
#pragma unroll
                        for (int n = 0; n < 2; ++n) v[bj][n] = v[bj][n] * rstd * gv[bj][n];
                    int kx;
                    if (!ctx) { const int ntok = row - b * SEQ; kx = ntok;
#pragma unroll
                        for (int bj = 0; bj < 2; ++bj) { const int pos = bj == 0 ? (ntok >> 6) : (ntok & 63);
                            const f32x4 c4 = *(const f32x4*)(ropec + pos * 16 + 4 * fq), s4 = *(const f32x4*)(ropes + pos * 16 + 4 * fq);
                            const f32x4 x1 = v[bj][0], x2 = v[bj][1]; v[bj][0] = x1 * c4 - x2 * s4; v[bj][1] = x2 * c4 + x1 * s4; } }
                    else kx = SEQ + (row - MLAT - b * NCTX);
#pragma unroll
                    for (int bj = 0; bj < 2; ++bj) {
                        f32x4 p0 = v[bj][0], p1 = v[bj][1];
                        if (!isK) { p0 = p0 * QSCALE; p1 = p1 * QSCALE; }
                        u32x4 w; w.x = cvt_pk_bf16(p0.x, p0.y); w.y = cvt_pk_bf16(p0.z, p0.w); w.z = cvt_pk_bf16(p1.x, p1.y); w.w = cvt_pk_bf16(p1.z, p1.w);
                        if (!isK) *(u32x4*)((bf16_t*)(ws + WS_QG) + ((size_t)row * 4 + h) * 128 + comp * 64 + (bj * 4 + fq) * 8) = w;
                        else *(u32x4*)(ws + WS_KIMG + ((size_t)((b * 4 + h) * NKT + (kx >> 6)) * 16 + comp * 8 + bj * 4 + fq) * 1024 + (kx & 63) * 16) = w;
                    }
                }
            return true;
        }
#pragma unroll
        for (int ai = 0; ai < 2; ++ai)
#pragma unroll
            for (int m = 0; m < 4; ++m) {
                const int row = rbase + ai * 128 + m * 16;
                if (pn == 8 || pn == 9) {
                    f32x4 p0, p1;
#pragma unroll
                    for (int e = 0; e < 4; ++e) { p0[e] = acc[ai][0][m][0][e] * fast_silu(acc[ai][1][m][0][e]); p1[e] = acc[ai][0][m][1][e] * fast_silu(acc[ai][1][m][1][e]); }
                    u32x4 w; w.x = cvt_pk_bf16(p0.x, p0.y); w.y = cvt_pk_bf16(p0.z, p0.w); w.z = cvt_pk_bf16(p1.x, p1.y); w.w = cvt_pk_bf16(p1.z, p1.w);
                    *(u32x4*)((bf16_t*)(ws + WS_UG) + (size_t)row * 256 + 128 * (pn - 8) + 32 * wc + 8 * fq) = w;
                    continue;
                }
#pragma unroll
                for (int bj = 0; bj < 2; ++bj) {
                    f32x4 p0 = acc[ai][bj][m][0], p1 = acc[ai][bj][m][1];
                    const int lc = 128 * bj + 32 * wc + 8 * fq;
                    unsigned char* dst;
                    if (pn < 6) { const int kx = ctx ? SEQ + (row - MLAT - b * NCTX) : row - b * SEQ; const int h = 2 * (pn - 4) + bj;
                        dst = ws + WS_VIMG + ((size_t)((b * 4 + h) * NKT + (kx >> 6)) * 16 + wc * 4 + ((kx & 63) >> 4)) * 1024 + (kx & 15) * 64 + fq * 16; }
                    else if (pn < 8) dst = ws + WS_Z2 + ((size_t)row * 512 + 256 * (pn - 6) + lc) * 2;
                    else if (pn == 10) dst = ws + WS_VC + ((size_t)row * 256 + lc) * 2;
                    else if (pn < 14) {
#pragma unroll
                        for (int e = 0; e < 4; ++e) { p0[e] = fast_silu(p0[e]); p1[e] = fast_silu(p1[e]); }
                        dst = ws + WS_GS + ((size_t)row * 768 + 256 * (pn - 11) + lc) * 2; }
                    else {
                        unsigned q0 = 0u, q1 = 0u;
#pragma unroll
                        for (int e = 0; e < 4; ++e) { q0 = ms_quant_pk(p0[e], e, q0); q1 = ms_quant_pk(p1[e], e, q1); }
                        unsigned char* d8 = ctx ? ws + WS_MSC + ((size_t)(row - MLAT) * 3072 + 256 * (pn - 14) + lc) : ws + WS_MS + ((size_t)row * 3072 + 256 * (pn - 14) + lc);
                        u32x2 w8; w8.x = q0; w8.y = q1; *(u32x2*)d8 = w8; continue; }
                    u32x4 w; w.x = cvt_pk_bf16(p0.x, p0.y); w.y = cvt_pk_bf16(p0.z, p0.w); w.z = cvt_pk_bf16(p1.x, p1.y); w.w = cvt_pk_bf16(p1.z, p1.w);
                    *(u32x4*)dst = w;
                }
            }
        return true;
    }
};

struct EpiY {
    const unsigned char* MS; bf16_t* Y;
    __device__ __forceinline__ bool operator()(f32x4 (&acc)[2][2][4][2], const pg8::Unit& u, int wr, int wc, int fr, int fq) const {
        const int rbase = u.pm * 256 + wr * 64 + fr; const int seg = u.seg;
#pragma unroll
        for (int ai = 0; ai < 2; ++ai)
#pragma unroll
            for (int m = 0; m < 4; ++m) {
                const int row = rbase + ai * 128 + m * 16;
#pragma unroll
                for (int bj = 0; bj < 2; ++bj) {
                    const int col = 256 * u.pn + 128 * bj + 32 * wc + 8 * fq;
                    const unsigned char* mp = MS + (size_t)row * 3072 + seg * 1024 + col;
                    const u32x2 mn = *(const u32x2*)mp;
                    f32x4& p0 = acc[ai][bj][m][0]; f32x4& p1 = acc[ai][bj][m][1];
                    if (seg < 2) { const u32x2 md = *(const u32x2*)(mp + 1024);
#pragma unroll
                        for (int e = 0; e < 4; ++e) { p0[e] *= ub(mn.x, e) * __builtin_amdgcn_rcpf(ub(md.x, e)); p1[e] *= ub(mn.y, e) * __builtin_amdgcn_rcpf(ub(md.y, e)); } }
                    else {
#pragma unroll
                        for (int e = 0; e < 4; ++e) { p0[e] *= ub(mn.x, e) * (1.0f / 255.0f); p1[e] *= ub(mn.y, e) * (1.0f / 255.0f); }
                        u32x4 w; w.x = cvt_pk_bf16(p0[0], p0[1]); w.y = cvt_pk_bf16(p0[2], p0[3]); w.z = cvt_pk_bf16(p1[0], p1[1]); w.w = cvt_pk_bf16(p1[2], p1[3]);
                        *(u32x4*)(Y + (size_t)row * DM + col) = w; }
                }
            }
        return seg == 2;
    }
};

struct EpiOut {
    const float* xlat; float* olat; const float* xctx; float* octx; const float* gate;
    __device__ __forceinline__ bool operator()(f32x4 (&acc)[2][2][4][2], const pg8::Unit& u, int wr, int wc, int fr, int fq) const {
        const bool ctx = u.pm >= 64; const int r = ctx ? 2 : (u.pm >> 5);
        const int rbase = u.pm * 256 + wr * 64 + fr;
        const float* src = ctx ? xctx - (size_t)MLAT * DM : xlat; float* dst = ctx ? octx - (size_t)MLAT * DM : olat;
#pragma unroll
        for (int bj = 0; bj < 2; ++bj)
#pragma unroll
            for (int n = 0; n < 2; ++n) {
                const int col = 256 * u.pn + 128 * bj + 32 * wc + 16 * n + 4 * fq;
                const f32x4 gv = *(const f32x4*)(gate + (size_t)r * 3072 + col);
#pragma unroll
                for (int ai = 0; ai < 2; ++ai)
#pragma unroll
                    for (int m = 0; m < 4; ++m) { const size_t off = (size_t)(rbase + ai * 128 + m * 16) * DM + col;
                        const f32x4 xo = *(const f32x4*)(src + off); *(f32x4*)(dst + off) = xo + gv * acc[ai][bj][m][n]; }
            }
        return true;
    }
};


__device__ __forceinline__ f32x4 mini_block(const bf16_t* A, int lda, const bf16_t* Bt, int ldb, int m0, int n0, int k0, int nk, int fr, int fq, f32x4 acc) {
    const bf16_t* ap = A + (size_t)(m0 + fr) * lda + k0 + 8 * fq; const bf16_t* bp = Bt + (size_t)(n0 + fr) * ldb + k0 + 8 * fq;
#pragma unroll 8
    for (int s = 0; s < nk; s += 32) acc = __builtin_amdgcn_mfma_f32_16x16x32_bf16(*(const bf16x8*)(bp + s), *(const bf16x8*)(ap + s), acc, 0, 0, 0);
    return acc;
}
__device__ __forceinline__ int mini_lcol(int n0, int fq) { return (n0 & ~31) + 8 * fq + 4 * ((n0 >> 4) & 1); }
__device__ __forceinline__ void ctx_merge_gates(unsigned char* ws, const bf16_t* Wl, int gw, int lane) {
    const int fr = lane & 15, fq = lane >> 4; const bf16_t* H = (const bf16_t*)(ws + WS_H); bf16_t* MS = (bf16_t*)(ws + WS_MS);
    for (int blk = gw; blk < 32 * 192; blk += GRID * NWAVES) { const int m0 = MLAT + 16 * (blk & 31), n0 = 16 * (blk >> 5);
        const f32x4 acc = mini_block(H, DM, Wl + (size_t)(14 * 256) * DM, DM, m0, n0, 0, DM, fr, fq, (f32x4){0.f, 0.f, 0.f, 0.f});
        u32x2 w; w.x = cvt_pk_bf16(fast_sigmoid(acc[0]), fast_sigmoid(acc[1])); w.y = cvt_pk_bf16(fast_sigmoid(acc[2]), fast_sigmoid(acc[3]));
        *(u32x2*)(MS + (size_t)(m0 + fr) * 3072 + mini_lcol(n0, fq)) = w; }
}
__device__ __forceinline__ void ctx_branch_proj(unsigned char* ws, const bf16_t* Wbr, int gw, int lane) {
    const int fr = lane & 15, fq = lane >> 4; const bf16_t* A = (const bf16_t*)(ws + WS_A); const unsigned char* MS = (const unsigned char*)(ws + WS_MSC) - (size_t)MLAT * 3072; bf16_t* Y = (bf16_t*)(ws + WS_H);
    for (int blk = gw; blk < 32 * 64; blk += GRID * NWAVES) { const int m0 = MLAT + 16 * (blk & 31), n0 = 16 * (blk >> 5); const int lc = mini_lcol(n0, fq);
        f32x4 y = {0.f, 0.f, 0.f, 0.f};
#pragma unroll
        for (int seg = 0; seg < 3; ++seg) { const int k0 = seg == 0 ? 0 : (seg == 1 ? 512 : 768), nk = seg == 0 ? 512 : 256;
            const f32x4 acc = mini_block(A, DM, Wbr, DM, m0, n0, k0, nk, fr, fq, (f32x4){0.f, 0.f, 0.f, 0.f});
            const unsigned mg = *(const unsigned*)(MS + (size_t)(m0 + fr) * 3072 + seg * 1024 + lc);
            y[0] += acc[0] * ub(mg, 0) * (1.0f / 255.0f); y[1] += acc[1] * ub(mg, 1) * (1.0f / 255.0f); y[2] += acc[2] * ub(mg, 2) * (1.0f / 255.0f); y[3] += acc[3] * ub(mg, 3) * (1.0f / 255.0f); }
        u32x2 w; w.x = cvt_pk_bf16(y[0], y[1]); w.y = cvt_pk_bf16(y[2], y[3]);
        *(u32x2*)(Y + (size_t)(m0 + fr) * DM + lc) = w; }
}
__device__ __forceinline__ void ctx_out_proj(unsigned char* ws, const bf16_t* Wout, const float* ctx_in, const float* gate_ctx, int gw, int lane) {
    const int fr = lane & 15, fq = lane >> 4; const bf16_t* Y = (const bf16_t*)(ws + WS_H); float* C1 = (float*)(ws + WS_CTX1);
    for (int blk = gw; blk < 32 * 64; blk += GRID * NWAVES) { const int m0 = MLAT + 16 * (blk & 31), n0 = 16 * (blk >> 5);
        const f32x4 acc = mini_block(Y, DM, Wout, DM, m0, n0, 0, DM, fr, fq, (f32x4){0.f, 0.f, 0.f, 0.f});
        const size_t off = (size_t)(m0 - MLAT + fr) * DM + n0 + 4 * fq;
        const f32x4 g = *(const f32x4*)(gate_ctx + n0 + 4 * fq), x = *(const f32x4*)(ctx_in + off);
        *(f32x4*)(C1 + off) = x + g * acc; }
}

typedef short v4i16_t __attribute__((ext_vector_type(4)));
__device__ __forceinline__ s16x4 vtr(LAS const unsigned char* p) { return __builtin_bit_cast(s16x4, __builtin_amdgcn_ds_read_tr16_b64_v4i16((LAS v4i16_t*)p)); }
__device__ __forceinline__ int tr_lane_off(int lane) { return ((lane >> 4) & 1) * 32 + (lane & 3) * 8 + (4 * (lane >> 5) + ((lane & 15) >> 2)) * 64; }
__device__ __forceinline__ bf16x8 bfrag(LAS const unsigned char* piece_plus_laneoff) {
    const s16x4 lo = vtr(piece_plus_laneoff), hi = vtr(piece_plus_laneoff + 512);
    return (bf16x8){lo[0], lo[1], lo[2], lo[3], hi[0], hi[1], hi[2], hi[3]};
}
template <class RP> __device__ __forceinline__ void stage_pieces(LAS unsigned char* dst, int nrows, int ncols, RP rp, int tid) {
    const int cpr = ncols >> 3, total = nrows * cpr, pcs = ncols >> 5;
    for (int c = tid; c < total; c += NTHREADS) { const int row = c / cpr, cc = c - row * cpr;
        const u32x4 v = *(const u32x4*)(rp(row) + cc * 8);
        *(LAS u32x4*)(dst + ((row >> 4) * pcs + (cc >> 2)) * 1024 + (row & 15) * 64 + (cc & 3) * 16) = v; }
}
#define MFMA32(a, b, c) __builtin_amdgcn_mfma_f32_32x32x16_bf16(a, b, c, 0, 0, 0)
__device__ __forceinline__ bf16x8 afrag_img(const bf16_t* img, int KS, int mb, int s, int lane) { return *(const bf16x8*)(img + ((size_t)(mb * KS + s) * 64 + lane) * 8); }

__device__ __forceinline__ void f1_unit(unsigned char* ws, LAS unsigned char* lds, int unit, int tid, int lane, int wave) {
    const int b = unit >> 7, c = (unit >> 1) & 63, chh = unit & 1;
    bf16_t* Z2 = (bf16_t*)(ws + WS_Z2);
    const bf16_t* base = Z2 + ((size_t)(b * SEQ + c)) * 512 + chh * 128;
    stage_pieces(lds, 128, 128, [&](int r) { return base + (size_t)r * 64 * 512; }, tid);
    stage_pieces(lds + 32768, 128, 128, [&](int r) { return base + (size_t)r * 64 * 512 + 256; }, tid);
    __syncthreads();
    const int mb = wave & 3, cbp = wave >> 2, hi = lane >> 5, r32 = lane & 31, lo = tr_lane_off(lane);
    const bf16_t* c128 = (const bf16_t*)(ws + WS_C128); const bf16_t* s128 = (const bf16_t*)(ws + WS_S128);
    f32x16 outr[2], t1[2], t2[2];
#pragma unroll
    for (int e = 0; e < 2; ++e) { outr[e] = f32x16{}; t1[e] = f32x16{}; t2[e] = f32x16{}; }
#pragma unroll 1
    for (int s = 0; s < 8; ++s) {
        const bf16x8 cf = afrag_img(c128, 8, mb, s, lane), sf = afrag_img(s128, 8, mb, s, lane);
#pragma unroll
        for (int e = 0; e < 2; ++e) {
            const bf16x8 xr = bfrag(lds + (s * 4 + 2 * cbp + e) * 1024 + lo), xi = bfrag(lds + 32768 + (s * 4 + 2 * cbp + e) * 1024 + lo);
            outr[e] = MFMA32(cf, xr, outr[e]); outr[e] = MFMA32(sf, xi, outr[e]); t1[e] = MFMA32(cf, xi, t1[e]); t2[e] = MFMA32(sf, xr, t2[e]);
        }
    }
    const f32x2* tw = (const f32x2*)(ws + WS_TW);
#pragma unroll
    for (int e = 0; e < 2; ++e)
#pragma unroll
        for (int r = 0; r < 16; ++r) {
            const int k1 = 32 * mb + crow(r, hi), ch = chh * 128 + 32 * (2 * cbp + e) + r32;
            const float yr = outr[e][r], yi = t1[e][r] - t2[e][r];
            const f32x2 t = tw[(c * k1) & 8191];
            bf16_t* o = Z2 + ((size_t)(b * SEQ + 64 * k1 + c)) * 512 + ch;
            o[0] = (bf16_t)f2bf(yr * t.x + yi * t.y); o[256] = (bf16_t)f2bf(yi * t.x - yr * t.y);
            if ((r & 3) == 3) __builtin_amdgcn_sched_barrier(0);
        }
    __syncthreads();
}

__device__ __forceinline__ void sgu_unit(const Args& a, int l, LAS unsigned char* lds, int cu, int tid, int lane, int wave) {
    unsigned char* ws = a.ws;
    const int row0 = cu < 128 ? cu * 128 : MLAT + (cu - 128) * 128;
    const bf16_t* VC = (const bf16_t*)(ws + WS_VC);
    {
        const int tok = tid >> 2, qt = tid & 3;
        const u32x4* src = (const u32x4*)(VC + (size_t)(row0 + tok) * 256 + qt * 64);
        u32x4 raw[8]; float s = 0.f;
#pragma unroll
        for (int i = 0; i < 8; ++i) { raw[i] = src[i]; s += (bflo(raw[i].x) + bfhi(raw[i].x)) + (bflo(raw[i].y) + bfhi(raw[i].y)) + (bflo(raw[i].z) + bfhi(raw[i].z)) + (bflo(raw[i].w) + bfhi(raw[i].w)); }
        s += __shfl_xor(s, 1); s += __shfl_xor(s, 2);
        const float mu = s * (1.0f / 256.0f); float q = 0.f;
#pragma unroll
        for (int i = 0; i < 8; ++i) {
#pragma unroll
            for (int e = 0; e < 4; ++e) { const float d0 = bflo(raw[i][e]) - mu, d1 = bfhi(raw[i][e]) - mu; q += d0 * d0 + d1 * d1; } }
        q += __shfl_xor(q, 1); q += __shfl_xor(q, 2);
        const float rstd = rsqrtf(q * (1.0f / 256.0f) + EPS);
        const float* lg = a.in[I_LNG] + l * 256 + qt * 64; const float* lb = a.in[I_LNB] + l * 256 + qt * 64;
#pragma unroll
        for (int i = 0; i < 8; ++i) { u32x4 w;
#pragma unroll
            for (int e = 0; e < 4; ++e) { const int ch = 8 * i + 2 * e; w[e] = pk2((bflo(raw[i][e]) - mu) * rstd * lg[ch] + lb[ch], (bfhi(raw[i][e]) - mu) * rstd * lg[ch + 1] + lb[ch + 1]); }
            const int cc = qt * 8 + i;
            *(LAS u32x4*)(lds + ((tok >> 4) * 8 + (cc >> 2)) * 1024 + (tok & 15) * 64 + (cc & 3) * 16) = w; __builtin_amdgcn_sched_barrier(0); }
    }
    __syncthreads();
    const int g = wave >> 1, ph = wave & 1, hi = lane >> 5, r32 = lane & 31, lo = tr_lane_off(lane);
    const bf16_t* img = (const bf16_t*)(ws + WS_WSIMG) + (size_t)(l * 4 + g) * 16384;
    f32x16 acc[2][2];
#pragma unroll
    for (int i = 0; i < 2; ++i) { acc[i][0] = f32x16{}; acc[i][1] = f32x16{}; }
#pragma unroll 1
    for (int s = 0; s < 8; ++s) {
        const bf16x8 a0 = afrag_img(img, 8, 2 * ph, s, lane), a1 = afrag_img(img, 8, 2 * ph + 1, s, lane);
        const bf16x8 b0 = bfrag(lds + (s * 8 + 2 * g) * 1024 + lo), b1 = bfrag(lds + (s * 8 + 2 * g + 1) * 1024 + lo);
        acc[0][0] = MFMA32(a0, b0, acc[0][0]); acc[0][1] = MFMA32(a0, b1, acc[0][1]); acc[1][0] = MFMA32(a1, b0, acc[1][0]); acc[1][1] = MFMA32(a1, b1, acc[1][1]);
    }
    const bf16_t* UG = (const bf16_t*)(ws + WS_UG); bf16_t* A = (bf16_t*)(ws + WS_A);
    const float* bs = a.in[I_BS] + (size_t)(l * 4 + g) * 128;
#pragma unroll
    for (int i = 0; i < 2; ++i)
#pragma unroll
        for (int e = 0; e < 2; ++e)
#pragma unroll
            for (int r = 0; r < 16; ++r) { const int p = 32 * (2 * ph + i) + crow(r, hi), ch = 64 * g + 32 * e + r32;
                const float sv = acc[i][e][r] + bs[p]; const float ug = bf2f(UG[(size_t)(row0 + p) * 256 + ch]);
                A[(size_t)(row0 + p) * DM + 768 + ch] = (bf16_t)f2bf(ug * sv); if ((r & 3) == 3) __builtin_amdgcn_sched_barrier(0); }
    __syncthreads();
}

__device__ __forceinline__ void ctxf_unit(const Args& a, int l, LAS unsigned char* lds, int unit, int tid, int lane, int wave) {
    unsigned char* ws = a.ws;
    const int b = unit >> 2, chq = unit & 3;
    const bf16_t* Z2 = (const bf16_t*)(ws + WS_Z2);
    stage_pieces(lds, 512, 64, [&](int k) { return Z2 + (size_t)(MLAT + b * NCTX + (k & 255)) * 512 + (k >> 8) * 256 + chq * 64; }, tid);
    __syncthreads();
    const int mb = wave, hi = lane >> 5, r32 = lane & 31, lo = tr_lane_off(lane);
    const bf16_t* img = (const bf16_t*)(ws + WS_TC256);
    f32x16 acc[2]; acc[0] = f32x16{}; acc[1] = f32x16{};
#pragma unroll 4
    for (int s = 0; s < 32; ++s) { const bf16x8 af = afrag_img(img, 32, mb, s, lane);
        acc[0] = MFMA32(af, bfrag(lds + (s * 2) * 1024 + lo), acc[0]); acc[1] = MFMA32(af, bfrag(lds + (s * 2 + 1) * 1024 + lo), acc[1]); }
    const bf16_t* GS = (const bf16_t*)(ws + WS_GS); bf16_t* A = (bf16_t*)(ws + WS_A);
#pragma unroll
    for (int e = 0; e < 2; ++e)
#pragma unroll
        for (int r = 0; r < 16; ++r) { const int np = 32 * mb + crow(r, hi), ch = 64 * chq + 32 * e + r32; const size_t row = MLAT + b * NCTX + np;
            const float v = acc[e][r] * (1.0f / 128.0f) + a.in[I_BF][l * 256 + ch];
            A[row * DM + 512 + ch] = (bf16_t)f2bf(v * bf2f(GS[row * 768 + 512 + ch])); if ((r & 3) == 3) __builtin_amdgcn_sched_barrier(0); }
    __syncthreads();
}

__device__ __forceinline__ void f2_unit(const Args& a, int l, LAS unsigned char* lds, int unit, int tid, int lane, int wave) {
    unsigned char* ws = a.ws;
    const int b = unit >> 7, k1 = unit & 127;
    const bf16_t* Z2 = (const bf16_t*)(ws + WS_Z2);
    stage_pieces(lds, 128, 256, [&](int k) { return Z2 + (size_t)(b * SEQ + 64 * k1 + (k & 63)) * 512 + (k >> 6) * 256; }, tid);
    __syncthreads();
    const int cb = wave, hi = lane >> 5, r32 = lane & 31, lo = tr_lane_off(lane);
    const bf16_t* img = (const bf16_t*)(ws + WS_T64);
    f32x16 acc[2]; acc[0] = f32x16{}; acc[1] = f32x16{};
#pragma unroll 4
    for (int s = 0; s < 8; ++s) { const bf16x8 bf = bfrag(lds + (s * 8 + cb) * 1024 + lo);
        acc[0] = MFMA32(afrag_img(img, 8, 0, s, lane), bf, acc[0]); acc[1] = MFMA32(afrag_img(img, 8, 1, s, lane), bf, acc[1]); }
    const bf16_t* GS = (const bf16_t*)(ws + WS_GS); bf16_t* A = (bf16_t*)(ws + WS_A);
    const float nrm = 0.0013810679320049757f;
#pragma unroll
    for (int mb = 0; mb < 2; ++mb)
#pragma unroll
        for (int r = 0; r < 16; ++r) { const int k2 = 32 * mb + crow(r, hi), ch = 32 * cb + r32; const size_t row = (size_t)b * SEQ + k1 + 128 * k2;
            const float v = acc[mb][r] * nrm + a.in[I_BF][l * 256 + ch];
            A[row * DM + 512 + ch] = (bf16_t)f2bf(v * bf2f(GS[row * 768 + 512 + ch])); if ((r & 3) == 3) __builtin_amdgcn_sched_barrier(0); }
    __syncthreads();
}

#ifndef DMA_TWICE
#define DMA_TWICE 0
#endif
#ifndef EXTRA_EXP
#define EXTRA_EXP 0
#endif
#ifndef EXTRA_MFMA
#define EXTRA_MFMA 0
#endif
__device__ __forceinline__ void glds16(const void* gsrc, unsigned lds_dst) { unsigned keep;
    asm volatile("s_mov_b32 %0, m0\n\ts_mov_b32 m0, %2\n\ts_nop 0\n\tglobal_load_lds_dwordx4 %1, off\n\ts_mov_b32 m0, %0" : "=&s"(keep) : "v"(gsrc), "s"(lds_dst) : "memory"); }
__device__ __forceinline__ void glds16x2(const void* gsrc, unsigned lds_dst) { unsigned keep;
    asm volatile("s_mov_b32 %0, m0\n\ts_mov_b32 m0, %2\n\ts_nop 0\n\tglobal_load_lds_dwordx4 %1, off\n\tglobal_load_lds_dwordx4 %1, off offset:1024\n\ts_mov_b32 m0, %0" : "=&s"(keep) : "v"(gsrc), "s"(lds_dst) : "memory"); }
__device__ __forceinline__ void attn_unit(const Args& a, int l, LAS unsigned char* lds, int b, int h, int qrow0, int t0, int nt, int tid, int lane, int wave, bool dry) {
    unsigned char* ws = a.ws;
    const int comp = wave >> 2, qg = wave & 3, hi = lane >> 5, r32 = lane & 31;
    const bf16_t* Qg = (const bf16_t*)(ws + WS_QG);
    const unsigned char* kimg = ws + WS_KIMG + (size_t)(b * 4 + h) * NKT * 16384;
    const unsigned char* vimg = ws + WS_VIMG + (size_t)(b * 4 + h) * NKT * 16384;
    bf16x8 qr[4];
    { const bf16_t* qp = Qg + ((size_t)(qrow0 + 32 * qg + r32) * 4 + h) * 128 + comp * 64 + 8 * hi;
#pragma unroll
      for (int d0 = 0; d0 < 4; ++d0) qr[d0] = *(const bf16x8*)(qp + 16 * d0); }
    asm volatile("" : "+v"(qr[0]), "+v"(qr[1]), "+v"(qr[2]), "+v"(qr[3]));
    f32x16 o[4];
#pragma unroll
    for (int d = 0; d < 4; ++d) o[d] = f32x16{};
    float lsum = 0.f;
    const int lo = tr_lane_off(lane);
    const unsigned lds0 = (unsigned)(uintptr_t)lds;
    constexpr int KSL = 16384, VBASE = 3 * KSL;
#define ATT_DMA_K(t, slotb) do { const unsigned char* s_ = kimg + (size_t)(t) * 16384 + wave * 2048 + lane * 16; const unsigned d_ = (unsigned)__builtin_amdgcn_readfirstlane((int)(lds0 + (slotb) + wave * 2048)); \
        glds16x2(s_, d_); if (DMA_TWICE) glds16x2(s_, d_); } while (0)
#define ATT_DMA_V(t, slotb) do { const unsigned char* s_ = vimg + (size_t)(t) * 16384 + wave * 2048 + lane * 16; const unsigned d_ = (unsigned)__builtin_amdgcn_readfirstlane((int)(lds0 + VBASE + (slotb) + wave * 2048)); \
        glds16x2(s_, d_); if (DMA_TWICE) glds16x2(s_, d_); } while (0)
#define ATT_WAIT_BAR(N) asm volatile("s_waitcnt vmcnt(" #N ") lgkmcnt(0)\n\ts_barrier" ::: "memory")
#define SBAR() __builtin_amdgcn_sched_barrier(0)
#define PIN(x) asm volatile("" : "+v"(x))
    LAS const unsigned char* kp0 = lds + comp * 8192 + hi * 1024 + r32 * 16;
    LAS const unsigned char* vp0 = lds + VBASE + lo;
    bf16x8 kf[8];
#define KRD(j, slotb) do { kf[j] = *(const LAS bf16x8*)(kp0 + (slotb) + ((j) >> 1) * 2048 + ((j) & 1) * 512); } while (0)
    f32x16 pA0 = f32x16{}, pA1 = f32x16{}, pB0, pB1;
    u32x4 pw0, pw1, pw2, pw3;
    bf16x8 vA[8], vB[8];
    int sl_prev = 0, sl_cur = 0, sl_next = KSL;
#define ROT() do { sl_prev = sl_cur; sl_cur = sl_next; sl_next = (sl_next == 2 * KSL) ? 0 : sl_next + KSL; } while (0)
    ATT_DMA_K(t0, 0); ATT_DMA_V(t0, 0); ATT_DMA_K(t0 + 1, KSL); ATT_DMA_K(t0 + 2, 2 * KSL);
    ATT_WAIT_BAR(0);
#pragma unroll
    for (int j = 0; j < 8; ++j) KRD(j, 0);
    ATT_WAIT_BAR(0);
#define PKW(P, B) cvt_pk_bf16(P[B], P[B + 1])
#define EX(v) __builtin_amdgcn_exp2f(v)
#define GAPA(i, C, CIN, a0, a1, a2, a3, W0, W1, PWV) do { vA[i] = bfrag(vpp_ + (i) * 1024); SBAR(); \
        C = MFMA32(kf[i], qr[(i) >> 1], CIN); if (EXTRA_MFMA) dacc = MFMA32(kf[i], qr[(i) >> 1], dacc); sacc += a0; sacc += a1; sacc += a2; sacc += a3; PIN(sacc); W0; W1; PIN(PWV); SBAR(); } while (0)
#define GAPB_V(j, d, PWV, X, B) do { o[d] = MFMA32(__builtin_bit_cast(bf16x8, PWV), vA[j], o[d]); X[B] = EX(X[B]); X[B + 1] = EX(X[B + 1]); PIN(X); if (EXTRA_EXP) { dmy = EX(dmy); PIN(dmy); } vB[j] = bfrag(vpp_ + (8 + (j)) * 1024); SBAR(); } while (0)
#define GAPB_K(j, d, PWV, X, B) do { o[d] = MFMA32(__builtin_bit_cast(bf16x8, PWV), vB[(j) - 8], o[d]); X[B] = EX(X[B]); X[B + 1] = EX(X[B + 1]); PIN(X); if (EXTRA_EXP) { dmy = EX(dmy); PIN(dmy); } KRD((j) - 8, sl_next); SBAR(); } while (0)
    const f32x16 zero16 = f32x16{}; float dmy = 0.5f; (void)dmy; f32x16 dacc = f32x16{}; (void)dacc;
#define STEP(C0, C1, P0, P1, t) do { SBAR(); \
        LAS const unsigned char* vpp_ = vp0 + sl_prev; float sacc = 0.f; \
        GAPA(0, C0, zero16, P0[0], P0[1], P0[2], P0[3],     pw0[0] = PKW(P0, 0),  pw0[1] = PKW(P0, 2),  pw0); \
        GAPA(1, C1, zero16, P0[4], P0[5], P0[6], P0[7],     pw0[2] = PKW(P0, 4),  pw0[3] = PKW(P0, 6),  pw0); \
        GAPA(2, C0, C0,     P0[8], P0[9], P0[10], P0[11],   pw1[0] = PKW(P0, 8),  pw1[1] = PKW(P0, 10), pw1); \
        GAPA(3, C1, C1,     P0[12], P0[13], P0[14], P0[15], pw1[2] = PKW(P0, 12), pw1[3] = PKW(P0, 14), pw1); \
        GAPA(4, C0, C0,     P1[0], P1[1], P1[2], P1[3],     pw2[0] = PKW(P1, 0),  pw2[1] = PKW(P1, 2),  pw2); \
        GAPA(5, C1, C1,     P1[4], P1[5], P1[6], P1[7],     pw2[2] = PKW(P1, 4),  pw2[3] = PKW(P1, 6),  pw2); \
        GAPA(6, C0, C0,     P1[8], P1[9], P1[10], P1[11],   pw3[0] = PKW(P1, 8),  pw3[1] = PKW(P1, 10), pw3); \
        GAPA(7, C1, C1,     P1[12], P1[13], P1[14], P1[15], pw3[2] = PKW(P1, 12), pw3[3] = PKW(P1, 14), pw3); \
        lsum += sacc; \
        if ((t) + 3 < nt) ATT_DMA_K(t0 + (t) + 3, sl_cur); \
        if ((t) + 1 < nt) ATT_DMA_V(t0 + (t) + 1, sl_next); \
        SBAR(); \
        GAPB_V(0, 0, pw0, C0, 0);  GAPB_V(1, 0, pw1, C0, 2);  GAPB_V(2, 0, pw2, C0, 4);  GAPB_V(3, 0, pw3, C0, 6); \
        GAPB_V(4, 1, pw0, C0, 8);  GAPB_V(5, 1, pw1, C0, 10); GAPB_V(6, 1, pw2, C0, 12); GAPB_V(7, 1, pw3, C0, 14); \
        GAPB_K(8, 2, pw0, C1, 0);  GAPB_K(9, 2, pw1, C1, 2);  GAPB_K(10, 2, pw2, C1, 4); GAPB_K(11, 2, pw3, C1, 6); \
        GAPB_K(12, 3, pw0, C1, 8); GAPB_K(13, 3, pw1, C1, 10); GAPB_K(14, 3, pw2, C1, 12); GAPB_K(15, 3, pw3, C1, 14); \
        if ((t) + 3 < nt) { if (DMA_TWICE) ATT_WAIT_BAR(8); else ATT_WAIT_BAR(4); } else ATT_WAIT_BAR(0); \
        ROT(); } while (0)
#pragma unroll 1
    for (int t = 0; t < nt; t += 2) {
        STEP(pB0, pB1, pA0, pA1, t);
        STEP(pA0, pA1, pB0, pB1, t + 1);
    }
    {
        float sacc = 0.f;
#pragma unroll
        for (int r = 0; r < 16; ++r) sacc += pA0[r] + pA1[r];
        lsum += sacc;
        pw0 = (u32x4){PKW(pA0, 0), PKW(pA0, 2), PKW(pA0, 4), PKW(pA0, 6)}; pw1 = (u32x4){PKW(pA0, 8), PKW(pA0, 10), PKW(pA0, 12), PKW(pA0, 14)};
        pw2 = (u32x4){PKW(pA1, 0), PKW(pA1, 2), PKW(pA1, 4), PKW(pA1, 6)}; pw3 = (u32x4){PKW(pA1, 8), PKW(pA1, 10), PKW(pA1, 12), PKW(pA1, 14)};
        LAS const unsigned char* vpp_ = vp0 + sl_prev;
#pragma unroll
        for (int d = 0; d < 4; ++d) {
            const bf16x8 f0 = bfrag(vpp_ + (d * 4 + 0) * 1024), f1 = bfrag(vpp_ + (d * 4 + 1) * 1024), f2 = bfrag(vpp_ + (d * 4 + 2) * 1024), f3 = bfrag(vpp_ + (d * 4 + 3) * 1024);
            o[d] = MFMA32(__builtin_bit_cast(bf16x8, pw0), f0, o[d]); o[d] = MFMA32(__builtin_bit_cast(bf16x8, pw1), f1, o[d]);
            o[d] = MFMA32(__builtin_bit_cast(bf16x8, pw2), f2, o[d]); o[d] = MFMA32(__builtin_bit_cast(bf16x8, pw3), f3, o[d]);
        }
    }
    ATT_WAIT_BAR(0);
#undef ATT_DMA_K
#undef ATT_DMA_V
#undef ATT_WAIT_BAR
#undef SBAR
#undef PIN
#undef KRD
#undef ROT
#undef PKW
#undef EX
#undef GAPA
#undef GAPB_V
#undef GAPB_K
#undef STEP
    if (EXTRA_MFMA) asm volatile("" :: "v"(dacc));
    if (dry) return;
    LAS float* ost = (LAS float*)lds;
    LAS float* lw = (LAS float*)(lds + 72 * 1024);
    lsum += __shfl_xor(lsum, 32);
    if (hi == 0) lw[wave * 32 + r32] = lsum;
    LDS_WAIT(); asm volatile("" ::: "memory");
    const float* lamp = (const float*)(ws + WS_LAM) + 2 * l;
    const float lam = lamp[0], oscale = lamp[1];
    float rl[16];
#pragma unroll
    for (int r = 0; r < 16; ++r) rl[r] = __builtin_amdgcn_rcpf(lw[wave * 32 + crow(r, hi)]);
    if (comp == 0) {
#pragma unroll
        for (int d = 0; d < 4; ++d)
#pragma unroll
            for (int r = 0; r < 16; ++r) ost[(32 * qg + crow(r, hi)) * 132 + 32 * d + r32] = o[d][r] * rl[r];
    }
    __syncthreads();
    if (comp == 1) {
#pragma unroll
        for (int d = 0; d < 4; ++d)
#pragma unroll
            for (int r = 0; r < 16; ++r) ost[(32 * qg + crow(r, hi)) * 132 + 32 * d + r32] -= lam * o[d][r] * rl[r];
    }
    __syncthreads();
    {
        const int row = tid >> 2, qt = tid & 3; const LAS float* src = ost + row * 132 + 32 * qt;
        float v[32]; float ss = 0.f;
#pragma unroll
        for (int i = 0; i < 32; ++i) { v[i] = src[i]; ss += v[i] * v[i]; }
        ss += __shfl_xor(ss, 1); ss += __shfl_xor(ss, 2);
        const float rstd = rsqrtf(ss * (1.0f / 128.0f) + EPS) * oscale;
        const size_t grow = (size_t)qrow0 + row;
        const bf16_t* gs = (const bf16_t*)(ws + WS_GS) + grow * 768 + h * 128 + 32 * qt;
        bf16_t* dst = (bf16_t*)(ws + WS_A) + grow * DM + h * 128 + 32 * qt;
        const float* gsub = a.in[I_GSUB] + l * 128 + 32 * qt;
#pragma unroll
        for (int i = 0; i < 4; ++i) { const u32x4 gw = *(const u32x4*)(gs + 8 * i); u32x4 w;
#pragma unroll
            for (int e = 0; e < 4; ++e) { const int j = 8 * i + 2 * e; w[e] = pk2(v[j] * rstd * gsub[j] * bflo(gw[e]), v[j + 1] * rstd * gsub[j + 1] * bfhi(gw[e])); }
            *(u32x4*)(dst + 8 * i) = w; }
    }
    __syncthreads();
}

#ifndef REPEAT_PHASE
#define REPEAT_PHASE (-1)
#endif
constexpr int N_PHASES = 13 + (REPEAT_PHASE >= 0 ? 1 : 0);
__global__ void __launch_bounds__(NTHREADS, 2) fwd_kernel(Args args) {
    extern __shared__ __attribute__((aligned(16))) unsigned char lds_raw[];
    LAS unsigned char* lds = (LAS unsigned char*)lds_raw;
    const int tid = threadIdx.x, lane = tid & 63, wave = __builtin_amdgcn_readfirstlane(tid >> 6);
    const int bx = blockIdx.x, vcu = (bx % 8) * (GRID / 8) + bx / 8;
    unsigned char* ws = args.ws;
    volatile LAS unsigned* MISC = (volatile LAS unsigned*)(lds + MISC_OFF);
    for (int u = tid; u < 32; u += NTHREADS) MISC[u] = 0u;
    __syncthreads();
    XcdBarrier bar; bar.bar = (unsigned*)(ws + WS_CTL) + CW_BAR; bar.x = 0; bar.st = nullptr;
    const bool one_launch = (args.ph_hi - args.ph_lo) > 1;
    if (one_launch) bar = xcd_barrier_post((unsigned*)(ws + WS_CTL) + CW_BAR, MISC + 8);
#ifndef REPEAT_PHASE
#define REPEAT_PHASE (-1)
#endif
#ifndef PRO_PROBE
#define PRO_PROBE 15
#endif
#ifndef PHMASK
#define PHMASK 0xffff
#endif
#define EN(b) (((PHMASK) >> (b)) & 1)
#define LAUNDER() int tid_ = tid, vcu_ = vcu; asm volatile("" : "+v"(tid_)); asm volatile("" : "+s"(vcu_)); const int lane_ = tid_ & 63, wave_ = __builtin_amdgcn_readfirstlane(tid_ >> 6); (void)lane_; (void)wave_
#pragma unroll 1
    for (int pc = args.ph_lo; pc < args.ph_hi; ++pc) {
        const int ph = (REPEAT_PHASE >= 0 && pc > REPEAT_PHASE) ? pc - 1 : pc;
        const int l = ph >= 7 ? 1 : 0;
        const bool second = (REPEAT_PHASE >= 0 && pc == REPEAT_PHASE + 1); (void)second;
        const int kind = ph == 0 ? 6 : ((ph == 1 || ph == 7) ? 7 : (ph < 7 ? ph - 2 : ph - 8));
        const bf16_t* Wl = (const bf16_t*)(ws + WS_WIN) + (size_t)l * NPHYS * DM;
        LAUNDER();
        if (kind == 6) { if (EN(0)) ph0_prologue(args, lds, tid_, lane_, wave_, vcu_, second ? PRO_PROBE : 15); }
        else if (kind == 7) { if (EN(1)) prepass(args, ph == 1 ? 0 : 1, lds, tid_, lane_, wave_, vcu_); }
        else if (kind == 0) { if (EN(2)) {
            pg8::Gemm g{(const bf16_t*)(ws + WS_H), Wl, DM, DM, 0, 0, 0, 16, 16, 16};
            TileSched S{vcu_ >> 5, vcu_ & 31, 0, 14, 1, l == 0 ? 52 : 8, l == 0 ? 0 : 2, l == 0 ? 26 : 4};
            EpiIn E{ws, args.in[I_GQ] + l * 64, args.in[I_GK] + l * 64, (const float*)(ws + WS_ROPE), (const float*)(ws + WS_ROPE) + 2048};
            pg8::gemm_phase<EpiIn, TileSched, true, true>(lds, g, S, E, tid_); } }
        else if (kind == 1) { if (EN(4)) {
            if (!second) {
                if (EN(8)) f1_unit(ws, lds, vcu_, tid_, lane_, wave_);
                const int nsgu = l == 0 ? 132 : 128;
                if (EN(9)) for (int cu = 255 - vcu_; cu < nsgu; cu += GRID) sgu_unit(args, l, lds, cu, tid_, lane_, wave_);
                if (EN(10) && l == 0 && vcu_ < 8) ctxf_unit(args, l, lds, vcu_, tid_, lane_, wave_);
            }
            const int bh = vcu_ >> 5, qb = vcu_ & 31;
            if (EN(12)) {
                const int nun = (l == 0 && qb < 2) ? 3 : 2;
#pragma unroll 1
                for (int ui = 0; ui < nun; ++ui) {
                    const int qrow0 = ui < 2 ? (bh >> 2) * SEQ + 256 * qb + 128 * ui : MLAT + (bh >> 2) * NCTX + 128 * qb;
                    attn_unit(args, l, lds, bh >> 2, bh & 3, qrow0, ui < 2 ? 0 : SEQ / 64, ui < 2 ? NKT : NCTX / 64, tid_, lane_, wave_, second);
                }
            } } }
        else if (kind == 2) { if (EN(5)) {
            if (EN(11)) f2_unit(args, l, lds, vcu_, tid_, lane_, wave_);
            pg8::Gemm g{(const bf16_t*)(ws + WS_H), Wl, DM, DM, 0, 0, 0, 16, 16, 16};
            TileSched S{vcu_ >> 5, vcu_ & 31, 14, 12, 1, 0, 14, 12};
            EpiIn E{ws, nullptr, nullptr, nullptr, nullptr};
            pg8::gemm_phase<EpiIn, TileSched, true, true>(lds, g, S, E, tid_); } }
        else if (kind == 3) { if (EN(6)) {
            pg8::Gemm g{(const bf16_t*)(ws + WS_A), (const bf16_t*)(ws + WS_WBR) + (size_t)l * DM * DM, DM, DM, 0, 512, 768, 8, 4, 4};
            TileSched S{vcu_ >> 5, vcu_ & 31, 0, 4, 3, 0, 0, 4};
            if (l == 0) ctx_branch_proj(ws, (const bf16_t*)(ws + WS_WBR), vcu_ * NWAVES + wave_, lane_);
            EpiY E{(const unsigned char*)(ws + WS_MS), (bf16_t*)(ws + WS_H)};
            pg8::gemm_phase<EpiY, TileSched, true, true>(lds, g, S, E, tid_); } }
        else { if (EN(7)) {
            pg8::Gemm g{(const bf16_t*)(ws + WS_H), (const bf16_t*)(ws + WS_WOUT) + (size_t)l * DM * DM, DM, DM, 0, 0, 0, 16, 16, 16};
            TileSched S{vcu_ >> 5, vcu_ & 31, 0, 4, 1, 0, 0, 4};
            if (l == 0) ctx_out_proj(ws, (const bf16_t*)(ws + WS_WOUT), args.in[I_CTX], (const float*)(ws + WS_MODF) + 2 * 3072 + 2048, vcu_ * NWAVES + wave_, lane_);
            EpiOut E{l == 0 ? args.in[I_X] : args.out, args.out, args.in[I_CTX], (float*)(ws + WS_CTX1), (const float*)(ws + WS_MODF) + (size_t)(l * 3) * 3072 + 2048};
            pg8::gemm_phase<EpiOut, TileSched, true, true>(lds, g, S, E, tid_); } }
        if (pc + 1 < args.ph_hi) { XcdBarrier b2_ = bar; asm volatile("" : "+s"(b2_.bar)); xcd_barrier(b2_); }
    }
}

extern "C" void kernel_launch(void* const* d_in, const int* in_sizes, int n_in, void* d_out, int out_size, void* d_ws, size_t ws_size, hipStream_t stream) {
    static int ready = 0;
    if (ready == 0) {
        if (n_in != 25 || out_size != MLAT * DM || ws_size < 256 * MiB) { fprintf(stderr, "kernel_launch: unexpected shapes (n_in %d out %d ws %zu)\n", n_in, out_size, ws_size); ready = -1; return; }
        int dev = 0, cus = 0, per_cu = 0;
        hipGetDevice(&dev); hipDeviceGetAttribute(&cus, hipDeviceAttributeMultiprocessorCount, dev);
        if (hipFuncSetAttribute((const void*)fwd_kernel, hipFuncAttributeMaxDynamicSharedMemorySize, LDS_BYTES) != hipSuccess) { fprintf(stderr, "kernel_launch: hipFuncSetAttribute failed\n"); ready = -1; return; }
        hipOccupancyMaxActiveBlocksPerMultiprocessor(&per_cu, (const void*)fwd_kernel, NTHREADS, LDS_BYTES);
        (void)hipGetLastError();
        if (cus != GRID || per_cu < 1) fprintf(stderr, "kernel_launch: note: %d CUs, occupancy %d blocks/CU (built for 256 CUs, 1 block/CU)\n", cus, per_cu);
        ready = (cus >= GRID) ? 1 : -1;
    }
    if (ready < 0) return;
    hipMemsetAsync((char*)d_ws + WS_CTL, 0, CTL_ZERO_BYTES, stream);
    Args a{};
    for (int i = 0; i < 25; ++i) a.in[i] = (const float*)d_in[i];
    a.out = (float*)d_out; a.ws = (unsigned char*)d_ws;
#if MK_N_LAUNCHES == 1
    a.ph_lo = 0; a.ph_hi = N_PHASES;
    hipLaunchKernelGGL(fwd_kernel, dim3(GRID), dim3(NTHREADS), LDS_BYTES, stream, a);
#else
    for (int p = 0; p < N_PHASES; ++p) { a.ph_lo = p; a.ph_hi = p + 1; hipLaunchKernelGGL(fwd_kernel, dim3(GRID), dim3(NTHREADS), LDS_BYTES, stream, a); }
#endif
}
```

```cpp
#include <hip/hip_runtime.h>
#include <cstdio>
#include <cstdint>

#ifndef MK_N_LAUNCHES
#define MK_N_LAUNCHES 1
#endif

#define LAS __attribute__((address_space(3)))
#define GAS __attribute__((address_space(1)))
typedef unsigned short bf16_t;
typedef short bf16x8 __attribute__((ext_vector_type(8)));
typedef short s16x4 __attribute__((ext_vector_type(4)));
typedef float f32x4 __attribute__((ext_vector_type(4)));
typedef float f32x2 __attribute__((ext_vector_type(2)));
typedef float f32x16 __attribute__((ext_vector_type(16)));
typedef unsigned u32x4 __attribute__((ext_vector_type(4)));
typedef unsigned u32x2 __attribute__((ext_vector_type(2)));

constexpr int DM = 1024, BATCH = 2, SEQ = 8192, NCTX = 256, DEPTH = 2;
constexpr int MLAT = BATCH * SEQ, MCTX = BATCH * NCTX, MT = MLAT + MCTX;
constexpr int NKEY = SEQ + NCTX, NKT = NKEY / 64;
constexpr int INW = 6400;
constexpr int OFF_Q = 0, OFF_K = 512, OFF_V = 1024, OFF_F = 1536, OFF_U = 1792, OFF_VC = 2048, OFF_GATE = 2304, OFF_MERGE = 3328;
constexpr int NPHYS = 6656;
constexpr float EPS = 1e-6f;
constexpr float QSCALE = 0.125f * 1.4426950408889634f;

constexpr size_t KiB = 1024, MiB = 1u << 20;
constexpr size_t WS_CTL = 0, CTL_ZERO_BYTES = 64 * KiB;
constexpr size_t WS_MODP = 1 * MiB;
constexpr size_t WS_MODF = WS_MODP + 2304 * KiB;
constexpr size_t WS_ROPE = WS_MODF + 72 * KiB;
constexpr size_t WS_TW = WS_ROPE + 16 * KiB;
constexpr size_t WS_LAM = WS_TW + 64 * KiB;
constexpr size_t WS_C128 = WS_LAM + 1 * KiB;
constexpr size_t WS_S128 = WS_C128 + 32 * KiB;
constexpr size_t WS_T64 = WS_S128 + 32 * KiB;
constexpr size_t WS_TC256 = WS_T64 + 16 * KiB;
constexpr size_t WS_WSIMG = WS_TC256 + 256 * KiB;
constexpr size_t WS_SMALL_END = WS_WSIMG + 256 * KiB;
static_assert(WS_SMALL_END <= 5 * MiB, "small tables");
constexpr size_t WS_WIN = 5 * MiB;
constexpr size_t WS_WBR = 31 * MiB;
constexpr size_t WS_WOUT = 35 * MiB;
constexpr size_t WS_CTX1 = 39 * MiB;
constexpr size_t WS_H = 41 * MiB;
constexpr size_t WS_A = 74 * MiB;
constexpr size_t WS_R = 107 * MiB;
constexpr size_t SZ_QG = (size_t)MT * 512 * 2, SZ_KIMG = (size_t)BATCH * 4 * NKT * 16384, SZ_Z2 = (size_t)MT * 512 * 2, SZ_UG = (size_t)MT * 256 * 2, SZ_GS = (size_t)MT * 768 * 2;
constexpr size_t WS_QG = WS_R, WS_KIMG = WS_QG + SZ_QG, WS_VIMG = WS_KIMG + SZ_KIMG, WS_Z2 = WS_VIMG + SZ_KIMG, WS_UG = WS_Z2 + SZ_Z2, WS_VC = WS_UG + SZ_UG, WS_GS = WS_VC + SZ_UG;
constexpr size_t WS_MS = WS_R;
constexpr size_t WS_END = WS_GS + SZ_GS;
constexpr size_t WS_X1B0 = 229 * MiB, WS_X1B1 = 215 * MiB;
constexpr int X1B_SPLIT = 13824;
constexpr size_t WS_MSC = 224 * MiB;
static_assert(WS_X1B1 >= WS_END && WS_X1B1 + (size_t)(MLAT - X1B_SPLIT) * 2048 <= WS_MSC && WS_MSC + (size_t)MCTX * 3072 <= WS_X1B0 && WS_X1B0 + (size_t)X1B_SPLIT * 2048 <= 256 * MiB, "x1b map");
static_assert(WS_MS + (size_t)MT * 3072 <= WS_Z2 && WS_END <= WS_MSC && WS_MSC + (size_t)MCTX * 3072 * 2 <= 256 * MiB, "d_ws map");

__host__ __device__ __forceinline__ size_t x1b_off(int row) { return row < X1B_SPLIT ? WS_X1B0 + (size_t)row * 2048 : WS_X1B1 + (size_t)(row - X1B_SPLIT) * 2048; }
__device__ __forceinline__ unsigned f2bf(float f) { unsigned u = __builtin_bit_cast(unsigned, f); return (u + 0x7fffu + ((u >> 16) & 1u)) >> 16; }
__device__ __forceinline__ unsigned pk2(float lo, float hi) { return f2bf(lo) | (f2bf(hi) << 16); }
__device__ __forceinline__ unsigned cvt_pk_bf16(float lo, float hi) { unsigned r; asm volatile("v_cvt_pk_bf16_f32 %0, %1, %2" : "=v"(r) : "v"(lo), "v"(hi)); return r; }
__device__ __forceinline__ float bf2f(unsigned short v) { return __builtin_bit_cast(float, (unsigned)v << 16); }
__device__ __forceinline__ float bflo(unsigned w) { return __builtin_bit_cast(float, w << 16); }
__device__ __forceinline__ float bfhi(unsigned w) { return __builtin_bit_cast(float, w & 0xffff0000u); }
__device__ __forceinline__ float fast_sigmoid(float x) { return __builtin_amdgcn_rcpf(1.0f + __builtin_amdgcn_exp2f(-1.4426950408889634f * x)); }
__device__ __forceinline__ unsigned ms_quant_pk(float x, unsigned sel, unsigned old) { const float q = __builtin_amdgcn_rcpf((1.0f / 255.0f) + __builtin_amdgcn_exp2f(__builtin_fmaf(x, -1.4426950408889634f, -7.994353436858858f)));
    return __builtin_amdgcn_cvt_pk_u8_f32(__builtin_fmaxf(q, 1.0f), sel, old); }
__device__ __forceinline__ float ub(unsigned w, int i) { return (float)((w >> (8 * i)) & 0xffu); }
__device__ __forceinline__ float fast_silu(float x) { return x * fast_sigmoid(x); }
__device__ __forceinline__ int crow(int r, int hi) { return (r & 3) + 8 * (r >> 2) + 4 * hi; }
__host__ __device__ __forceinline__ int perm32(int rho) { const int n = rho >> 4, i = rho & 15; return 8 * (i >> 2) + 4 * n + (i & 3); }
__host__ __device__ __forceinline__ int invperm32(int c) { return 16 * ((c >> 2) & 1) + 4 * (c >> 3) + (c & 3); }
#define LDS_WAIT() asm volatile("s_waitcnt lgkmcnt(0)" ::: "memory")
#define VM_WAIT() asm volatile("s_waitcnt vmcnt(0)" ::: "memory")

namespace pg8 {
constexpr int BM = 256, BK = 64, HALF = 128, HTB = HALF * BK * 2  , STAGE_BYTES = 8 * HTB;
__host__ __device__ __forceinline__ int lds_byte(int r, int c) { const int st = (r >> 4) * 2 + (c >> 5), rr = r & 15, cc = c & 31, ob = rr * 64 + cc * 2; return st * 1024 + (ob ^ (((ob >> 9) & 1) << 5)); }
__host__ __device__ __forceinline__ void stage_rc(int b, int& R, int& C) { const int st = b / 1024, sb = b % 1024, swz = sb ^ (((sb >> 9) & 1) << 5); R = (st >> 1) * 16 + swz / 64; C = (st & 1) * 32 + (swz % 64) / 2; }

struct Unit { int pm, pn, seg; };
struct Gemm { const bf16_t* A; const bf16_t* Bt; int lda, ldb; int k0_0, k0_1, k0_2; int nt_0, nt_1, nt_2; };

template <class Epi, class Sched, bool ALIGN_EPI = false, bool SP2 = false>
__device__ __forceinline__ void gemm_phase(LAS unsigned char* lds, const Gemm g, const Sched& S, const Epi& E, const int tid) {
    const int wid = __builtin_amdgcn_readfirstlane(tid >> 6), lane = tid & 63, wr = wid >> 2, wc = wid & 3, fr = lane & 15, fq = lane >> 4;
    unsigned voffA[2], voffB[2];
#pragma unroll
    for (int i = 0; i < 2; ++i) { int R, C; stage_rc(tid * 16 + i * 8192, R, C); voffA[i] = (unsigned)(R * g.lda + C) * 2u; voffB[i] = (unsigned)(R * g.ldb + C) * 2u; }
    const size_t kstep = (size_t)(BK * 2);
    const size_t hstepA = (size_t)HALF * g.lda * 2, hstepB = (size_t)HALF * g.ldb * 2;
    const size_t tstepA = 2 * hstepA, tstepB = 2 * hstepB;
    const unsigned ldsw = (unsigned)wid * 1024u;
    const int aoff = lds_byte(wr * 64 + fr, fq * 8), boff = lds_byte(wc * 32 + fr, fq * 8);
#define PG8_SA(b, h) (((b) * 2 + (h)) * HTB)
#define PG8_SB(b, h) ((4 + (b) * 2 + (h)) * HTB)
#define PG8_STAGE(bufoff, gbase, voff) do { _Pragma("unroll") for (int _i = 0; _i < 2; ++_i) \
        __builtin_amdgcn_global_load_lds((const unsigned*)((const char*)(gbase) + (voff)[_i]), (LAS unsigned*)(lds + (bufoff) + ldsw + _i * 8192), 16, 0, 0); } while (0)
#define PG8_LDA(dst, b, h) do { _Pragma("unroll") for (int m = 0; m < 4; ++m) _Pragma("unroll") for (int k = 0; k < 2; ++k) dst[m][k] = *(const LAS bf16x8*)(lds + PG8_SA(b, h) + aoff + m * 2048 + k * 1024); } while (0)
#define PG8_LDB(dst, b, h) do { _Pragma("unroll") for (int n = 0; n < 2; ++n) _Pragma("unroll") for (int k = 0; k < 2; ++k) dst[n][k] = *(const LAS bf16x8*)(lds + PG8_SB(b, h) + boff + n * 2048 + k * 1024); } while (0)
#define PG8_MMA(ai, bj, At, Bt) do { __builtin_amdgcn_s_setprio(1); _Pragma("unroll") for (int m = 0; m < 4; ++m) _Pragma("unroll") for (int n = 0; n < 2; ++n) _Pragma("unroll") for (int k = 0; k < 2; ++k) \
        acc[ai][bj][m][n] = __builtin_amdgcn_mfma_f32_16x16x32_bf16(Bt[n][k], At[m][k], acc[ai][bj][m][n], 0, 0, 0); __builtin_amdgcn_s_setprio(0); } while (0)
#define PG8_WAIT_V(n) asm volatile("s_waitcnt vmcnt(" #n ")" ::: "memory")
#define PG8_WAIT_L(n) asm volatile("s_waitcnt lgkmcnt(" #n ")" ::: "memory")
#define PG8_BAR __builtin_amdgcn_s_barrier()
#define PG8_SCHED __builtin_amdgcn_sched_barrier(0)
#define PG8_K0(u) ((u).seg == 0 ? g.k0_0 : ((u).seg == 1 ? g.k0_1 : g.k0_2))
#define PG8_NT(u) ((u).seg == 0 ? g.nt_0 : ((u).seg == 1 ? g.nt_1 : g.nt_2))
#define PG8_UA(u) ((const char*)g.A + (size_t)(u).pm * tstepA + (size_t)PG8_K0(u) * 2)
#define PG8_UB(u) ((const char*)g.Bt + (size_t)(u).pn * tstepB + (size_t)PG8_K0(u) * 2)
    Unit cur, nxt; int ui = 0;
    if (!S.next(0, cur)) return;
    f32x4 acc[2][2][4][2];
#pragma unroll
    for (int a = 0; a < 2; ++a)
#pragma unroll
        for (int b = 0; b < 2; ++b)
#pragma unroll
            for (int m = 0; m < 4; ++m)
#pragma unroll
                for (int n = 0; n < 2; ++n) acc[a][b][m][n] = (f32x4){0.f, 0.f, 0.f, 0.f};
    bf16x8 At[4][2], B0[2][2], B1[2][2];
    const char* cA = PG8_UA(cur); const char* cB = PG8_UB(cur); int nt = PG8_NT(cur);
    if constexpr (SP2) {
        PG8_STAGE(PG8_SB(0, 0), cB, voffB); PG8_STAGE(PG8_SB(0, 1), cB + hstepB, voffB); PG8_STAGE(PG8_SA(0, 0), cA, voffA); PG8_STAGE(PG8_SA(0, 1), cA + hstepA, voffA);
        if (wr == 1) PG8_BAR;
        PG8_WAIT_V(2); PG8_BAR;
        PG8_STAGE(PG8_SB(1, 0), cB + kstep, voffB); PG8_STAGE(PG8_SA(1, 0), cA + kstep, voffA); PG8_STAGE(PG8_SB(1, 1), cB + hstepB + kstep, voffB);
        PG8_WAIT_V(6); PG8_BAR;
    } else {
        PG8_STAGE(PG8_SB(0, 0), cB, voffB); PG8_STAGE(PG8_SA(0, 0), cA, voffA); PG8_STAGE(PG8_SB(0, 1), cB + hstepB, voffB); PG8_STAGE(PG8_SA(0, 1), cA + hstepA, voffA);
        if (wr == 1) PG8_BAR;
        PG8_WAIT_V(4); PG8_BAR;
        PG8_STAGE(PG8_SB(1, 0), cB + kstep, voffB); PG8_STAGE(PG8_SA(1, 0), cA + kstep, voffA); PG8_STAGE(PG8_SB(1, 1), cB + hstepB + kstep, voffB);
        PG8_WAIT_V(6); PG8_BAR;
    }
    for (;;) {
        const bool has_next = S.next(ui + 1, nxt);
        const char* nA = has_next ? PG8_UA(nxt) : cA; const char* nB = has_next ? PG8_UB(nxt) : cB;
        for (int t = 0; t < nt; t += 2) {
            const bool last = (t == nt - 2);
            const char* a1 = cA + (size_t)(t + 1) * kstep;
            const char* a2 = last ? nA : cA + (size_t)(t + 2) * kstep; const char* b2 = last ? nB : cB + (size_t)(t + 2) * kstep;
            const char* a3 = a2 + kstep; const char* b3 = b2 + kstep;
            if constexpr (SP2) {
            PG8_LDB(B0, 0, 0); PG8_LDB(B1, 0, 1); PG8_SCHED; PG8_LDA(At, 0, 0); PG8_STAGE(PG8_SA(1, 1), a1 + hstepA, voffA);
            PG8_WAIT_V(8); PG8_WAIT_L(0); PG8_BAR; PG8_MMA(0, 0, At, B0); PG8_MMA(0, 1, At, B1); PG8_BAR; PG8_SCHED;
            PG8_LDA(At, 0, 1); PG8_STAGE(PG8_SB(0, 0), b2, voffB); PG8_STAGE(PG8_SB(0, 1), b2 + hstepB, voffB); PG8_STAGE(PG8_SA(0, 0), a2, voffA);
            PG8_WAIT_V(8); PG8_WAIT_L(0); PG8_BAR; PG8_MMA(1, 0, At, B0); PG8_MMA(1, 1, At, B1); PG8_BAR; PG8_SCHED;
            PG8_LDB(B0, 1, 0); PG8_LDB(B1, 1, 1); PG8_SCHED; PG8_LDA(At, 1, 0); PG8_STAGE(PG8_SA(0, 1), a2 + hstepA, voffA);
            PG8_WAIT_V(8); PG8_WAIT_L(0); PG8_BAR; PG8_MMA(0, 0, At, B0); PG8_MMA(0, 1, At, B1); PG8_BAR; PG8_SCHED;
            PG8_LDA(At, 1, 1); PG8_STAGE(PG8_SB(1, 0), b3, voffB); PG8_STAGE(PG8_SB(1, 1), b3 + hstepB, voffB); PG8_STAGE(PG8_SA(1, 0), a3, voffA);
            PG8_WAIT_V(8); PG8_WAIT_L(0); PG8_BAR; PG8_MMA(1, 0, At, B0); PG8_MMA(1, 1, At, B1); PG8_BAR; PG8_SCHED;
            } else {
            PG8_LDB(B0, 0, 0); PG8_SCHED; PG8_LDA(At, 0, 0); PG8_STAGE(PG8_SA(1, 1), a1 + hstepA, voffA);
            PG8_WAIT_L(8); PG8_BAR; PG8_WAIT_L(0); PG8_MMA(0, 0, At, B0); PG8_BAR; PG8_SCHED;
            PG8_LDB(B1, 0, 1); PG8_STAGE(PG8_SB(0, 0), b2, voffB);
            PG8_BAR; PG8_WAIT_L(0); PG8_MMA(0, 1, At, B1); PG8_BAR;
            PG8_LDA(At, 0, 1); PG8_STAGE(PG8_SA(0, 0), a2, voffA);
            PG8_BAR; PG8_WAIT_L(0); PG8_MMA(1, 0, At, B0); PG8_BAR; PG8_SCHED;
            PG8_STAGE(PG8_SB(0, 1), b2 + hstepB, voffB);
            PG8_WAIT_V(6); PG8_BAR; PG8_MMA(1, 1, At, B1); PG8_BAR;
            PG8_LDB(B0, 1, 0); PG8_SCHED; PG8_LDA(At, 1, 0); PG8_STAGE(PG8_SA(0, 1), a2 + hstepA, voffA);
            PG8_WAIT_L(8); PG8_BAR; PG8_WAIT_L(0); PG8_MMA(0, 0, At, B0); PG8_BAR; PG8_SCHED;
            PG8_LDB(B1, 1, 1); PG8_STAGE(PG8_SB(1, 0), b3, voffB);
            PG8_BAR; PG8_WAIT_L(0); PG8_MMA(0, 1, At, B1); PG8_BAR;
            PG8_LDA(At, 1, 1); PG8_STAGE(PG8_SA(1, 0), a3, voffA);
            PG8_BAR; PG8_WAIT_L(0); PG8_MMA(1, 0, At, B0); PG8_BAR; PG8_SCHED;
            PG8_STAGE(PG8_SB(1, 1), b3 + hstepB, voffB);
            PG8_WAIT_V(6); PG8_BAR; PG8_MMA(1, 1, At, B1); PG8_BAR;
            }
        }
        if constexpr (ALIGN_EPI) { if (wr == 0) PG8_BAR; }
        const bool reset_acc = E(acc, cur, wr, wc, fr, fq);
        if (!has_next) break;
        if (reset_acc) {
#pragma unroll
        for (int a = 0; a < 2; ++a)
#pragma unroll
            for (int b = 0; b < 2; ++b)
#pragma unroll
                for (int m = 0; m < 4; ++m)
#pragma unroll
                    for (int n = 0; n < 2; ++n) acc[a][b][m][n] = (f32x4){0.f, 0.f, 0.f, 0.f};
        }
        cur = nxt; cA = nA; cB = nB; nt = PG8_NT(cur); ++ui;
        if constexpr (ALIGN_EPI) { if (wr == 1) PG8_BAR; }
    }
    PG8_WAIT_V(0);
    if constexpr (!ALIGN_EPI) { if (wr == 0) PG8_BAR; }
    PG8_BAR;
#undef PG8_SA
#undef PG8_SB
#undef PG8_STAGE
#undef PG8_LDA
#undef PG8_LDB
#undef PG8_MMA
#undef PG8_WAIT_V
#undef PG8_WAIT_L
#undef PG8_BAR
#undef PG8_SCHED
#undef PG8_K0
#undef PG8_NT
#undef PG8_UA
#undef PG8_UB
}
}

#define XB_TMO      128
#define XB_XCNT(j)  (256  + 64 * (j))
#define XB_XSUB(j)  (1280 + 64 * (j))
#define XB_XGEN(j)  (2304 + 64 * (j))
#define XB_TOP      3328
#define XB_TOPGEN   3392
#define XCD_BAR_WORDS 3456
#define XB_SPIN_CAP (1u << 18)
__device__ __forceinline__ unsigned xb_ld(unsigned* p)              { return __hip_atomic_load(p, __ATOMIC_RELAXED, __HIP_MEMORY_SCOPE_AGENT); }
__device__ __forceinline__ unsigned xb_add(unsigned* p, unsigned v) { return __hip_atomic_fetch_add(p, v, __ATOMIC_RELAXED, __HIP_MEMORY_SCOPE_AGENT); }
__device__ __forceinline__ unsigned xb_xcc_id() { return (unsigned)__builtin_amdgcn_s_getreg((3 << 11) | 20) & 0xFu; }
#define XB_SPIN(cond, bar) do { unsigned _sp = 0; while (cond) { __builtin_amdgcn_s_sleep(1); \
    if ((++_sp & 255u) == 0u) { if (xb_ld(&(bar)[XB_TMO])) break; if (_sp > XB_SPIN_CAP) { atomicAdd(&(bar)[XB_TMO], 1u); break; } } } } while (0)
struct XcdBarrier { unsigned* bar; unsigned x; volatile LAS unsigned* st; };
__device__ __forceinline__ XcdBarrier xcd_barrier_post(unsigned* bar, volatile LAS unsigned* st) {
    XcdBarrier b; b.bar = bar; b.x = xb_xcc_id(); b.st = st;
    if (threadIdx.x == 0) (void)xb_add(&bar[XB_XCNT(b.x)], 1u);
    return b;
}
__device__ __forceinline__ void xcd_barrier_complete(unsigned* bar, unsigned x, unsigned& nloc, unsigned& nx) {
    const unsigned G = gridDim.x * gridDim.y * gridDim.z;
    unsigned sum, cnt, mine, sp = 0u;
    for (;;) {
        sum = 0u; cnt = 0u; mine = 0u;
#pragma unroll
        for (unsigned j = 0; j < 16; ++j) { const unsigned c = xb_ld(&bar[XB_XCNT(j)]); sum += c; cnt += (c > 0u) ? 1u : 0u; mine = (j == x) ? c : mine; }
        if (sum == G) break;
        __builtin_amdgcn_s_sleep(1);
        if ((++sp & 255u) == 0u) { if (xb_ld(&bar[XB_TMO])) break; if (sp > XB_SPIN_CAP) { atomicAdd(&bar[XB_TMO], 1u); break; } }
    }
    nloc = mine > 0u ? mine : 1u; nx = cnt > 0u ? cnt : 1u;
}
__device__ __forceinline__ void xcd_barrier(const XcdBarrier& b) {
    asm volatile("s_waitcnt vmcnt(0)" ::: "memory");
    __syncthreads();
    if (threadIdx.x == 0) {
        unsigned* bar = b.bar;
        __builtin_amdgcn_s_waitcnt(0);
        unsigned nloc = b.st[0], nx = b.st[1];
        if (nloc == 0u) { xcd_barrier_complete(bar, b.x, nloc, nx); b.st[0] = nloc; b.st[1] = nx; }
        const unsigned old = xb_add(&bar[XB_XSUB(b.x)], 1u);
        const unsigned gen = old / nloc;
        if (old + 1u == (gen + 1u) * nloc) {
            __builtin_amdgcn_fence(__ATOMIC_RELEASE, "agent");
            asm volatile("s_waitcnt vmcnt(0)" ::: "memory");
            const unsigned og = xb_add(&bar[XB_TOP], 1u);
            const unsigned tg = og / nx;
            if (og + 1u == (tg + 1u) * nx) xb_add(&bar[XB_TOPGEN], 1u);
            else XB_SPIN(xb_ld(&bar[XB_TOPGEN]) == tg, bar);
            __builtin_amdgcn_fence(__ATOMIC_ACQUIRE, "agent");
            xb_add(&bar[XB_XGEN(b.x)], 1u);
            asm volatile("s_waitcnt vmcnt(0)" ::: "memory");
        } else {
            XB_SPIN(xb_ld(&bar[XB_XGEN(b.x)]) == gen, bar);
            __builtin_amdgcn_fence(__ATOMIC_ACQUIRE, "agent");
            asm volatile("s_waitcnt vmcnt(0)" ::: "memory");
        }
    }
    __syncthreads();
}

constexpr int NWAVES = 8, NTHREADS = 512, GRID = 256;
constexpr int LDS_BYTES = 147456;
constexpr int MISC_OFF = 131072 + 320;
constexpr int CW_BAR = 4096;

struct Args {
    const float* in[25];
    float* out; unsigned char* ws;
    int ph_lo, ph_hi;
};

struct Frame {
    LAS unsigned char* lds;
    int tid, lane, wave, vcu;
    const float* const* in;
    float* out; unsigned char* ws;
};
enum { I_X = 0, I_C, I_CTX, I_CCTX, I_WADA, I_BADA, I_GNORM, I_WIN, I_GQ, I_GK, I_LQ1, I_LK1, I_LQ2, I_LK2, I_GSUB, I_WF, I_BF, I_LNG, I_LNB, I_WS, I_BS, I_WBRA, I_WBRB, I_WBRC, I_WOUT };

__device__ __forceinline__ void transpose_item(const float* W, int ldw, int k0, int lcol0, bool perm, bf16_t* dst, int ldd, int prow0, int dcol0, LAS float* scr, int lane) {
#pragma unroll 8
    for (int i = 0; i < 32; ++i) { const int kk = 2 * i + (lane >> 5); scr[kk * 33 + (lane & 31)] = W[(size_t)(k0 + kk) * ldw + lcol0 + (lane & 31)]; }
    LDS_WAIT(); asm volatile("" ::: "memory");
    const int c = lane & 7;
#pragma unroll
    for (int j = 0; j < 4; ++j) { const int n = (lane >> 3) + 8 * j; const int jn = perm ? perm32(n) : n; const LAS float* s = scr + (8 * c) * 33 + jn;
        u32x4 o; o.x = pk2(s[0 * 33], s[1 * 33]); o.y = pk2(s[2 * 33], s[3 * 33]); o.z = pk2(s[4 * 33], s[5 * 33]); o.w = pk2(s[6 * 33], s[7 * 33]);
        *(GAS u32x4*)(dst + (size_t)(prow0 + n) * ldd + dcol0 + k0 + 8 * c) = o; }
    LDS_WAIT(); asm volatile("" ::: "memory");
}
__device__ __forceinline__ bool win_block_map(int pb, int& lcol, bool& perm) {
    const int tile = pb >> 3, w = pb & 7, bj = w >> 2, wc = w & 3;
    if (tile < 2) { lcol = OFF_Q + (4 * (tile & 1) + wc) * 64 + 32 * bj; perm = false; return true; }
    if (tile < 4) { lcol = OFF_K + (4 * (tile & 1) + wc) * 64 + 32 * bj; perm = false; return true; }
    perm = true;
    if (tile < 6) { lcol = OFF_V + 256 * (tile - 4) + 32 * w; return true; }
    if (tile < 8) return false;
    if (tile < 10) { lcol = (bj == 0 ? OFF_U : OFF_GATE + 768) + 128 * (tile - 8) + 32 * wc; return true; }
    if (tile == 10) { lcol = OFF_VC + 32 * w; return true; }
    if (tile < 14) { lcol = OFF_GATE + 256 * (tile - 11) + 32 * w; return true; }
    lcol = OFF_MERGE + 256 * (tile - 14) + 32 * w; return true;
}
__device__ __forceinline__ float cos2pi(int a, int n) { return cospif(2.0f * (float)a / (float)n); }
__device__ __forceinline__ float sin2pi(int a, int n) { return sinpif(2.0f * (float)a / (float)n); }

__device__ __forceinline__ void ph0_prologue(const Args& a, LAS unsigned char* lds, int tid, int lane, int wave, int vcu, int pmask) {
    unsigned char* ws = a.ws;
    const int gw = vcu * NWAVES + wave, NGW = GRID * NWAVES;
    const int gt = vcu * NTHREADS + tid, NGT = GRID * NTHREADS;
    if (pmask & 1) {
        LAS float* scr = (LAS float*)(lds + wave * 16384);
        constexpr int I_WIN_N = DEPTH * 208 * 16;
        constexpr int I_BR_N = DEPTH * 32 * 16;
        constexpr int I_OUT_N = DEPTH * 32 * 16;
        for (int it = gw; it < I_WIN_N + I_BR_N + I_OUT_N; it += NGW) {
            int r = it;
            if (r < I_WIN_N) {
                const int l = r / (208 * 16), q = r % (208 * 16), pb = q >> 4, kb = q & 15; int lcol; bool perm;
                if (!win_block_map(pb, lcol, perm)) continue;
                transpose_item(a.in[I_WIN] + (size_t)l * DM * INW, INW, 64 * kb, lcol, perm, (bf16_t*)(ws + WS_WIN) + (size_t)l * NPHYS * DM, DM, 32 * pb, 0, scr, lane);
                continue;
            }
            r -= I_WIN_N;
            if (r < I_BR_N) {
                const int l = r / 512, q = r % 512, pb = q >> 4, kb = q & 15;
                const float* W; int ksrc;
                if (kb < 8) { W = a.in[I_WBRA] + (size_t)l * 512 * DM; ksrc = 64 * kb; } else if (kb < 12) { W = a.in[I_WBRB] + (size_t)l * 256 * DM; ksrc = 64 * (kb - 8); } else { W = a.in[I_WBRC] + (size_t)l * 256 * DM; ksrc = 64 * (kb - 12); }
                transpose_item(W, DM, ksrc, 32 * pb, true, (bf16_t*)(ws + WS_WBR) + (size_t)l * DM * DM, DM, 32 * pb, 64 * kb - ksrc, scr, lane);
                continue;
            }
            r -= I_BR_N;
            { const int l = r / 512, q = r % 512, pb = q >> 4, kb = q & 15;
              transpose_item(a.in[I_WOUT] + (size_t)l * DM * DM, DM, 64 * kb, 32 * pb, true, (bf16_t*)(ws + WS_WOUT) + (size_t)l * DM * DM, DM, 32 * pb, 0, scr, lane); }
        }
    }
    __syncthreads();
    if (pmask & 2) {
        LAS float* Wb = (LAS float*)lds;
        LAS float* TR = Wb + 64 * 65;
        LAS float* Tt = TR + 64 * 128;
        LAS float* Wf = Tt + 64 * 132;
        for (int it = vcu; it < DEPTH * 4 * 16; it += GRID) {
            const int l = it / 64, g = (it >> 4) & 3, kb = it & 15;
            const float* win = a.in[I_WIN] + (size_t)l * DM * INW; const float* wf = a.in[I_WF] + (size_t)(l * 4 + g) * 64 * 64;
            for (int e = tid; e < 4096; e += NTHREADS) { const int r = e >> 6, c = e & 63; Wb[r * 65 + c] = win[(size_t)(64 * kb + r) * INW + OFF_F + 64 * g + c]; Wf[e] = wf[e]; }
            for (int e = tid; e < 64 * 128; e += NTHREADS) { const int c = e >> 7, ri = (e >> 6) & 1, cp = e & 63; const int ph = (c * cp) & 63; TR[e] = ri ? -sin2pi(ph, 64) : cos2pi(ph, 64); }
            __syncthreads();
            const int tk = tid >> 5, tn = tid & 31;
            { f32x4 acc[4];
#pragma unroll
              for (int i = 0; i < 4; ++i) acc[i] = (f32x4){0.f, 0.f, 0.f, 0.f};
#pragma unroll 4
              for (int c = 0; c < 64; ++c) { const f32x4 bv = *(const LAS f32x4*)(TR + c * 128 + 4 * tn);
#pragma unroll
                  for (int i = 0; i < 4; ++i) acc[i] += bv * Wb[(4 * tk + i) * 65 + c]; }
#pragma unroll
              for (int i = 0; i < 4; ++i) *(LAS f32x4*)(Tt + (4 * tk + i) * 132 + 4 * tn) = acc[i]; }
            __syncthreads();
            { const int ri = tn >> 4, td = tn & 15;
              f32x4 acc[4];
#pragma unroll
              for (int i = 0; i < 4; ++i) acc[i] = (f32x4){0.f, 0.f, 0.f, 0.f};
#pragma unroll 4
              for (int cp = 0; cp < 64; ++cp) { const f32x4 bv = *(const LAS f32x4*)(Wf + cp * 64 + 4 * td);
#pragma unroll
                  for (int i = 0; i < 4; ++i) acc[i] += bv * Tt[(4 * tk + i) * 132 + ri * 64 + cp]; }
              bf16_t* dst = (bf16_t*)(ws + WS_WIN) + (size_t)l * NPHYS * DM;
#pragma unroll
              for (int e = 0; e < 4; ++e) { const int ch = 64 * g + 4 * td + e, prow = 6 * 256 + ri * 256 + (ch & ~31) + invperm32(ch & 31);
                  u32x2 w; w.x = pk2(acc[0][e], acc[1][e]); w.y = pk2(acc[2][e], acc[3][e]);
                  *(u32x2*)(dst + (size_t)prow * DM + 64 * kb + 4 * tk) = w; } }
            __syncthreads();
        }
    }
    if (pmask & 4) {
        float* ropec = (float*)(ws + WS_ROPE); float* ropes = ropec + 2048;
        for (int e = gt; e < 2048; e += NGT) { const int pos = e >> 4, f = e & 15; const float freq = powf(10000.0f, -(float)(2 * f) / 32.0f); const float ang = (float)pos * freq; ropec[e] = cosf(ang); ropes[e] = sinf(ang); }
        f32x2* tw = (f32x2*)(ws + WS_TW);
        for (int e = gt; e < 8192; e += NGT) tw[e] = (f32x2){cos2pi(e, 8192), sin2pi(e, 8192)};
        bf16_t* c128 = (bf16_t*)(ws + WS_C128); bf16_t* s128 = (bf16_t*)(ws + WS_S128);
        for (int e = gt; e < 4 * 8 * 64 * 8; e += NGT) { const int j = e & 7, ln = (e >> 3) & 63, s = (e >> 9) & 7, mb = e >> 12; const int row = 32 * mb + (ln & 31), k = 16 * s + 8 * (j >> 2) + 4 * (ln >> 5) + (j & 3);
            const int ph = (row * k) & 127; c128[e] = (bf16_t)f2bf(cos2pi(ph, 128)); s128[e] = (bf16_t)f2bf(sin2pi(ph, 128)); }
        bf16_t* t64 = (bf16_t*)(ws + WS_T64);
        for (int e = gt; e < 2 * 8 * 64 * 8; e += NGT) { const int j = e & 7, ln = (e >> 3) & 63, s = (e >> 9) & 7, mb = e >> 12; const int row = 32 * mb + (ln & 31), k = 16 * s + 8 * (j >> 2) + 4 * (ln >> 5) + (j & 3);
            const int ri = k >> 6, c = k & 63, ph = (row * c) & 63; t64[e] = (bf16_t)f2bf(ri ? sin2pi(ph, 64) : cos2pi(ph, 64)); }
        bf16_t* tc256 = (bf16_t*)(ws + WS_TC256);
        for (int e = gt; e < 8 * 32 * 64 * 8; e += NGT) { const int j = e & 7, ln = (e >> 3) & 63, s = (e >> 9) & 31, mb = e >> 14; const int row = 32 * mb + (ln & 31), k = 16 * s + 8 * (j >> 2) + 4 * (ln >> 5) + (j & 3);
            const int ri = k >> 8, n = k & 255, ph = (row * n) & 255; tc256[e] = (bf16_t)f2bf(ri ? sin2pi(ph, 256) : cos2pi(ph, 256)); }
        bf16_t* wsimg = (bf16_t*)(ws + WS_WSIMG);
        for (int e = gt; e < DEPTH * 4 * 4 * 8 * 64 * 8; e += NGT) { const int j = e & 7, ln = (e >> 3) & 63, s = (e >> 9) & 7, mb = (e >> 12) & 3, lg = e >> 14; const int row = 32 * mb + (ln & 31), k = 16 * s + 8 * (j >> 2) + 4 * (ln >> 5) + (j & 3);
            wsimg[e] = (bf16_t)f2bf(a.in[I_WS][(size_t)lg * 128 * 128 + row * 128 + k]); }
        if (gt < DEPTH) { const int l = gt; float s1 = 0.f, s2 = 0.f;
            for (int i = 0; i < 64; ++i) { s1 += a.in[I_LQ1][l * 64 + i] * a.in[I_LK1][l * 64 + i]; s2 += a.in[I_LQ2][l * 64 + i] * a.in[I_LK2][l * 64 + i]; }
            const float lam_init = 0.8f - 0.6f * expf(-0.3f * (float)l);
            float* lam = (float*)(ws + WS_LAM); lam[2 * l] = expf(s1) - expf(s2) + lam_init; lam[2 * l + 1] = 1.0f - lam_init; }
    }
    if (pmask & 8) {
        float* part = (float*)(ws + WS_MODP);
        for (int it = gw; it < DEPTH * 12 * 32; it += NGW) {
            const int l = it / 384, q = it % 384, cc = q >> 5, kc = q & 31; const int col = 256 * cc + 4 * lane;
            const float* w = a.in[I_WADA] + (size_t)l * DM * 3072 + col;
            f32x4 s0 = {0.f, 0.f, 0.f, 0.f}, s1 = s0, s2 = s0;
#pragma unroll 8
            for (int kk = 0; kk < 32; ++kk) { const int k = 32 * kc + kk; const f32x4 wv = *(const f32x4*)(w + (size_t)k * 3072);
                const float a0 = fast_silu(a.in[I_C][k]), a1 = fast_silu(a.in[I_C][DM + k]), a2 = fast_silu(a.in[I_CCTX][k]);
                s0 += wv * a0; s1 += wv * a1; s2 += wv * a2; }
            float* p = part + ((size_t)(l * 32 + kc) * 3) * 3072 + col;
            *(f32x4*)(p) = s0; *(f32x4*)(p + 3072) = s1; *(f32x4*)(p + 2 * 3072) = s2;
        }
    }
}

__device__ __forceinline__ void prepass(const Args& a, int l, LAS unsigned char* lds, int tid, int lane, int wave, int vcu) {
    unsigned char* ws = a.ws;
    const float* part = (const float*)(ws + WS_MODP); float* modf = (float*)(ws + WS_MODF);
    if (l == 0) {
        if (tid < 72) { const int o = vcu * 72 + tid; const int ll = o / 9216, rj = o % 9216, r = rj / 3072, j = rj % 3072; float s = a.in[I_BADA][ll * 3072 + j];
#pragma unroll 4
            for (int kc = 0; kc < 32; ++kc) s += part[((size_t)(ll * 32 + kc) * 3 + r) * 3072 + j];
            modf[o] = s; }
    }
    const int row0 = vcu * 66, row1 = row0 + 66;
    LAS float* coef = (LAS float*)lds;
    for (int r = 0; r < 3; ++r) {
        const int lo = r == 0 ? 0 : (r == 1 ? SEQ : MLAT), hi = r == 0 ? SEQ : (r == 1 ? MLAT : MT);
        if (row1 <= lo || row0 >= hi) continue;
        for (int k = tid; k < DM; k += NTHREADS) {
            float sh, sc;
            if (l == 0) { sh = a.in[I_BADA][k]; sc = a.in[I_BADA][DM + k];
#pragma unroll 4
                for (int kc = 0; kc < 32; ++kc) { const float* p = part + ((size_t)(kc) * 3 + r) * 3072; sh += p[k]; sc += p[DM + k]; } }
            else { sh = modf[(size_t)(l * 3 + r) * 3072 + k]; sc = modf[(size_t)(l * 3 + r) * 3072 + DM + k]; }
            coef[(r * 2) * DM + k] = a.in[I_GNORM][l * DM + k] * (1.0f + sc); coef[(r * 2 + 1) * DM + k] = sh;
        }
    }
    __syncthreads();
    const float* xlat = l == 0 ? a.in[I_X] : a.out; const float* xctx = l == 0 ? a.in[I_CTX] : (const float*)(ws + WS_CTX1);
    bf16_t* H = (bf16_t*)(ws + WS_H);
    for (int m = row0 + wave; m < row1; m += NWAVES) {
        const int r = m < SEQ ? 0 : (m < MLAT ? 1 : 2);
        const float* xrow = m < MLAT ? xlat + (size_t)m * DM : xctx + (size_t)(m - MLAT) * DM;
        const GAS f32x4* xr = (const GAS f32x4*)xrow + lane;
        f32x4 v[4]; float s2 = 0.f;
        if (l == 1 && m < MLAT) {
            const GAS u32x2* xb = (const GAS u32x2*)(ws + x1b_off(m)) + lane;
#pragma unroll
            for (int j = 0; j < 4; ++j) { const u32x2 t = xb[64 * j]; v[j] = (f32x4){bflo(t.x), bfhi(t.x), bflo(t.y), bfhi(t.y)}; }
        } else {
#pragma unroll
            for (int j = 0; j < 4; ++j) v[j] = xr[64 * j];
        }
#pragma unroll
        for (int j = 0; j < 4; ++j) s2 += (v[j].x * v[j].x + v[j].y * v[j].y) + (v[j].z * v[j].z + v[j].w * v[j].w);
#pragma unroll
        for (int o = 1; o < 64; o <<= 1) s2 += __shfl_xor(s2, o);
        const float rstd = rsqrtf(s2 * (1.0f / DM) + EPS);
        GAS u32x2* o8 = (GAS u32x2*)(H + (size_t)m * DM) + lane;
#pragma unroll
        for (int j = 0; j < 4; ++j) { const f32x4 ga = *(const LAS f32x4*)(coef + (r * 2) * DM + 256 * j + 4 * lane), sh = *(const LAS f32x4*)(coef + (r * 2 + 1) * DM + 256 * j + 4 * lane);
            const f32x4 h = v[j] * rstd * ga + sh; u32x2 w; w.x = pk2(h.x, h.y); w.y = pk2(h.z, h.w); o8[64 * j] = w; }
    }
    __syncthreads();
}

struct TileSched {
    int x, c, pn0, npn, nseg, nctx, cpn0, cnpn;
    __device__ __forceinline__ bool next(int i, pg8::Unit& u) const {
        const int ti = i / nseg; u.seg = i - ti * nseg;
        const int j = ti * 32 + c;
        if (j < 8 * npn) { u.pm = 8 * x + (j & 7); u.pn = pn0 + (j >> 3); return true; }
        const int id = (j - 8 * npn) * 8 + x;
        if (id < nctx) { u.pm = 64 + (id & 1); u.pn = cpn0 + (id >> 1); return true; }
        return false;
    }
};

struct EpiIn {
    unsigned char* ws; const float* gq; const float* gk; const float* ropec; const float* ropes;
    __device__ __forceinline__ bool operator()(f32x4 (&acc)[2][2][4][2], const pg8::Unit& u, int wr, int wc, int fr, int fq) const {
        const bool ctx = u.pm >= 64; const int b = ctx ? u.pm - 64 : (u.pm >> 5);
        const int rbase = u.pm * 256 + wr * 64 + fr;
        const int pn = u.pn;
        if (pn < 4) {
            const bool isK = pn >= 2; const int gi = 4 * (pn & 1) + wc, h = gi >> 1, comp = gi & 1;
            const float* gsrc = isK ? gk : gq;
            f32x4 gv[2][2];
#pragma unroll
            for (int bj = 0; bj < 2; ++bj)
#pragma unroll
                for (int n = 0; n < 2; ++n) gv[bj][n] = *(const f32x4*)(gsrc + 32 * bj + 16 * n + 4 * fq);
#pragma unroll
            for (int ai = 0; ai < 2; ++ai)
#pragma unroll
                for (int m = 0; m < 4; ++m) {
                    const int row = rbase + ai * 128 + m * 16;
                    f32x4 v[2][2]; float ss = 0.f;
#pragma unroll
                    for (int bj = 0; bj < 2; ++bj)
#pragma unroll
                        for (int n = 0; n < 2; ++n) { v[bj][n] = acc[ai][bj][m][n]; ss += (v[bj][n].x * v[bj][n].x + v[bj][n].y * v[bj][n].y) + (v[bj][n].z * v[bj][n].z + v[bj][n].w * v[bj][n].w); }
                    ss += __shfl_xor(ss, 16); ss += __shfl_xor(ss, 32);
                    const float rstd = rsqrtf(ss * (1.0f / 64.0f) + EPS);
#pragma unroll
                    for (int bj = 0; bj < 2; ++bj)
#pragma unroll
                        for (int n = 0; n < 2; ++n) v[bj][n] = v[bj][n] * rstd * gv[bj][n];
                    int kx;
                    if (!ctx) { const int ntok = row - b * SEQ; kx = ntok;
#pragma unroll
                        for (int bj = 0; bj < 2; ++bj) { const int pos = bj == 0 ? (ntok >> 6) : (ntok & 63);
                            const f32x4 c4 = *(const f32x4*)(ropec + pos * 16 + 4 * fq), s4 = *(const f32x4*)(ropes + pos * 16 + 4 * fq);
                            const f32x4 x1 = v[bj][0], x2 = v[bj][1]; v[bj][0] = x1 * c4 - x2 * s4; v[bj][1] = x2 * c4 + x1 * s4; } }
                    else kx = SEQ + (row - MLAT - b * NCTX);
#pragma unroll
                    for (int bj = 0; bj < 2; ++bj) {
                        f32x4 p0 = v[bj][0], p1 = v[bj][1];
                        if (!isK) { p0 = p0 * QSCALE; p1 = p1 * QSCALE; }
                        u32x4 w; w.x = cvt_pk_bf16(p0.x, p0.y); w.y = cvt_pk_bf16(p0.z, p0.w); w.z = cvt_pk_bf16(p1.x, p1.y); w.w = cvt_pk_bf16(p1.z, p1.w);
                        if (!isK) *(u32x4*)((bf16_t*)(ws + WS_QG) + ((size_t)row * 4 + h) * 128 + comp * 64 + (bj * 4 + fq) * 8) = w;
                        else *(u32x4*)(ws + WS_KIMG + ((size_t)((b * 4 + h) * NKT + (kx >> 6)) * 16 + comp * 8 + bj * 4 + fq) * 1024 + (kx & 63) * 16) = w;
                    }
                }
            return true;
        }
#pragma unroll
        for (int ai = 0; ai < 2; ++ai)
#pragma unroll
            for (int m = 0; m < 4; ++m) {
                const int row = rbase + ai * 128 + m * 16;
                if (pn == 8 || pn == 9) {
                    f32x4 p0, p1;
#pragma unroll
                    for (int e = 0; e < 4; ++e) { p0[e] = acc[ai][0][m][0][e] * fast_silu(acc[ai][1][m][0][e]); p1[e] = acc[ai][0][m][1][e] * fast_silu(acc[ai][1][m][1][e]); }
                    u32x4 w; w.x = cvt_pk_bf16(p0.x, p0.y); w.y = cvt_pk_bf16(p0.z, p0.w); w.z = cvt_pk_bf16(p1.x, p1.y); w.w = cvt_pk_bf16(p1.z, p1.w);
                    *(u32x4*)((bf16_t*)(ws + WS_UG) + (size_t)row * 256 + 128 * (pn - 8) + 32 * wc + 8 * fq) = w;
                    continue;
                }
#pragma unroll
                for (int bj = 0; bj < 2; ++bj) {
                    f32x4 p0 = acc[ai][bj][m][0], p1 = acc[ai][bj][m][1];
                    const int lc = 128 * bj + 32 * wc + 8 * fq;
                    unsigned char* dst;
                    if (pn < 6) { const int kx = ctx ? SEQ + (row - MLAT - b * NCTX) : row - b * SEQ; const int h = 2 * (pn - 4) + bj;
                        dst = ws + WS_VIMG + ((size_t)((b * 4 + h) * NKT + (kx >> 6)) * 16 + wc * 4 + ((kx & 63) >> 4)) * 1024 + (kx & 15) * 64 + fq * 16; }
                    else if (pn < 8) dst = ws + WS_Z2 + ((size_t)row * 512 + 256 * (pn - 6) + lc) * 2;
                    else if (pn == 10) dst = ws + WS_VC + ((size_t)row * 256 + lc) * 2;
                    else if (pn < 14) {
#pragma unroll
                        for (int e = 0; e < 4; ++e) { p0[e] = fast_silu(p0[e]); p1[e] = fast_silu(p1[e]); }
                        dst = ws + WS_GS + ((size_t)row * 768 + 256 * (pn - 11) + lc) * 2; }
                    else {
                        unsigned q0 = 0u, q1 = 0u;
#pragma unroll
                        for (int e = 0; e < 4; ++e) { q0 = ms_quant_pk(p0[e], e, q0); q1 = ms_quant_pk(p1[e], e, q1); }
                        unsigned char* d8 = ctx ? ws + WS_MSC + ((size_t)(row - MLAT) * 3072 + 256 * (pn - 14) + lc) : ws + WS_MS + ((size_t)row * 3072 + 256 * (pn - 14) + lc);
                        u32x2 w8; w8.x = q0; w8.y = q1; *(u32x2*)d8 = w8; continue; }
                    u32x4 w; w.x = cvt_pk_bf16(p0.x, p0.y); w.y = cvt_pk_bf16(p0.z, p0.w); w.z = cvt_pk_bf16(p1.x, p1.y); w.w = cvt_pk_bf16(p1.z, p1.w);
                    *(u32x4*)dst = w;
                }
            }
        return true;
    }
};

struct EpiY {
    const unsigned char* MS; bf16_t* Y;
    __device__ __forceinline__ bool operator()(f32x4 (&acc)[2][2][4][2], const pg8::Unit& u, int wr, int wc, int fr, int fq) const {
        const int rbase = u.pm * 256 + wr * 64 + fr; const int seg = u.seg;
#pragma unroll
        for (int ai = 0; ai < 2; ++ai)
#pragma unroll
            for (int m = 0; m < 4; ++m) {
                const int row = rbase + ai * 128 + m * 16;
#pragma unroll
                for (int bj = 0; bj < 2; ++bj) {
                    const int col = 256 * u.pn + 128 * bj + 32 * wc + 8 * fq;
                    const unsigned char* mp = MS + (size_t)row * 3072 + seg * 1024 + col;
                    const u32x2 mn = *(const u32x2*)mp;
                    f32x4& p0 = acc[ai][bj][m][0]; f32x4& p1 = acc[ai][bj][m][1];
                    if (seg < 2) { const u32x2 md = *(const u32x2*)(mp + 1024);
#pragma unroll
                        for (int e = 0; e < 4; ++e) { p0[e] *= ub(mn.x, e) * __builtin_amdgcn_rcpf(ub(md.x, e)); p1[e] *= ub(mn.y, e) * __builtin_amdgcn_rcpf(ub(md.y, e)); } }
                    else {
#pragma unroll
                        for (int e = 0; e < 4; ++e) { p0[e] *= ub(mn.x, e) * (1.0f / 255.0f); p1[e] *= ub(mn.y, e) * (1.0f / 255.0f); }
                        u32x4 w; w.x = cvt_pk_bf16(p0[0], p0[1]); w.y = cvt_pk_bf16(p0[2], p0[3]); w.z = cvt_pk_bf16(p1[0], p1[1]); w.w = cvt_pk_bf16(p1[2], p1[3]);
                        *(u32x4*)(Y + (size_t)row * DM + col) = w; }
                }
            }
        return seg == 2;
    }
};

struct EpiOut {
    const float* xin; float* out; unsigned char* ws; const float* gate; int layer;
    __device__ __forceinline__ bool operator()(f32x4 (&acc)[2][2][4][2], const pg8::Unit& u, int wr, int wc, int fr, int fq) const {
        const int r = u.pm >> 5;
        const int rbase = u.pm * 256 + wr * 64 + fr;
        f32x4 xa[2][2], xb[2][2], xc[2][2];
#define EO_C(g) (256 * u.pn + 128 * ((g) >> 2) + 32 * wc + 8 * fq)
#define EO_ROW(g, mm) (rbase + (((g) >> 1) & 1) * 128 + (2 * ((g) & 1) + (mm)) * 16)
#define EO_LOAD(dst, g) do { _Pragma("unroll") for (int mm = 0; mm < 2; ++mm) { \
            if (layer == 0) { const float* p_ = xin + (size_t)EO_ROW(g, mm) * DM + EO_C(g); dst[mm][0] = *(const f32x4*)p_; dst[mm][1] = *(const f32x4*)(p_ + 4); } \
            else { const u32x4 t_ = *(const u32x4*)(ws + x1b_off(EO_ROW(g, mm)) + (size_t)EO_C(g) * 2); dst[mm][0] = (f32x4){bflo(t_.x), bfhi(t_.x), bflo(t_.y), bfhi(t_.y)}; dst[mm][1] = (f32x4){bflo(t_.z), bfhi(t_.z), bflo(t_.w), bfhi(t_.w)}; } } } while (0)
#define EO_STORE(srcv, g) do { const f32x4 g0_ = *(const f32x4*)(gate + (size_t)r * 3072 + EO_C(g)), g1_ = *(const f32x4*)(gate + (size_t)r * 3072 + EO_C(g) + 4); \
            _Pragma("unroll") for (int mm = 0; mm < 2; ++mm) { \
                const f32x4 y0_ = srcv[mm][0] + g0_ * acc[((g) >> 1) & 1][(g) >> 2][2 * ((g) & 1) + mm][0], y1_ = srcv[mm][1] + g1_ * acc[((g) >> 1) & 1][(g) >> 2][2 * ((g) & 1) + mm][1]; \
                if (layer == 0) { u32x4 w_; w_.x = cvt_pk_bf16(y0_.x, y0_.y); w_.y = cvt_pk_bf16(y0_.z, y0_.w); w_.z = cvt_pk_bf16(y1_.x, y1_.y); w_.w = cvt_pk_bf16(y1_.z, y1_.w); *(u32x4*)(ws + x1b_off(EO_ROW(g, mm)) + (size_t)EO_C(g) * 2) = w_; } \
                else { float* p_ = out + (size_t)EO_ROW(g, mm) * DM + EO_C(g); *(f32x4*)p_ = y0_; *(f32x4*)(p_ + 4) = y1_; } } } while (0)
        EO_LOAD(xa, 0); EO_LOAD(xb, 1); EO_LOAD(xc, 2);
        EO_STORE(xa, 0); EO_LOAD(xa, 3);
        EO_STORE(xb, 1); EO_LOAD(xb, 4);
        EO_STORE(xc, 2); EO_LOAD(xc, 5);
        EO_STORE(xa, 3); EO_LOAD(xa, 6);
        EO_STORE(xb, 4); EO_LOAD(xb, 7);
        EO_STORE(xc, 5); EO_STORE(xa, 6); EO_STORE(xb, 7);
#undef EO_C
#undef EO_ROW
#undef EO_LOAD
#undef EO_STORE
        return true;
    }
};

__device__ __forceinline__ f32x4 mini_block(const bf16_t* A, int lda, const bf16_t* Bt, int ldb, int m0, int n0, int k0, int nk, int fr, int fq, f32x4 acc) {
    const bf16_t* ap = A + (size_t)(m0 + fr) * lda + k0 + 8 * fq; const bf16_t* bp = Bt + (size_t)(n0 + fr) * ldb + k0 + 8 * fq;
#pragma unroll 8
    for (int s = 0; s < nk; s += 32) acc = __builtin_amdgcn_mfma_f32_16x16x32_bf16(*(const bf16x8*)(bp + s), *(const bf16x8*)(ap + s), acc, 0, 0, 0);
    return acc;
}
__device__ __forceinline__ int mini_lcol(int n0, int fq) { return (n0 & ~31) + 8 * fq + 4 * ((n0 >> 4) & 1); }
__device__ __forceinline__ void ctx_merge_gates(unsigned char* ws, const bf16_t* Wl, int gw, int lane) {
    const int fr = lane & 15, fq = lane >> 4; const bf16_t* H = (const bf16_t*)(ws + WS_H); bf16_t* MS = (bf16_t*)(ws + WS_MS);
    for (int blk = gw; blk < 32 * 192; blk += GRID * NWAVES) { const int m0 = MLAT + 16 * (blk & 31), n0 = 16 * (blk >> 5);
        const f32x4 acc = mini_block(H, DM, Wl + (size_t)(14 * 256) * DM, DM, m0, n0, 0, DM, fr, fq, (f32x4){0.f, 0.f, 0.f, 0.f});
        u32x2 w; w.x = cvt_pk_bf16(fast_sigmoid(acc[0]), fast_sigmoid(acc[1])); w.y = cvt_pk_bf16(fast_sigmoid(acc[2]), fast_sigmoid(acc[3]));
        *(u32x2*)(MS + (size_t)(m0 + fr) * 3072 + mini_lcol(n0, fq)) = w; }
}
__device__ __forceinline__ void ctx_branch_proj(unsigned char* ws, const bf16_t* Wbr, int gw, int lane) {
    const int fr = lane & 15, fq = lane >> 4; const bf16_t* A = (const bf16_t*)(ws + WS_A); const unsigned char* MS = (const unsigned char*)(ws + WS_MSC) - (size_t)MLAT * 3072; bf16_t* Y = (bf16_t*)(ws + WS_H);
    for (int blk = gw; blk < 32 * 64; blk += GRID * NWAVES) { const int m0 = MLAT + 16 * (blk & 31), n0 = 16 * (blk >> 5); const int lc = mini_lcol(n0, fq);
        f32x4 y = {0.f, 0.f, 0.f, 0.f};
#pragma unroll
        for (int seg = 0; seg < 3; ++seg) { const int k0 = seg == 0 ? 0 : (seg == 1 ? 512 : 768), nk = seg == 0 ? 512 : 256;
            const f32x4 acc = mini_block(A, DM, Wbr, DM, m0, n0, k0, nk, fr, fq, (f32x4){0.f, 0.f, 0.f, 0.f});
            const unsigned mg = *(const unsigned*)(MS + (size_t)(m0 + fr) * 3072 + seg * 1024 + lc);
            y[0] += acc[0] * ub(mg, 0) * (1.0f / 255.0f); y[1] += acc[1] * ub(mg, 1) * (1.0f / 255.0f); y[2] += acc[2] * ub(mg, 2) * (1.0f / 255.0f); y[3] += acc[3] * ub(mg, 3) * (1.0f / 255.0f); }
        u32x2 w; w.x = cvt_pk_bf16(y[0], y[1]); w.y = cvt_pk_bf16(y[2], y[3]);
        *(u32x2*)(Y + (size_t)(m0 + fr) * DM + lc) = w; }
}
__device__ __forceinline__ void ctx_out_proj(unsigned char* ws, const bf16_t* Wout, const float* ctx_in, const float* gate_ctx, int gw, int lane) {
    const int fr = lane & 15, fq = lane >> 4; const bf16_t* Y = (const bf16_t*)(ws + WS_H); float* C1 = (float*)(ws + WS_CTX1);
    for (int blk = gw; blk < 32 * 64; blk += GRID * NWAVES) { const int m0 = MLAT + 16 * (blk & 31), n0 = 16 * (blk >> 5);
        const f32x4 acc = mini_block(Y, DM, Wout, DM, m0, n0, 0, DM, fr, fq, (f32x4){0.f, 0.f, 0.f, 0.f});
        const int col = mini_lcol(n0, fq); const size_t off = (size_t)(m0 - MLAT + fr) * DM + col;
        const f32x4 g = *(const f32x4*)(gate_ctx + col), x = *(const f32x4*)(ctx_in + off);
        *(f32x4*)(C1 + off) = x + g * acc; }
}

typedef short v4i16_t __attribute__((ext_vector_type(4)));
__device__ __forceinline__ s16x4 vtr(LAS const unsigned char* p) { return __builtin_bit_cast(s16x4, __builtin_amdgcn_ds_read_tr16_b64_v4i16((LAS v4i16_t*)p)); }
__device__ __forceinline__ int tr_lane_off(int lane) { return ((lane >> 4) & 1) * 32 + (lane & 3) * 8 + (4 * (lane >> 5) + ((lane & 15) >> 2)) * 64; }
__device__ __forceinline__ bf16x8 bfrag(LAS const unsigned char* piece_plus_laneoff) {
    const s16x4 lo = vtr(piece_plus_laneoff), hi = vtr(piece_plus_laneoff + 512);
    return (bf16x8){lo[0], lo[1], lo[2], lo[3], hi[0], hi[1], hi[2], hi[3]};
}
template <class RP> __device__ __forceinline__ void stage_pieces(LAS unsigned char* dst, int nrows, int ncols, RP rp, int tid) {
    const int cpr = ncols >> 3, total = nrows * cpr, pcs = ncols >> 5;
    for (int c = tid; c < total; c += NTHREADS) { const int row = c / cpr, cc = c - row * cpr;
        const u32x4 v = *(const u32x4*)(rp(row) + cc * 8);
        *(LAS u32x4*)(dst + ((row >> 4) * pcs + (cc >> 2)) * 1024 + (row & 15) * 64 + (cc & 3) * 16) = v; }
}
#define MFMA32(a, b, c) __builtin_amdgcn_mfma_f32_32x32x16_bf16(a, b, c, 0, 0, 0)
__device__ __forceinline__ bf16x8 afrag_img(const bf16_t* img, int KS, int mb, int s, int lane) { return *(const bf16x8*)(img + ((size_t)(mb * KS + s) * 64 + lane) * 8); }

__device__ __forceinline__ void f1_unit(unsigned char* ws, LAS unsigned char* lds, int unit, int tid, int lane, int wave) {
    const int b = unit >> 7, c = (unit >> 1) & 63, chh = unit & 1;
    bf16_t* Z2 = (bf16_t*)(ws + WS_Z2);
    const bf16_t* base = Z2 + ((size_t)(b * SEQ + c)) * 512 + chh * 128;
    stage_pieces(lds, 128, 128, [&](int r) { return base + (size_t)r * 64 * 512; }, tid);
    stage_pieces(lds + 32768, 128, 128, [&](int r) { return base + (size_t)r * 64 * 512 + 256; }, tid);
    __syncthreads();
    const int mb = wave & 3, cbp = wave >> 2, hi = lane >> 5, r32 = lane & 31, lo = tr_lane_off(lane);
    const bf16_t* c128 = (const bf16_t*)(ws + WS_C128); const bf16_t* s128 = (const bf16_t*)(ws + WS_S128);
    f32x16 outr[2], t1[2], t2[2];
#pragma unroll
    for (int e = 0; e < 2; ++e) { outr[e] = f32x16{}; t1[e] = f32x16{}; t2[e] = f32x16{}; }
#pragma unroll 1
    for (int s = 0; s < 8; ++s) {
        const bf16x8 cf = afrag_img(c128, 8, mb, s, lane), sf = afrag_img(s128, 8, mb, s, lane);
#pragma unroll
        for (int e = 0; e < 2; ++e) {
            const bf16x8 xr = bfrag(lds + (s * 4 + 2 * cbp + e) * 1024 + lo), xi = bfrag(lds + 32768 + (s * 4 + 2 * cbp + e) * 1024 + lo);
            outr[e] = MFMA32(cf, xr, outr[e]); outr[e] = MFMA32(sf, xi, outr[e]); t1[e] = MFMA32(cf, xi, t1[e]); t2[e] = MFMA32(sf, xr, t2[e]);
        }
    }
    const f32x2* tw = (const f32x2*)(ws + WS_TW);
#pragma unroll
    for (int e = 0; e < 2; ++e)
#pragma unroll
        for (int r = 0; r < 16; ++r) {
            const int k1 = 32 * mb + crow(r, hi), ch = chh * 128 + 32 * (2 * cbp + e) + r32;
            const float yr = outr[e][r], yi = t1[e][r] - t2[e][r];
            const f32x2 t = tw[(c * k1) & 8191];
            bf16_t* o = Z2 + ((size_t)(b * SEQ + 64 * k1 + c)) * 512 + ch;
            o[0] = (bf16_t)f2bf(yr * t.x + yi * t.y); o[256] = (bf16_t)f2bf(yi * t.x - yr * t.y);
            if ((r & 3) == 3) __builtin_amdgcn_sched_barrier(0);
        }
    __syncthreads();
}

__device__ __forceinline__ void sgu_unit(const Args& a, int l, LAS unsigned char* lds, int cu, int tid, int lane, int wave) {
    unsigned char* ws = a.ws;
    const int row0 = cu < 128 ? cu * 128 : MLAT + (cu - 128) * 128;
    const bf16_t* VC = (const bf16_t*)(ws + WS_VC);
    {
        const int tok = tid >> 2, qt = tid & 3;
        const u32x4* src = (const u32x4*)(VC + (size_t)(row0 + tok) * 256 + qt * 64);
        u32x4 raw[8]; float s = 0.f;
#pragma unroll
        for (int i = 0; i < 8; ++i) { raw[i] = src[i]; s += (bflo(raw[i].x) + bfhi(raw[i].x)) + (bflo(raw[i].y) + bfhi(raw[i].y)) + (bflo(raw[i].z) + bfhi(raw[i].z)) + (bflo(raw[i].w) + bfhi(raw[i].w)); }
        s += __shfl_xor(s, 1); s += __shfl_xor(s, 2);
        const float mu = s * (1.0f / 256.0f); float q = 0.f;
#pragma unroll
        for (int i = 0; i < 8; ++i) {
#pragma unroll
            for (int e = 0; e < 4; ++e) { const float d0 = bflo(raw[i][e]) - mu, d1 = bfhi(raw[i][e]) - mu; q += d0 * d0 + d1 * d1; } }
        q += __shfl_xor(q, 1); q += __shfl_xor(q, 2);
        const float rstd = rsqrtf(q * (1.0f / 256.0f) + EPS);
        const float* lg = a.in[I_LNG] + l * 256 + qt * 64; const float* lb = a.in[I_LNB] + l * 256 + qt * 64;
#pragma unroll
        for (int i = 0; i < 8; ++i) { u32x4 w;
#pragma unroll
            for (int e = 0; e < 4; ++e) { const int ch = 8 * i + 2 * e; w[e] = pk2((bflo(raw[i][e]) - mu) * rstd * lg[ch] + lb[ch], (bfhi(raw[i][e]) - mu) * rstd * lg[ch + 1] + lb[ch + 1]); }
            const int cc = qt * 8 + i;
            *(LAS u32x4*)(lds + ((tok >> 4) * 8 + (cc >> 2)) * 1024 + (tok & 15) * 64 + (cc & 3) * 16) = w; __builtin_amdgcn_sched_barrier(0); }
    }
    __syncthreads();
    const int g = wave >> 1, ph = wave & 1, hi = lane >> 5, r32 = lane & 31, lo = tr_lane_off(lane);
    const bf16_t* img = (const bf16_t*)(ws + WS_WSIMG) + (size_t)(l * 4 + g) * 16384;
    f32x16 acc[2][2];
#pragma unroll
    for (int i = 0; i < 2; ++i) { acc[i][0] = f32x16{}; acc[i][1] = f32x16{}; }
#pragma unroll 1
    for (int s = 0; s < 8; ++s) {
        const bf16x8 a0 = afrag_img(img, 8, 2 * ph, s, lane), a1 = afrag_img(img, 8, 2 * ph + 1, s, lane);
        const bf16x8 b0 = bfrag(lds + (s * 8 + 2 * g) * 1024 + lo), b1 = bfrag(lds + (s * 8 + 2 * g + 1) * 1024 + lo);
        acc[0][0] = MFMA32(a0, b0, acc[0][0]); acc[0][1] = MFMA32(a0, b1, acc[0][1]); acc[1][0] = MFMA32(a1, b0, acc[1][0]); acc[1][1] = MFMA32(a1, b1, acc[1][1]);
    }
    const bf16_t* UG = (const bf16_t*)(ws + WS_UG); bf16_t* A = (bf16_t*)(ws + WS_A);
    const float* bs = a.in[I_BS] + (size_t)(l * 4 + g) * 128;
#pragma unroll
    for (int i = 0; i < 2; ++i)
#pragma unroll
        for (int e = 0; e < 2; ++e)
#pragma unroll
            for (int r = 0; r < 16; ++r) { const int p = 32 * (2 * ph + i) + crow(r, hi), ch = 64 * g + 32 * e + r32;
                const float sv = acc[i][e][r] + bs[p]; const float ug = bf2f(UG[(size_t)(row0 + p) * 256 + ch]);
                A[(size_t)(row0 + p) * DM + 768 + ch] = (bf16_t)f2bf(ug * sv); if ((r & 3) == 3) __builtin_amdgcn_sched_barrier(0); }
    __syncthreads();
}

__device__ __forceinline__ void ctxf_unit(const Args& a, int l, LAS unsigned char* lds, int unit, int tid, int lane, int wave) {
    unsigned char* ws = a.ws;
    const int b = unit >> 2, chq = unit & 3;
    const bf16_t* Z2 = (const bf16_t*)(ws + WS_Z2);
    stage_pieces(lds, 512, 64, [&](int k) { return Z2 + (size_t)(MLAT + b * NCTX + (k & 255)) * 512 + (k >> 8) * 256 + chq * 64; }, tid);
    __syncthreads();
    const int mb = wave, hi = lane >> 5, r32 = lane & 31, lo = tr_lane_off(lane);
    const bf16_t* img = (const bf16_t*)(ws + WS_TC256);
    f32x16 acc[2]; acc[0] = f32x16{}; acc[1] = f32x16{};
#pragma unroll 4
    for (int s = 0; s < 32; ++s) { const bf16x8 af = afrag_img(img, 32, mb, s, lane);
        acc[0] = MFMA32(af, bfrag(lds + (s * 2) * 1024 + lo), acc[0]); acc[1] = MFMA32(af, bfrag(lds + (s * 2 + 1) * 1024 + lo), acc[1]); }
    const bf16_t* GS = (const bf16_t*)(ws + WS_GS); bf16_t* A = (bf16_t*)(ws + WS_A);
#pragma unroll
    for (int e = 0; e < 2; ++e)
#pragma unroll
        for (int r = 0; r < 16; ++r) { const int np = 32 * mb + crow(r, hi), ch = 64 * chq + 32 * e + r32; const size_t row = MLAT + b * NCTX + np;
            const float v = acc[e][r] * (1.0f / 128.0f) + a.in[I_BF][l * 256 + ch];
            A[row * DM + 512 + ch] = (bf16_t)f2bf(v * bf2f(GS[row * 768 + 512 + ch])); if ((r & 3) == 3) __builtin_amdgcn_sched_barrier(0); }
    __syncthreads();
}

__device__ __forceinline__ void f2_unit(const Args& a, int l, LAS unsigned char* lds, int unit, int tid, int lane, int wave) {
    unsigned char* ws = a.ws;
    const int b = unit >> 7, k1 = unit & 127;
    const bf16_t* Z2 = (const bf16_t*)(ws + WS_Z2);
    stage_pieces(lds, 128, 256, [&](int k) { return Z2 + (size_t)(b * SEQ + 64 * k1 + (k & 63)) * 512 + (k >> 6) * 256; }, tid);
    __syncthreads();
    const int cb = wave, hi = lane >> 5, r32 = lane & 31, lo = tr_lane_off(lane);
    const bf16_t* img = (const bf16_t*)(ws + WS_T64);
    f32x16 acc[2]; acc[0] = f32x16{}; acc[1] = f32x16{};
#pragma unroll 4
    for (int s = 0; s < 8; ++s) { const bf16x8 bf = bfrag(lds + (s * 8 + cb) * 1024 + lo);
        acc[0] = MFMA32(afrag_img(img, 8, 0, s, lane), bf, acc[0]); acc[1] = MFMA32(afrag_img(img, 8, 1, s, lane), bf, acc[1]); }
    const bf16_t* GS = (const bf16_t*)(ws + WS_GS); bf16_t* A = (bf16_t*)(ws + WS_A);
    const float nrm = 0.0013810679320049757f;
#pragma unroll
    for (int mb = 0; mb < 2; ++mb)
#pragma unroll
        for (int r = 0; r < 16; ++r) { const int k2 = 32 * mb + crow(r, hi), ch = 32 * cb + r32; const size_t row = (size_t)b * SEQ + k1 + 128 * k2;
            const float v = acc[mb][r] * nrm + a.in[I_BF][l * 256 + ch];
            A[row * DM + 512 + ch] = (bf16_t)f2bf(v * bf2f(GS[row * 768 + 512 + ch])); if ((r & 3) == 3) __builtin_amdgcn_sched_barrier(0); }
    __syncthreads();
}

#ifndef DMA_TWICE
#define DMA_TWICE 0
#endif
#ifndef EXTRA_EXP
#define EXTRA_EXP 0
#endif
#ifndef EXTRA_MFMA
#define EXTRA_MFMA 0
#endif
__device__ __forceinline__ void glds16(const void* gsrc, unsigned lds_dst) { unsigned keep;
    asm volatile("s_mov_b32 %0, m0\n\ts_mov_b32 m0, %2\n\ts_nop 0\n\tglobal_load_lds_dwordx4 %1, off\n\ts_mov_b32 m0, %0" : "=&s"(keep) : "v"(gsrc), "s"(lds_dst) : "memory"); }
__device__ __forceinline__ void glds16x2(const void* gsrc, unsigned lds_dst) { unsigned keep;
    asm volatile("s_mov_b32 %0, m0\n\ts_mov_b32 m0, %2\n\ts_nop 0\n\tglobal_load_lds_dwordx4 %1, off\n\tglobal_load_lds_dwordx4 %1, off offset:1024\n\ts_mov_b32 m0, %0" : "=&s"(keep) : "v"(gsrc), "s"(lds_dst) : "memory"); }
__device__ __forceinline__ void attn_unit(const Args& a, int l, LAS unsigned char* lds, int b, int h, int qrow0, int t0, int nt, int tid, int lane, int wave, bool dry) {
    unsigned char* ws = a.ws;
    const int comp = wave >> 2, qg = wave & 3, hi = lane >> 5, r32 = lane & 31;
    const bf16_t* Qg = (const bf16_t*)(ws + WS_QG);
    const unsigned char* kimg = ws + WS_KIMG + (size_t)(b * 4 + h) * NKT * 16384;
    const unsigned char* vimg = ws + WS_VIMG + (size_t)(b * 4 + h) * NKT * 16384;
    bf16x8 qr[4];
    { const bf16_t* qp = Qg + ((size_t)(qrow0 + 32 * qg + r32) * 4 + h) * 128 + comp * 64 + 8 * hi;
#pragma unroll
      for (int d0 = 0; d0 < 4; ++d0) qr[d0] = *(const bf16x8*)(qp + 16 * d0); }
    asm volatile("" : "+v"(qr[0]), "+v"(qr[1]), "+v"(qr[2]), "+v"(qr[3]));
    f32x16 o[4];
#pragma unroll
    for (int d = 0; d < 4; ++d) o[d] = f32x16{};
    float lsum = 0.f;
    const int lo = tr_lane_off(lane);
    const unsigned lds0 = (unsigned)(uintptr_t)lds;
    constexpr int KSL = 16384, VBASE = 3 * KSL;
#define ATT_DMA_K(t, slotb) do { const unsigned char* s_ = kimg + (size_t)(t) * 16384 + wave * 2048 + lane * 16; const unsigned d_ = (unsigned)__builtin_amdgcn_readfirstlane((int)(lds0 + (slotb) + wave * 2048)); \
        glds16x2(s_, d_); if (DMA_TWICE) glds16x2(s_, d_); } while (0)
#define ATT_DMA_V(t, slotb) do { const unsigned char* s_ = vimg + (size_t)(t) * 16384 + wave * 2048 + lane * 16; const unsigned d_ = (unsigned)__builtin_amdgcn_readfirstlane((int)(lds0 + VBASE + (slotb) + wave * 2048)); \
        glds16x2(s_, d_); if (DMA_TWICE) glds16x2(s_, d_); } while (0)
#define ATT_WAIT_BAR(N) asm volatile("s_waitcnt vmcnt(" #N ") lgkmcnt(0)\n\ts_barrier" ::: "memory")
#define SBAR() __builtin_amdgcn_sched_barrier(0)
#define PIN(x) asm volatile("" : "+v"(x))
    LAS const unsigned char* kp0 = lds + comp * 8192 + hi * 1024 + r32 * 16;
    LAS const unsigned char* vp0 = lds + VBASE + lo;
    bf16x8 kf[8];
#define KRD(j, slotb) do { kf[j] = *(const LAS bf16x8*)(kp0 + (slotb) + ((j) >> 1) * 2048 + ((j) & 1) * 512); } while (0)
    f32x16 pA0 = f32x16{}, pA1 = f32x16{}, pB0, pB1;
    u32x4 pw0, pw1, pw2, pw3;
    bf16x8 vA[8], vB[8];
    int sl_prev = 0, sl_cur = 0, sl_next = KSL;
#define ROT() do { sl_prev = sl_cur; sl_cur = sl_next; sl_next = (sl_next == 2 * KSL) ? 0 : sl_next + KSL; } while (0)
    ATT_DMA_K(t0, 0); ATT_DMA_V(t0, 0); ATT_DMA_K(t0 + 1, KSL); ATT_DMA_K(t0 + 2, 2 * KSL);
    ATT_WAIT_BAR(0);
#pragma unroll
    for (int j = 0; j < 8; ++j) KRD(j, 0);
    ATT_WAIT_BAR(0);
#define PKW(P, B) cvt_pk_bf16(P[B], P[B + 1])
#define EX(v) __builtin_amdgcn_exp2f(v)
#define GAPA(i, C, CIN, a0, a1, a2, a3, W0, W1, PWV) do { vA[i] = bfrag(vpp_ + (i) * 1024); SBAR(); \
        C = MFMA32(kf[i], qr[(i) >> 1], CIN); if (EXTRA_MFMA) dacc = MFMA32(kf[i], qr[(i) >> 1], dacc); sacc += a0; sacc += a1; sacc += a2; sacc += a3; PIN(sacc); W0; W1; PIN(PWV); SBAR(); } while (0)
#define GAPB_V(j, d, PWV, X, B) do { o[d] = MFMA32(__builtin_bit_cast(bf16x8, PWV), vA[j], o[d]); X[B] = EX(X[B]); X[B + 1] = EX(X[B + 1]); PIN(X); if (EXTRA_EXP) { dmy = EX(dmy); PIN(dmy); } vB[j] = bfrag(vpp_ + (8 + (j)) * 1024); SBAR(); } while (0)
#define GAPB_K(j, d, PWV, X, B) do { o[d] = MFMA32(__builtin_bit_cast(bf16x8, PWV), vB[(j) - 8], o[d]); X[B] = EX(X[B]); X[B + 1] = EX(X[B + 1]); PIN(X); if (EXTRA_EXP) { dmy = EX(dmy); PIN(dmy); } KRD((j) - 8, sl_next); SBAR(); } while (0)
    const f32x16 zero16 = f32x16{}; float dmy = 0.5f; (void)dmy; f32x16 dacc = f32x16{}; (void)dacc;
#define STEP(C0, C1, P0, P1, t) do { SBAR(); \
        LAS const unsigned char* vpp_ = vp0 + sl_prev; float sacc = 0.f; \
        GAPA(0, C0, zero16, P0[0], P0[1], P0[2], P0[3],     pw0[0] = PKW(P0, 0),  pw0[1] = PKW(P0, 2),  pw0); \
        GAPA(1, C1, zero16, P0[4], P0[5], P0[6], P0[7],     pw0[2] = PKW(P0, 4),  pw0[3] = PKW(P0, 6),  pw0); \
        GAPA(2, C0, C0,     P0[8], P0[9], P0[10], P0[11],   pw1[0] = PKW(P0, 8),  pw1[1] = PKW(P0, 10), pw1); \
        GAPA(3, C1, C1,     P0[12], P0[13], P0[14], P0[15], pw1[2] = PKW(P0, 12), pw1[3] = PKW(P0, 14), pw1); \
        GAPA(4, C0, C0,     P1[0], P1[1], P1[2], P1[3],     pw2[0] = PKW(P1, 0),  pw2[1] = PKW(P1, 2),  pw2); \
        GAPA(5, C1, C1,     P1[4], P1[5], P1[6], P1[7],     pw2[2] = PKW(P1, 4),  pw2[3] = PKW(P1, 6),  pw2); \
        GAPA(6, C0, C0,     P1[8], P1[9], P1[10], P1[11],   pw3[0] = PKW(P1, 8),  pw3[1] = PKW(P1, 10), pw3); \
        GAPA(7, C1, C1,     P1[12], P1[13], P1[14], P1[15], pw3[2] = PKW(P1, 12), pw3[3] = PKW(P1, 14), pw3); \
        lsum += sacc; \
        if ((t) + 3 < nt) ATT_DMA_K(t0 + (t) + 3, sl_cur); \
        if ((t) + 1 < nt) ATT_DMA_V(t0 + (t) + 1, sl_next); \
        SBAR(); \
        GAPB_V(0, 0, pw0, C0, 0);  GAPB_V(1, 0, pw1, C0, 2);  GAPB_V(2, 0, pw2, C0, 4);  GAPB_V(3, 0, pw3, C0, 6); \
        GAPB_V(4, 1, pw0, C0, 8);  GAPB_V(5, 1, pw1, C0, 10); GAPB_V(6, 1, pw2, C0, 12); GAPB_V(7, 1, pw3, C0, 14); \
        GAPB_K(8, 2, pw0, C1, 0);  GAPB_K(9, 2, pw1, C1, 2);  GAPB_K(10, 2, pw2, C1, 4); GAPB_K(11, 2, pw3, C1, 6); \
        GAPB_K(12, 3, pw0, C1, 8); GAPB_K(13, 3, pw1, C1, 10); GAPB_K(14, 3, pw2, C1, 12); GAPB_K(15, 3, pw3, C1, 14); \
        if ((t) + 3 < nt) { if (DMA_TWICE) ATT_WAIT_BAR(8); else ATT_WAIT_BAR(4); } else ATT_WAIT_BAR(0); \
        ROT(); } while (0)
#pragma unroll 1
    for (int t = 0; t < nt; t += 2) {
        STEP(pB0, pB1, pA0, pA1, t);
        STEP(pA0, pA1, pB0, pB1, t + 1);
    }
    {
        float sacc = 0.f;
#pragma unroll
        for (int r = 0; r < 16; ++r) sacc += pA0[r] + pA1[r];
        lsum += sacc;
        pw0 = (u32x4){PKW(pA0, 0), PKW(pA0, 2), PKW(pA0, 4), PKW(pA0, 6)}; pw1 = (u32x4){PKW(pA0, 8), PKW(pA0, 10), PKW(pA0, 12), PKW(pA0, 14)};
        pw2 = (u32x4){PKW(pA1, 0), PKW(pA1, 2), PKW(pA1, 4), PKW(pA1, 6)}; pw3 = (u32x4){PKW(pA1, 8), PKW(pA1, 10), PKW(pA1, 12), PKW(pA1, 14)};
        LAS const unsigned char* vpp_ = vp0 + sl_prev;
#pragma unroll
        for (int d = 0; d < 4; ++d) {
            const bf16x8 f0 = bfrag(vpp_ + (d * 4 + 0) * 1024), f1 = bfrag(vpp_ + (d * 4 + 1) * 1024), f2 = bfrag(vpp_ + (d * 4 + 2) * 1024), f3 = bfrag(vpp_ + (d * 4 + 3) * 1024);
            o[d] = MFMA32(__builtin_bit_cast(bf16x8, pw0), f0, o[d]); o[d] = MFMA32(__builtin_bit_cast(bf16x8, pw1), f1, o[d]);
            o[d] = MFMA32(__builtin_bit_cast(bf16x8, pw2), f2, o[d]); o[d] = MFMA32(__builtin_bit_cast(bf16x8, pw3), f3, o[d]);
        }
    }
    ATT_WAIT_BAR(0);
#undef ATT_DMA_K
#undef ATT_DMA_V
#undef ATT_WAIT_BAR
#undef SBAR
#undef PIN
#undef KRD
#undef ROT
#undef PKW
#undef EX
#undef GAPA
#undef GAPB_V
#undef GAPB_K
#undef STEP
    if (EXTRA_MFMA) asm volatile("" :: "v"(dacc));
    if (dry) return;
    LAS float* ost = (LAS float*)lds;
    LAS float* lw = (LAS float*)(lds + 72 * 1024);
    lsum += __shfl_xor(lsum, 32);
    if (hi == 0) lw[wave * 32 + r32] = lsum;
    LDS_WAIT(); asm volatile("" ::: "memory");
    const float* lamp = (const float*)(ws + WS_LAM) + 2 * l;
    const float lam = lamp[0], oscale = lamp[1];
    float rl[16];
#pragma unroll
    for (int r = 0; r < 16; ++r) rl[r] = __builtin_amdgcn_rcpf(lw[wave * 32 + crow(r, hi)]);
    if (comp == 0) {
#pragma unroll
        for (int d = 0; d < 4; ++d)
#pragma unroll
            for (int r = 0; r < 16; ++r) ost[(32 * qg + crow(r, hi)) * 132 + 32 * d + r32] = o[d][r] * rl[r];
    }
    __syncthreads();
    if (comp == 1) {
#pragma unroll
        for (int d = 0; d < 4; ++d)
#pragma unroll
            for (int r = 0; r < 16; ++r) ost[(32 * qg + crow(r, hi)) * 132 + 32 * d + r32] -= lam * o[d][r] * rl[r];
    }
    __syncthreads();
    {
        const int row = tid >> 2, qt = tid & 3; const LAS float* src = ost + row * 132 + 32 * qt;
        float v[32]; float ss = 0.f;
#pragma unroll
        for (int i = 0; i < 32; ++i) { v[i] = src[i]; ss += v[i] * v[i]; }
        ss += __shfl_xor(ss, 1); ss += __shfl_xor(ss, 2);
        const float rstd = rsqrtf(ss * (1.0f / 128.0f) + EPS) * oscale;
        const size_t grow = (size_t)qrow0 + row;
        const bf16_t* gs = (const bf16_t*)(ws + WS_GS) + grow * 768 + h * 128 + 32 * qt;
        bf16_t* dst = (bf16_t*)(ws + WS_A) + grow * DM + h * 128 + 32 * qt;
        const float* gsub = a.in[I_GSUB] + l * 128 + 32 * qt;
#pragma unroll
        for (int i = 0; i < 4; ++i) { const u32x4 gw = *(const u32x4*)(gs + 8 * i); u32x4 w;
#pragma unroll
            for (int e = 0; e < 4; ++e) { const int j = 8 * i + 2 * e; w[e] = pk2(v[j] * rstd * gsub[j] * bflo(gw[e]), v[j + 1] * rstd * gsub[j + 1] * bfhi(gw[e])); }
            *(u32x4*)(dst + 8 * i) = w; }
    }
    __syncthreads();
}

#ifndef REPEAT_PHASE
#define REPEAT_PHASE (-1)
#endif
constexpr int N_PHASES = 13 + (REPEAT_PHASE >= 0 ? 1 : 0);
__global__ void __launch_bounds__(NTHREADS, 2) fwd_kernel(Args args) {
    extern __shared__ __attribute__((aligned(16))) unsigned char lds_raw[];
    LAS unsigned char* lds = (LAS unsigned char*)lds_raw;
    const int tid = threadIdx.x, lane = tid & 63, wave = __builtin_amdgcn_readfirstlane(tid >> 6);
    const int bx = blockIdx.x, vcu = (bx % 8) * (GRID / 8) + bx / 8;
    unsigned char* ws = args.ws;
    volatile LAS unsigned* MISC = (volatile LAS unsigned*)(lds + MISC_OFF);
    for (int u = tid; u < 32; u += NTHREADS) MISC[u] = 0u;
    __syncthreads();
    XcdBarrier bar; bar.bar = (unsigned*)(ws + WS_CTL) + CW_BAR; bar.x = 0; bar.st = nullptr;
    const bool one_launch = (args.ph_hi - args.ph_lo) > 1;
    if (one_launch) bar = xcd_barrier_post((unsigned*)(ws + WS_CTL) + CW_BAR, MISC + 8);
#ifndef REPEAT_PHASE
#define REPEAT_PHASE (-1)
#endif
#ifndef PRO_PROBE
#define PRO_PROBE 15
#endif
#ifndef PHMASK
#define PHMASK 0xffff
#endif
#define EN(b) (((PHMASK) >> (b)) & 1)
#define LAUNDER() int tid_ = tid, vcu_ = vcu; asm volatile("" : "+v"(tid_)); asm volatile("" : "+s"(vcu_)); const int lane_ = tid_ & 63, wave_ = __builtin_amdgcn_readfirstlane(tid_ >> 6); (void)lane_; (void)wave_
#pragma unroll 1
    for (int pc = args.ph_lo; pc < args.ph_hi; ++pc) {
        const int ph = (REPEAT_PHASE >= 0 && pc > REPEAT_PHASE) ? pc - 1 : pc;
        const int l = ph >= 7 ? 1 : 0;
        const bool second = (REPEAT_PHASE >= 0 && pc == REPEAT_PHASE + 1); (void)second;
        const int kind = ph == 0 ? 6 : ((ph == 1 || ph == 7) ? 7 : (ph < 7 ? ph - 2 : ph - 8));
        const bf16_t* Wl = (const bf16_t*)(ws + WS_WIN) + (size_t)l * NPHYS * DM;
        LAUNDER();
        if (kind == 6) { if (EN(0)) ph0_prologue(args, lds, tid_, lane_, wave_, vcu_, second ? PRO_PROBE : 15); }
        else if (kind == 7) { if (EN(1)) prepass(args, ph == 1 ? 0 : 1, lds, tid_, lane_, wave_, vcu_); }
        else if (kind == 0) { if (EN(2)) {
            pg8::Gemm g{(const bf16_t*)(ws + WS_H), Wl, DM, DM, 0, 0, 0, 16, 16, 16};
            TileSched S{vcu_ >> 5, vcu_ & 31, 0, 14, 1, l == 0 ? 52 : 8, l == 0 ? 0 : 2, l == 0 ? 26 : 4};
            EpiIn E{ws, args.in[I_GQ] + l * 64, args.in[I_GK] + l * 64, (const float*)(ws + WS_ROPE), (const float*)(ws + WS_ROPE) + 2048};
            pg8::gemm_phase<EpiIn, TileSched, true, true>(lds, g, S, E, tid_); } }
        else if (kind == 1) { if (EN(4)) {
            if (!second) {
                if (EN(8)) f1_unit(ws, lds, vcu_, tid_, lane_, wave_);
                const int nsgu = l == 0 ? 132 : 128;
                if (EN(9)) for (int cu = 255 - vcu_; cu < nsgu; cu += GRID) sgu_unit(args, l, lds, cu, tid_, lane_, wave_);
                if (EN(10) && l == 0 && vcu_ < 8) ctxf_unit(args, l, lds, vcu_, tid_, lane_, wave_);
            }
            const int bh = vcu_ >> 5, qb = vcu_ & 31;
            if (EN(12)) {
                const int nun = (l == 0 && qb < 2) ? 3 : 2;
#pragma unroll 1
                for (int ui = 0; ui < nun; ++ui) {
                    const int qrow0 = ui < 2 ? (bh >> 2) * SEQ + 256 * qb + 128 * ui : MLAT + (bh >> 2) * NCTX + 128 * qb;
                    attn_unit(args, l, lds, bh >> 2, bh & 3, qrow0, ui < 2 ? 0 : SEQ / 64, ui < 2 ? NKT : NCTX / 64, tid_, lane_, wave_, second);
                }
            } } }
        else if (kind == 2) { if (EN(5)) {
            if (EN(11)) f2_unit(args, l, lds, vcu_, tid_, lane_, wave_);
            pg8::Gemm g{(const bf16_t*)(ws + WS_H), Wl, DM, DM, 0, 0, 0, 16, 16, 16};
            TileSched S{vcu_ >> 5, vcu_ & 31, 14, 12, 1, 0, 14, 12};
            EpiIn E{ws, nullptr, nullptr, nullptr, nullptr};
            pg8::gemm_phase<EpiIn, TileSched, true, true>(lds, g, S, E, tid_); } }
        else if (kind == 3) { if (EN(6)) {
            pg8::Gemm g{(const bf16_t*)(ws + WS_A), (const bf16_t*)(ws + WS_WBR) + (size_t)l * DM * DM, DM, DM, 0, 512, 768, 8, 4, 4};
            TileSched S{vcu_ >> 5, vcu_ & 31, 0, 4, 3, 0, 0, 4};
            if (l == 0) ctx_branch_proj(ws, (const bf16_t*)(ws + WS_WBR), vcu_ * NWAVES + wave_, lane_);
            EpiY E{(const unsigned char*)(ws + WS_MS), (bf16_t*)(ws + WS_H)};
            pg8::gemm_phase<EpiY, TileSched, true, true>(lds, g, S, E, tid_); } }
        else { if (EN(7)) {
            pg8::Gemm g{(const bf16_t*)(ws + WS_H), (const bf16_t*)(ws + WS_WOUT) + (size_t)l * DM * DM, DM, DM, 0, 0, 0, 16, 16, 16};
            TileSched S{vcu_ >> 5, vcu_ & 31, 0, 4, 1, 0, 0, 4};
            if (l == 0) ctx_out_proj(ws, (const bf16_t*)(ws + WS_WOUT), args.in[I_CTX], (const float*)(ws + WS_MODF) + 2 * 3072 + 2048, vcu_ * NWAVES + wave_, lane_);
            EpiOut E{args.in[I_X], args.out, ws, (const float*)(ws + WS_MODF) + (size_t)(l * 3) * 3072 + 2048, l};
            pg8::gemm_phase<EpiOut, TileSched, true, true>(lds, g, S, E, tid_); } }
        if (pc + 1 < args.ph_hi) { XcdBarrier b2_ = bar; asm volatile("" : "+s"(b2_.bar)); xcd_barrier(b2_); }
    }
}

extern "C" void kernel_launch(void* const* d_in, const int* in_sizes, int n_in, void* d_out, int out_size, void* d_ws, size_t ws_size, hipStream_t stream) {
    static int ready = 0;
    if (ready == 0) {
        if (n_in != 25 || out_size != MLAT * DM || ws_size < 256 * MiB) { fprintf(stderr, "kernel_launch: unexpected shapes (n_in %d out %d ws %zu)\n", n_in, out_size, ws_size); ready = -1; return; }
        int dev = 0, cus = 0, per_cu = 0;
        hipGetDevice(&dev); hipDeviceGetAttribute(&cus, hipDeviceAttributeMultiprocessorCount, dev);
        if (hipFuncSetAttribute((const void*)fwd_kernel, hipFuncAttributeMaxDynamicSharedMemorySize, LDS_BYTES) != hipSuccess) { fprintf(stderr, "kernel_launch: hipFuncSetAttribute failed\n"); ready = -1; return; }
        hipOccupancyMaxActiveBlocksPerMultiprocessor(&per_cu, (const void*)fwd_kernel, NTHREADS, LDS_BYTES);
        (void)hipGetLastError();
        if (cus != GRID || per_cu < 1) fprintf(stderr, "kernel_launch: note: %d CUs, occupancy %d blocks/CU (built for 256 CUs, 1 block/CU)\n", cus, per_cu);
        ready = (cus >= GRID) ? 1 : -1;
    }
    if (ready < 0) return;
    hipMemsetAsync((char*)d_ws + WS_CTL, 0, CTL_ZERO_BYTES, stream);
    Args a{};
    for (int i = 0; i < 25; ++i) a.in[i] = (const float*)d_in[i];
    a.out = (float*)d_out; a.ws = (unsigned char*)d_ws;
#if MK_N_LAUNCHES == 1
    a.ph_lo = 0; a.ph_hi = N_PHASES;
    hipLaunchKernelGGL(fwd_kernel, dim3(GRID), dim3(NTHREADS), LDS_BYTES, stream, a);
#else
    for (int p = 0; p < N_PHASES; ++p) { a.ph_lo = p; a.ph_hi = p + 1; hipLaunchKernelGGL(fwd_kernel, dim3(GRID), dim3(NTHREADS), LDS_BYTES, stream, a); }
#endif
}
```

```cpp
#include <hip/hip_runtime.h>
#include <cstdio>
#include <cstdint>

#ifndef MK_N_LAUNCHES
#define MK_N_LAUNCHES 1
#endif

#define LAS __attribute__((address_space(3)))
#define GAS __attribute__((address_space(1)))
typedef unsigned short bf16_t;
typedef short bf16x8 __attribute__((ext_vector_type(8)));
typedef short s16x4 __attribute__((ext_vector_type(4)));
typedef float f32x4 __attribute__((ext_vector_type(4)));
typedef float f32x2 __attribute__((ext_vector_type(2)));
typedef float f32x16 __attribute__((ext_vector_type(16)));
typedef unsigned u32x4 __attribute__((ext_vector_type(4)));
typedef unsigned u32x2 __attribute__((ext_vector_type(2)));

constexpr int DM = 1024, BATCH = 2, SEQ = 8192, NCTX = 256, DEPTH = 2;
constexpr int MLAT = BATCH * SEQ, MCTX = BATCH * NCTX, MT = MLAT + MCTX;
constexpr int NKEY = SEQ + NCTX, NKT = NKEY / 64;
constexpr int INW = 6400;
constexpr int OFF_Q = 0, OFF_K = 512, OFF_V = 1024, OFF_F = 1536, OFF_U = 1792, OFF_VC = 2048, OFF_GATE = 2304, OFF_MERGE = 3328;
constexpr int NPHYS = 6656;
constexpr float EPS = 1e-6f;
constexpr float QSCALE = 0.125f * 1.4426950408889634f;

constexpr size_t KiB = 1024, MiB = 1u << 20;
constexpr size_t WS_CTL = 0, CTL_ZERO_BYTES = 64 * KiB;
constexpr size_t WS_MODP = 1 * MiB;
constexpr size_t WS_MODF = WS_MODP + 2304 * KiB;
constexpr size_t WS_ROPE = WS_MODF + 72 * KiB;
constexpr size_t WS_TW = WS_ROPE + 16 * KiB;
constexpr size_t WS_LAM = WS_TW + 64 * KiB;
constexpr size_t WS_C128 = WS_LAM + 1 * KiB;
constexpr size_t WS_S128 = WS_C128 + 32 * KiB;
constexpr size_t WS_T64 = WS_S128 + 32 * KiB;
constexpr size_t WS_TC256 = WS_T64 + 16 * KiB;
constexpr size_t WS_WSIMG = WS_TC256 + 256 * KiB;
constexpr size_t WS_SMALL_END = WS_WSIMG + 256 * KiB;
static_assert(WS_SMALL_END <= 5 * MiB, "small tables");
constexpr size_t WS_WIN = 5 * MiB;
constexpr size_t WS_WBR = 31 * MiB;
constexpr size_t WS_WOUT = 35 * MiB;
constexpr size_t WS_CTX1 = 39 * MiB;
constexpr size_t WS_H = 41 * MiB;
constexpr size_t WS_A = 74 * MiB;
constexpr size_t WS_R = 107 * MiB;
constexpr size_t SZ_QG = (size_t)MT * 512 * 2, SZ_KIMG = (size_t)BATCH * 4 * NKT * 16384, SZ_Z2 = (size_t)MT * 512 * 2, SZ_UG = (size_t)MT * 256 * 2, SZ_GS = (size_t)MT * 768 * 2;
constexpr size_t WS_QG = WS_R, WS_KIMG = WS_QG + SZ_QG, WS_VIMG = WS_KIMG + SZ_KIMG, WS_Z2 = WS_VIMG + SZ_KIMG, WS_UG = WS_Z2 + SZ_Z2, WS_VC = WS_UG + SZ_UG, WS_GS = WS_VC + SZ_UG;
constexpr size_t WS_Y = WS_Z2;
static_assert(WS_Z2 + (size_t)MT * DM * 2 == WS_GS, "Y overlays Z2 | UG | VC exactly");
constexpr size_t WS_MS = WS_R;
constexpr size_t WS_END = WS_GS + SZ_GS;
constexpr size_t WS_X1B0 = 229 * MiB, WS_X1B1 = 215 * MiB;
constexpr int X1B_SPLIT = 13824;
constexpr size_t WS_MSC = 224 * MiB;
static_assert(WS_X1B1 >= WS_END && WS_X1B1 + (size_t)(MLAT - X1B_SPLIT) * 2048 <= WS_MSC && WS_MSC + (size_t)MCTX * 3072 <= WS_X1B0 && WS_X1B0 + (size_t)X1B_SPLIT * 2048 <= 256 * MiB, "x1b map");
static_assert(WS_MS + (size_t)MT * 3072 <= WS_Z2 && WS_END <= WS_MSC && WS_MSC + (size_t)MCTX * 3072 * 2 <= 256 * MiB, "d_ws map");

__host__ __device__ __forceinline__ size_t x1b_off(int row) { return row < X1B_SPLIT ? WS_X1B0 + (size_t)row * 2048 : WS_X1B1 + (size_t)(row - X1B_SPLIT) * 2048; }
__device__ __forceinline__ unsigned f2bf(float f) { unsigned u = __builtin_bit_cast(unsigned, f); return (u + 0x7fffu + ((u >> 16) & 1u)) >> 16; }
__device__ __forceinline__ unsigned pk2(float lo, float hi) { return f2bf(lo) | (f2bf(hi) << 16); }
__device__ __forceinline__ unsigned cvt_pk_bf16(float lo, float hi) { unsigned r; asm volatile("v_cvt_pk_bf16_f32 %0, %1, %2" : "=v"(r) : "v"(lo), "v"(hi)); return r; }
__device__ __forceinline__ float bf2f(unsigned short v) { return __builtin_bit_cast(float, (unsigned)v << 16); }
__device__ __forceinline__ float bflo(unsigned w) { return __builtin_bit_cast(float, w << 16); }
__device__ __forceinline__ float bfhi(unsigned w) { return __builtin_bit_cast(float, w & 0xffff0000u); }
__device__ __forceinline__ float fast_sigmoid(float x) { return __builtin_amdgcn_rcpf(1.0f + __builtin_amdgcn_exp2f(-1.4426950408889634f * x)); }
__device__ __forceinline__ unsigned ms_quant_pk(float x, unsigned sel, unsigned old) { const float q = __builtin_amdgcn_rcpf((1.0f / 255.0f) + __builtin_amdgcn_exp2f(__builtin_fmaf(x, -1.4426950408889634f, -7.994353436858858f)));
    return __builtin_amdgcn_cvt_pk_u8_f32(__builtin_fmaxf(q, 1.0f), sel, old); }
__device__ __forceinline__ float ub(unsigned w, int i) { return (float)((w >> (8 * i)) & 0xffu); }
__device__ __forceinline__ float fast_silu(float x) { return x * fast_sigmoid(x); }
__device__ __forceinline__ int crow(int r, int hi) { return (r & 3) + 8 * (r >> 2) + 4 * hi; }
__host__ __device__ __forceinline__ int perm32(int rho) { const int n = rho >> 4, i = rho & 15; return 8 * (i >> 2) + 4 * n + (i & 3); }
__host__ __device__ __forceinline__ int invperm32(int c) { return 16 * ((c >> 2) & 1) + 4 * (c >> 3) + (c & 3); }
#define LDS_WAIT() asm volatile("s_waitcnt lgkmcnt(0)" ::: "memory")
#define VM_WAIT() asm volatile("s_waitcnt vmcnt(0)" ::: "memory")

namespace pg8 {
constexpr int BM = 256, BK = 64, HALF = 128, HTB = HALF * BK * 2  , STAGE_BYTES = 8 * HTB;
__host__ __device__ __forceinline__ int lds_byte(int r, int c) { const int st = (r >> 4) * 2 + (c >> 5), rr = r & 15, cc = c & 31, ob = rr * 64 + cc * 2; return st * 1024 + (ob ^ (((ob >> 9) & 1) << 5)); }
__host__ __device__ __forceinline__ void stage_rc(int b, int& R, int& C) { const int st = b / 1024, sb = b % 1024, swz = sb ^ (((sb >> 9) & 1) << 5); R = (st >> 1) * 16 + swz / 64; C = (st & 1) * 32 + (swz % 64) / 2; }

struct Unit { int pm, pn, seg, set; };
struct Gemm { const bf16_t* A; const bf16_t* Bt; int lda, ldb; int k0_0, k0_1, k0_2; int nt_0, nt_1, nt_2; const bf16_t* A1; const bf16_t* Bt1; int nt_set1; };

template <class Epi, class Sched, bool ALIGN_EPI = false, bool SP2 = false>
__device__ __forceinline__ void gemm_phase(LAS unsigned char* lds, const Gemm g, const Sched& S, const Epi& E, const int tid) {
    const int wid = __builtin_amdgcn_readfirstlane(tid >> 6), lane = tid & 63, wr = wid >> 2, wc = wid & 3, fr = lane & 15, fq = lane >> 4;
    unsigned voffA[2], voffB[2];
#pragma unroll
    for (int i = 0; i < 2; ++i) { int R, C; stage_rc(tid * 16 + i * 8192, R, C); voffA[i] = (unsigned)(R * g.lda + C) * 2u; voffB[i] = (unsigned)(R * g.ldb + C) * 2u; }
    const size_t kstep = (size_t)(BK * 2);
    const size_t hstepA = (size_t)HALF * g.lda * 2, hstepB = (size_t)HALF * g.ldb * 2;
    const size_t tstepA = 2 * hstepA, tstepB = 2 * hstepB;
    const unsigned ldsw = (unsigned)wid * 1024u;
    const int aoff = lds_byte(wr * 64 + fr, fq * 8), boff = lds_byte(wc * 32 + fr, fq * 8);
#define PG8_SA(b, h) (((b) * 2 + (h)) * HTB)
#define PG8_SB(b, h) ((4 + (b) * 2 + (h)) * HTB)
#define PG8_STAGE(bufoff, gbase, voff) do { _Pragma("unroll") for (int _i = 0; _i < 2; ++_i) \
        __builtin_amdgcn_global_load_lds((const unsigned*)((const char*)(gbase) + (voff)[_i]), (LAS unsigned*)(lds + (bufoff) + ldsw + _i * 8192), 16, 0, 0); } while (0)
#define PG8_LDA(dst, b, h) do { _Pragma("unroll") for (int m = 0; m < 4; ++m) _Pragma("unroll") for (int k = 0; k < 2; ++k) dst[m][k] = *(const LAS bf16x8*)(lds + PG8_SA(b, h) + aoff + m * 2048 + k * 1024); } while (0)
#define PG8_LDB(dst, b, h) do { _Pragma("unroll") for (int n = 0; n < 2; ++n) _Pragma("unroll") for (int k = 0; k < 2; ++k) dst[n][k] = *(const LAS bf16x8*)(lds + PG8_SB(b, h) + boff + n * 2048 + k * 1024); } while (0)
#define PG8_MMA(ai, bj, At, Bt) do { __builtin_amdgcn_s_setprio(1); _Pragma("unroll") for (int m = 0; m < 4; ++m) _Pragma("unroll") for (int n = 0; n < 2; ++n) _Pragma("unroll") for (int k = 0; k < 2; ++k) \
        acc[ai][bj][m][n] = __builtin_amdgcn_mfma_f32_16x16x32_bf16(Bt[n][k], At[m][k], acc[ai][bj][m][n], 0, 0, 0); __builtin_amdgcn_s_setprio(0); } while (0)
#define PG8_WAIT_V(n) asm volatile("s_waitcnt vmcnt(" #n ")" ::: "memory")
#define PG8_WAIT_L(n) asm volatile("s_waitcnt lgkmcnt(" #n ")" ::: "memory")
#define PG8_BAR __builtin_amdgcn_s_barrier()
#define PG8_SCHED __builtin_amdgcn_sched_barrier(0)
#define PG8_K0(u) ((u).set ? 0 : ((u).seg == 0 ? g.k0_0 : ((u).seg == 1 ? g.k0_1 : g.k0_2)))
#define PG8_NT(u) ((u).set ? g.nt_set1 : ((u).seg == 0 ? g.nt_0 : ((u).seg == 1 ? g.nt_1 : g.nt_2)))
#define PG8_UA(u) ((const char*)((u).set ? g.A1 : g.A) + (size_t)(u).pm * tstepA + (size_t)PG8_K0(u) * 2)
#define PG8_UB(u) ((const char*)((u).set ? g.Bt1 : g.Bt) + (size_t)(u).pn * tstepB + (size_t)PG8_K0(u) * 2)
    Unit cur, nxt; int ui = 0;
    if (!S.next(0, cur)) return;
    f32x4 acc[2][2][4][2];
#pragma unroll
    for (int a = 0; a < 2; ++a)
#pragma unroll
        for (int b = 0; b < 2; ++b)
#pragma unroll
            for (int m = 0; m < 4; ++m)
#pragma unroll
                for (int n = 0; n < 2; ++n) acc[a][b][m][n] = (f32x4){0.f, 0.f, 0.f, 0.f};
    bf16x8 At[4][2], B0[2][2], B1[2][2];
    const char* cA = PG8_UA(cur); const char* cB = PG8_UB(cur); int nt = PG8_NT(cur);
    if constexpr (SP2) {
        PG8_STAGE(PG8_SB(0, 0), cB, voffB); PG8_STAGE(PG8_SB(0, 1), cB + hstepB, voffB); PG8_STAGE(PG8_SA(0, 0), cA, voffA); PG8_STAGE(PG8_SA(0, 1), cA + hstepA, voffA);
        if (wr == 1) PG8_BAR;
        PG8_WAIT_V(2); PG8_BAR;
        PG8_STAGE(PG8_SB(1, 0), cB + kstep, voffB); PG8_STAGE(PG8_SA(1, 0), cA + kstep, voffA); PG8_STAGE(PG8_SB(1, 1), cB + hstepB + kstep, voffB);
        PG8_WAIT_V(6); PG8_BAR;
    } else {
        PG8_STAGE(PG8_SB(0, 0), cB, voffB); PG8_STAGE(PG8_SA(0, 0), cA, voffA); PG8_STAGE(PG8_SB(0, 1), cB + hstepB, voffB); PG8_STAGE(PG8_SA(0, 1), cA + hstepA, voffA);
        if (wr == 1) PG8_BAR;
        PG8_WAIT_V(4); PG8_BAR;
        PG8_STAGE(PG8_SB(1, 0), cB + kstep, voffB); PG8_STAGE(PG8_SA(1, 0), cA + kstep, voffA); PG8_STAGE(PG8_SB(1, 1), cB + hstepB + kstep, voffB);
        PG8_WAIT_V(6); PG8_BAR;
    }
    for (;;) {
        const bool has_next = S.next(ui + 1, nxt);
        const char* nA = has_next ? PG8_UA(nxt) : cA; const char* nB = has_next ? PG8_UB(nxt) : cB;
        for (int t = 0; t < nt; t += 2) {
            const bool last = (t == nt - 2);
            if (last && has_next) S.a_ready(nxt);
            const char* a1 = cA + (size_t)(t + 1) * kstep;
            const char* a2 = last ? nA : cA + (size_t)(t + 2) * kstep; const char* b2 = last ? nB : cB + (size_t)(t + 2) * kstep;
            const char* a3 = a2 + kstep; const char* b3 = b2 + kstep;
            if constexpr (SP2) {
            PG8_LDB(B0, 0, 0); PG8_LDB(B1, 0, 1); PG8_SCHED; PG8_LDA(At, 0, 0); PG8_STAGE(PG8_SA(1, 1), a1 + hstepA, voffA);
            PG8_WAIT_V(8); PG8_WAIT_L(0); PG8_BAR; PG8_MMA(0, 0, At, B0); PG8_MMA(0, 1, At, B1); PG8_BAR; PG8_SCHED;
            PG8_LDA(At, 0, 1); PG8_STAGE(PG8_SB(0, 0), b2, voffB); PG8_STAGE(PG8_SB(0, 1), b2 + hstepB, voffB); PG8_STAGE(PG8_SA(0, 0), a2, voffA);
            PG8_WAIT_V(8); PG8_WAIT_L(0); PG8_BAR; PG8_MMA(1, 0, At, B0); PG8_MMA(1, 1, At, B1); PG8_BAR; PG8_SCHED;
            PG8_LDB(B0, 1, 0); PG8_LDB(B1, 1, 1); PG8_SCHED; PG8_LDA(At, 1, 0); PG8_STAGE(PG8_SA(0, 1), a2 + hstepA, voffA);
            PG8_WAIT_V(8); PG8_WAIT_L(0); PG8_BAR; PG8_MMA(0, 0, At, B0); PG8_MMA(0, 1, At, B1); PG8_BAR; PG8_SCHED;
            PG8_LDA(At, 1, 1); PG8_STAGE(PG8_SB(1, 0), b3, voffB); PG8_STAGE(PG8_SB(1, 1), b3 + hstepB, voffB); PG8_STAGE(PG8_SA(1, 0), a3, voffA);
            PG8_WAIT_V(8); PG8_WAIT_L(0); PG8_BAR; PG8_MMA(1, 0, At, B0); PG8_MMA(1, 1, At, B1); PG8_BAR; PG8_SCHED;
            } else {
            PG8_LDB(B0, 0, 0); PG8_SCHED; PG8_LDA(At, 0, 0); PG8_STAGE(PG8_SA(1, 1), a1 + hstepA, voffA);
            PG8_WAIT_L(8); PG8_BAR; PG8_WAIT_L(0); PG8_MMA(0, 0, At, B0); PG8_BAR; PG8_SCHED;
            PG8_LDB(B1, 0, 1); PG8_STAGE(PG8_SB(0, 0), b2, voffB);
            PG8_BAR; PG8_WAIT_L(0); PG8_MMA(0, 1, At, B1); PG8_BAR;
            PG8_LDA(At, 0, 1); PG8_STAGE(PG8_SA(0, 0), a2, voffA);
            PG8_BAR; PG8_WAIT_L(0); PG8_MMA(1, 0, At, B0); PG8_BAR; PG8_SCHED;
            PG8_STAGE(PG8_SB(0, 1), b2 + hstepB, voffB);
            PG8_WAIT_V(6); PG8_BAR; PG8_MMA(1, 1, At, B1); PG8_BAR;
            PG8_LDB(B0, 1, 0); PG8_SCHED; PG8_LDA(At, 1, 0); PG8_STAGE(PG8_SA(0, 1), a2 + hstepA, voffA);
            PG8_WAIT_L(8); PG8_BAR; PG8_WAIT_L(0); PG8_MMA(0, 0, At, B0); PG8_BAR; PG8_SCHED;
            PG8_LDB(B1, 1, 1); PG8_STAGE(PG8_SB(1, 0), b3, voffB);
            PG8_BAR; PG8_WAIT_L(0); PG8_MMA(0, 1, At, B1); PG8_BAR;
            PG8_LDA(At, 1, 1); PG8_STAGE(PG8_SA(1, 0), a3, voffA);
            PG8_BAR; PG8_WAIT_L(0); PG8_MMA(1, 0, At, B0); PG8_BAR; PG8_SCHED;
            PG8_STAGE(PG8_SB(1, 1), b3 + hstepB, voffB);
            PG8_WAIT_V(6); PG8_BAR; PG8_MMA(1, 1, At, B1); PG8_BAR;
            }
        }
        if constexpr (ALIGN_EPI) { if (wr == 0) PG8_BAR; }
        const bool reset_acc = E(acc, cur, wr, wc, fr, fq);
        if (!has_next) break;
        if (reset_acc) {
#pragma unroll
        for (int a = 0; a < 2; ++a)
#pragma unroll
            for (int b = 0; b < 2; ++b)
#pragma unroll
                for (int m = 0; m < 4; ++m)
#pragma unroll
                    for (int n = 0; n < 2; ++n) acc[a][b][m][n] = (f32x4){0.f, 0.f, 0.f, 0.f};
        }
        cur = nxt; cA = nA; cB = nB; nt = PG8_NT(cur); ++ui;
        if constexpr (ALIGN_EPI) { if (wr == 1) PG8_BAR; }
    }
    PG8_WAIT_V(0);
    if constexpr (!ALIGN_EPI) { if (wr == 0) PG8_BAR; }
    PG8_BAR;
#undef PG8_SA
#undef PG8_SB
#undef PG8_STAGE
#undef PG8_LDA
#undef PG8_LDB
#undef PG8_MMA
#undef PG8_WAIT_V
#undef PG8_WAIT_L
#undef PG8_BAR
#undef PG8_SCHED
#undef PG8_K0
#undef PG8_NT
#undef PG8_UA
#undef PG8_UB
}
}

#define XB_TMO      128
#define XB_XCNT(j)  (256  + 64 * (j))
#define XB_XSUB(j)  (1280 + 64 * (j))
#define XB_XGEN(j)  (2304 + 64 * (j))
#define XB_TOP      3328
#define XB_TOPGEN   3392
#define XCD_BAR_WORDS 3456
#define XB_SPIN_CAP (1u << 18)
__device__ __forceinline__ unsigned xb_ld(unsigned* p)              { return __hip_atomic_load(p, __ATOMIC_RELAXED, __HIP_MEMORY_SCOPE_AGENT); }
__device__ __forceinline__ unsigned xb_add(unsigned* p, unsigned v) { return __hip_atomic_fetch_add(p, v, __ATOMIC_RELAXED, __HIP_MEMORY_SCOPE_AGENT); }
__device__ __forceinline__ unsigned xb_xcc_id() { return (unsigned)__builtin_amdgcn_s_getreg((3 << 11) | 20) & 0xFu; }
#define XB_SPIN(cond, bar) do { unsigned _sp = 0; while (cond) { __builtin_amdgcn_s_sleep(1); \
    if ((++_sp & 255u) == 0u) { if (xb_ld(&(bar)[XB_TMO])) break; if (_sp > XB_SPIN_CAP) { atomicAdd(&(bar)[XB_TMO], 1u); break; } } } } while (0)
struct XcdBarrier { unsigned* bar; unsigned x; volatile LAS unsigned* st; };
__device__ __forceinline__ XcdBarrier xcd_barrier_post(unsigned* bar, volatile LAS unsigned* st) {
    XcdBarrier b; b.bar = bar; b.x = xb_xcc_id(); b.st = st;
    if (threadIdx.x == 0) (void)xb_add(&bar[XB_XCNT(b.x)], 1u);
    return b;
}
__device__ __forceinline__ void xcd_barrier_complete(unsigned* bar, unsigned x, unsigned& nloc, unsigned& nx) {
    const unsigned G = gridDim.x * gridDim.y * gridDim.z;
    unsigned sum, cnt, mine, sp = 0u;
    for (;;) {
        sum = 0u; cnt = 0u; mine = 0u;
#pragma unroll
        for (unsigned j = 0; j < 16; ++j) { const unsigned c = xb_ld(&bar[XB_XCNT(j)]); sum += c; cnt += (c > 0u) ? 1u : 0u; mine = (j == x) ? c : mine; }
        if (sum == G) break;
        __builtin_amdgcn_s_sleep(1);
        if ((++sp & 255u) == 0u) { if (xb_ld(&bar[XB_TMO])) break; if (sp > XB_SPIN_CAP) { atomicAdd(&bar[XB_TMO], 1u); break; } }
    }
    nloc = mine > 0u ? mine : 1u; nx = cnt > 0u ? cnt : 1u;
}
__device__ __forceinline__ void xcd_barrier(const XcdBarrier& b) {
    asm volatile("s_waitcnt vmcnt(0)" ::: "memory");
    __syncthreads();
    if (threadIdx.x == 0) {
        unsigned* bar = b.bar;
        __builtin_amdgcn_s_waitcnt(0);
        const unsigned nloc = b.st[0], nx = b.st[1];
        const unsigned old = xb_add(&bar[XB_XSUB(b.x)], 1u);
        const unsigned gen = old / nloc;
        if (old + 1u == (gen + 1u) * nloc) {
            __builtin_amdgcn_fence(__ATOMIC_RELEASE, "agent");
            asm volatile("s_waitcnt vmcnt(0)" ::: "memory");
            const unsigned og = xb_add(&bar[XB_TOP], 1u);
            const unsigned tg = og / nx;
            if (og + 1u == (tg + 1u) * nx) xb_add(&bar[XB_TOPGEN], 1u);
            else XB_SPIN(xb_ld(&bar[XB_TOPGEN]) == tg, bar);
            __builtin_amdgcn_fence(__ATOMIC_ACQUIRE, "agent");
            xb_add(&bar[XB_XGEN(b.x)], 1u);
            asm volatile("s_waitcnt vmcnt(0)" ::: "memory");
        } else {
            XB_SPIN(xb_ld(&bar[XB_XGEN(b.x)]) == gen, bar);
            __builtin_amdgcn_fence(__ATOMIC_ACQUIRE, "agent");
            asm volatile("s_waitcnt vmcnt(0)" ::: "memory");
        }
    }
    __syncthreads();
}


__device__ __forceinline__ void split_arrive(unsigned* sp, const XcdBarrier& b, bool hier) {
    asm volatile("s_waitcnt vmcnt(0)" ::: "memory");
    __syncthreads();
    if (threadIdx.x == 0) {
        if (hier) { const unsigned nloc = b.st[0];
            const unsigned old = xb_add(&sp[64 * b.x], 1u);
            if (old + 1u == nloc) { __builtin_amdgcn_fence(__ATOMIC_RELEASE, "agent"); asm volatile("s_waitcnt vmcnt(0)" ::: "memory"); xb_add(&sp[64 * 16], 1u); } }
        else { __builtin_amdgcn_fence(__ATOMIC_RELEASE, "agent"); asm volatile("s_waitcnt vmcnt(0)" ::: "memory"); xb_add(&sp[64 * 16], 1u); }
    }
}
__device__ __forceinline__ void split_wait(unsigned* sp, const XcdBarrier& b, bool hier, unsigned* tmo) {
    if (threadIdx.x < 64) {
        const unsigned need = hier ? b.st[1] : gridDim.x;
        unsigned spn = 0;
        while ((unsigned)__builtin_amdgcn_readfirstlane((int)xb_ld(&sp[64 * 16])) < need) { __builtin_amdgcn_s_sleep(2);
            if ((++spn & 255u) == 0u) { if (xb_ld(tmo)) break; if (spn > XB_SPIN_CAP) { if (threadIdx.x == 0) atomicAdd(tmo, 1u); break; } } }
        __builtin_amdgcn_fence(__ATOMIC_ACQUIRE, "agent");
        asm volatile("s_waitcnt vmcnt(0)" ::: "memory");
    }
    asm volatile("" ::: "memory"); __builtin_amdgcn_s_barrier(); asm volatile("" ::: "memory");
}

constexpr int NWAVES = 8, NTHREADS = 512, GRID = 256;
constexpr int LDS_BYTES = 147456;
constexpr int MISC_OFF = 131072 + 320;
constexpr int CW_BAR = 4096;

struct Args {
    const float* in[25];
    float* out; unsigned char* ws;
    int ph_lo, ph_hi;
};

enum { I_X = 0, I_C, I_CTX, I_CCTX, I_WADA, I_BADA, I_GNORM, I_WIN, I_GQ, I_GK, I_LQ1, I_LK1, I_LQ2, I_LK2, I_GSUB, I_WF, I_BF, I_LNG, I_LNB, I_WS, I_BS, I_WBRA, I_WBRB, I_WBRC, I_WOUT };

__device__ __forceinline__ void transpose_item(const float* W, int ldw, int k0, int lcol0, bool perm, bf16_t* dst, int ldd, int prow0, int dcol0, LAS float* scr, int lane) {
#pragma unroll 8
    for (int i = 0; i < 32; ++i) { const int kk = 2 * i + (lane >> 5); scr[kk * 33 + (lane & 31)] = W[(size_t)(k0 + kk) * ldw + lcol0 + (lane & 31)]; }
    LDS_WAIT(); asm volatile("" ::: "memory");
    const int c = lane & 7;
#pragma unroll
    for (int j = 0; j < 4; ++j) { const int n = (lane >> 3) + 8 * j; const int jn = perm ? perm32(n) : n; const LAS float* s = scr + (8 * c) * 33 + jn;
        u32x4 o; o.x = pk2(s[0 * 33], s[1 * 33]); o.y = pk2(s[2 * 33], s[3 * 33]); o.z = pk2(s[4 * 33], s[5 * 33]); o.w = pk2(s[6 * 33], s[7 * 33]);
        *(GAS u32x4*)(dst + (size_t)(prow0 + n) * ldd + dcol0 + k0 + 8 * c) = o; }
    LDS_WAIT(); asm volatile("" ::: "memory");
}
__device__ __forceinline__ bool win_block_map(int pb, int& lcol, bool& perm) {
    const int tile = pb >> 3, w = pb & 7, bj = w >> 2, wc = w & 3;
    if (tile < 2) { lcol = OFF_Q + (4 * (tile & 1) + wc) * 64 + 32 * bj; perm = false; return true; }
    if (tile < 4) { lcol = OFF_K + (4 * (tile & 1) + wc) * 64 + 32 * bj; perm = false; return true; }
    perm = true;
    if (tile < 6) { lcol = OFF_V + 256 * (tile - 4) + 32 * w; return true; }
    if (tile < 8) return false;
    if (tile < 10) { lcol = (bj == 0 ? OFF_U : OFF_GATE + 768) + 128 * (tile - 8) + 32 * wc; return true; }
    if (tile == 10) { lcol = OFF_VC + 32 * w; return true; }
    if (tile < 14) { lcol = OFF_GATE + 256 * (tile - 11) + 32 * w; return true; }
    lcol = OFF_MERGE + 256 * (tile - 14) + 32 * w; return true;
}
__device__ __forceinline__ float cos2pi(int a, int n) { return cospif(2.0f * (float)a / (float)n); }
__device__ __forceinline__ float sin2pi(int a, int n) { return sinpif(2.0f * (float)a / (float)n); }

__device__ __forceinline__ void ph0_mods(const Args& a, int lane, int wave, int vcu);
__device__ __forceinline__ void ph0_prologue(const Args& a, LAS unsigned char* lds, int tid, int lane, int wave, int vcu, int pmask) {
    unsigned char* ws = a.ws;
    const int gw = vcu * NWAVES + wave, NGW = GRID * NWAVES;
    const int gt = vcu * NTHREADS + tid, NGT = GRID * NTHREADS;
    if (pmask & 1) {
        LAS float* scr = (LAS float*)(lds + wave * 16384);
        constexpr int I_WIN_N = DEPTH * 208 * 16;
        constexpr int I_BR_N = DEPTH * 32 * 16;
        constexpr int I_OUT_N = DEPTH * 32 * 16;
        for (int it = gw; it < I_WIN_N + I_BR_N + I_OUT_N; it += NGW) {
            int r = it;
            if (r < I_WIN_N) {
                const int l = r / (208 * 16), q = r % (208 * 16), pb = q >> 4, kb = q & 15; int lcol; bool perm;
                if (!win_block_map(pb, lcol, perm)) continue;
                transpose_item(a.in[I_WIN] + (size_t)l * DM * INW, INW, 64 * kb, lcol, perm, (bf16_t*)(ws + WS_WIN) + (size_t)l * NPHYS * DM, DM, 32 * pb, 0, scr, lane);
                continue;
            }
            r -= I_WIN_N;
            if (r < I_BR_N) {
                const int l = r / 512, q = r % 512, pb = q >> 4, kb = q & 15;
                const float* W; int ksrc;
                if (kb < 8) { W = a.in[I_WBRA] + (size_t)l * 512 * DM; ksrc = 64 * kb; } else if (kb < 12) { W = a.in[I_WBRB] + (size_t)l * 256 * DM; ksrc = 64 * (kb - 8); } else { W = a.in[I_WBRC] + (size_t)l * 256 * DM; ksrc = 64 * (kb - 12); }
                transpose_item(W, DM, ksrc, 32 * pb, true, (bf16_t*)(ws + WS_WBR) + (size_t)l * DM * DM, DM, 32 * pb, 64 * kb - ksrc, scr, lane);
                continue;
            }
            r -= I_BR_N;
            { const int l = r / 512, q = r % 512, pb = q >> 4, kb = q & 15;
              transpose_item(a.in[I_WOUT] + (size_t)l * DM * DM, DM, 64 * kb, 32 * pb, true, (bf16_t*)(ws + WS_WOUT) + (size_t)l * DM * DM, DM, 32 * pb, 0, scr, lane); }
        }
    }
    __syncthreads();
    if (pmask & 2) {
        LAS float* Wb = (LAS float*)lds;
        LAS float* TR = Wb + 64 * 65;
        LAS float* Tt = TR + 64 * 128;
        LAS float* Wf = Tt + 64 * 132;
        for (int it = vcu; it < DEPTH * 4 * 16; it += GRID) {
            const int l = it / 64, g = (it >> 4) & 3, kb = it & 15;
            const float* win = a.in[I_WIN] + (size_t)l * DM * INW; const float* wf = a.in[I_WF] + (size_t)(l * 4 + g) * 64 * 64;
            for (int e = tid; e < 4096; e += NTHREADS) { const int r = e >> 6, c = e & 63; Wb[r * 65 + c] = win[(size_t)(64 * kb + r) * INW + OFF_F + 64 * g + c]; Wf[e] = wf[e]; }
            for (int e = tid; e < 64 * 128; e += NTHREADS) { const int c = e >> 7, ri = (e >> 6) & 1, cp = e & 63; const int ph = (c * cp) & 63; TR[e] = ri ? -sin2pi(ph, 64) : cos2pi(ph, 64); }
            __syncthreads();
            const int tk = tid >> 5, tn = tid & 31;
            { f32x4 acc[4];
#pragma unroll
              for (int i = 0; i < 4; ++i) acc[i] = (f32x4){0.f, 0.f, 0.f, 0.f};
#pragma unroll 4
              for (int c = 0; c < 64; ++c) { const f32x4 bv = *(const LAS f32x4*)(TR + c * 128 + 4 * tn);
#pragma unroll
                  for (int i = 0; i < 4; ++i) acc[i] += bv * Wb[(4 * tk + i) * 65 + c]; }
#pragma unroll
              for (int i = 0; i < 4; ++i) *(LAS f32x4*)(Tt + (4 * tk + i) * 132 + 4 * tn) = acc[i]; }
            __syncthreads();
            { const int ri = tn >> 4, td = tn & 15;
              f32x4 acc[4];
#pragma unroll
              for (int i = 0; i < 4; ++i) acc[i] = (f32x4){0.f, 0.f, 0.f, 0.f};
#pragma unroll 4
              for (int cp = 0; cp < 64; ++cp) { const f32x4 bv = *(const LAS f32x4*)(Wf + cp * 64 + 4 * td);
#pragma unroll
                  for (int i = 0; i < 4; ++i) acc[i] += bv * Tt[(4 * tk + i) * 132 + ri * 64 + cp]; }
              bf16_t* dst = (bf16_t*)(ws + WS_WIN) + (size_t)l * NPHYS * DM;
#pragma unroll
              for (int e = 0; e < 4; ++e) { const int ch = 64 * g + 4 * td + e, prow = 6 * 256 + ri * 256 + (ch & ~31) + invperm32(ch & 31);
                  u32x2 w; w.x = pk2(acc[0][e], acc[1][e]); w.y = pk2(acc[2][e], acc[3][e]);
                  *(u32x2*)(dst + (size_t)prow * DM + 64 * kb + 4 * tk) = w; } }
            __syncthreads();
        }
    }
    if (pmask & 4) {
        float* ropec = (float*)(ws + WS_ROPE); float* ropes = ropec + 2048;
        for (int e = gt; e < 2048; e += NGT) { const int pos = e >> 4, f = e & 15; const float freq = powf(10000.0f, -(float)(2 * f) / 32.0f); const float ang = (float)pos * freq; ropec[e] = cosf(ang); ropes[e] = sinf(ang); }
        f32x2* tw = (f32x2*)(ws + WS_TW);
        for (int e = gt; e < 8192; e += NGT) tw[e] = (f32x2){cos2pi(e, 8192), sin2pi(e, 8192)};
        bf16_t* c128 = (bf16_t*)(ws + WS_C128); bf16_t* s128 = (bf16_t*)(ws + WS_S128);
        for (int e = gt; e < 4 * 8 * 64 * 8; e += NGT) { const int j = e & 7, ln = (e >> 3) & 63, s = (e >> 9) & 7, mb = e >> 12; const int row = 32 * mb + (ln & 31), k = 16 * s + 8 * (j >> 2) + 4 * (ln >> 5) + (j & 3);
            const int ph = (row * k) & 127; c128[e] = (bf16_t)f2bf(cos2pi(ph, 128)); s128[e] = (bf16_t)f2bf(sin2pi(ph, 128)); }
        bf16_t* t64 = (bf16_t*)(ws + WS_T64);
        for (int e = gt; e < 2 * 8 * 64 * 8; e += NGT) { const int j = e & 7, ln = (e >> 3) & 63, s = (e >> 9) & 7, mb = e >> 12; const int row = 32 * mb + (ln & 31), k = 16 * s + 8 * (j >> 2) + 4 * (ln >> 5) + (j & 3);
            const int ri = k >> 6, c = k & 63, ph = (row * c) & 63; t64[e] = (bf16_t)f2bf(ri ? sin2pi(ph, 64) : cos2pi(ph, 64)); }
        bf16_t* tc256 = (bf16_t*)(ws + WS_TC256);
        for (int e = gt; e < 8 * 32 * 64 * 8; e += NGT) { const int j = e & 7, ln = (e >> 3) & 63, s = (e >> 9) & 31, mb = e >> 14; const int row = 32 * mb + (ln & 31), k = 16 * s + 8 * (j >> 2) + 4 * (ln >> 5) + (j & 3);
            const int ri = k >> 8, n = k & 255, ph = (row * n) & 255; tc256[e] = (bf16_t)f2bf(ri ? sin2pi(ph, 256) : cos2pi(ph, 256)); }
        bf16_t* wsimg = (bf16_t*)(ws + WS_WSIMG);
        for (int e = gt; e < DEPTH * 4 * 4 * 8 * 64 * 8; e += NGT) { const int j = e & 7, ln = (e >> 3) & 63, s = (e >> 9) & 7, mb = (e >> 12) & 3, lg = e >> 14; const int row = 32 * mb + (ln & 31), k = 16 * s + 8 * (j >> 2) + 4 * (ln >> 5) + (j & 3);
            wsimg[e] = (bf16_t)f2bf(a.in[I_WS][(size_t)lg * 128 * 128 + row * 128 + k]); }
        if (gt < DEPTH) { const int l = gt; float s1 = 0.f, s2 = 0.f;
            for (int i = 0; i < 64; ++i) { s1 += a.in[I_LQ1][l * 64 + i] * a.in[I_LK1][l * 64 + i]; s2 += a.in[I_LQ2][l * 64 + i] * a.in[I_LK2][l * 64 + i]; }
            const float lam_init = 0.8f - 0.6f * expf(-0.3f * (float)l);
            float* lam = (float*)(ws + WS_LAM); lam[2 * l] = expf(s1) - expf(s2) + lam_init; lam[2 * l + 1] = 1.0f - lam_init; }
    }
}

__device__ __forceinline__ void ph0_mods(const Args& a, int lane, int wave, int vcu) {
    unsigned char* ws = a.ws; const int gw = vcu * NWAVES + wave, NGW = GRID * NWAVES;
    {
        float* part = (float*)(ws + WS_MODP);
        for (int it = gw; it < DEPTH * 12 * 32; it += NGW) {
            const int l = it / 384, q = it % 384, cc = q >> 5, kc = q & 31; const int col = 256 * cc + 4 * lane;
            const float* w = a.in[I_WADA] + (size_t)l * DM * 3072 + col;
            f32x4 s0 = {0.f, 0.f, 0.f, 0.f}, s1 = s0, s2 = s0;
#pragma unroll 8
            for (int kk = 0; kk < 32; ++kk) { const int k = 32 * kc + kk; const f32x4 wv = *(const f32x4*)(w + (size_t)k * 3072);
                const float a0 = fast_silu(a.in[I_C][k]), a1 = fast_silu(a.in[I_C][DM + k]), a2 = fast_silu(a.in[I_CCTX][k]);
                s0 += wv * a0; s1 += wv * a1; s2 += wv * a2; }
            float* p = part + ((size_t)(l * 32 + kc) * 3) * 3072 + col;
            *(f32x4*)(p) = s0; *(f32x4*)(p + 3072) = s1; *(f32x4*)(p + 2 * 3072) = s2;
        }
    }
}

__device__ __forceinline__ void prepass(const Args& a, int l, LAS unsigned char* lds, int tid, int lane, int wave, int vcu) {
    unsigned char* ws = a.ws;
    const float* part = (const float*)(ws + WS_MODP); float* modf = (float*)(ws + WS_MODF);
    if (l == 0) {
        if (tid < 72) { const int o = vcu * 72 + tid; const int ll = o / 9216, rj = o % 9216, r = rj / 3072, j = rj % 3072; float s = a.in[I_BADA][ll * 3072 + j];
#pragma unroll
            for (int kc = 0; kc < 32; ++kc) s += part[((size_t)(ll * 32 + kc) * 3 + r) * 3072 + j];
            modf[o] = s; }
    }
    const int row0 = vcu * 66, row1 = row0 + 66;
    LAS float* coef = (LAS float*)lds;
    for (int r = 0; r < 3; ++r) {
        const int lo = r == 0 ? 0 : (r == 1 ? SEQ : MLAT), hi = r == 0 ? SEQ : (r == 1 ? MLAT : MT);
        if (row1 <= lo || row0 >= hi) continue;
        for (int k = tid; k < DM; k += NTHREADS) {
            float sh, sc;
            if (l == 0) { sh = a.in[I_BADA][k]; sc = a.in[I_BADA][DM + k];
#pragma unroll
                for (int kc = 0; kc < 32; ++kc) { const float* p = part + ((size_t)(kc) * 3 + r) * 3072; sh += p[k]; sc += p[DM + k]; } }
            else { sh = modf[(size_t)(l * 3 + r) * 3072 + k]; sc = modf[(size_t)(l * 3 + r) * 3072 + DM + k]; }
            coef[(r * 2) * DM + k] = a.in[I_GNORM][l * DM + k] * (1.0f + sc); coef[(r * 2 + 1) * DM + k] = sh;
        }
    }
    __syncthreads();
    const float* xlat = l == 0 ? a.in[I_X] : a.out; const float* xctx = l == 0 ? a.in[I_CTX] : (const float*)(ws + WS_CTX1);
    bf16_t* H = (bf16_t*)(ws + WS_H);
    for (int mb = row0 + 4 * wave; mb < row1; mb += 4 * NWAVES) {
        f32x4 v[4][4]; float s2[4];
#pragma unroll
        for (int q = 0; q < 4; ++q) { const int m = (mb + q < row1) ? mb + q : mb;
            if (l == 1 && m < MLAT) { const GAS u32x2* xb = (const GAS u32x2*)(ws + x1b_off(m)) + lane;
#pragma unroll
                for (int j = 0; j < 4; ++j) { const u32x2 t = xb[64 * j]; v[q][j] = (f32x4){bflo(t.x), bfhi(t.x), bflo(t.y), bfhi(t.y)}; } }
            else { const float* xrow = m < MLAT ? xlat + (size_t)m * DM : xctx + (size_t)(m - MLAT) * DM; const GAS f32x4* xr = (const GAS f32x4*)xrow + lane;
#pragma unroll
                for (int j = 0; j < 4; ++j) v[q][j] = xr[64 * j]; } }
#pragma unroll
        for (int q = 0; q < 4; ++q) { float t = 0.f;
#pragma unroll
            for (int j = 0; j < 4; ++j) t += (v[q][j].x * v[q][j].x + v[q][j].y * v[q][j].y) + (v[q][j].z * v[q][j].z + v[q][j].w * v[q][j].w);
            s2[q] = t; }
#pragma unroll
        for (int o = 1; o < 64; o <<= 1) {
#pragma unroll
            for (int q = 0; q < 4; ++q) s2[q] += __shfl_xor(s2[q], o); }
#pragma unroll
        for (int q = 0; q < 4; ++q) { const int m = mb + q; if (m >= row1) break;
            const int r = m < SEQ ? 0 : (m < MLAT ? 1 : 2);
            const float rstd = rsqrtf(s2[q] * (1.0f / DM) + EPS);
            GAS u32x2* o8 = (GAS u32x2*)(H + (size_t)m * DM) + lane;
#pragma unroll
            for (int j = 0; j < 4; ++j) { const f32x4 ga = *(const LAS f32x4*)(coef + (r * 2) * DM + 256 * j + 4 * lane), sh = *(const LAS f32x4*)(coef + (r * 2 + 1) * DM + 256 * j + 4 * lane);
                const f32x4 h = v[q][j] * rstd * ga + sh; u32x2 w; w.x = pk2(h.x, h.y); w.y = pk2(h.z, h.w); o8[64 * j] = w; } }
    }
    __syncthreads();
}

struct TileSched {
    int x, c, pn0, npn, nseg, nctx, cpn0, cnpn;
    __device__ __forceinline__ bool next(int i, pg8::Unit& u) const {
        const int ti = i / nseg; u.seg = i - ti * nseg; u.set = 0;
        const int j = ti * 32 + c;
        if (j < 8 * npn) { u.pm = 8 * x + (j & 7); u.pn = pn0 + (j >> 3); return true; }
        const int id = (j - 8 * npn) * 8 + x;
        if (id < nctx) { u.pm = 64 + (id & 1); u.pn = cpn0 + (id >> 1); return true; }
        return false;
    }
    __device__ __forceinline__ void a_ready(const pg8::Unit&) const {}
};

struct EpiIn {
    unsigned char* ws; const float* gq; const float* gk; const float* ropec; const float* ropes;
    __device__ __forceinline__ bool operator()(f32x4 (&acc)[2][2][4][2], const pg8::Unit& u, int wr, int wc, int fr, int fq) const {
        const bool ctx = u.pm >= 64; const int b = ctx ? u.pm - 64 : (u.pm >> 5);
        const int rbase = u.pm * 256 + wr * 64 + fr;
        const int pn = u.pn;
        if (pn < 4) {
            const bool isK = pn >= 2; const int gi = 4 * (pn & 1) + wc, h = gi >> 1, comp = gi & 1;
            const float* gsrc = isK ? gk : gq;
            f32x4 gv[2][2];
#pragma unroll
            for (int bj = 0; bj < 2; ++bj)
#pragma unroll
                for (int n = 0; n < 2; ++n) gv[bj][n] = *(const f32x4*)(gsrc + 32 * bj + 16 * n + 4 * fq);
#pragma unroll
            for (int ai = 0; ai < 2; ++ai)
#pragma unroll
                for (int m = 0; m < 4; ++m) {
                    const int row = rbase + ai * 128 + m * 16;
                    f32x4 v[2][2]; float ss = 0.f;
#pragma unroll
                    for (int bj = 0; bj < 2; ++bj)
#pragma unroll
                        for (int n = 0; n < 2; ++n) { v[bj][n] = acc[ai][bj][m][n]; ss += (v[bj][n].x * v[bj][n].x + v[bj][n].y * v[bj][n].y) + (v[bj][n].z * v[bj][n].z + v[bj][n].w * v[bj][n].w); }
                    ss += __shfl_xor(ss, 16); ss += __shfl_xor(ss, 32);
                    const float rstd = rsqrtf(ss * (1.0f / 64.0f) + EPS);
#pragma unroll
                    for (int bj = 0; bj < 2; ++bj)
#pragma unroll
                        for (int n = 0; n < 2; ++n) v[bj][n] = v[bj][n] * rstd * gv[bj][n];
                    int kx;
                    if (!ctx) { const int ntok = row - b * SEQ; kx = ntok;
#pragma unroll
                        for (int bj = 0; bj < 2; ++bj) { const int pos = bj == 0 ? (ntok >> 6) : (ntok & 63);
                            const f32x4 c4 = *(const f32x4*)(ropec + pos * 16 + 4 * fq), s4 = *(const f32x4*)(ropes + pos * 16 + 4 * fq);
                            const f32x4 x1 = v[bj][0], x2 = v[bj][1]; v[bj][0] = x1 * c4 - x2 * s4; v[bj][1] = x2 * c4 + x1 * s4; } }
                    else kx = SEQ + (row - MLAT - b * NCTX);
#pragma unroll
                    for (int bj = 0; bj < 2; ++bj) {
                        f32x4 p0 = v[bj][0], p1 = v[bj][1];
                        if (!isK) { p0 = p0 * QSCALE; p1 = p1 * QSCALE; }
                        u32x4 w; w.x = cvt_pk_bf16(p0.x, p0.y); w.y = cvt_pk_bf16(p0.z, p0.w); w.z = cvt_pk_bf16(p1.x, p1.y); w.w = cvt_pk_bf16(p1.z, p1.w);
                        if (!isK) *(u32x4*)((bf16_t*)(ws + WS_QG) + ((size_t)row * 4 + h) * 128 + comp * 64 + (bj * 4 + fq) * 8) = w;
                        else *(u32x4*)(ws + WS_KIMG + ((size_t)((b * 4 + h) * NKT + (kx >> 6)) * 16 + comp * 8 + bj * 4 + fq) * 1024 + (kx & 63) * 16) = w;
                    }
                }
            return true;
        }
#pragma unroll
        for (int ai = 0; ai < 2; ++ai)
#pragma unroll
            for (int m = 0; m < 4; ++m) {
                const int row = rbase + ai * 128 + m * 16;
                if (pn == 8 || pn == 9) {
                    f32x4 p0, p1;
#pragma unroll
                    for (int e = 0; e < 4; ++e) { p0[e] = acc[ai][0][m][0][e] * fast_silu(acc[ai][1][m][0][e]); p1[e] = acc[ai][0][m][1][e] * fast_silu(acc[ai][1][m][1][e]); }
                    u32x4 w; w.x = cvt_pk_bf16(p0.x, p0.y); w.y = cvt_pk_bf16(p0.z, p0.w); w.z = cvt_pk_bf16(p1.x, p1.y); w.w = cvt_pk_bf16(p1.z, p1.w);
                    *(u32x4*)((bf16_t*)(ws + WS_UG) + (size_t)row * 256 + 128 * (pn - 8) + 32 * wc + 8 * fq) = w;
                    continue;
                }
#pragma unroll
                for (int bj = 0; bj < 2; ++bj) {
                    f32x4 p0 = acc[ai][bj][m][0], p1 = acc[ai][bj][m][1];
                    const int lc = 128 * bj + 32 * wc + 8 * fq;
                    unsigned char* dst;
                    if (pn < 6) { const int kx = ctx ? SEQ + (row - MLAT - b * NCTX) : row - b * SEQ; const int h = 2 * (pn - 4) + bj;
                        dst = ws + WS_VIMG + ((size_t)((b * 4 + h) * NKT + (kx >> 6)) * 16 + wc * 4 + ((kx & 63) >> 4)) * 1024 + (kx & 15) * 64 + fq * 16; }
                    else if (pn < 8) dst = ws + WS_Z2 + ((size_t)row * 512 + 256 * (pn - 6) + lc) * 2;
                    else if (pn == 10) dst = ws + WS_VC + ((size_t)row * 256 + lc) * 2;
                    else if (pn < 14) {
#pragma unroll
                        for (int e = 0; e < 4; ++e) { p0[e] = fast_silu(p0[e]); p1[e] = fast_silu(p1[e]); }
                        dst = ws + WS_GS + ((size_t)row * 768 + 256 * (pn - 11) + lc) * 2; }
                    else {
                        unsigned q0 = 0u, q1 = 0u;
#pragma unroll
                        for (int e = 0; e < 4; ++e) { q0 = ms_quant_pk(p0[e], e, q0); q1 = ms_quant_pk(p1[e], e, q1); }
                        unsigned char* d8 = ctx ? ws + WS_MSC + ((size_t)(row - MLAT) * 3072 + 256 * (pn - 14) + lc) : ws + WS_MS + ((size_t)row * 3072 + 256 * (pn - 14) + lc);
                        u32x2 w8; w8.x = q0; w8.y = q1; *(u32x2*)d8 = w8; continue; }
                    u32x4 w; w.x = cvt_pk_bf16(p0.x, p0.y); w.y = cvt_pk_bf16(p0.z, p0.w); w.z = cvt_pk_bf16(p1.x, p1.y); w.w = cvt_pk_bf16(p1.z, p1.w);
                    *(u32x4*)dst = w;
                }
            }
        return true;
    }
};

struct EpiY {
    const unsigned char* MS; bf16_t* Y;
    __device__ __forceinline__ bool operator()(f32x4 (&acc)[2][2][4][2], const pg8::Unit& u, int wr, int wc, int fr, int fq) const {
        const int rbase = u.pm * 256 + wr * 64 + fr; const int seg = u.seg;
#pragma unroll
        for (int ai = 0; ai < 2; ++ai)
#pragma unroll
            for (int m = 0; m < 4; ++m) {
                const int row = rbase + ai * 128 + m * 16;
#pragma unroll
                for (int bj = 0; bj < 2; ++bj) {
                    const int col = 256 * u.pn + 128 * bj + 32 * wc + 8 * fq;
                    const unsigned char* mp = MS + (size_t)row * 3072 + seg * 1024 + col;
                    const u32x2 mn = *(const u32x2*)mp;
                    f32x4& p0 = acc[ai][bj][m][0]; f32x4& p1 = acc[ai][bj][m][1];
                    if (seg < 2) { const u32x2 md = *(const u32x2*)(mp + 1024);
#pragma unroll
                        for (int e = 0; e < 4; ++e) { p0[e] *= ub(mn.x, e) * __builtin_amdgcn_rcpf(ub(md.x, e)); p1[e] *= ub(mn.y, e) * __builtin_amdgcn_rcpf(ub(md.y, e)); } }
                    else {
#pragma unroll
                        for (int e = 0; e < 4; ++e) { p0[e] *= ub(mn.x, e) * (1.0f / 255.0f); p1[e] *= ub(mn.y, e) * (1.0f / 255.0f); }
                        u32x4 w; w.x = cvt_pk_bf16(p0[0], p0[1]); w.y = cvt_pk_bf16(p0[2], p0[3]); w.z = cvt_pk_bf16(p1[0], p1[1]); w.w = cvt_pk_bf16(p1[2], p1[3]);
                        *(u32x4*)(Y + (size_t)row * DM + col) = w; }
                }
            }
        return seg == 2;
    }
};


struct FusedSched {
    int x, c; unsigned* sp; XcdBarrier bar; bool hier; unsigned* tmo;
    __device__ __forceinline__ bool next(int i, pg8::Unit& u) const {
        if (i >= 6) return false;
        u.pm = 8 * x + (c & 7);
        if (i < 3) { u.pn = 14 + 4 * i + (c >> 3); u.seg = 0; u.set = 1; } else { u.pn = c >> 3; u.seg = i - 3; u.set = 0; }
        return true;
    }
    __device__ __forceinline__ void a_ready(const pg8::Unit& u) const { if (u.set == 0 && u.seg == 1) split_wait(sp, bar, hier, tmo); }
};
struct EpiMY {
    EpiIn ein; EpiY ey;
    __device__ __forceinline__ bool operator()(f32x4 (&acc)[2][2][4][2], const pg8::Unit& u, int wr, int wc, int fr, int fq) const { return u.set ? ein(acc, u, wr, wc, fr, fq) : ey(acc, u, wr, wc, fr, fq); }
};

struct EpiOut {
    const float* xin; float* out; unsigned char* ws; const float* gate; int layer;
    __device__ __forceinline__ bool operator()(f32x4 (&acc)[2][2][4][2], const pg8::Unit& u, int wr, int wc, int fr, int fq) const {
        const int r = u.pm >> 5;
        const int rbase = u.pm * 256 + wr * 64 + fr;
        f32x4 xa[2][2], xb[2][2], xc[2][2];
#define EO_C(g) (256 * u.pn + 128 * ((g) >> 2) + 32 * wc + 8 * fq)
#define EO_ROW(g, mm) (rbase + (((g) >> 1) & 1) * 128 + (2 * ((g) & 1) + (mm)) * 16)
#define EO_LOAD(dst, g) do { _Pragma("unroll") for (int mm = 0; mm < 2; ++mm) { \
            if (layer == 0) { const float* p_ = xin + (size_t)EO_ROW(g, mm) * DM + EO_C(g); dst[mm][0] = *(const f32x4*)p_; dst[mm][1] = *(const f32x4*)(p_ + 4); } \
            else { const u32x4 t_ = *(const u32x4*)(ws + x1b_off(EO_ROW(g, mm)) + (size_t)EO_C(g) * 2); dst[mm][0] = (f32x4){bflo(t_.x), bfhi(t_.x), bflo(t_.y), bfhi(t_.y)}; dst[mm][1] = (f32x4){bflo(t_.z), bfhi(t_.z), bflo(t_.w), bfhi(t_.w)}; } } } while (0)
#define EO_STORE(srcv, g) do { const f32x4 g0_ = *(const f32x4*)(gate + (size_t)r * 3072 + EO_C(g)), g1_ = *(const f32x4*)(gate + (size_t)r * 3072 + EO_C(g) + 4); \
            _Pragma("unroll") for (int mm = 0; mm < 2; ++mm) { \
                const f32x4 y0_ = srcv[mm][0] + g0_ * acc[((g) >> 1) & 1][(g) >> 2][2 * ((g) & 1) + mm][0], y1_ = srcv[mm][1] + g1_ * acc[((g) >> 1) & 1][(g) >> 2][2 * ((g) & 1) + mm][1]; \
                if (layer == 0) { u32x4 w_; w_.x = cvt_pk_bf16(y0_.x, y0_.y); w_.y = cvt_pk_bf16(y0_.z, y0_.w); w_.z = cvt_pk_bf16(y1_.x, y1_.y); w_.w = cvt_pk_bf16(y1_.z, y1_.w); *(u32x4*)(ws + x1b_off(EO_ROW(g, mm)) + (size_t)EO_C(g) * 2) = w_; } \
                else { float* p_ = out + (size_t)EO_ROW(g, mm) * DM + EO_C(g); *(f32x4*)p_ = y0_; *(f32x4*)(p_ + 4) = y1_; } } } while (0)
        EO_LOAD(xa, 0); EO_LOAD(xb, 1); EO_LOAD(xc, 2);
        EO_STORE(xa, 0); EO_LOAD(xa, 3);
        EO_STORE(xb, 1); EO_LOAD(xb, 4);
        EO_STORE(xc, 2); EO_LOAD(xc, 5);
        EO_STORE(xa, 3); EO_LOAD(xa, 6);
        EO_STORE(xb, 4); EO_LOAD(xb, 7);
        EO_STORE(xc, 5); EO_STORE(xa, 6); EO_STORE(xb, 7);
#undef EO_C
#undef EO_ROW
#undef EO_LOAD
#undef EO_STORE
        return true;
    }
};

__device__ __forceinline__ f32x4 mini_block(const bf16_t* A, int lda, const bf16_t* Bt, int ldb, int m0, int n0, int k0, int nk, int fr, int fq, f32x4 acc) {
    const bf16_t* ap = A + (size_t)(m0 + fr) * lda + k0 + 8 * fq; const bf16_t* bp = Bt + (size_t)(n0 + fr) * ldb + k0 + 8 * fq;
#pragma unroll 8
    for (int s = 0; s < nk; s += 32) acc = __builtin_amdgcn_mfma_f32_16x16x32_bf16(*(const bf16x8*)(bp + s), *(const bf16x8*)(ap + s), acc, 0, 0, 0);
    return acc;
}
__device__ __forceinline__ int mini_lcol(int n0, int fq) { return (n0 & ~31) + 8 * fq + 4 * ((n0 >> 4) & 1); }
__device__ __forceinline__ void ctx_merge_gates(unsigned char* ws, const bf16_t* Wl, int gw, int lane) {
    const int fr = lane & 15, fq = lane >> 4; const bf16_t* H = (const bf16_t*)(ws + WS_H); bf16_t* MS = (bf16_t*)(ws + WS_MS);
    for (int blk = gw; blk < 32 * 192; blk += GRID * NWAVES) { const int m0 = MLAT + 16 * (blk & 31), n0 = 16 * (blk >> 5);
        const f32x4 acc = mini_block(H, DM, Wl + (size_t)(14 * 256) * DM, DM, m0, n0, 0, DM, fr, fq, (f32x4){0.f, 0.f, 0.f, 0.f});
        u32x2 w; w.x = cvt_pk_bf16(fast_sigmoid(acc[0]), fast_sigmoid(acc[1])); w.y = cvt_pk_bf16(fast_sigmoid(acc[2]), fast_sigmoid(acc[3]));
        *(u32x2*)(MS + (size_t)(m0 + fr) * 3072 + mini_lcol(n0, fq)) = w; }
}
__device__ __forceinline__ void ctx_branch_proj(unsigned char* ws, const bf16_t* Wbr, int gw, int lane) {
    const int fr = lane & 15, fq = lane >> 4; const bf16_t* A = (const bf16_t*)(ws + WS_A); const unsigned char* MS = (const unsigned char*)(ws + WS_MSC) - (size_t)MLAT * 3072; bf16_t* Y = (bf16_t*)(ws + WS_Y);
    for (int blk = gw; blk < 32 * 64; blk += GRID * NWAVES) { const int m0 = MLAT + 16 * (blk & 31), n0 = 16 * (blk >> 5); const int lc = mini_lcol(n0, fq);
        f32x4 y = {0.f, 0.f, 0.f, 0.f};
#pragma unroll
        for (int seg = 0; seg < 3; ++seg) { const int k0 = seg == 0 ? 0 : (seg == 1 ? 512 : 768), nk = seg == 0 ? 512 : 256;
            const f32x4 acc = mini_block(A, DM, Wbr, DM, m0, n0, k0, nk, fr, fq, (f32x4){0.f, 0.f, 0.f, 0.f});
            const unsigned mg = *(const unsigned*)(MS + (size_t)(m0 + fr) * 3072 + seg * 1024 + lc);
            y[0] += acc[0] * ub(mg, 0) * (1.0f / 255.0f); y[1] += acc[1] * ub(mg, 1) * (1.0f / 255.0f); y[2] += acc[2] * ub(mg, 2) * (1.0f / 255.0f); y[3] += acc[3] * ub(mg, 3) * (1.0f / 255.0f); }
        u32x2 w; w.x = cvt_pk_bf16(y[0], y[1]); w.y = cvt_pk_bf16(y[2], y[3]);
        *(u32x2*)(Y + (size_t)(m0 + fr) * DM + lc) = w; }
}
__device__ __forceinline__ void ctx_out_proj(unsigned char* ws, const bf16_t* Wout, const float* ctx_in, const float* gate_ctx, int gw, int lane) {
    const int fr = lane & 15, fq = lane >> 4; const bf16_t* Y = (const bf16_t*)(ws + WS_Y); float* C1 = (float*)(ws + WS_CTX1);
    for (int blk = gw; blk < 32 * 64; blk += GRID * NWAVES) { const int m0 = MLAT + 16 * (blk & 31), n0 = 16 * (blk >> 5);
        const f32x4 acc = mini_block(Y, DM, Wout, DM, m0, n0, 0, DM, fr, fq, (f32x4){0.f, 0.f, 0.f, 0.f});
        const int col = mini_lcol(n0, fq); const size_t off = (size_t)(m0 - MLAT + fr) * DM + col;
        const f32x4 g = *(const f32x4*)(gate_ctx + col), x = *(const f32x4*)(ctx_in + off);
        *(f32x4*)(C1 + off) = x + g * acc; }
}

typedef short v4i16_t __attribute__((ext_vector_type(4)));
__device__ __forceinline__ s16x4 vtr(LAS const unsigned char* p) { return __builtin_bit_cast(s16x4, __builtin_amdgcn_ds_read_tr16_b64_v4i16((LAS v4i16_t*)p)); }
__device__ __forceinline__ int tr_lane_off(int lane) { return ((lane >> 4) & 1) * 32 + (lane & 3) * 8 + (4 * (lane >> 5) + ((lane & 15) >> 2)) * 64; }
__device__ __forceinline__ bf16x8 bfrag(LAS const unsigned char* piece_plus_laneoff) {
    const s16x4 lo = vtr(piece_plus_laneoff), hi = vtr(piece_plus_laneoff + 512);
    return (bf16x8){lo[0], lo[1], lo[2], lo[3], hi[0], hi[1], hi[2], hi[3]};
}
template <class RP> __device__ __forceinline__ void stage_pieces(LAS unsigned char* dst, int nrows, int ncols, RP rp, int tid) {
    const int cpr = ncols >> 3, total = nrows * cpr, pcs = ncols >> 5;
    for (int c = tid; c < total; c += NTHREADS) { const int row = c / cpr, cc = c - row * cpr;
        const u32x4 v = *(const u32x4*)(rp(row) + cc * 8);
        *(LAS u32x4*)(dst + ((row >> 4) * pcs + (cc >> 2)) * 1024 + (row & 15) * 64 + (cc & 3) * 16) = v; }
}
#define MFMA32(a, b, c) __builtin_amdgcn_mfma_f32_32x32x16_bf16(a, b, c, 0, 0, 0)
__device__ __forceinline__ bf16x8 afrag_img(const bf16_t* img, int KS, int mb, int s, int lane) { return *(const bf16x8*)(img + ((size_t)(mb * KS + s) * 64 + lane) * 8); }

__device__ __forceinline__ void f1_unit(unsigned char* ws, LAS unsigned char* lds, int unit, int tid, int lane, int wave) {
    const int b = unit >> 7, c = (unit >> 1) & 63, chh = unit & 1;
    bf16_t* Z2 = (bf16_t*)(ws + WS_Z2);
    const bf16_t* base = Z2 + ((size_t)(b * SEQ + c)) * 512 + chh * 128;
    stage_pieces(lds, 128, 128, [&](int r) { return base + (size_t)r * 64 * 512; }, tid);
    stage_pieces(lds + 32768, 128, 128, [&](int r) { return base + (size_t)r * 64 * 512 + 256; }, tid);
    __syncthreads();
    const int mb = wave & 3, cbp = wave >> 2, hi = lane >> 5, r32 = lane & 31, lo = tr_lane_off(lane);
    const bf16_t* c128 = (const bf16_t*)(ws + WS_C128); const bf16_t* s128 = (const bf16_t*)(ws + WS_S128);
    f32x16 outr[2], t1[2], t2[2];
#pragma unroll
    for (int e = 0; e < 2; ++e) { outr[e] = f32x16{}; t1[e] = f32x16{}; t2[e] = f32x16{}; }
#pragma unroll 1
    for (int s = 0; s < 8; ++s) {
        const bf16x8 cf = afrag_img(c128, 8, mb, s, lane), sf = afrag_img(s128, 8, mb, s, lane);
#pragma unroll
        for (int e = 0; e < 2; ++e) {
            const bf16x8 xr = bfrag(lds + (s * 4 + 2 * cbp + e) * 1024 + lo), xi = bfrag(lds + 32768 + (s * 4 + 2 * cbp + e) * 1024 + lo);
            outr[e] = MFMA32(cf, xr, outr[e]); outr[e] = MFMA32(sf, xi, outr[e]); t1[e] = MFMA32(cf, xi, t1[e]); t2[e] = MFMA32(sf, xr, t2[e]);
        }
    }
    const f32x2* tw = (const f32x2*)(ws + WS_TW);
#pragma unroll
    for (int e = 0; e < 2; ++e)
#pragma unroll
        for (int r = 0; r < 16; ++r) {
            const int k1 = 32 * mb + crow(r, hi), ch = chh * 128 + 32 * (2 * cbp + e) + r32;
            const float yr = outr[e][r], yi = t1[e][r] - t2[e][r];
            const f32x2 t = tw[(c * k1) & 8191];
            bf16_t* o = Z2 + ((size_t)(b * SEQ + 64 * k1 + c)) * 512 + ch;
            o[0] = (bf16_t)f2bf(yr * t.x + yi * t.y); o[256] = (bf16_t)f2bf(yi * t.x - yr * t.y);
            if ((r & 3) == 3) __builtin_amdgcn_sched_barrier(0);
        }
    __syncthreads();
}

__device__ __forceinline__ void sgu_unit(const Args& a, int l, LAS unsigned char* lds, int cu, int tid, int lane, int wave) {
    unsigned char* ws = a.ws;
    const int row0 = cu < 128 ? cu * 128 : MLAT + (cu - 128) * 128;
    const bf16_t* VC = (const bf16_t*)(ws + WS_VC);
    {
        const int tok = tid >> 2, qt = tid & 3;
        const u32x4* src = (const u32x4*)(VC + (size_t)(row0 + tok) * 256 + qt * 64);
        u32x4 raw[8]; float s = 0.f;
#pragma unroll
        for (int i = 0; i < 8; ++i) { raw[i] = src[i]; s += (bflo(raw[i].x) + bfhi(raw[i].x)) + (bflo(raw[i].y) + bfhi(raw[i].y)) + (bflo(raw[i].z) + bfhi(raw[i].z)) + (bflo(raw[i].w) + bfhi(raw[i].w)); }
        s += __shfl_xor(s, 1); s += __shfl_xor(s, 2);
        const float mu = s * (1.0f / 256.0f); float q = 0.f;
#pragma unroll
        for (int i = 0; i < 8; ++i) {
#pragma unroll
            for (int e = 0; e < 4; ++e) { const float d0 = bflo(raw[i][e]) - mu, d1 = bfhi(raw[i][e]) - mu; q += d0 * d0 + d1 * d1; } }
        q += __shfl_xor(q, 1); q += __shfl_xor(q, 2);
        const float rstd = rsqrtf(q * (1.0f / 256.0f) + EPS);
        const float* lg = a.in[I_LNG] + l * 256 + qt * 64; const float* lb = a.in[I_LNB] + l * 256 + qt * 64;
#pragma unroll
        for (int i = 0; i < 8; ++i) { u32x4 w;
#pragma unroll
            for (int e = 0; e < 4; ++e) { const int ch = 8 * i + 2 * e; w[e] = pk2((bflo(raw[i][e]) - mu) * rstd * lg[ch] + lb[ch], (bfhi(raw[i][e]) - mu) * rstd * lg[ch + 1] + lb[ch + 1]); }
            const int cc = qt * 8 + i;
            *(LAS u32x4*)(lds + ((tok >> 4) * 8 + (cc >> 2)) * 1024 + (tok & 15) * 64 + (cc & 3) * 16) = w; __builtin_amdgcn_sched_barrier(0); }
    }
    __syncthreads();
    const int g = wave >> 1, ph = wave & 1, hi = lane >> 5, r32 = lane & 31, lo = tr_lane_off(lane);
    const bf16_t* img = (const bf16_t*)(ws + WS_WSIMG) + (size_t)(l * 4 + g) * 16384;
    f32x16 acc[2][2];
#pragma unroll
    for (int i = 0; i < 2; ++i) { acc[i][0] = f32x16{}; acc[i][1] = f32x16{}; }
#pragma unroll 1
    for (int s = 0; s < 8; ++s) {
        const bf16x8 a0 = afrag_img(img, 8, 2 * ph, s, lane), a1 = afrag_img(img, 8, 2 * ph + 1, s, lane);
        const bf16x8 b0 = bfrag(lds + (s * 8 + 2 * g) * 1024 + lo), b1 = bfrag(lds + (s * 8 + 2 * g + 1) * 1024 + lo);
        acc[0][0] = MFMA32(a0, b0, acc[0][0]); acc[0][1] = MFMA32(a0, b1, acc[0][1]); acc[1][0] = MFMA32(a1, b0, acc[1][0]); acc[1][1] = MFMA32(a1, b1, acc[1][1]);
    }
    const bf16_t* UG = (const bf16_t*)(ws + WS_UG); bf16_t* A = (bf16_t*)(ws + WS_A);
    const float* bs = a.in[I_BS] + (size_t)(l * 4 + g) * 128;
#pragma unroll
    for (int i = 0; i < 2; ++i)
#pragma unroll
        for (int e = 0; e < 2; ++e)
#pragma unroll
            for (int r = 0; r < 16; ++r) { const int p = 32 * (2 * ph + i) + crow(r, hi), ch = 64 * g + 32 * e + r32;
                const float sv = acc[i][e][r] + bs[p]; const float ug = bf2f(UG[(size_t)(row0 + p) * 256 + ch]);
                A[(size_t)(row0 + p) * DM + 768 + ch] = (bf16_t)f2bf(ug * sv); if ((r & 3) == 3) __builtin_amdgcn_sched_barrier(0); }
    __syncthreads();
}

__device__ __forceinline__ void ctxf_unit(const Args& a, int l, LAS unsigned char* lds, int unit, int tid, int lane, int wave) {
    unsigned char* ws = a.ws;
    const int b = unit >> 2, chq = unit & 3;
    const bf16_t* Z2 = (const bf16_t*)(ws + WS_Z2);
    stage_pieces(lds, 512, 64, [&](int k) { return Z2 + (size_t)(MLAT + b * NCTX + (k & 255)) * 512 + (k >> 8) * 256 + chq * 64; }, tid);
    __syncthreads();
    const int mb = wave, hi = lane >> 5, r32 = lane & 31, lo = tr_lane_off(lane);
    const bf16_t* img = (const bf16_t*)(ws + WS_TC256);
    f32x16 acc[2]; acc[0] = f32x16{}; acc[1] = f32x16{};
#pragma unroll 4
    for (int s = 0; s < 32; ++s) { const bf16x8 af = afrag_img(img, 32, mb, s, lane);
        acc[0] = MFMA32(af, bfrag(lds + (s * 2) * 1024 + lo), acc[0]); acc[1] = MFMA32(af, bfrag(lds + (s * 2 + 1) * 1024 + lo), acc[1]); }
    const bf16_t* GS = (const bf16_t*)(ws + WS_GS); bf16_t* A = (bf16_t*)(ws + WS_A);
#pragma unroll
    for (int e = 0; e < 2; ++e)
#pragma unroll
        for (int r = 0; r < 16; ++r) { const int np = 32 * mb + crow(r, hi), ch = 64 * chq + 32 * e + r32; const size_t row = MLAT + b * NCTX + np;
            const float v = acc[e][r] * (1.0f / 128.0f) + a.in[I_BF][l * 256 + ch];
            A[row * DM + 512 + ch] = (bf16_t)f2bf(v * bf2f(GS[row * 768 + 512 + ch])); if ((r & 3) == 3) __builtin_amdgcn_sched_barrier(0); }
    __syncthreads();
}

__device__ __forceinline__ void f2_unit(const Args& a, int l, LAS unsigned char* lds, int unit, int tid, int lane, int wave) {
    unsigned char* ws = a.ws;
    const int b = unit >> 7, k1 = unit & 127;
    const bf16_t* Z2 = (const bf16_t*)(ws + WS_Z2);
    stage_pieces(lds, 128, 256, [&](int k) { return Z2 + (size_t)(b * SEQ + 64 * k1 + (k & 63)) * 512 + (k >> 6) * 256; }, tid);
    __syncthreads();
    const int cb = wave, hi = lane >> 5, r32 = lane & 31, lo = tr_lane_off(lane);
    const bf16_t* img = (const bf16_t*)(ws + WS_T64);
    f32x16 acc[2]; acc[0] = f32x16{}; acc[1] = f32x16{};
#pragma unroll 4
    for (int s = 0; s < 8; ++s) { const bf16x8 bf = bfrag(lds + (s * 8 + cb) * 1024 + lo);
        acc[0] = MFMA32(afrag_img(img, 8, 0, s, lane), bf, acc[0]); acc[1] = MFMA32(afrag_img(img, 8, 1, s, lane), bf, acc[1]); }
    const bf16_t* GS = (const bf16_t*)(ws + WS_GS); bf16_t* A = (bf16_t*)(ws + WS_A);
    const float nrm = 0.0013810679320049757f;
#pragma unroll
    for (int mb = 0; mb < 2; ++mb)
#pragma unroll
        for (int r = 0; r < 16; ++r) { const int k2 = 32 * mb + crow(r, hi), ch = 32 * cb + r32; const size_t row = (size_t)b * SEQ + k1 + 128 * k2;
            const float v = acc[mb][r] * nrm + a.in[I_BF][l * 256 + ch];
            A[row * DM + 512 + ch] = (bf16_t)f2bf(v * bf2f(GS[row * 768 + 512 + ch])); if ((r & 3) == 3) __builtin_amdgcn_sched_barrier(0); }
    __syncthreads();
}

#ifndef DMA_TWICE
#define DMA_TWICE 0
#endif
#ifndef EXTRA_EXP
#define EXTRA_EXP 0
#endif
#ifndef EXTRA_MFMA
#define EXTRA_MFMA 0
#endif
__device__ __forceinline__ void glds16(const void* gsrc, unsigned lds_dst) { unsigned keep;
    asm volatile("s_mov_b32 %0, m0\n\ts_mov_b32 m0, %2\n\ts_nop 0\n\tglobal_load_lds_dwordx4 %1, off\n\ts_mov_b32 m0, %0" : "=&s"(keep) : "v"(gsrc), "s"(lds_dst) : "memory"); }
__device__ __forceinline__ void glds16x2(const void* gsrc, unsigned lds_dst) { unsigned keep;
    asm volatile("s_mov_b32 %0, m0\n\ts_mov_b32 m0, %2\n\ts_nop 0\n\tglobal_load_lds_dwordx4 %1, off\n\tglobal_load_lds_dwordx4 %1, off offset:1024\n\ts_mov_b32 m0, %0" : "=&s"(keep) : "v"(gsrc), "s"(lds_dst) : "memory"); }
__device__ __forceinline__ void attn_unit(const Args& a, int l, LAS unsigned char* lds, int b, int h, int qrow0, int t0, int nt, int tid, int lane, int wave, bool dry) {
    unsigned char* ws = a.ws;
    const int comp = wave >> 2, qg = wave & 3, hi = lane >> 5, r32 = lane & 31;
    const bf16_t* Qg = (const bf16_t*)(ws + WS_QG);
    const unsigned char* kimg = ws + WS_KIMG + (size_t)(b * 4 + h) * NKT * 16384;
    const unsigned char* vimg = ws + WS_VIMG + (size_t)(b * 4 + h) * NKT * 16384;
    bf16x8 qr[4];
    { const bf16_t* qp = Qg + ((size_t)(qrow0 + 32 * qg + r32) * 4 + h) * 128 + comp * 64 + 8 * hi;
#pragma unroll
      for (int d0 = 0; d0 < 4; ++d0) qr[d0] = *(const bf16x8*)(qp + 16 * d0); }
    asm volatile("" : "+v"(qr[0]), "+v"(qr[1]), "+v"(qr[2]), "+v"(qr[3]));
    f32x16 o[4];
#pragma unroll
    for (int d = 0; d < 4; ++d) o[d] = f32x16{};
    float lsum = 0.f;
    const int lo = tr_lane_off(lane);
    const unsigned lds0 = (unsigned)(uintptr_t)lds;
    constexpr int KSL = 16384, VBASE = 3 * KSL;
#define ATT_DMA_K(t, slotb) do { const unsigned char* s_ = kimg + (size_t)(t) * 16384 + wave * 2048 + lane * 16; const unsigned d_ = (unsigned)__builtin_amdgcn_readfirstlane((int)(lds0 + (slotb) + wave * 2048)); \
        glds16x2(s_, d_); if (DMA_TWICE) glds16x2(s_, d_); } while (0)
#define ATT_DMA_V(t, slotb) do { const unsigned char* s_ = vimg + (size_t)(t) * 16384 + wave * 2048 + lane * 16; const unsigned d_ = (unsigned)__builtin_amdgcn_readfirstlane((int)(lds0 + VBASE + (slotb) + wave * 2048)); \
        glds16x2(s_, d_); if (DMA_TWICE) glds16x2(s_, d_); } while (0)
#define ATT_WAIT_BAR(N) asm volatile("s_waitcnt vmcnt(" #N ") lgkmcnt(0)\n\ts_barrier" ::: "memory")
#define SBAR() __builtin_amdgcn_sched_barrier(0)
#define PIN(x) asm volatile("" : "+v"(x))
    LAS const unsigned char* kp0 = lds + comp * 8192 + hi * 1024 + r32 * 16;
    LAS const unsigned char* vp0 = lds + VBASE + lo;
    bf16x8 kf[8];
#define KRD(j, slotb) do { kf[j] = *(const LAS bf16x8*)(kp0 + (slotb) + ((j) >> 1) * 2048 + ((j) & 1) * 512); } while (0)
    f32x16 pA0 = f32x16{}, pA1 = f32x16{}, pB0, pB1;
    u32x4 pw0, pw1, pw2, pw3;
    bf16x8 vA[8], vB[8];
    int sl_prev = 0, sl_cur = 0, sl_next = KSL;
#define ROT() do { sl_prev = sl_cur; sl_cur = sl_next; sl_next = (sl_next == 2 * KSL) ? 0 : sl_next + KSL; } while (0)
    ATT_DMA_K(t0, 0); ATT_DMA_V(t0, 0); ATT_DMA_K(t0 + 1, KSL); ATT_DMA_K(t0 + 2, 2 * KSL);
    ATT_WAIT_BAR(0);
#pragma unroll
    for (int j = 0; j < 8; ++j) KRD(j, 0);
    ATT_WAIT_BAR(0);
#define PKW(P, B) cvt_pk_bf16(P[B], P[B + 1])
#define EX(v) __builtin_amdgcn_exp2f(v)
#define GAPA(i, C, CIN, a0, a1, a2, a3, W0, W1, PWV) do { vA[i] = bfrag(vpp_ + (i) * 1024); SBAR(); \
        C = MFMA32(kf[i], qr[(i) >> 1], CIN); if (EXTRA_MFMA) dacc = MFMA32(kf[i], qr[(i) >> 1], dacc); sacc += a0; sacc += a1; sacc += a2; sacc += a3; PIN(sacc); W0; W1; PIN(PWV); SBAR(); } while (0)
#define GAPB_V(j, d, PWV, X, B) do { o[d] = MFMA32(__builtin_bit_cast(bf16x8, PWV), vA[j], o[d]); X[B] = EX(X[B]); X[B + 1] = EX(X[B + 1]); PIN(X); if (EXTRA_EXP) { dmy = EX(dmy); PIN(dmy); } vB[j] = bfrag(vpp_ + (8 + (j)) * 1024); SBAR(); } while (0)
#define GAPB_K(j, d, PWV, X, B) do { o[d] = MFMA32(__builtin_bit_cast(bf16x8, PWV), vB[(j) - 8], o[d]); X[B] = EX(X[B]); X[B + 1] = EX(X[B + 1]); PIN(X); if (EXTRA_EXP) { dmy = EX(dmy); PIN(dmy); } KRD((j) - 8, sl_next); SBAR(); } while (0)
    const f32x16 zero16 = f32x16{}; float dmy = 0.5f; (void)dmy; f32x16 dacc = f32x16{}; (void)dacc;
#define STEP(C0, C1, P0, P1, t) do { SBAR(); \
        LAS const unsigned char* vpp_ = vp0 + sl_prev; float sacc = 0.f; \
        GAPA(0, C0, zero16, P0[0], P0[1], P0[2], P0[3],     pw0[0] = PKW(P0, 0),  pw0[1] = PKW(P0, 2),  pw0); \
        GAPA(1, C1, zero16, P0[4], P0[5], P0[6], P0[7],     pw0[2] = PKW(P0, 4),  pw0[3] = PKW(P0, 6),  pw0); \
        GAPA(2, C0, C0,     P0[8], P0[9], P0[10], P0[11],   pw1[0] = PKW(P0, 8),  pw1[1] = PKW(P0, 10), pw1); \
        GAPA(3, C1, C1,     P0[12], P0[13], P0[14], P0[15], pw1[2] = PKW(P0, 12), pw1[3] = PKW(P0, 14), pw1); \
        GAPA(4, C0, C0,     P1[0], P1[1], P1[2], P1[3],     pw2[0] = PKW(P1, 0),  pw2[1] = PKW(P1, 2),  pw2); \
        GAPA(5, C1, C1,     P1[4], P1[5], P1[6], P1[7],     pw2[2] = PKW(P1, 4),  pw2[3] = PKW(P1, 6),  pw2); \
        GAPA(6, C0, C0,     P1[8], P1[9], P1[10], P1[11],   pw3[0] = PKW(P1, 8),  pw3[1] = PKW(P1, 10), pw3); \
        GAPA(7, C1, C1,     P1[12], P1[13], P1[14], P1[15], pw3[2] = PKW(P1, 12), pw3[3] = PKW(P1, 14), pw3); \
        lsum += sacc; \
        if ((t) + 3 < nt) ATT_DMA_K(t0 + (t) + 3, sl_cur); \
        if ((t) + 1 < nt) ATT_DMA_V(t0 + (t) + 1, sl_next); \
        SBAR(); \
        GAPB_V(0, 0, pw0, C0, 0);  GAPB_V(1, 0, pw1, C0, 2);  GAPB_V(2, 0, pw2, C0, 4);  GAPB_V(3, 0, pw3, C0, 6); \
        GAPB_V(4, 1, pw0, C0, 8);  GAPB_V(5, 1, pw1, C0, 10); GAPB_V(6, 1, pw2, C0, 12); GAPB_V(7, 1, pw3, C0, 14); \
        GAPB_K(8, 2, pw0, C1, 0);  GAPB_K(9, 2, pw1, C1, 2);  GAPB_K(10, 2, pw2, C1, 4); GAPB_K(11, 2, pw3, C1, 6); \
        GAPB_K(12, 3, pw0, C1, 8); GAPB_K(13, 3, pw1, C1, 10); GAPB_K(14, 3, pw2, C1, 12); GAPB_K(15, 3, pw3, C1, 14); \
        if ((t) + 3 < nt) { if (DMA_TWICE) ATT_WAIT_BAR(8); else ATT_WAIT_BAR(4); } else ATT_WAIT_BAR(0); \
        ROT(); } while (0)
#pragma unroll 1
    for (int t = 0; t < nt; t += 2) {
        STEP(pB0, pB1, pA0, pA1, t);
        STEP(pA0, pA1, pB0, pB1, t + 1);
    }
    {
        float sacc = 0.f;
#pragma unroll
        for (int r = 0; r < 16; ++r) sacc += pA0[r] + pA1[r];
        lsum += sacc;
        pw0 = (u32x4){PKW(pA0, 0), PKW(pA0, 2), PKW(pA0, 4), PKW(pA0, 6)}; pw1 = (u32x4){PKW(pA0, 8), PKW(pA0, 10), PKW(pA0, 12), PKW(pA0, 14)};
        pw2 = (u32x4){PKW(pA1, 0), PKW(pA1, 2), PKW(pA1, 4), PKW(pA1, 6)}; pw3 = (u32x4){PKW(pA1, 8), PKW(pA1, 10), PKW(pA1, 12), PKW(pA1, 14)};
        LAS const unsigned char* vpp_ = vp0 + sl_prev;
#pragma unroll
        for (int d = 0; d < 4; ++d) {
            const bf16x8 f0 = bfrag(vpp_ + (d * 4 + 0) * 1024), f1 = bfrag(vpp_ + (d * 4 + 1) * 1024), f2 = bfrag(vpp_ + (d * 4 + 2) * 1024), f3 = bfrag(vpp_ + (d * 4 + 3) * 1024);
            o[d] = MFMA32(__builtin_bit_cast(bf16x8, pw0), f0, o[d]); o[d] = MFMA32(__builtin_bit_cast(bf16x8, pw1), f1, o[d]);
            o[d] = MFMA32(__builtin_bit_cast(bf16x8, pw2), f2, o[d]); o[d] = MFMA32(__builtin_bit_cast(bf16x8, pw3), f3, o[d]);
        }
    }
    ATT_WAIT_BAR(0);
#undef ATT_DMA_K
#undef ATT_DMA_V
#undef ATT_WAIT_BAR
#undef SBAR
#undef PIN
#undef KRD
#undef ROT
#undef PKW
#undef EX
#undef GAPA
#undef GAPB_V
#undef GAPB_K
#undef STEP
    if (EXTRA_MFMA) asm volatile("" :: "v"(dacc));
    if (dry) return;
    LAS float* ost = (LAS float*)lds;
    LAS float* lw = (LAS float*)(lds + 72 * 1024);
    lsum += __shfl_xor(lsum, 32);
    if (hi == 0) lw[wave * 32 + r32] = lsum;
    LDS_WAIT(); asm volatile("" ::: "memory");
    const float* lamp = (const float*)(ws + WS_LAM) + 2 * l;
    const float lam = lamp[0], oscale = lamp[1];
    float rl[16];
#pragma unroll
    for (int r = 0; r < 16; ++r) rl[r] = __builtin_amdgcn_rcpf(lw[wave * 32 + crow(r, hi)]);
    if (comp == 0) {
#pragma unroll
        for (int d = 0; d < 4; ++d)
#pragma unroll
            for (int r = 0; r < 16; ++r) ost[(32 * qg + crow(r, hi)) * 132 + 32 * d + r32] = o[d][r] * rl[r];
    }
    __syncthreads();
    if (comp == 1) {
#pragma unroll
        for (int d = 0; d < 4; ++d)
#pragma unroll
            for (int r = 0; r < 16; ++r) ost[(32 * qg + crow(r, hi)) * 132 + 32 * d + r32] -= lam * o[d][r] * rl[r];
    }
    __syncthreads();
    {
        const int row = tid >> 2, qt = tid & 3; const LAS float* src = ost + row * 132 + 32 * qt;
        float v[32]; float ss = 0.f;
#pragma unroll
        for (int i = 0; i < 32; ++i) { v[i] = src[i]; ss += v[i] * v[i]; }
        ss += __shfl_xor(ss, 1); ss += __shfl_xor(ss, 2);
        const float rstd = rsqrtf(ss * (1.0f / 128.0f) + EPS) * oscale;
        const size_t grow = (size_t)qrow0 + row;
        const bf16_t* gs = (const bf16_t*)(ws + WS_GS) + grow * 768 + h * 128 + 32 * qt;
        bf16_t* dst = (bf16_t*)(ws + WS_A) + grow * DM + h * 128 + 32 * qt;
        const float* gsub = a.in[I_GSUB] + l * 128 + 32 * qt;
#pragma unroll
        for (int i = 0; i < 4; ++i) { const u32x4 gw = *(const u32x4*)(gs + 8 * i); u32x4 w;
#pragma unroll
            for (int e = 0; e < 4; ++e) { const int j = 8 * i + 2 * e; w[e] = pk2(v[j] * rstd * gsub[j] * bflo(gw[e]), v[j + 1] * rstd * gsub[j + 1] * bfhi(gw[e])); }
            *(u32x4*)(dst + 8 * i) = w; }
    }
    __syncthreads();
}

#ifndef REPEAT_PHASE
#define REPEAT_PHASE (-1)
#endif
constexpr int N_PHASES = 10 + (REPEAT_PHASE >= 0 ? 1 : 0);
__global__ void __launch_bounds__(NTHREADS, 2) fwd_kernel(Args args) {
    extern __shared__ __attribute__((aligned(16))) unsigned char lds_raw[];
    LAS unsigned char* lds = (LAS unsigned char*)lds_raw;
    const int tid = threadIdx.x, lane = tid & 63, wave = __builtin_amdgcn_readfirstlane(tid >> 6);
    const int bx = blockIdx.x, vcu = (bx % 8) * (GRID / 8) + bx / 8;
    unsigned char* ws = args.ws;
    volatile LAS unsigned* MISC = (volatile LAS unsigned*)(lds + MISC_OFF);
    for (int u = tid; u < 32; u += NTHREADS) MISC[u] = 0u;
    __syncthreads();
    XcdBarrier bar; bar.bar = (unsigned*)(ws + WS_CTL) + CW_BAR; bar.x = 0; bar.st = nullptr;
    const bool one_launch = (args.ph_hi - args.ph_lo) > 1;
    if (one_launch) { bar = xcd_barrier_post((unsigned*)(ws + WS_CTL) + CW_BAR, MISC + 8);
        if (tid == 0) { unsigned nloc, nx; xcd_barrier_complete(bar.bar, bar.x, nloc, nx); MISC[8] = nloc; MISC[9] = nx; }
        __syncthreads(); }
#ifndef REPEAT_PHASE
#define REPEAT_PHASE (-1)
#endif
#ifndef PRO_PROBE
#define PRO_PROBE 15
#endif
#ifndef PHMASK
#define PHMASK 0xffff
#endif
#define EN(b) (((PHMASK) >> (b)) & 1)
#define LAUNDER() int wave_ = wave, vcu_ = vcu; asm volatile("" : "+s"(wave_)); asm volatile("" : "+s"(vcu_)); int lane_ = (int)__builtin_amdgcn_mbcnt_hi(~0u, __builtin_amdgcn_mbcnt_lo(~0u, 0u)); asm volatile("" : "+v"(lane_)); const int tid_ = wave_ * 64 + lane_; (void)lane_; (void)wave_
#pragma unroll 1
    for (int pc = args.ph_lo; pc < args.ph_hi; ++pc) {
        const int ph = (REPEAT_PHASE >= 0 && pc > REPEAT_PHASE) ? pc - 1 : pc;
        const int l = ph >= 5 ? 1 : 0;
        const bool second = (REPEAT_PHASE >= 0 && pc == REPEAT_PHASE + 1); (void)second;
        const int kind = ph == 0 ? 6 : (ph == 5 ? 7 : (ph < 5 ? ph - 1 : ph - 6));
        const bf16_t* Wl = (const bf16_t*)(ws + WS_WIN) + (size_t)l * NPHYS * DM;
        LAUNDER();
        if (kind == 6) { if (EN(0)) {
            unsigned* sp0 = (unsigned*)(ws + WS_CTL) + 8192 + 4096;
            ph0_mods(args, lane_, wave_, vcu_);
            split_arrive(sp0, bar, one_launch);
            ph0_prologue(args, lds, tid_, lane_, wave_, vcu_, second ? PRO_PROBE : 7);
            split_wait(sp0, bar, one_launch, (unsigned*)(ws + WS_CTL) + CW_BAR + XB_TMO); } }
        if (kind == 6 || kind == 7) { if (EN(1)) { int wave2 = wave, vcu2 = vcu; asm volatile("" : "+s"(wave2)); asm volatile("" : "+s"(vcu2)); int lane2 = (int)__builtin_amdgcn_mbcnt_hi(~0u, __builtin_amdgcn_mbcnt_lo(~0u, 0u)); asm volatile("" : "+v"(lane2)); const int tid2 = wave2 * 64 + lane2;
            prepass(args, kind == 6 ? 0 : 1, lds, tid2, lane2, wave2, vcu2); } }
        else if (kind == 0) { if (EN(2)) {
            pg8::Gemm g{(const bf16_t*)(ws + WS_H), Wl, DM, DM, 0, 0, 0, 16, 16, 16, nullptr, nullptr, 0};
            TileSched S{vcu_ >> 5, vcu_ & 31, 0, 14, 1, l == 0 ? 52 : 8, l == 0 ? 0 : 2, l == 0 ? 26 : 4};
            EpiIn E{ws, args.in[I_GQ] + l * 64, args.in[I_GK] + l * 64, (const float*)(ws + WS_ROPE), (const float*)(ws + WS_ROPE) + 2048};
            pg8::gemm_phase<EpiIn, TileSched, true, true>(lds, g, S, E, tid_); } }
        else if (kind == 1) { if (EN(4)) {
            if (!second) {
                if (EN(8)) f1_unit(ws, lds, vcu_, tid_, lane_, wave_);
                const int nsgu = l == 0 ? 132 : 128;
                if (EN(9)) for (int cu = 255 - vcu_; cu < nsgu; cu += GRID) sgu_unit(args, l, lds, cu, tid_, lane_, wave_);
                if (EN(10) && l == 0 && vcu_ < 8) ctxf_unit(args, l, lds, vcu_, tid_, lane_, wave_);
            }
            const int bh = vcu_ >> 5, qb = vcu_ & 31;
            if (EN(12)) {
                const int nun = (l == 0 && qb < 2) ? 3 : 2;
#pragma unroll 1
                for (int ui = 0; ui < nun; ++ui) {
                    const int qrow0 = ui < 2 ? (bh >> 2) * SEQ + 256 * qb + 128 * ui : MLAT + (bh >> 2) * NCTX + 128 * qb;
                    attn_unit(args, l, lds, bh >> 2, bh & 3, qrow0, ui < 2 ? 0 : SEQ / 64, ui < 2 ? NKT : NCTX / 64, tid_, lane_, wave_, second);
                }
            } } }
        else if (kind == 2) { if (EN(5)) {
            unsigned* sp = (unsigned*)(ws + WS_CTL) + 8192 + l * 2048;
            if (EN(11)) f2_unit(args, l, lds, vcu_, tid_, lane_, wave_);
            split_arrive(sp, bar, one_launch);
            if (l == 0) ctx_branch_proj(ws, (const bf16_t*)(ws + WS_WBR), vcu_ * NWAVES + wave_, lane_);
            pg8::Gemm g{(const bf16_t*)(ws + WS_A), (const bf16_t*)(ws + WS_WBR) + (size_t)l * DM * DM, DM, DM, 0, 512, 768, 8, 4, 4, (const bf16_t*)(ws + WS_H), Wl, 16};
            FusedSched S{vcu_ >> 5, vcu_ & 31, sp, bar, one_launch, (unsigned*)(ws + WS_CTL) + CW_BAR + XB_TMO};
            EpiMY E{EpiIn{ws, nullptr, nullptr, nullptr, nullptr}, EpiY{(const unsigned char*)(ws + WS_MS), (bf16_t*)(ws + WS_Y)}};
            pg8::gemm_phase<EpiMY, FusedSched, true, true>(lds, g, S, E, tid_); } }
        else { if (EN(7)) {
            pg8::Gemm g{(const bf16_t*)(ws + WS_Y), (const bf16_t*)(ws + WS_WOUT) + (size_t)l * DM * DM, DM, DM, 0, 0, 0, 16, 16, 16, nullptr, nullptr, 0};
            TileSched S{vcu_ >> 5, vcu_ & 31, 0, 4, 1, 0, 0, 4};
            if (l == 0) ctx_out_proj(ws, (const bf16_t*)(ws + WS_WOUT), args.in[I_CTX], (const float*)(ws + WS_MODF) + 2 * 3072 + 2048, vcu_ * NWAVES + wave_, lane_);
            EpiOut E{args.in[I_X], args.out, ws, (const float*)(ws + WS_MODF) + (size_t)(l * 3) * 3072 + 2048, l};
            pg8::gemm_phase<EpiOut, TileSched, true, true>(lds, g, S, E, tid_); } }
        if (pc + 1 < args.ph_hi) { XcdBarrier b2_ = bar; asm volatile("" : "+s"(b2_.bar)); xcd_barrier(b2_); }
    }
}

extern "C" void kernel_launch(void* const* d_in, const int* in_sizes, int n_in, void* d_out, int out_size, void* d_ws, size_t ws_size, hipStream_t stream) {
    static int ready = 0;
    if (ready == 0) {
        if (n_in != 25 || out_size != MLAT * DM || ws_size < 256 * MiB) { fprintf(stderr, "kernel_launch: unexpected shapes (n_in %d out %d ws %zu)\n", n_in, out_size, ws_size); ready = -1; return; }
        int dev = 0, cus = 0, per_cu = 0;
        hipGetDevice(&dev); hipDeviceGetAttribute(&cus, hipDeviceAttributeMultiprocessorCount, dev);
        if (hipFuncSetAttribute((const void*)fwd_kernel, hipFuncAttributeMaxDynamicSharedMemorySize, LDS_BYTES) != hipSuccess) { fprintf(stderr, "kernel_launch: hipFuncSetAttribute failed\n"); ready = -1; return; }
        hipOccupancyMaxActiveBlocksPerMultiprocessor(&per_cu, (const void*)fwd_kernel, NTHREADS, LDS_BYTES);
        (void)hipGetLastError();
        if (cus != GRID || per_cu < 1) fprintf(stderr, "kernel_launch: note: %d CUs, occupancy %d blocks/CU (built for 256 CUs, 1 block/CU)\n", cus, per_cu);
        ready = (cus >= GRID) ? 1 : -1;
    }
    if (ready < 0) return;
    hipMemsetAsync((char*)d_ws + WS_CTL, 0, CTL_ZERO_BYTES, stream);
    Args a{};
    for (int i = 0; i < 25; ++i) a.in[i] = (const float*)d_in[i];
    a.out = (float*)d_out; a.ws = (unsigned char*)d_ws;
#if MK_N_LAUNCHES == 1
    a.ph_lo = 0; a.ph_hi = N_PHASES;
    hipLaunchKernelGGL(fwd_kernel, dim3(GRID), dim3(NTHREADS), LDS_BYTES, stream, a);
#else
    for (int p = 0; p < N_PHASES; ++p) { a.ph_lo = p; a.ph_hi = p + 1; hipLaunchKernelGGL(fwd_kernel, dim3(GRID), dim3(NTHREADS), LDS_BYTES, stream, a); }
#endif
}
```

```cpp
#include <hip/hip_runtime.h>
#include <cstdio>
#include <cstdint>

#ifndef MK_N_LAUNCHES
#define MK_N_LAUNCHES 1
#endif

#define LAS __attribute__((address_space(3)))
#define GAS __attribute__((address_space(1)))
typedef unsigned short bf16_t;
typedef short bf16x8 __attribute__((ext_vector_type(8)));
typedef short s16x4 __attribute__((ext_vector_type(4)));
typedef float f32x4 __attribute__((ext_vector_type(4)));
typedef float f32x2 __attribute__((ext_vector_type(2)));
typedef float f32x16 __attribute__((ext_vector_type(16)));
typedef unsigned u32x4 __attribute__((ext_vector_type(4)));
typedef unsigned u32x2 __attribute__((ext_vector_type(2)));

constexpr int DM = 1024, BATCH = 2, SEQ = 8192, NCTX = 256, DEPTH = 2;
constexpr int MLAT = BATCH * SEQ, MCTX = BATCH * NCTX, MT = MLAT + MCTX;
constexpr int NKEY = SEQ + NCTX, NKT = NKEY / 64;
constexpr int INW = 6400;
constexpr int OFF_Q = 0, OFF_K = 512, OFF_V = 1024, OFF_F = 1536, OFF_U = 1792, OFF_VC = 2048, OFF_GATE = 2304, OFF_MERGE = 3328;
constexpr int NPHYS = 6656;
constexpr float EPS = 1e-6f;
constexpr float QSCALE = 0.125f * 1.4426950408889634f;

constexpr size_t KiB = 1024, MiB = 1u << 20;
constexpr size_t WS_CTL = 0, CTL_ZERO_BYTES = 64 * KiB;
constexpr size_t WS_MODP = 1 * MiB;
constexpr size_t WS_MODF = WS_MODP + 2304 * KiB;
constexpr size_t WS_ROPE = WS_MODF + 72 * KiB;
constexpr size_t WS_TW = WS_ROPE + 16 * KiB;
constexpr size_t WS_LAM = WS_TW + 64 * KiB;
constexpr size_t WS_C128 = WS_LAM + 1 * KiB;
constexpr size_t WS_S128 = WS_C128 + 32 * KiB;
constexpr size_t WS_T64 = WS_S128 + 32 * KiB;
constexpr size_t WS_TC256 = WS_T64 + 16 * KiB;
constexpr size_t WS_WSIMG = WS_TC256 + 256 * KiB;
constexpr size_t WS_SMALL_END = WS_WSIMG + 256 * KiB;
static_assert(WS_SMALL_END <= 5 * MiB, "small tables");
constexpr size_t WS_WIN = 5 * MiB;
constexpr size_t WS_WBR = 31 * MiB;
constexpr size_t WS_WOUT = 35 * MiB;
constexpr size_t WS_CTX1 = 39 * MiB;
constexpr size_t WS_H = 41 * MiB;
constexpr size_t WS_A = 74 * MiB;
constexpr size_t WS_R = 107 * MiB;
constexpr size_t SZ_QG = (size_t)MT * 512 * 2, SZ_KIMG = (size_t)BATCH * 4 * NKT * 16384, SZ_Z2 = (size_t)MT * 512 * 2, SZ_UG = (size_t)MT * 256 * 2, SZ_GS = (size_t)MT * 768 * 2;
constexpr size_t WS_QG = WS_R, WS_KIMG = WS_QG + SZ_QG, WS_VIMG = WS_KIMG + SZ_KIMG, WS_Z2 = WS_VIMG + SZ_KIMG, WS_UG = WS_Z2 + SZ_Z2, WS_VC = WS_UG + SZ_UG, WS_GS = WS_VC + SZ_UG;
constexpr size_t WS_Y = WS_Z2;
static_assert(WS_Z2 + (size_t)MT * DM * 2 == WS_GS, "Y overlays Z2 | UG | VC exactly");
constexpr size_t WS_MS = WS_R;
constexpr size_t WS_END = WS_GS + SZ_GS;
constexpr size_t WS_X1B0 = 229 * MiB, WS_X1B1 = 215 * MiB;
constexpr int X1B_SPLIT = 13824;
constexpr size_t WS_MSC = 224 * MiB;
static_assert(WS_X1B1 >= WS_END && WS_X1B1 + (size_t)(MLAT - X1B_SPLIT) * 2048 <= WS_MSC && WS_MSC + (size_t)MCTX * 3072 <= WS_X1B0 && WS_X1B0 + (size_t)X1B_SPLIT * 2048 <= 256 * MiB, "x1b map");
static_assert(WS_MS + (size_t)MT * 3072 <= WS_Z2 && WS_END <= WS_MSC && WS_MSC + (size_t)MCTX * 3072 * 2 <= 256 * MiB, "d_ws map");

__host__ __device__ __forceinline__ size_t x1b_off(int row) { return row < X1B_SPLIT ? WS_X1B0 + (size_t)row * 2048 : WS_X1B1 + (size_t)(row - X1B_SPLIT) * 2048; }
__device__ __forceinline__ unsigned f2bf(float f) { unsigned u = __builtin_bit_cast(unsigned, f); return (u + 0x7fffu + ((u >> 16) & 1u)) >> 16; }
__device__ __forceinline__ unsigned pk2(float lo, float hi) { return f2bf(lo) | (f2bf(hi) << 16); }
__device__ __forceinline__ unsigned cvt_pk_bf16(float lo, float hi) { unsigned r; asm volatile("v_cvt_pk_bf16_f32 %0, %1, %2" : "=v"(r) : "v"(lo), "v"(hi)); return r; }
__device__ __forceinline__ float bf2f(unsigned short v) { return __builtin_bit_cast(float, (unsigned)v << 16); }
__device__ __forceinline__ float bflo(unsigned w) { return __builtin_bit_cast(float, w << 16); }
__device__ __forceinline__ float bfhi(unsigned w) { return __builtin_bit_cast(float, w & 0xffff0000u); }
__device__ __forceinline__ float fast_sigmoid(float x) { return __builtin_amdgcn_rcpf(1.0f + __builtin_amdgcn_exp2f(-1.4426950408889634f * x)); }
__device__ __forceinline__ unsigned ms_quant_pk(float x, unsigned sel, unsigned old) { const float q = __builtin_amdgcn_rcpf((1.0f / 255.0f) + __builtin_amdgcn_exp2f(__builtin_fmaf(x, -1.4426950408889634f, -7.994353436858858f)));
    return __builtin_amdgcn_cvt_pk_u8_f32(__builtin_fmaxf(q, 1.0f), sel, old); }
__device__ __forceinline__ float ub(unsigned w, int i) { return (float)((w >> (8 * i)) & 0xffu); }
__device__ __forceinline__ float fast_silu(float x) { return x * fast_sigmoid(x); }
__device__ __forceinline__ int crow(int r, int hi) { return (r & 3) + 8 * (r >> 2) + 4 * hi; }
__host__ __device__ __forceinline__ int perm32(int rho) { const int n = rho >> 4, i = rho & 15; return 8 * (i >> 2) + 4 * n + (i & 3); }
__host__ __device__ __forceinline__ int invperm32(int c) { return 16 * ((c >> 2) & 1) + 4 * (c >> 3) + (c & 3); }
#define LDS_WAIT() asm volatile("s_waitcnt lgkmcnt(0)" ::: "memory")
#define VM_WAIT() asm volatile("s_waitcnt vmcnt(0)" ::: "memory")

namespace pg8 {
constexpr int BM = 256, BK = 64, HALF = 128, HTB = HALF * BK * 2  , STAGE_BYTES = 8 * HTB;
__host__ __device__ __forceinline__ int lds_byte(int r, int c) { const int st = (r >> 4) * 2 + (c >> 5), rr = r & 15, cc = c & 31, ob = rr * 64 + cc * 2; return st * 1024 + (ob ^ (((ob >> 9) & 1) << 5)); }
__host__ __device__ __forceinline__ void stage_rc(int b, int& R, int& C) { const int st = b / 1024, sb = b % 1024, swz = sb ^ (((sb >> 9) & 1) << 5); R = (st >> 1) * 16 + swz / 64; C = (st & 1) * 32 + (swz % 64) / 2; }

struct Unit { int pm, pn, seg, set; };
struct Gemm { const bf16_t* A; const bf16_t* Bt; int lda, ldb; int k0_0, k0_1, k0_2; int nt_0, nt_1, nt_2; const bf16_t* A1; const bf16_t* Bt1; int nt_set1; };

template <class Epi, class Sched, bool ALIGN_EPI = false, bool SP2 = false>
__device__ __forceinline__ void gemm_phase(LAS unsigned char* lds, const Gemm g, const Sched& S, const Epi& E, const int tid) {
    const int wid = __builtin_amdgcn_readfirstlane(tid >> 6), lane = tid & 63, wr = wid >> 2, wc = wid & 3, fr = lane & 15, fq = lane >> 4;
    unsigned voffA[2], voffB[2];
#pragma unroll
    for (int i = 0; i < 2; ++i) { int R, C; stage_rc(tid * 16 + i * 8192, R, C); voffA[i] = (unsigned)(R * g.lda + C) * 2u; voffB[i] = (unsigned)(R * g.ldb + C) * 2u; }
    const size_t kstep = (size_t)(BK * 2);
    const size_t hstepA = (size_t)HALF * g.lda * 2, hstepB = (size_t)HALF * g.ldb * 2;
    const size_t tstepA = 2 * hstepA, tstepB = 2 * hstepB;
    const unsigned ldsw = (unsigned)wid * 1024u;
    const int aoff = lds_byte(wr * 64 + fr, fq * 8), boff = lds_byte(wc * 32 + fr, fq * 8);
#define PG8_SA(b, h) (((b) * 2 + (h)) * HTB)
#define PG8_SB(b, h) ((4 + (b) * 2 + (h)) * HTB)
#define PG8_STAGE(bufoff, gbase, voff) do { _Pragma("unroll") for (int _i = 0; _i < 2; ++_i) \
        __builtin_amdgcn_global_load_lds((const unsigned*)((const char*)(gbase) + (voff)[_i]), (LAS unsigned*)(lds + (bufoff) + ldsw + _i * 8192), 16, 0, 0); } while (0)
#define PG8_LDA(dst, b, h) do { _Pragma("unroll") for (int m = 0; m < 4; ++m) _Pragma("unroll") for (int k = 0; k < 2; ++k) dst[m][k] = *(const LAS bf16x8*)(lds + PG8_SA(b, h) + aoff + m * 2048 + k * 1024); } while (0)
#define PG8_LDB(dst, b, h) do { _Pragma("unroll") for (int n = 0; n < 2; ++n) _Pragma("unroll") for (int k = 0; k < 2; ++k) dst[n][k] = *(const LAS bf16x8*)(lds + PG8_SB(b, h) + boff + n * 2048 + k * 1024); } while (0)
#define PG8_MMA(ai, bj, At, Bt) do { __builtin_amdgcn_s_setprio(1); _Pragma("unroll") for (int m = 0; m < 4; ++m) _Pragma("unroll") for (int n = 0; n < 2; ++n) _Pragma("unroll") for (int k = 0; k < 2; ++k) \
        acc[ai][bj][m][n] = __builtin_amdgcn_mfma_f32_16x16x32_bf16(Bt[n][k], At[m][k], acc[ai][bj][m][n], 0, 0, 0); __builtin_amdgcn_s_setprio(0); } while (0)
#define PG8_WAIT_V(n) asm volatile("s_waitcnt vmcnt(" #n ")" ::: "memory")
#define PG8_WAIT_L(n) asm volatile("s_waitcnt lgkmcnt(" #n ")" ::: "memory")
#define PG8_BAR __builtin_amdgcn_s_barrier()
#define PG8_SCHED __builtin_amdgcn_sched_barrier(0)
#define PG8_K0(u) ((u).set ? 0 : ((u).seg == 0 ? g.k0_0 : ((u).seg == 1 ? g.k0_1 : g.k0_2)))
#define PG8_NT(u) ((u).set ? g.nt_set1 : ((u).seg == 0 ? g.nt_0 : ((u).seg == 1 ? g.nt_1 : g.nt_2)))
#define PG8_UA(u) ((const char*)((u).set ? g.A1 : g.A) + (size_t)(u).pm * tstepA + (size_t)PG8_K0(u) * 2)
#define PG8_UB(u) ((const char*)((u).set ? g.Bt1 : g.Bt) + (size_t)(u).pn * tstepB + (size_t)PG8_K0(u) * 2)
    Unit cur, nxt; int ui = 0;
    if (!S.next(0, cur)) return;
    f32x4 acc[2][2][4][2];
#pragma unroll
    for (int a = 0; a < 2; ++a)
#pragma unroll
        for (int b = 0; b < 2; ++b)
#pragma unroll
            for (int m = 0; m < 4; ++m)
#pragma unroll
                for (int n = 0; n < 2; ++n) acc[a][b][m][n] = (f32x4){0.f, 0.f, 0.f, 0.f};
    bf16x8 At[4][2], B0[2][2], B1[2][2];
    const char* cA = PG8_UA(cur); const char* cB = PG8_UB(cur); int nt = PG8_NT(cur);
    if constexpr (SP2) {
        PG8_STAGE(PG8_SB(0, 0), cB, voffB); PG8_STAGE(PG8_SB(0, 1), cB + hstepB, voffB); PG8_STAGE(PG8_SA(0, 0), cA, voffA); PG8_STAGE(PG8_SA(0, 1), cA + hstepA, voffA);
        if (wr == 1) PG8_BAR;
        PG8_WAIT_V(2); PG8_BAR;
        PG8_STAGE(PG8_SB(1, 0), cB + kstep, voffB); PG8_STAGE(PG8_SA(1, 0), cA + kstep, voffA); PG8_STAGE(PG8_SB(1, 1), cB + hstepB + kstep, voffB);
        PG8_WAIT_V(6); PG8_BAR;
    } else {
        PG8_STAGE(PG8_SB(0, 0), cB, voffB); PG8_STAGE(PG8_SA(0, 0), cA, voffA); PG8_STAGE(PG8_SB(0, 1), cB + hstepB, voffB); PG8_STAGE(PG8_SA(0, 1), cA + hstepA, voffA);
        if (wr == 1) PG8_BAR;
        PG8_WAIT_V(4); PG8_BAR;
        PG8_STAGE(PG8_SB(1, 0), cB + kstep, voffB); PG8_STAGE(PG8_SA(1, 0), cA + kstep, voffA); PG8_STAGE(PG8_SB(1, 1), cB + hstepB + kstep, voffB);
        PG8_WAIT_V(6); PG8_BAR;
    }
    for (;;) {
        const bool has_next = S.next(ui + 1, nxt);
        const char* nA = has_next ? PG8_UA(nxt) : cA; const char* nB = has_next ? PG8_UB(nxt) : cB;
        for (int t = 0; t < nt; t += 2) {
            const bool last = (t == nt - 2);
            if (last && has_next) S.a_ready(nxt);
            const char* a1 = cA + (size_t)(t + 1) * kstep;
            const char* a2 = last ? nA : cA + (size_t)(t + 2) * kstep; const char* b2 = last ? nB : cB + (size_t)(t + 2) * kstep;
            const char* a3 = a2 + kstep; const char* b3 = b2 + kstep;
            if constexpr (SP2) {
            PG8_LDB(B0, 0, 0); PG8_LDB(B1, 0, 1); PG8_SCHED; PG8_LDA(At, 0, 0); PG8_STAGE(PG8_SA(1, 1), a1 + hstepA, voffA);
            PG8_WAIT_V(8); PG8_WAIT_L(0); PG8_BAR; PG8_MMA(0, 0, At, B0); PG8_MMA(0, 1, At, B1); PG8_BAR; PG8_SCHED;
            PG8_LDA(At, 0, 1); PG8_STAGE(PG8_SB(0, 0), b2, voffB); PG8_STAGE(PG8_SB(0, 1), b2 + hstepB, voffB); PG8_STAGE(PG8_SA(0, 0), a2, voffA);
            PG8_WAIT_V(8); PG8_WAIT_L(0); PG8_BAR; PG8_MMA(1, 0, At, B0); PG8_MMA(1, 1, At, B1); PG8_BAR; PG8_SCHED;
            PG8_LDB(B0, 1, 0); PG8_LDB(B1, 1, 1); PG8_SCHED; PG8_LDA(At, 1, 0); PG8_STAGE(PG8_SA(0, 1), a2 + hstepA, voffA);
            PG8_WAIT_V(8); PG8_WAIT_L(0); PG8_BAR; PG8_MMA(0, 0, At, B0); PG8_MMA(0, 1, At, B1); PG8_BAR; PG8_SCHED;
            PG8_LDA(At, 1, 1); PG8_STAGE(PG8_SB(1, 0), b3, voffB); PG8_STAGE(PG8_SB(1, 1), b3 + hstepB, voffB); PG8_STAGE(PG8_SA(1, 0), a3, voffA);
            PG8_WAIT_V(8); PG8_WAIT_L(0); PG8_BAR; PG8_MMA(1, 0, At, B0); PG8_MMA(1, 1, At, B1); PG8_BAR; PG8_SCHED;
            } else {
            PG8_LDB(B0, 0, 0); PG8_SCHED; PG8_LDA(At, 0, 0); PG8_STAGE(PG8_SA(1, 1), a1 + hstepA, voffA);
            PG8_WAIT_L(8); PG8_BAR; PG8_WAIT_L(0); PG8_MMA(0, 0, At, B0); PG8_BAR; PG8_SCHED;
            PG8_LDB(B1, 0, 1); PG8_STAGE(PG8_SB(0, 0), b2, voffB);
            PG8_BAR; PG8_WAIT_L(0); PG8_MMA(0, 1, At, B1); PG8_BAR;
            PG8_LDA(At, 0, 1); PG8_STAGE(PG8_SA(0, 0), a2, voffA);
            PG8_BAR; PG8_WAIT_L(0); PG8_MMA(1, 0, At, B0); PG8_BAR; PG8_SCHED;
            PG8_STAGE(PG8_SB(0, 1), b2 + hstepB, voffB);
            PG8_WAIT_V(6); PG8_BAR; PG8_MMA(1, 1, At, B1); PG8_BAR;
            PG8_LDB(B0, 1, 0); PG8_SCHED; PG8_LDA(At, 1, 0); PG8_STAGE(PG8_SA(0, 1), a2 + hstepA, voffA);
            PG8_WAIT_L(8); PG8_BAR; PG8_WAIT_L(0); PG8_MMA(0, 0, At, B0); PG8_BAR; PG8_SCHED;
            PG8_LDB(B1, 1, 1); PG8_STAGE(PG8_SB(1, 0), b3, voffB);
            PG8_BAR; PG8_WAIT_L(0); PG8_MMA(0, 1, At, B1); PG8_BAR;
            PG8_LDA(At, 1, 1); PG8_STAGE(PG8_SA(1, 0), a3, voffA);
            PG8_BAR; PG8_WAIT_L(0); PG8_MMA(1, 0, At, B0); PG8_BAR; PG8_SCHED;
            PG8_STAGE(PG8_SB(1, 1), b3 + hstepB, voffB);
            PG8_WAIT_V(6); PG8_BAR; PG8_MMA(1, 1, At, B1); PG8_BAR;
            }
        }
        if constexpr (ALIGN_EPI) { if (wr == 0) PG8_BAR; }
        const bool reset_acc = E(acc, cur, wr, wc, fr, fq);
        if (!has_next) break;
        if (reset_acc) {
#pragma unroll
        for (int a = 0; a < 2; ++a)
#pragma unroll
            for (int b = 0; b < 2; ++b)
#pragma unroll
                for (int m = 0; m < 4; ++m)
#pragma unroll
                    for (int n = 0; n < 2; ++n) acc[a][b][m][n] = (f32x4){0.f, 0.f, 0.f, 0.f};
        }
        cur = nxt; cA = nA; cB = nB; nt = PG8_NT(cur); ++ui;
        if constexpr (ALIGN_EPI) { if (wr == 1) PG8_BAR; }
    }
    PG8_WAIT_V(0);
    if constexpr (!ALIGN_EPI) { if (wr == 0) PG8_BAR; }
    PG8_BAR;
#undef PG8_SA
#undef PG8_SB
#undef PG8_STAGE
#undef PG8_LDA
#undef PG8_LDB
#undef PG8_MMA
#undef PG8_WAIT_V
#undef PG8_WAIT_L
#undef PG8_BAR
#undef PG8_SCHED
#undef PG8_K0
#undef PG8_NT
#undef PG8_UA
#undef PG8_UB
}
}

#define XB_TMO      128
#define XB_XCNT(j)  (256  + 64 * (j))
#define XB_XSUB(j)  (1280 + 64 * (j))
#define XB_XGEN(j)  (2304 + 64 * (j))
#define XB_TOP      3328
#define XB_TOPGEN   3392
#define XCD_BAR_WORDS 3456
#define XB_SPIN_CAP (1u << 18)
__device__ __forceinline__ unsigned xb_ld(unsigned* p)              { return __hip_atomic_load(p, __ATOMIC_RELAXED, __HIP_MEMORY_SCOPE_AGENT); }
__device__ __forceinline__ unsigned xb_add(unsigned* p, unsigned v) { return __hip_atomic_fetch_add(p, v, __ATOMIC_RELAXED, __HIP_MEMORY_SCOPE_AGENT); }
__device__ __forceinline__ unsigned xb_xcc_id() { return (unsigned)__builtin_amdgcn_s_getreg((3 << 11) | 20) & 0xFu; }
#define XB_SPIN(cond, bar) do { unsigned _sp = 0; while (cond) { __builtin_amdgcn_s_sleep(1); \
    if ((++_sp & 255u) == 0u) { if (xb_ld(&(bar)[XB_TMO])) break; if (_sp > XB_SPIN_CAP) { atomicAdd(&(bar)[XB_TMO], 1u); break; } } } } while (0)
struct XcdBarrier { unsigned* bar; unsigned x; volatile LAS unsigned* st; };
__device__ __forceinline__ XcdBarrier xcd_barrier_post(unsigned* bar, volatile LAS unsigned* st) {
    XcdBarrier b; b.bar = bar; b.x = xb_xcc_id(); b.st = st;
    if (threadIdx.x == 0) (void)xb_add(&bar[XB_XCNT(b.x)], 1u);
    return b;
}
__device__ __forceinline__ void xcd_barrier_complete(unsigned* bar, unsigned x, unsigned& nloc, unsigned& nx) {
    const unsigned G = gridDim.x * gridDim.y * gridDim.z;
    unsigned sum, cnt, mine, sp = 0u;
    for (;;) {
        sum = 0u; cnt = 0u; mine = 0u;
#pragma unroll
        for (unsigned j = 0; j < 16; ++j) { const unsigned c = xb_ld(&bar[XB_XCNT(j)]); sum += c; cnt += (c > 0u) ? 1u : 0u; mine = (j == x) ? c : mine; }
        if (sum == G) break;
        __builtin_amdgcn_s_sleep(1);
        if ((++sp & 255u) == 0u) { if (xb_ld(&bar[XB_TMO])) break; if (sp > XB_SPIN_CAP) { atomicAdd(&bar[XB_TMO], 1u); break; } }
    }
    nloc = mine > 0u ? mine : 1u; nx = cnt > 0u ? cnt : 1u;
}
__device__ __forceinline__ void xcd_barrier(const XcdBarrier& b) {
    asm volatile("s_waitcnt vmcnt(0)" ::: "memory");
    __syncthreads();
    if (threadIdx.x == 0) {
        unsigned* bar = b.bar;
        __builtin_amdgcn_s_waitcnt(0);
        const unsigned nloc = b.st[0], nx = b.st[1];
        const unsigned old = xb_add(&bar[XB_XSUB(b.x)], 1u);
        const unsigned gen = old / nloc;
        if (old + 1u == (gen + 1u) * nloc) {
            __builtin_amdgcn_fence(__ATOMIC_RELEASE, "agent");
            asm volatile("s_waitcnt vmcnt(0)" ::: "memory");
            const unsigned og = xb_add(&bar[XB_TOP], 1u);
            const unsigned tg = og / nx;
            if (og + 1u == (tg + 1u) * nx) xb_add(&bar[XB_TOPGEN], 1u);
            else XB_SPIN(xb_ld(&bar[XB_TOPGEN]) == tg, bar);
            __builtin_amdgcn_fence(__ATOMIC_ACQUIRE, "agent");
            xb_add(&bar[XB_XGEN(b.x)], 1u);
            asm volatile("s_waitcnt vmcnt(0)" ::: "memory");
        } else {
            XB_SPIN(xb_ld(&bar[XB_XGEN(b.x)]) == gen, bar);
            __builtin_amdgcn_fence(__ATOMIC_ACQUIRE, "agent");
            asm volatile("s_waitcnt vmcnt(0)" ::: "memory");
        }
    }
    __syncthreads();
}


__device__ __forceinline__ void split_arrive(unsigned* sp, const XcdBarrier& b, bool hier) {
    asm volatile("s_waitcnt vmcnt(0)" ::: "memory");
    __syncthreads();
    if (threadIdx.x == 0) {
        if (hier) { const unsigned nloc = b.st[0];
            const unsigned old = xb_add(&sp[64 * b.x], 1u);
            if (old + 1u == nloc) { __builtin_amdgcn_fence(__ATOMIC_RELEASE, "agent"); asm volatile("s_waitcnt vmcnt(0)" ::: "memory"); xb_add(&sp[64 * 16], 1u); } }
        else { __builtin_amdgcn_fence(__ATOMIC_RELEASE, "agent"); asm volatile("s_waitcnt vmcnt(0)" ::: "memory"); xb_add(&sp[64 * 16], 1u); }
    }
}
__device__ __forceinline__ void split_wait(unsigned* sp, const XcdBarrier& b, bool hier, unsigned* tmo) {
    if (threadIdx.x < 64) {
        const unsigned need = hier ? b.st[1] : gridDim.x;
        unsigned spn = 0;
        while ((unsigned)__builtin_amdgcn_readfirstlane((int)xb_ld(&sp[64 * 16])) < need) { __builtin_amdgcn_s_sleep(2);
            if ((++spn & 255u) == 0u) { if (xb_ld(tmo)) break; if (spn > XB_SPIN_CAP) { if (threadIdx.x == 0) atomicAdd(tmo, 1u); break; } } }
        __builtin_amdgcn_fence(__ATOMIC_ACQUIRE, "agent");
        asm volatile("s_waitcnt vmcnt(0)" ::: "memory");
    }
    asm volatile("" ::: "memory"); __builtin_amdgcn_s_barrier(); asm volatile("" ::: "memory");
}

constexpr int NWAVES = 8, NTHREADS = 512, GRID = 256;
constexpr int LDS_BYTES = 151552;
constexpr int MISC_OFF = 131072 + 320;
constexpr int ROPE_LDS = 132096;
constexpr int CW_BAR = 4096;

struct Args {
    const float* in[25];
    float* out; unsigned char* ws;
    int ph_lo, ph_hi;
};

enum { I_X = 0, I_C, I_CTX, I_CCTX, I_WADA, I_BADA, I_GNORM, I_WIN, I_GQ, I_GK, I_LQ1, I_LK1, I_LQ2, I_LK2, I_GSUB, I_WF, I_BF, I_LNG, I_LNB, I_WS, I_BS, I_WBRA, I_WBRB, I_WBRC, I_WOUT };

__device__ __forceinline__ void transpose_item(const float* W, int ldw, int k0, int lcol0, bool perm, bf16_t* dst, int ldd, int prow0, int dcol0, LAS float* scr, int lane) {
#pragma unroll 8
    for (int i = 0; i < 32; ++i) { const int kk = 2 * i + (lane >> 5); scr[kk * 33 + (lane & 31)] = W[(size_t)(k0 + kk) * ldw + lcol0 + (lane & 31)]; }
    LDS_WAIT(); asm volatile("" ::: "memory");
    const int c = lane & 7;
#pragma unroll
    for (int j = 0; j < 4; ++j) { const int n = (lane >> 3) + 8 * j; const int jn = perm ? perm32(n) : n; const LAS float* s = scr + (8 * c) * 33 + jn;
        u32x4 o; o.x = pk2(s[0 * 33], s[1 * 33]); o.y = pk2(s[2 * 33], s[3 * 33]); o.z = pk2(s[4 * 33], s[5 * 33]); o.w = pk2(s[6 * 33], s[7 * 33]);
        *(GAS u32x4*)(dst + (size_t)(prow0 + n) * ldd + dcol0 + k0 + 8 * c) = o; }
    LDS_WAIT(); asm volatile("" ::: "memory");
}
__device__ __forceinline__ bool win_block_map(int pb, int& lcol, bool& perm) {
    const int tile = pb >> 3, w = pb & 7, bj = w >> 2, wc = w & 3;
    if (tile < 2) { lcol = OFF_Q + (4 * (tile & 1) + wc) * 64 + 32 * bj; perm = false; return true; }
    if (tile < 4) { lcol = OFF_K + (4 * (tile & 1) + wc) * 64 + 32 * bj; perm = false; return true; }
    perm = true;
    if (tile < 6) { lcol = OFF_V + 256 * (tile - 4) + 32 * w; return true; }
    if (tile < 8) return false;
    if (tile < 10) { lcol = (bj == 0 ? OFF_U : OFF_GATE + 768) + 128 * (tile - 8) + 32 * wc; return true; }
    if (tile == 10) { lcol = OFF_VC + 32 * w; return true; }
    if (tile < 14) { lcol = OFF_GATE + 256 * (tile - 11) + 32 * w; return true; }
    lcol = OFF_MERGE + 256 * (tile - 14) + 32 * w; return true;
}
__device__ __forceinline__ float cos2pi(int a, int n) { return cospif(2.0f * (float)a / (float)n); }
__device__ __forceinline__ float sin2pi(int a, int n) { return sinpif(2.0f * (float)a / (float)n); }

__device__ __forceinline__ void ph0_mods(const Args& a, int lane, int wave, int vcu);
__device__ __forceinline__ void ph0_prologue(const Args& a, LAS unsigned char* lds, int tid, int lane, int wave, int vcu, int pmask) {
    unsigned char* ws = a.ws;
    const int gw = vcu * NWAVES + wave, NGW = GRID * NWAVES;
    const int gt = vcu * NTHREADS + tid, NGT = GRID * NTHREADS;
    if (pmask & 1) {
        LAS float* scr = (LAS float*)(lds + wave * 16384);
        constexpr int I_WIN_N = DEPTH * 208 * 16;
        constexpr int I_BR_N = DEPTH * 32 * 16;
        constexpr int I_OUT_N = DEPTH * 32 * 16;
        for (int it = gw; it < I_WIN_N + I_BR_N + I_OUT_N; it += NGW) {
            int r = it;
            if (r < I_WIN_N) {
                const int l = r / (208 * 16), q = r % (208 * 16), pb = q >> 4, kb = q & 15; int lcol; bool perm;
                if (!win_block_map(pb, lcol, perm)) continue;
                transpose_item(a.in[I_WIN] + (size_t)l * DM * INW, INW, 64 * kb, lcol, perm, (bf16_t*)(ws + WS_WIN) + (size_t)l * NPHYS * DM, DM, 32 * pb, 0, scr, lane);
                continue;
            }
            r -= I_WIN_N;
            if (r < I_BR_N) {
                const int l = r / 512, q = r % 512, pb = q >> 4, kb = q & 15;
                const float* W; int ksrc;
                if (kb < 8) { W = a.in[I_WBRA] + (size_t)l * 512 * DM; ksrc = 64 * kb; } else if (kb < 12) { W = a.in[I_WBRB] + (size_t)l * 256 * DM; ksrc = 64 * (kb - 8); } else { W = a.in[I_WBRC] + (size_t)l * 256 * DM; ksrc = 64 * (kb - 12); }
                transpose_item(W, DM, ksrc, 32 * pb, true, (bf16_t*)(ws + WS_WBR) + (size_t)l * DM * DM, DM, 32 * pb, 64 * kb - ksrc, scr, lane);
                continue;
            }
            r -= I_BR_N;
            { const int l = r / 512, q = r % 512, pb = q >> 4, kb = q & 15;
              transpose_item(a.in[I_WOUT] + (size_t)l * DM * DM, DM, 64 * kb, 32 * pb, true, (bf16_t*)(ws + WS_WOUT) + (size_t)l * DM * DM, DM, 32 * pb, 0, scr, lane); }
        }
    }
    __syncthreads();
    if (pmask & 2) {
        LAS float* Wb = (LAS float*)lds;
        LAS float* TR = Wb + 64 * 65;
        LAS float* Tt = TR + 64 * 128;
        LAS float* Wf = Tt + 64 * 132;
        for (int it = vcu; it < DEPTH * 4 * 16; it += GRID) {
            const int l = it / 64, g = (it >> 4) & 3, kb = it & 15;
            const float* win = a.in[I_WIN] + (size_t)l * DM * INW; const float* wf = a.in[I_WF] + (size_t)(l * 4 + g) * 64 * 64;
            for (int e = tid; e < 4096; e += NTHREADS) { const int r = e >> 6, c = e & 63; Wb[r * 65 + c] = win[(size_t)(64 * kb + r) * INW + OFF_F + 64 * g + c]; Wf[e] = wf[e]; }
            for (int e = tid; e < 64 * 128; e += NTHREADS) { const int c = e >> 7, ri = (e >> 6) & 1, cp = e & 63; const int ph = (c * cp) & 63; TR[e] = ri ? -sin2pi(ph, 64) : cos2pi(ph, 64); }
            __syncthreads();
            const int tk = tid >> 5, tn = tid & 31;
            { f32x4 acc[4];
#pragma unroll
              for (int i = 0; i < 4; ++i) acc[i] = (f32x4){0.f, 0.f, 0.f, 0.f};
#pragma unroll 4
              for (int c = 0; c < 64; ++c) { const f32x4 bv = *(const LAS f32x4*)(TR + c * 128 + 4 * tn);
#pragma unroll
                  for (int i = 0; i < 4; ++i) acc[i] += bv * Wb[(4 * tk + i) * 65 + c]; }
#pragma unroll
              for (int i = 0; i < 4; ++i) *(LAS f32x4*)(Tt + (4 * tk + i) * 132 + 4 * tn) = acc[i]; }
            __syncthreads();
            { const int ri = tn >> 4, td = tn & 15;
              f32x4 acc[4];
#pragma unroll
              for (int i = 0; i < 4; ++i) acc[i] = (f32x4){0.f, 0.f, 0.f, 0.f};
#pragma unroll 4
              for (int cp = 0; cp < 64; ++cp) { const f32x4 bv = *(const LAS f32x4*)(Wf + cp * 64 + 4 * td);
#pragma unroll
                  for (int i = 0; i < 4; ++i) acc[i] += bv * Tt[(4 * tk + i) * 132 + ri * 64 + cp]; }
              bf16_t* dst = (bf16_t*)(ws + WS_WIN) + (size_t)l * NPHYS * DM;
#pragma unroll
              for (int e = 0; e < 4; ++e) { const int ch = 64 * g + 4 * td + e, prow = 6 * 256 + ri * 256 + (ch & ~31) + invperm32(ch & 31);
                  u32x2 w; w.x = pk2(acc[0][e], acc[1][e]); w.y = pk2(acc[2][e], acc[3][e]);
                  *(u32x2*)(dst + (size_t)prow * DM + 64 * kb + 4 * tk) = w; } }
            __syncthreads();
        }
    }
    if (pmask & 4) {
        float* ropec = (float*)(ws + WS_ROPE); float* ropes = ropec + 2048;
        for (int e = gt; e < 2048; e += NGT) { const int pos = e >> 4, f = e & 15; const float freq = powf(10000.0f, -(float)(2 * f) / 32.0f); const float ang = (float)pos * freq; ropec[e] = cosf(ang); ropes[e] = sinf(ang); }
        f32x2* tw = (f32x2*)(ws + WS_TW);
        for (int e = gt; e < 8192; e += NGT) tw[e] = (f32x2){cos2pi(e, 8192), sin2pi(e, 8192)};
        bf16_t* c128 = (bf16_t*)(ws + WS_C128); bf16_t* s128 = (bf16_t*)(ws + WS_S128);
        for (int e = gt; e < 4 * 8 * 64 * 8; e += NGT) { const int j = e & 7, ln = (e >> 3) & 63, s = (e >> 9) & 7, mb = e >> 12; const int row = 32 * mb + (ln & 31), k = 16 * s + 8 * (j >> 2) + 4 * (ln >> 5) + (j & 3);
            const int ph = (row * k) & 127; c128[e] = (bf16_t)f2bf(cos2pi(ph, 128)); s128[e] = (bf16_t)f2bf(sin2pi(ph, 128)); }
        bf16_t* t64 = (bf16_t*)(ws + WS_T64);
        for (int e = gt; e < 2 * 8 * 64 * 8; e += NGT) { const int j = e & 7, ln = (e >> 3) & 63, s = (e >> 9) & 7, mb = e >> 12; const int row = 32 * mb + (ln & 31), k = 16 * s + 8 * (j >> 2) + 4 * (ln >> 5) + (j & 3);
            const int ri = k >> 6, c = k & 63, ph = (row * c) & 63; t64[e] = (bf16_t)f2bf(ri ? sin2pi(ph, 64) : cos2pi(ph, 64)); }
        bf16_t* tc256 = (bf16_t*)(ws + WS_TC256);
        for (int e = gt; e < 8 * 32 * 64 * 8; e += NGT) { const int j = e & 7, ln = (e >> 3) & 63, s = (e >> 9) & 31, mb = e >> 14; const int row = 32 * mb + (ln & 31), k = 16 * s + 8 * (j >> 2) + 4 * (ln >> 5) + (j & 3);
            const int ri = k >> 8, n = k & 255, ph = (row * n) & 255; tc256[e] = (bf16_t)f2bf(ri ? sin2pi(ph, 256) : cos2pi(ph, 256)); }
        bf16_t* wsimg = (bf16_t*)(ws + WS_WSIMG);
        for (int e = gt; e < DEPTH * 4 * 4 * 8 * 64 * 8; e += NGT) { const int j = e & 7, ln = (e >> 3) & 63, s = (e >> 9) & 7, mb = (e >> 12) & 3, lg = e >> 14; const int row = 32 * mb + (ln & 31), k = 16 * s + 8 * (j >> 2) + 4 * (ln >> 5) + (j & 3);
            wsimg[e] = (bf16_t)f2bf(a.in[I_WS][(size_t)lg * 128 * 128 + row * 128 + k]); }
        if (gt < DEPTH) { const int l = gt; float s1 = 0.f, s2 = 0.f;
            for (int i = 0; i < 64; ++i) { s1 += a.in[I_LQ1][l * 64 + i] * a.in[I_LK1][l * 64 + i]; s2 += a.in[I_LQ2][l * 64 + i] * a.in[I_LK2][l * 64 + i]; }
            const float lam_init = 0.8f - 0.6f * expf(-0.3f * (float)l);
            float* lam = (float*)(ws + WS_LAM); lam[2 * l] = expf(s1) - expf(s2) + lam_init; lam[2 * l + 1] = 1.0f - lam_init; }
    }
}

__device__ __forceinline__ void ph0_mods(const Args& a, int lane, int wave, int vcu) {
    unsigned char* ws = a.ws; const int gw = vcu * NWAVES + wave, NGW = GRID * NWAVES;
    {
        float* part = (float*)(ws + WS_MODP);
        for (int it = gw; it < DEPTH * 12 * 32; it += NGW) {
            const int l = it / 384, q = it % 384, cc = q >> 5, kc = q & 31; const int col = 256 * cc + 4 * lane;
            const float* w = a.in[I_WADA] + (size_t)l * DM * 3072 + col;
            f32x4 s0 = {0.f, 0.f, 0.f, 0.f}, s1 = s0, s2 = s0;
#pragma unroll 8
            for (int kk = 0; kk < 32; ++kk) { const int k = 32 * kc + kk; const f32x4 wv = *(const f32x4*)(w + (size_t)k * 3072);
                const float a0 = fast_silu(a.in[I_C][k]), a1 = fast_silu(a.in[I_C][DM + k]), a2 = fast_silu(a.in[I_CCTX][k]);
                s0 += wv * a0; s1 += wv * a1; s2 += wv * a2; }
            float* p = part + ((size_t)(l * 32 + kc) * 3) * 3072 + col;
            *(f32x4*)(p) = s0; *(f32x4*)(p + 3072) = s1; *(f32x4*)(p + 2 * 3072) = s2;
        }
    }
}

__device__ __forceinline__ void prepass(const Args& a, int l, LAS unsigned char* lds, int tid, int lane, int wave, int vcu) {
    unsigned char* ws = a.ws;
    const float* part = (const float*)(ws + WS_MODP); float* modf = (float*)(ws + WS_MODF);
    if (l == 0) {
        if (tid < 72) { const int o = vcu * 72 + tid; const int ll = o / 9216, rj = o % 9216, r = rj / 3072, j = rj % 3072; float s = a.in[I_BADA][ll * 3072 + j];
#pragma unroll
            for (int kc = 0; kc < 32; ++kc) s += part[((size_t)(ll * 32 + kc) * 3 + r) * 3072 + j];
            modf[o] = s; }
    }
    const int row0 = vcu * 66, row1 = row0 + 66;
    LAS float* coef = (LAS float*)lds;
    for (int r = 0; r < 3; ++r) {
        const int lo = r == 0 ? 0 : (r == 1 ? SEQ : MLAT), hi = r == 0 ? SEQ : (r == 1 ? MLAT : MT);
        if (row1 <= lo || row0 >= hi) continue;
        for (int k = tid; k < DM; k += NTHREADS) {
            float sh, sc;
            if (l == 0) { sh = a.in[I_BADA][k]; sc = a.in[I_BADA][DM + k];
#pragma unroll
                for (int kc = 0; kc < 32; ++kc) { const float* p = part + ((size_t)(kc) * 3 + r) * 3072; sh += p[k]; sc += p[DM + k]; } }
            else { sh = modf[(size_t)(l * 3 + r) * 3072 + k]; sc = modf[(size_t)(l * 3 + r) * 3072 + DM + k]; }
            coef[(r * 2) * DM + k] = a.in[I_GNORM][l * DM + k] * (1.0f + sc); coef[(r * 2 + 1) * DM + k] = sh;
        }
    }
    __syncthreads();
    const float* xlat = l == 0 ? a.in[I_X] : a.out; const float* xctx = l == 0 ? a.in[I_CTX] : (const float*)(ws + WS_CTX1);
    bf16_t* H = (bf16_t*)(ws + WS_H);
    for (int mb = row0 + 4 * wave; mb < row1; mb += 4 * NWAVES) {
        f32x4 v[4][4]; float s2[4];
#pragma unroll
        for (int q = 0; q < 4; ++q) { const int m = (mb + q < row1) ? mb + q : mb;
            if (l == 1 && m < MLAT) { const GAS u32x2* xb = (const GAS u32x2*)(ws + x1b_off(m)) + lane;
#pragma unroll
                for (int j = 0; j < 4; ++j) { const u32x2 t = xb[64 * j]; v[q][j] = (f32x4){bflo(t.x), bfhi(t.x), bflo(t.y), bfhi(t.y)}; } }
            else { const float* xrow = m < MLAT ? xlat + (size_t)m * DM : xctx + (size_t)(m - MLAT) * DM; const GAS f32x4* xr = (const GAS f32x4*)xrow + lane;
#pragma unroll
                for (int j = 0; j < 4; ++j) v[q][j] = xr[64 * j]; } }
#pragma unroll
        for (int q = 0; q < 4; ++q) { float t = 0.f;
#pragma unroll
            for (int j = 0; j < 4; ++j) t += (v[q][j].x * v[q][j].x + v[q][j].y * v[q][j].y) + (v[q][j].z * v[q][j].z + v[q][j].w * v[q][j].w);
            s2[q] = t; }
#pragma unroll
        for (int o = 1; o < 64; o <<= 1) {
#pragma unroll
            for (int q = 0; q < 4; ++q) s2[q] += __shfl_xor(s2[q], o); }
#pragma unroll
        for (int q = 0; q < 4; ++q) { const int m = mb + q; if (m >= row1) break;
            const int r = m < SEQ ? 0 : (m < MLAT ? 1 : 2);
            const float rstd = rsqrtf(s2[q] * (1.0f / DM) + EPS);
            GAS u32x2* o8 = (GAS u32x2*)(H + (size_t)m * DM) + lane;
#pragma unroll
            for (int j = 0; j < 4; ++j) { const f32x4 ga = *(const LAS f32x4*)(coef + (r * 2) * DM + 256 * j + 4 * lane), sh = *(const LAS f32x4*)(coef + (r * 2 + 1) * DM + 256 * j + 4 * lane);
                const f32x4 h = v[q][j] * rstd * ga + sh; u32x2 w; w.x = pk2(h.x, h.y); w.y = pk2(h.z, h.w); o8[64 * j] = w; } }
    }
    __syncthreads();
}

struct TileSched {
    int x, c, pn0, npn, nseg, nctx, cpn0, cnpn;
    __device__ __forceinline__ bool next(int i, pg8::Unit& u) const {
        const int ti = i / nseg; u.seg = i - ti * nseg; u.set = 0;
        const int j = ti * 32 + c;
        if (j < 8 * npn) { u.pm = 8 * x + (j & 7); u.pn = pn0 + (j >> 3); return true; }
        const int id = (j - 8 * npn) * 8 + x;
        if (id < nctx) { u.pm = 64 + (id & 1); u.pn = cpn0 + (id >> 1); return true; }
        return false;
    }
    __device__ __forceinline__ void a_ready(const pg8::Unit&) const {}
};

struct EpiIn {
    unsigned char* ws; const float* gq; const float* gk; LAS const float* ropec; LAS const float* ropes;
    __device__ __forceinline__ bool operator()(f32x4 (&acc)[2][2][4][2], const pg8::Unit& u, int wr, int wc, int fr, int fq) const {
        const bool ctx = u.pm >= 64; const int b = ctx ? u.pm - 64 : (u.pm >> 5);
        const int rbase = u.pm * 256 + wr * 64 + fr;
        const int pn = u.pn;
        if (pn < 4) {
            const bool isK = pn >= 2; const int gi = 4 * (pn & 1) + wc, h = gi >> 1, comp = gi & 1;
            const float* gsrc = isK ? gk : gq;
            f32x4 gv[2][2];
#pragma unroll
            for (int bj = 0; bj < 2; ++bj)
#pragma unroll
                for (int n = 0; n < 2; ++n) gv[bj][n] = *(const f32x4*)(gsrc + 32 * bj + 16 * n + 4 * fq);
#pragma unroll
            for (int ai = 0; ai < 2; ++ai)
#pragma unroll
                for (int m = 0; m < 4; ++m) {
                    const int row = rbase + ai * 128 + m * 16;
                    f32x4 v[2][2]; float ss = 0.f;
#pragma unroll
                    for (int bj = 0; bj < 2; ++bj)
#pragma unroll
                        for (int n = 0; n < 2; ++n) { v[bj][n] = acc[ai][bj][m][n]; ss += (v[bj][n].x * v[bj][n].x + v[bj][n].y * v[bj][n].y) + (v[bj][n].z * v[bj][n].z + v[bj][n].w * v[bj][n].w); }
                    ss += __shfl_xor(ss, 16); ss += __shfl_xor(ss, 32);
                    const float rstd = rsqrtf(ss * (1.0f / 64.0f) + EPS);
#pragma unroll
                    for (int bj = 0; bj < 2; ++bj)
#pragma unroll
                        for (int n = 0; n < 2; ++n) v[bj][n] = v[bj][n] * rstd * gv[bj][n];
                    int kx;
                    if (!ctx) { const int ntok = row - b * SEQ; kx = ntok;
#pragma unroll
                        for (int bj = 0; bj < 2; ++bj) { const int pos = bj == 0 ? (ntok >> 6) : (ntok & 63);
                            const f32x4 c4 = *(LAS const f32x4*)(ropec + pos * 16 + 4 * fq), s4 = *(LAS const f32x4*)(ropes + pos * 16 + 4 * fq);
                            const f32x4 x1 = v[bj][0], x2 = v[bj][1]; v[bj][0] = x1 * c4 - x2 * s4; v[bj][1] = x2 * c4 + x1 * s4; } }
                    else kx = SEQ + (row - MLAT - b * NCTX);
#pragma unroll
                    for (int bj = 0; bj < 2; ++bj) {
                        f32x4 p0 = v[bj][0], p1 = v[bj][1];
                        if (!isK) { p0 = p0 * QSCALE; p1 = p1 * QSCALE; }
                        u32x4 w; w.x = cvt_pk_bf16(p0.x, p0.y); w.y = cvt_pk_bf16(p0.z, p0.w); w.z = cvt_pk_bf16(p1.x, p1.y); w.w = cvt_pk_bf16(p1.z, p1.w);
                        if (!isK) *(u32x4*)((bf16_t*)(ws + WS_QG) + ((size_t)row * 4 + h) * 128 + comp * 64 + (bj * 4 + fq) * 8) = w;
                        else *(u32x4*)(ws + WS_KIMG + ((size_t)((b * 4 + h) * NKT + (kx >> 6)) * 16 + comp * 8 + bj * 4 + fq) * 1024 + (kx & 63) * 16) = w;
                    }
                }
            return true;
        }
#pragma unroll
        for (int ai = 0; ai < 2; ++ai)
#pragma unroll
            for (int m = 0; m < 4; ++m) {
                const int row = rbase + ai * 128 + m * 16;
                if (pn == 8 || pn == 9) {
                    f32x4 p0, p1;
#pragma unroll
                    for (int e = 0; e < 4; ++e) { p0[e] = acc[ai][0][m][0][e] * fast_silu(acc[ai][1][m][0][e]); p1[e] = acc[ai][0][m][1][e] * fast_silu(acc[ai][1][m][1][e]); }
                    u32x4 w; w.x = cvt_pk_bf16(p0.x, p0.y); w.y = cvt_pk_bf16(p0.z, p0.w); w.z = cvt_pk_bf16(p1.x, p1.y); w.w = cvt_pk_bf16(p1.z, p1.w);
                    *(u32x4*)((bf16_t*)(ws + WS_UG) + (size_t)row * 256 + 128 * (pn - 8) + 32 * wc + 8 * fq) = w;
                    continue;
                }
#pragma unroll
                for (int bj = 0; bj < 2; ++bj) {
                    f32x4 p0 = acc[ai][bj][m][0], p1 = acc[ai][bj][m][1];
                    const int lc = 128 * bj + 32 * wc + 8 * fq;
                    unsigned char* dst;
                    if (pn < 6) { const int kx = ctx ? SEQ + (row - MLAT - b * NCTX) : row - b * SEQ; const int h = 2 * (pn - 4) + bj;
                        dst = ws + WS_VIMG + ((size_t)((b * 4 + h) * NKT + (kx >> 6)) * 16 + wc * 4 + ((kx & 63) >> 4)) * 1024 + (kx & 15) * 64 + fq * 16; }
                    else if (pn < 8) dst = ws + WS_Z2 + ((size_t)row * 512 + 256 * (pn - 6) + lc) * 2;
                    else if (pn == 10) dst = ws + WS_VC + ((size_t)row * 256 + lc) * 2;
                    else if (pn < 14) {
#pragma unroll
                        for (int e = 0; e < 4; ++e) { p0[e] = fast_silu(p0[e]); p1[e] = fast_silu(p1[e]); }
                        dst = ws + WS_GS + ((size_t)row * 768 + 256 * (pn - 11) + lc) * 2; }
                    else {
                        unsigned q0 = 0u, q1 = 0u;
#pragma unroll
                        for (int e = 0; e < 4; ++e) { q0 = ms_quant_pk(p0[e], e, q0); q1 = ms_quant_pk(p1[e], e, q1); }
                        unsigned char* d8 = ctx ? ws + WS_MSC + ((size_t)(row - MLAT) * 3072 + 256 * (pn - 14) + lc) : ws + WS_MS + ((size_t)row * 3072 + 256 * (pn - 14) + lc);
                        u32x2 w8; w8.x = q0; w8.y = q1; *(u32x2*)d8 = w8; continue; }
                    u32x4 w; w.x = cvt_pk_bf16(p0.x, p0.y); w.y = cvt_pk_bf16(p0.z, p0.w); w.z = cvt_pk_bf16(p1.x, p1.y); w.w = cvt_pk_bf16(p1.z, p1.w);
                    *(u32x4*)dst = w;
                }
            }
        return true;
    }
};

struct EpiY {
    const unsigned char* MS; bf16_t* Y;
    __device__ __forceinline__ bool operator()(f32x4 (&acc)[2][2][4][2], const pg8::Unit& u, int wr, int wc, int fr, int fq) const {
        const int rbase = u.pm * 256 + wr * 64 + fr; const int seg = u.seg;
#pragma unroll
        for (int ai = 0; ai < 2; ++ai) {
            u32x2 mn[4][2], md[4][2];
#pragma unroll
            for (int m = 0; m < 4; ++m)
#pragma unroll
                for (int bj = 0; bj < 2; ++bj) { const unsigned char* mp = MS + (size_t)(rbase + ai * 128 + m * 16) * 3072 + seg * 1024 + 256 * u.pn + 128 * bj + 32 * wc + 8 * fq;
                    mn[m][bj] = *(const u32x2*)mp; md[m][bj] = seg < 2 ? *(const u32x2*)(mp + 1024) : (u32x2){0u, 0u}; }
            __builtin_amdgcn_sched_barrier(0);
#pragma unroll
            for (int m = 0; m < 4; ++m) {
                const int row = rbase + ai * 128 + m * 16;
#pragma unroll
                for (int bj = 0; bj < 2; ++bj) {
                    const int col = 256 * u.pn + 128 * bj + 32 * wc + 8 * fq;
                    const u32x2 a_ = mn[m][bj], d_ = md[m][bj];
                    f32x4& p0 = acc[ai][bj][m][0]; f32x4& p1 = acc[ai][bj][m][1];
                    if (seg < 2) {
#pragma unroll
                        for (int e = 0; e < 4; ++e) { p0[e] *= ub(a_.x, e) * __builtin_amdgcn_rcpf(ub(d_.x, e)); p1[e] *= ub(a_.y, e) * __builtin_amdgcn_rcpf(ub(d_.y, e)); } }
                    else {
#pragma unroll
                        for (int e = 0; e < 4; ++e) { p0[e] *= ub(a_.x, e) * (1.0f / 255.0f); p1[e] *= ub(a_.y, e) * (1.0f / 255.0f); }
                        u32x4 w; w.x = cvt_pk_bf16(p0[0], p0[1]); w.y = cvt_pk_bf16(p0[2], p0[3]); w.z = cvt_pk_bf16(p1[0], p1[1]); w.w = cvt_pk_bf16(p1[2], p1[3]);
                        *(u32x4*)(Y + (size_t)row * DM + col) = w; }
                }
            }
            __builtin_amdgcn_sched_barrier(0);
        }
        return seg == 2;
    }
};


struct FusedSched {
    int x, c; unsigned* sp; XcdBarrier bar; bool hier; unsigned* tmo;
    __device__ __forceinline__ bool next(int i, pg8::Unit& u) const {
        if (i >= 6) return false;
        u.pm = 8 * x + (c & 7);
        if (i < 3) { u.pn = 14 + 4 * i + (c >> 3); u.seg = 0; u.set = 1; } else { u.pn = c >> 3; u.seg = i - 3; u.set = 0; }
        return true;
    }
    __device__ __forceinline__ void a_ready(const pg8::Unit& u) const { if (u.set == 0 && u.seg == 1) split_wait(sp, bar, hier, tmo); }
};
struct EpiMY {
    EpiIn ein; EpiY ey;
    __device__ __forceinline__ bool operator()(f32x4 (&acc)[2][2][4][2], const pg8::Unit& u, int wr, int wc, int fr, int fq) const { return u.set ? ein(acc, u, wr, wc, fr, fq) : ey(acc, u, wr, wc, fr, fq); }
};

struct EpiOut {
    const float* xin; float* out; unsigned char* ws; const float* gate; int layer;
    __device__ __forceinline__ bool operator()(f32x4 (&acc)[2][2][4][2], const pg8::Unit& u, int wr, int wc, int fr, int fq) const {
        const int r = u.pm >> 5;
        const int rbase = u.pm * 256 + wr * 64 + fr;
        f32x4 xa[2][2], xb[2][2], xc[2][2];
#define EO_C(g) (256 * u.pn + 128 * ((g) >> 2) + 32 * wc + 8 * fq)
#define EO_ROW(g, mm) (rbase + (((g) >> 1) & 1) * 128 + (2 * ((g) & 1) + (mm)) * 16)
#define EO_LOAD(dst, g) do { _Pragma("unroll") for (int mm = 0; mm < 2; ++mm) { \
            if (layer == 0) { const float* p_ = xin + (size_t)EO_ROW(g, mm) * DM + EO_C(g); dst[mm][0] = *(const f32x4*)p_; dst[mm][1] = *(const f32x4*)(p_ + 4); } \
            else { const u32x4 t_ = *(const u32x4*)(ws + x1b_off(EO_ROW(g, mm)) + (size_t)EO_C(g) * 2); dst[mm][0] = (f32x4){bflo(t_.x), bfhi(t_.x), bflo(t_.y), bfhi(t_.y)}; dst[mm][1] = (f32x4){bflo(t_.z), bfhi(t_.z), bflo(t_.w), bfhi(t_.w)}; } } } while (0)
#define EO_STORE(srcv, g) do { const f32x4 g0_ = *(const f32x4*)(gate + (size_t)r * 3072 + EO_C(g)), g1_ = *(const f32x4*)(gate + (size_t)r * 3072 + EO_C(g) + 4); \
            _Pragma("unroll") for (int mm = 0; mm < 2; ++mm) { \
                const f32x4 y0_ = srcv[mm][0] + g0_ * acc[((g) >> 1) & 1][(g) >> 2][2 * ((g) & 1) + mm][0], y1_ = srcv[mm][1] + g1_ * acc[((g) >> 1) & 1][(g) >> 2][2 * ((g) & 1) + mm][1]; \
                if (layer == 0) { u32x4 w_; w_.x = cvt_pk_bf16(y0_.x, y0_.y); w_.y = cvt_pk_bf16(y0_.z, y0_.w); w_.z = cvt_pk_bf16(y1_.x, y1_.y); w_.w = cvt_pk_bf16(y1_.z, y1_.w); *(u32x4*)(ws + x1b_off(EO_ROW(g, mm)) + (size_t)EO_C(g) * 2) = w_; } \
                else { float* p_ = out + (size_t)EO_ROW(g, mm) * DM + EO_C(g); *(f32x4*)p_ = y0_; *(f32x4*)(p_ + 4) = y1_; } } } while (0)
        EO_LOAD(xa, 0); EO_LOAD(xb, 1); EO_LOAD(xc, 2);
        EO_STORE(xa, 0); EO_LOAD(xa, 3);
        EO_STORE(xb, 1); EO_LOAD(xb, 4);
        EO_STORE(xc, 2); EO_LOAD(xc, 5);
        EO_STORE(xa, 3); EO_LOAD(xa, 6);
        EO_STORE(xb, 4); EO_LOAD(xb, 7);
        EO_STORE(xc, 5); EO_STORE(xa, 6); EO_STORE(xb, 7);
#undef EO_C
#undef EO_ROW
#undef EO_LOAD
#undef EO_STORE
        return true;
    }
};

__device__ __forceinline__ f32x4 mini_block(const bf16_t* A, int lda, const bf16_t* Bt, int ldb, int m0, int n0, int k0, int nk, int fr, int fq, f32x4 acc) {
    const bf16_t* ap = A + (size_t)(m0 + fr) * lda + k0 + 8 * fq; const bf16_t* bp = Bt + (size_t)(n0 + fr) * ldb + k0 + 8 * fq;
#pragma unroll 16
    for (int s = 0; s < nk; s += 32) acc = __builtin_amdgcn_mfma_f32_16x16x32_bf16(*(const bf16x8*)(bp + s), *(const bf16x8*)(ap + s), acc, 0, 0, 0);
    return acc;
}
__device__ __forceinline__ int mini_lcol(int n0, int fq) { return (n0 & ~31) + 8 * fq + 4 * ((n0 >> 4) & 1); }
__device__ __forceinline__ void ctx_merge_gates(unsigned char* ws, const bf16_t* Wl, int gw, int lane) {
    const int fr = lane & 15, fq = lane >> 4; const bf16_t* H = (const bf16_t*)(ws + WS_H); bf16_t* MS = (bf16_t*)(ws + WS_MS);
    for (int blk = gw; blk < 32 * 192; blk += GRID * NWAVES) { const int m0 = MLAT + 16 * (blk & 31), n0 = 16 * (blk >> 5);
        const f32x4 acc = mini_block(H, DM, Wl + (size_t)(14 * 256) * DM, DM, m0, n0, 0, DM, fr, fq, (f32x4){0.f, 0.f, 0.f, 0.f});
        u32x2 w; w.x = cvt_pk_bf16(fast_sigmoid(acc[0]), fast_sigmoid(acc[1])); w.y = cvt_pk_bf16(fast_sigmoid(acc[2]), fast_sigmoid(acc[3]));
        *(u32x2*)(MS + (size_t)(m0 + fr) * 3072 + mini_lcol(n0, fq)) = w; }
}
__device__ __forceinline__ void ctx_branch_proj(unsigned char* ws, const bf16_t* Wbr, int gw, int lane) {
    const int fr = lane & 15, fq = lane >> 4; const bf16_t* A = (const bf16_t*)(ws + WS_A); const unsigned char* MS = (const unsigned char*)(ws + WS_MSC) - (size_t)MLAT * 3072; bf16_t* Y = (bf16_t*)(ws + WS_Y);
    for (int blk = gw; blk < 32 * 64; blk += GRID * NWAVES) { const int m0 = MLAT + 16 * (blk & 31), n0 = 16 * (blk >> 5); const int lc = mini_lcol(n0, fq);
        f32x4 y = {0.f, 0.f, 0.f, 0.f};
#pragma unroll
        for (int seg = 0; seg < 3; ++seg) { const int k0 = seg == 0 ? 0 : (seg == 1 ? 512 : 768), nk = seg == 0 ? 512 : 256;
            const f32x4 acc = mini_block(A, DM, Wbr, DM, m0, n0, k0, nk, fr, fq, (f32x4){0.f, 0.f, 0.f, 0.f});
            const unsigned mg = *(const unsigned*)(MS + (size_t)(m0 + fr) * 3072 + seg * 1024 + lc);
            y[0] += acc[0] * ub(mg, 0) * (1.0f / 255.0f); y[1] += acc[1] * ub(mg, 1) * (1.0f / 255.0f); y[2] += acc[2] * ub(mg, 2) * (1.0f / 255.0f); y[3] += acc[3] * ub(mg, 3) * (1.0f / 255.0f); }
        u32x2 w; w.x = cvt_pk_bf16(y[0], y[1]); w.y = cvt_pk_bf16(y[2], y[3]);
        *(u32x2*)(Y + (size_t)(m0 + fr) * DM + lc) = w; }
}
__device__ __forceinline__ void ctx_out_proj(unsigned char* ws, const bf16_t* Wout, const float* ctx_in, const float* gate_ctx, int gw, int lane) {
    const int fr = lane & 15, fq = lane >> 4; const bf16_t* Y = (const bf16_t*)(ws + WS_Y); float* C1 = (float*)(ws + WS_CTX1);
    for (int blk = gw; blk < 32 * 64; blk += GRID * NWAVES) { const int m0 = MLAT + 16 * (blk & 31), n0 = 16 * (blk >> 5);
        const f32x4 acc = mini_block(Y, DM, Wout, DM, m0, n0, 0, DM, fr, fq, (f32x4){0.f, 0.f, 0.f, 0.f});
        const int col = mini_lcol(n0, fq); const size_t off = (size_t)(m0 - MLAT + fr) * DM + col;
        const f32x4 g = *(const f32x4*)(gate_ctx + col), x = *(const f32x4*)(ctx_in + off);
        *(f32x4*)(C1 + off) = x + g * acc; }
}

typedef short v4i16_t __attribute__((ext_vector_type(4)));
__device__ __forceinline__ s16x4 vtr(LAS const unsigned char* p) { return __builtin_bit_cast(s16x4, __builtin_amdgcn_ds_read_tr16_b64_v4i16((LAS v4i16_t*)p)); }
__device__ __forceinline__ int tr_lane_off(int lane) { return ((lane >> 4) & 1) * 32 + (lane & 3) * 8 + (4 * (lane >> 5) + ((lane & 15) >> 2)) * 64; }
__device__ __forceinline__ bf16x8 bfrag(LAS const unsigned char* piece_plus_laneoff) {
    const s16x4 lo = vtr(piece_plus_laneoff), hi = vtr(piece_plus_laneoff + 512);
    return (bf16x8){lo[0], lo[1], lo[2], lo[3], hi[0], hi[1], hi[2], hi[3]};
}
template <int NROWS, int NCOLS, class RP> __device__ __forceinline__ void stage_pieces(LAS unsigned char* dst, RP rp, int tid) {
    constexpr int cpr = NCOLS >> 3, total = NROWS * cpr, pcs = NCOLS >> 5, NIT = total / NTHREADS;
    static_assert(total % NTHREADS == 0, "stage_pieces: whole passes only");
    u32x4 v[NIT];
#pragma unroll
    for (int i = 0; i < NIT; ++i) { const int c = tid + i * NTHREADS, row = c / cpr, cc = c - row * cpr; v[i] = *(const u32x4*)(rp(row) + cc * 8); }
#pragma unroll
    for (int i = 0; i < NIT; ++i) { const int c = tid + i * NTHREADS, row = c / cpr, cc = c - row * cpr;
        *(LAS u32x4*)(dst + ((row >> 4) * pcs + (cc >> 2)) * 1024 + (row & 15) * 64 + (cc & 3) * 16) = v[i]; }
}
#define MFMA32(a, b, c) __builtin_amdgcn_mfma_f32_32x32x16_bf16(a, b, c, 0, 0, 0)
__device__ __forceinline__ bf16x8 afrag_img(const bf16_t* img, int KS, int mb, int s, int lane) { return *(const bf16x8*)(img + ((size_t)(mb * KS + s) * 64 + lane) * 8); }

__device__ __forceinline__ void f1_unit(unsigned char* ws, LAS unsigned char* lds, int unit, int tid, int lane, int wave) {
    const int b = unit >> 7, c = (unit >> 1) & 63, chh = unit & 1;
    bf16_t* Z2 = (bf16_t*)(ws + WS_Z2);
    const bf16_t* base = Z2 + ((size_t)(b * SEQ + c)) * 512 + chh * 128;
    stage_pieces<128, 128>(lds, [&](int r) { return base + (size_t)r * 64 * 512; }, tid);
    stage_pieces<128, 128>(lds + 32768, [&](int r) { return base + (size_t)r * 64 * 512 + 256; }, tid);
    bf16x8 cfa[8], sfa[8];
    { const bf16_t* c128_ = (const bf16_t*)(ws + WS_C128); const bf16_t* s128_ = (const bf16_t*)(ws + WS_S128);
#pragma unroll
      for (int s = 0; s < 8; ++s) { cfa[s] = afrag_img(c128_, 8, wave & 3, s, lane); sfa[s] = afrag_img(s128_, 8, wave & 3, s, lane); } }
    __syncthreads();
    const int mb = wave & 3, cbp = wave >> 2, hi = lane >> 5, r32 = lane & 31, lo = tr_lane_off(lane);
    f32x16 outr[2], t1[2], t2[2];
#pragma unroll
    for (int e = 0; e < 2; ++e) { outr[e] = f32x16{}; t1[e] = f32x16{}; t2[e] = f32x16{}; }
#pragma unroll
    for (int s = 0; s < 8; ++s) {
        const bf16x8 cf = cfa[s], sf = sfa[s];
#pragma unroll
        for (int e = 0; e < 2; ++e) {
            const bf16x8 xr = bfrag(lds + (s * 4 + 2 * cbp + e) * 1024 + lo), xi = bfrag(lds + 32768 + (s * 4 + 2 * cbp + e) * 1024 + lo);
            outr[e] = MFMA32(cf, xr, outr[e]); outr[e] = MFMA32(sf, xi, outr[e]); t1[e] = MFMA32(cf, xi, t1[e]); t2[e] = MFMA32(sf, xr, t2[e]);
        }
    }
    const f32x2* tw = (const f32x2*)(ws + WS_TW);
    f32x2 twv[16];
#pragma unroll
    for (int r = 0; r < 16; ++r) twv[r] = tw[(c * (32 * mb + crow(r, hi))) & 8191];
    __builtin_amdgcn_sched_barrier(0);
#pragma unroll
    for (int e = 0; e < 2; ++e)
#pragma unroll
        for (int r = 0; r < 16; ++r) {
            const int k1 = 32 * mb + crow(r, hi), ch = chh * 128 + 32 * (2 * cbp + e) + r32;
            const float yr = outr[e][r], yi = t1[e][r] - t2[e][r];
            const f32x2 t = twv[r];
            bf16_t* o = Z2 + ((size_t)(b * SEQ + 64 * k1 + c)) * 512 + ch;
            o[0] = (bf16_t)f2bf(yr * t.x + yi * t.y); o[256] = (bf16_t)f2bf(yi * t.x - yr * t.y);
            if ((r & 3) == 3) __builtin_amdgcn_sched_barrier(0);
        }
    __syncthreads();
}

__device__ __forceinline__ void sgu_unit(const Args& a, int l, LAS unsigned char* lds, int cu, int tid, int lane, int wave) {
    unsigned char* ws = a.ws;
    const int row0 = cu < 128 ? cu * 128 : MLAT + (cu - 128) * 128;
    const bf16_t* VC = (const bf16_t*)(ws + WS_VC);
    {
        const int tok = tid >> 2, qt = tid & 3;
        const u32x4* src = (const u32x4*)(VC + (size_t)(row0 + tok) * 256 + qt * 64);
        u32x4 raw[8]; float s = 0.f;
#pragma unroll
        for (int i = 0; i < 8; ++i) { raw[i] = src[i]; s += (bflo(raw[i].x) + bfhi(raw[i].x)) + (bflo(raw[i].y) + bfhi(raw[i].y)) + (bflo(raw[i].z) + bfhi(raw[i].z)) + (bflo(raw[i].w) + bfhi(raw[i].w)); }
        s += __shfl_xor(s, 1); s += __shfl_xor(s, 2);
        const float mu = s * (1.0f / 256.0f); float q = 0.f;
#pragma unroll
        for (int i = 0; i < 8; ++i) {
#pragma unroll
            for (int e = 0; e < 4; ++e) { const float d0 = bflo(raw[i][e]) - mu, d1 = bfhi(raw[i][e]) - mu; q += d0 * d0 + d1 * d1; } }
        q += __shfl_xor(q, 1); q += __shfl_xor(q, 2);
        const float rstd = rsqrtf(q * (1.0f / 256.0f) + EPS);
        const float* lg = a.in[I_LNG] + l * 256 + qt * 64; const float* lb = a.in[I_LNB] + l * 256 + qt * 64;
#pragma unroll
        for (int i = 0; i < 8; ++i) { u32x4 w;
#pragma unroll
            for (int e = 0; e < 4; ++e) { const int ch = 8 * i + 2 * e; w[e] = pk2((bflo(raw[i][e]) - mu) * rstd * lg[ch] + lb[ch], (bfhi(raw[i][e]) - mu) * rstd * lg[ch + 1] + lb[ch + 1]); }
            const int cc = qt * 8 + i;
            *(LAS u32x4*)(lds + ((tok >> 4) * 8 + (cc >> 2)) * 1024 + (tok & 15) * 64 + (cc & 3) * 16) = w; __builtin_amdgcn_sched_barrier(0); }
    }
    bf16x8 wa0[8], wa1[8];
    { const bf16_t* img_ = (const bf16_t*)(ws + WS_WSIMG) + (size_t)(l * 4 + (wave >> 1)) * 16384;
#pragma unroll
      for (int s = 0; s < 8; ++s) { wa0[s] = afrag_img(img_, 8, 2 * (wave & 1), s, lane); wa1[s] = afrag_img(img_, 8, 2 * (wave & 1) + 1, s, lane); } }
    __syncthreads();
    const int g = wave >> 1, ph = wave & 1, hi = lane >> 5, r32 = lane & 31, lo = tr_lane_off(lane);
    f32x16 acc[2][2];
#pragma unroll
    for (int i = 0; i < 2; ++i) { acc[i][0] = f32x16{}; acc[i][1] = f32x16{}; }
#pragma unroll
    for (int s = 0; s < 8; ++s) {
        const bf16x8 a0 = wa0[s], a1 = wa1[s];
        const bf16x8 b0 = bfrag(lds + (s * 8 + 2 * g) * 1024 + lo), b1 = bfrag(lds + (s * 8 + 2 * g + 1) * 1024 + lo);
        acc[0][0] = MFMA32(a0, b0, acc[0][0]); acc[0][1] = MFMA32(a0, b1, acc[0][1]); acc[1][0] = MFMA32(a1, b0, acc[1][0]); acc[1][1] = MFMA32(a1, b1, acc[1][1]);
    }
    const bf16_t* UG = (const bf16_t*)(ws + WS_UG); bf16_t* A = (bf16_t*)(ws + WS_A);
    const float* bs = a.in[I_BS] + (size_t)(l * 4 + g) * 128;
#pragma unroll
    for (int i = 0; i < 2; ++i)
#pragma unroll
        for (int e = 0; e < 2; ++e) {
            unsigned short ugv[16]; float bsv[16];
#pragma unroll
            for (int r = 0; r < 16; ++r) { const int p = 32 * (2 * ph + i) + crow(r, hi); ugv[r] = UG[(size_t)(row0 + p) * 256 + 64 * g + 32 * e + r32]; bsv[r] = bs[p]; }
            __builtin_amdgcn_sched_barrier(0);
#pragma unroll
            for (int r = 0; r < 16; ++r) { const int p = 32 * (2 * ph + i) + crow(r, hi), ch = 64 * g + 32 * e + r32;
                A[(size_t)(row0 + p) * DM + 768 + ch] = (bf16_t)f2bf(bf2f(ugv[r]) * (acc[i][e][r] + bsv[r])); }
            __builtin_amdgcn_sched_barrier(0);
        }
    __syncthreads();
}

__device__ __forceinline__ void ctxf_unit(const Args& a, int l, LAS unsigned char* lds, int unit, int tid, int lane, int wave) {
    unsigned char* ws = a.ws;
    const int b = unit >> 2, chq = unit & 3;
    const bf16_t* Z2 = (const bf16_t*)(ws + WS_Z2);
    stage_pieces<512, 64>(lds, [&](int k) { return Z2 + (size_t)(MLAT + b * NCTX + (k & 255)) * 512 + (k >> 8) * 256 + chq * 64; }, tid);
    __syncthreads();
    const int mb = wave, hi = lane >> 5, r32 = lane & 31, lo = tr_lane_off(lane);
    const bf16_t* img = (const bf16_t*)(ws + WS_TC256);
    f32x16 acc[2]; acc[0] = f32x16{}; acc[1] = f32x16{};
#pragma unroll
    for (int sh = 0; sh < 2; ++sh) { bf16x8 af[16];
#pragma unroll
        for (int s = 0; s < 16; ++s) af[s] = afrag_img(img, 32, mb, 16 * sh + s, lane);
#pragma unroll
        for (int s = 0; s < 16; ++s) { acc[0] = MFMA32(af[s], bfrag(lds + ((16 * sh + s) * 2) * 1024 + lo), acc[0]); acc[1] = MFMA32(af[s], bfrag(lds + ((16 * sh + s) * 2 + 1) * 1024 + lo), acc[1]); } }
    const bf16_t* GS = (const bf16_t*)(ws + WS_GS); bf16_t* A = (bf16_t*)(ws + WS_A);
#pragma unroll
    for (int e = 0; e < 2; ++e) { unsigned short gv[16]; const float bfv = a.in[I_BF][l * 256 + 64 * chq + 32 * e + r32];
#pragma unroll
        for (int r = 0; r < 16; ++r) { const size_t row = MLAT + b * NCTX + 32 * mb + crow(r, hi); gv[r] = GS[row * 768 + 512 + 64 * chq + 32 * e + r32]; }
        __builtin_amdgcn_sched_barrier(0);
#pragma unroll
        for (int r = 0; r < 16; ++r) { const size_t row = MLAT + b * NCTX + 32 * mb + crow(r, hi);
            A[row * DM + 512 + 64 * chq + 32 * e + r32] = (bf16_t)f2bf((acc[e][r] * (1.0f / 128.0f) + bfv) * bf2f(gv[r])); }
        __builtin_amdgcn_sched_barrier(0); }
    __syncthreads();
}

__device__ __forceinline__ void f2_unit(const Args& a, int l, LAS unsigned char* lds, int unit, int tid, int lane, int wave) {
    unsigned char* ws = a.ws;
    const int b = unit >> 7, k1 = unit & 127;
    const bf16_t* Z2 = (const bf16_t*)(ws + WS_Z2);
    stage_pieces<128, 256>(lds, [&](int k) { return Z2 + (size_t)(b * SEQ + 64 * k1 + (k & 63)) * 512 + (k >> 6) * 256; }, tid);
    bf16x8 ta0[8], ta1[8];
    { const bf16_t* img_ = (const bf16_t*)(ws + WS_T64);
#pragma unroll
      for (int s = 0; s < 8; ++s) { ta0[s] = afrag_img(img_, 8, 0, s, lane); ta1[s] = afrag_img(img_, 8, 1, s, lane); } }
    __syncthreads();
    const int cb = wave, hi = lane >> 5, r32 = lane & 31, lo = tr_lane_off(lane);
    f32x16 acc[2]; acc[0] = f32x16{}; acc[1] = f32x16{};
#pragma unroll
    for (int s = 0; s < 8; ++s) { const bf16x8 bf = bfrag(lds + (s * 8 + cb) * 1024 + lo);
        acc[0] = MFMA32(ta0[s], bf, acc[0]); acc[1] = MFMA32(ta1[s], bf, acc[1]); }
    const bf16_t* GS = (const bf16_t*)(ws + WS_GS); bf16_t* A = (bf16_t*)(ws + WS_A);
    const float nrm = 0.0013810679320049757f;
    const float bfv = a.in[I_BF][l * 256 + 32 * cb + r32];
#pragma unroll
    for (int mb = 0; mb < 2; ++mb) {
        unsigned short gv[16];
#pragma unroll
        for (int r = 0; r < 16; ++r) { const size_t row = (size_t)b * SEQ + k1 + 128 * (32 * mb + crow(r, hi)); gv[r] = GS[row * 768 + 512 + 32 * cb + r32]; }
        __builtin_amdgcn_sched_barrier(0);
#pragma unroll
        for (int r = 0; r < 16; ++r) { const size_t row = (size_t)b * SEQ + k1 + 128 * (32 * mb + crow(r, hi));
            A[row * DM + 512 + 32 * cb + r32] = (bf16_t)f2bf((acc[mb][r] * nrm + bfv) * bf2f(gv[r])); }
        __builtin_amdgcn_sched_barrier(0);
    }
    __syncthreads();
}

#ifndef DMA_TWICE
#define DMA_TWICE 0
#endif
#ifndef EXTRA_EXP
#define EXTRA_EXP 0
#endif
#ifndef EXTRA_MFMA
#define EXTRA_MFMA 0
#endif
__device__ __forceinline__ void glds16(const void* gsrc, unsigned lds_dst) { unsigned keep;
    asm volatile("s_mov_b32 %0, m0\n\ts_mov_b32 m0, %2\n\ts_nop 0\n\tglobal_load_lds_dwordx4 %1, off\n\ts_mov_b32 m0, %0" : "=&s"(keep) : "v"(gsrc), "s"(lds_dst) : "memory"); }
__device__ __forceinline__ void glds16x2(const void* gsrc, unsigned lds_dst) { unsigned keep;
    asm volatile("s_mov_b32 %0, m0\n\ts_mov_b32 m0, %2\n\ts_nop 0\n\tglobal_load_lds_dwordx4 %1, off\n\tglobal_load_lds_dwordx4 %1, off offset:1024\n\ts_mov_b32 m0, %0" : "=&s"(keep) : "v"(gsrc), "s"(lds_dst) : "memory"); }
__device__ __forceinline__ void attn_unit(const Args& a, int l, LAS unsigned char* lds, int b, int h, int qrow0, int t0, int nt, int tid, int lane, int wave, bool dry) {
    unsigned char* ws = a.ws;
    const int comp = wave >> 2, qg = wave & 3, hi = lane >> 5, r32 = lane & 31;
    const bf16_t* Qg = (const bf16_t*)(ws + WS_QG);
    const unsigned char* kimg = ws + WS_KIMG + (size_t)(b * 4 + h) * NKT * 16384;
    const unsigned char* vimg = ws + WS_VIMG + (size_t)(b * 4 + h) * NKT * 16384;
    bf16x8 qr[4];
    { const bf16_t* qp = Qg + ((size_t)(qrow0 + 32 * qg + r32) * 4 + h) * 128 + comp * 64 + 8 * hi;
#pragma unroll
      for (int d0 = 0; d0 < 4; ++d0) qr[d0] = *(const bf16x8*)(qp + 16 * d0); }
    asm volatile("" : "+v"(qr[0]), "+v"(qr[1]), "+v"(qr[2]), "+v"(qr[3]));
    f32x16 o[4];
#pragma unroll
    for (int d = 0; d < 4; ++d) o[d] = f32x16{};
    float lsum = 0.f;
    const int lo = tr_lane_off(lane);
    const unsigned lds0 = (unsigned)(uintptr_t)lds;
    constexpr int KSL = 16384, VBASE = 3 * KSL;
#define ATT_DMA_K(t, slotb) do { const unsigned char* s_ = kimg + (size_t)(t) * 16384 + wave * 2048 + lane * 16; const unsigned d_ = (unsigned)__builtin_amdgcn_readfirstlane((int)(lds0 + (slotb) + wave * 2048)); \
        glds16x2(s_, d_); if (DMA_TWICE) glds16x2(s_, d_); } while (0)
#define ATT_DMA_V(t, slotb) do { const unsigned char* s_ = vimg + (size_t)(t) * 16384 + wave * 2048 + lane * 16; const unsigned d_ = (unsigned)__builtin_amdgcn_readfirstlane((int)(lds0 + VBASE + (slotb) + wave * 2048)); \
        glds16x2(s_, d_); if (DMA_TWICE) glds16x2(s_, d_); } while (0)
#define ATT_WAIT_BAR(N) asm volatile("s_waitcnt vmcnt(" #N ") lgkmcnt(0)\n\ts_barrier" ::: "memory")
#define SBAR() __builtin_amdgcn_sched_barrier(0)
#define PIN(x) asm volatile("" : "+v"(x))
    LAS const unsigned char* kp0 = lds + comp * 8192 + hi * 1024 + r32 * 16;
    LAS const unsigned char* vp0 = lds + VBASE + lo;
    bf16x8 kf[8];
#define KRD(j, slotb) do { kf[j] = *(const LAS bf16x8*)(kp0 + (slotb) + ((j) >> 1) * 2048 + ((j) & 1) * 512); } while (0)
    f32x16 pA0 = f32x16{}, pA1 = f32x16{}, pB0, pB1;
    u32x4 pw0, pw1, pw2, pw3;
    bf16x8 vA[8], vB[8];
    int sl_prev = 0, sl_cur = 0, sl_next = KSL;
#define ROT() do { sl_prev = sl_cur; sl_cur = sl_next; sl_next = (sl_next == 2 * KSL) ? 0 : sl_next + KSL; } while (0)
    ATT_DMA_K(t0, 0); ATT_DMA_V(t0, 0); ATT_DMA_K(t0 + 1, KSL); ATT_DMA_K(t0 + 2, 2 * KSL);
    ATT_WAIT_BAR(0);
#pragma unroll
    for (int j = 0; j < 8; ++j) KRD(j, 0);
    ATT_WAIT_BAR(0);
#define PKW(P, B) cvt_pk_bf16(P[B], P[B + 1])
#define EX(v) __builtin_amdgcn_exp2f(v)
#define GAPA(i, C, CIN, a0, a1, a2, a3, W0, W1, PWV) do { vA[i] = bfrag(vpp_ + (i) * 1024); SBAR(); \
        C = MFMA32(kf[i], qr[(i) >> 1], CIN); if (EXTRA_MFMA) dacc = MFMA32(kf[i], qr[(i) >> 1], dacc); sacc += a0; sacc += a1; sacc += a2; sacc += a3; PIN(sacc); W0; W1; PIN(PWV); SBAR(); } while (0)
#define GAPB_V(j, d, PWV, X, B) do { o[d] = MFMA32(__builtin_bit_cast(bf16x8, PWV), vA[j], o[d]); X[B] = EX(X[B]); X[B + 1] = EX(X[B + 1]); PIN(X); if (EXTRA_EXP) { dmy = EX(dmy); PIN(dmy); } vB[j] = bfrag(vpp_ + (8 + (j)) * 1024); SBAR(); } while (0)
#define GAPB_K(j, d, PWV, X, B) do { o[d] = MFMA32(__builtin_bit_cast(bf16x8, PWV), vB[(j) - 8], o[d]); X[B] = EX(X[B]); X[B + 1] = EX(X[B + 1]); PIN(X); if (EXTRA_EXP) { dmy = EX(dmy); PIN(dmy); } KRD((j) - 8, sl_next); SBAR(); } while (0)
    const f32x16 zero16 = f32x16{}; float dmy = 0.5f; (void)dmy; f32x16 dacc = f32x16{}; (void)dacc;
#define STEP(C0, C1, P0, P1, t) do { SBAR(); \
        LAS const unsigned char* vpp_ = vp0 + sl_prev; float sacc = 0.f; \
        GAPA(0, C0, zero16, P0[0], P0[1], P0[2], P0[3],     pw0[0] = PKW(P0, 0),  pw0[1] = PKW(P0, 2),  pw0); \
        GAPA(1, C1, zero16, P0[4], P0[5], P0[6], P0[7],     pw0[2] = PKW(P0, 4),  pw0[3] = PKW(P0, 6),  pw0); \
        GAPA(2, C0, C0,     P0[8], P0[9], P0[10], P0[11],   pw1[0] = PKW(P0, 8),  pw1[1] = PKW(P0, 10), pw1); \
        GAPA(3, C1, C1,     P0[12], P0[13], P0[14], P0[15], pw1[2] = PKW(P0, 12), pw1[3] = PKW(P0, 14), pw1); \
        GAPA(4, C0, C0,     P1[0], P1[1], P1[2], P1[3],     pw2[0] = PKW(P1, 0),  pw2[1] = PKW(P1, 2),  pw2); \
        GAPA(5, C1, C1,     P1[4], P1[5], P1[6], P1[7],     pw2[2] = PKW(P1, 4),  pw2[3] = PKW(P1, 6),  pw2); \
        GAPA(6, C0, C0,     P1[8], P1[9], P1[10], P1[11],   pw3[0] = PKW(P1, 8),  pw3[1] = PKW(P1, 10), pw3); \
        GAPA(7, C1, C1,     P1[12], P1[13], P1[14], P1[15], pw3[2] = PKW(P1, 12), pw3[3] = PKW(P1, 14), pw3); \
        lsum += sacc; \
        if ((t) + 3 < nt) ATT_DMA_K(t0 + (t) + 3, sl_cur); \
        if ((t) + 1 < nt) ATT_DMA_V(t0 + (t) + 1, sl_next); \
        SBAR(); \
        GAPB_V(0, 0, pw0, C0, 0);  GAPB_V(1, 0, pw1, C0, 2);  GAPB_V(2, 0, pw2, C0, 4);  GAPB_V(3, 0, pw3, C0, 6); \
        GAPB_V(4, 1, pw0, C0, 8);  GAPB_V(5, 1, pw1, C0, 10); GAPB_V(6, 1, pw2, C0, 12); GAPB_V(7, 1, pw3, C0, 14); \
        GAPB_K(8, 2, pw0, C1, 0);  GAPB_K(9, 2, pw1, C1, 2);  GAPB_K(10, 2, pw2, C1, 4); GAPB_K(11, 2, pw3, C1, 6); \
        GAPB_K(12, 3, pw0, C1, 8); GAPB_K(13, 3, pw1, C1, 10); GAPB_K(14, 3, pw2, C1, 12); GAPB_K(15, 3, pw3, C1, 14); \
        if ((t) + 3 < nt) { if (DMA_TWICE) ATT_WAIT_BAR(8); else ATT_WAIT_BAR(4); } else ATT_WAIT_BAR(0); \
        ROT(); } while (0)
#pragma unroll 1
    for (int t = 0; t < nt; t += 2) {
        STEP(pB0, pB1, pA0, pA1, t);
        STEP(pA0, pA1, pB0, pB1, t + 1);
    }
    {
        float sacc = 0.f;
#pragma unroll
        for (int r = 0; r < 16; ++r) sacc += pA0[r] + pA1[r];
        lsum += sacc;
        pw0 = (u32x4){PKW(pA0, 0), PKW(pA0, 2), PKW(pA0, 4), PKW(pA0, 6)}; pw1 = (u32x4){PKW(pA0, 8), PKW(pA0, 10), PKW(pA0, 12), PKW(pA0, 14)};
        pw2 = (u32x4){PKW(pA1, 0), PKW(pA1, 2), PKW(pA1, 4), PKW(pA1, 6)}; pw3 = (u32x4){PKW(pA1, 8), PKW(pA1, 10), PKW(pA1, 12), PKW(pA1, 14)};
        LAS const unsigned char* vpp_ = vp0 + sl_prev;
#pragma unroll
        for (int d = 0; d < 4; ++d) {
            const bf16x8 f0 = bfrag(vpp_ + (d * 4 + 0) * 1024), f1 = bfrag(vpp_ + (d * 4 + 1) * 1024), f2 = bfrag(vpp_ + (d * 4 + 2) * 1024), f3 = bfrag(vpp_ + (d * 4 + 3) * 1024);
            o[d] = MFMA32(__builtin_bit_cast(bf16x8, pw0), f0, o[d]); o[d] = MFMA32(__builtin_bit_cast(bf16x8, pw1), f1, o[d]);
            o[d] = MFMA32(__builtin_bit_cast(bf16x8, pw2), f2, o[d]); o[d] = MFMA32(__builtin_bit_cast(bf16x8, pw3), f3, o[d]);
        }
    }
    ATT_WAIT_BAR(0);
#undef ATT_DMA_K
#undef ATT_DMA_V
#undef ATT_WAIT_BAR
#undef SBAR
#undef PIN
#undef KRD
#undef ROT
#undef PKW
#undef EX
#undef GAPA
#undef GAPB_V
#undef GAPB_K
#undef STEP
    if (EXTRA_MFMA) asm volatile("" :: "v"(dacc));
    if (dry) return;
    LAS float* ost = (LAS float*)lds;
    LAS float* lw = (LAS float*)(lds + 72 * 1024);
    lsum += __shfl_xor(lsum, 32);
    if (hi == 0) lw[wave * 32 + r32] = lsum;
    LDS_WAIT(); asm volatile("" ::: "memory");
    const float* lamp = (const float*)(ws + WS_LAM) + 2 * l;
    const float lam = lamp[0], oscale = lamp[1];
    float rl[16];
#pragma unroll
    for (int r = 0; r < 16; ++r) rl[r] = __builtin_amdgcn_rcpf(lw[wave * 32 + crow(r, hi)]);
    if (comp == 0) {
#pragma unroll
        for (int d = 0; d < 4; ++d)
#pragma unroll
            for (int r = 0; r < 16; ++r) ost[(32 * qg + crow(r, hi)) * 132 + 32 * d + r32] = o[d][r] * rl[r];
    }
    __syncthreads();
    if (comp == 1) {
#pragma unroll
        for (int d = 0; d < 4; ++d)
#pragma unroll
            for (int r = 0; r < 16; ++r) ost[(32 * qg + crow(r, hi)) * 132 + 32 * d + r32] -= lam * o[d][r] * rl[r];
    }
    __syncthreads();
    {
        const int row = tid >> 2, qt = tid & 3; const LAS float* src = ost + row * 132 + 32 * qt;
        float v[32]; float ss = 0.f;
#pragma unroll
        for (int i = 0; i < 32; ++i) { v[i] = src[i]; ss += v[i] * v[i]; }
        ss += __shfl_xor(ss, 1); ss += __shfl_xor(ss, 2);
        const float rstd = rsqrtf(ss * (1.0f / 128.0f) + EPS) * oscale;
        const size_t grow = (size_t)qrow0 + row;
        const bf16_t* gs = (const bf16_t*)(ws + WS_GS) + grow * 768 + h * 128 + 32 * qt;
        bf16_t* dst = (bf16_t*)(ws + WS_A) + grow * DM + h * 128 + 32 * qt;
        const float* gsub = a.in[I_GSUB] + l * 128 + 32 * qt;
#pragma unroll
        for (int i = 0; i < 4; ++i) { const u32x4 gw = *(const u32x4*)(gs + 8 * i); u32x4 w;
#pragma unroll
            for (int e = 0; e < 4; ++e) { const int j = 8 * i + 2 * e; w[e] = pk2(v[j] * rstd * gsub[j] * bflo(gw[e]), v[j + 1] * rstd * gsub[j + 1] * bfhi(gw[e])); }
            *(u32x4*)(dst + 8 * i) = w; }
    }
    __syncthreads();
}

#ifndef REPEAT_PHASE
#define REPEAT_PHASE (-1)
#endif
constexpr int N_PHASES = 10 + (REPEAT_PHASE >= 0 ? 1 : 0);
__global__ void __launch_bounds__(NTHREADS, 2) fwd_kernel(Args args) {
    extern __shared__ __attribute__((aligned(16))) unsigned char lds_raw[];
    LAS unsigned char* lds = (LAS unsigned char*)lds_raw;
    const int tid = threadIdx.x, lane = tid & 63, wave = __builtin_amdgcn_readfirstlane(tid >> 6);
    const int bx = blockIdx.x, vcu = (bx % 8) * (GRID / 8) + bx / 8;
    unsigned char* ws = args.ws;
    volatile LAS unsigned* MISC = (volatile LAS unsigned*)(lds + MISC_OFF);
    for (int u = tid; u < 32; u += NTHREADS) MISC[u] = 0u;
    __syncthreads();
    XcdBarrier bar; bar.bar = (unsigned*)(ws + WS_CTL) + CW_BAR; bar.x = 0; bar.st = nullptr;
    const bool one_launch = (args.ph_hi - args.ph_lo) > 1;
    if (one_launch) { bar = xcd_barrier_post((unsigned*)(ws + WS_CTL) + CW_BAR, MISC + 8);
        if (tid == 0) { unsigned nloc, nx; xcd_barrier_complete(bar.bar, bar.x, nloc, nx); MISC[8] = nloc; MISC[9] = nx; }
        __syncthreads(); }
#ifndef REPEAT_PHASE
#define REPEAT_PHASE (-1)
#endif
#ifndef PRO_PROBE
#define PRO_PROBE 15
#endif
#ifndef PHMASK
#define PHMASK 0xffff
#endif
#define EN(b) (((PHMASK) >> (b)) & 1)
#define LAUNDER() int wave_ = wave, vcu_ = vcu; asm volatile("" : "+s"(wave_)); asm volatile("" : "+s"(vcu_)); int lane_ = (int)__builtin_amdgcn_mbcnt_hi(~0u, __builtin_amdgcn_mbcnt_lo(~0u, 0u)); asm volatile("" : "+v"(lane_)); const int tid_ = wave_ * 64 + lane_; (void)lane_; (void)wave_
#pragma unroll 1
    for (int pc = args.ph_lo; pc < args.ph_hi; ++pc) {
        const int ph = (REPEAT_PHASE >= 0 && pc > REPEAT_PHASE) ? pc - 1 : pc;
        const int l = ph >= 5 ? 1 : 0;
        const bool second = (REPEAT_PHASE >= 0 && pc == REPEAT_PHASE + 1); (void)second;
        const int kind = ph == 0 ? 6 : (ph == 5 ? 7 : (ph < 5 ? ph - 1 : ph - 6));
        const bf16_t* Wl = (const bf16_t*)(ws + WS_WIN) + (size_t)l * NPHYS * DM;
        LAUNDER();
        if (kind == 6) { if (EN(0)) {
            unsigned* sp0 = (unsigned*)(ws + WS_CTL) + 8192 + 4096;
            ph0_mods(args, lane_, wave_, vcu_);
            split_arrive(sp0, bar, one_launch);
            ph0_prologue(args, lds, tid_, lane_, wave_, vcu_, second ? PRO_PROBE : 7);
            split_wait(sp0, bar, one_launch, (unsigned*)(ws + WS_CTL) + CW_BAR + XB_TMO); } }
        if (kind == 6 || kind == 7) { if (EN(1)) { int wave2 = wave, vcu2 = vcu; asm volatile("" : "+s"(wave2)); asm volatile("" : "+s"(vcu2)); int lane2 = (int)__builtin_amdgcn_mbcnt_hi(~0u, __builtin_amdgcn_mbcnt_lo(~0u, 0u)); asm volatile("" : "+v"(lane2)); const int tid2 = wave2 * 64 + lane2;
            prepass(args, kind == 6 ? 0 : 1, lds, tid2, lane2, wave2, vcu2); } }
        else if (kind == 0) { if (EN(2)) {
            pg8::Gemm g{(const bf16_t*)(ws + WS_H), Wl, DM, DM, 0, 0, 0, 16, 16, 16, nullptr, nullptr, 0};
            TileSched S{vcu_ >> 5, vcu_ & 31, 0, 14, 1, l == 0 ? 52 : 8, l == 0 ? 0 : 2, l == 0 ? 26 : 4};
            EpiIn E{ws, args.in[I_GQ] + l * 64, args.in[I_GK] + l * 64, (LAS const float*)(lds + ROPE_LDS), (LAS const float*)(lds + ROPE_LDS) + 2048};
            { const float* rt = (const float*)(ws + WS_ROPE); LAS float* rl_ = (LAS float*)(lds + ROPE_LDS);
#pragma unroll
              for (int i = 0; i < 8; ++i) rl_[tid_ + i * NTHREADS] = rt[tid_ + i * NTHREADS];
              __syncthreads(); }
            pg8::gemm_phase<EpiIn, TileSched, true, true>(lds, g, S, E, tid_); } }
        else if (kind == 1) { if (EN(4)) {
            if (!second) {
                if (EN(8)) f1_unit(ws, lds, vcu_, tid_, lane_, wave_);
                const int nsgu = l == 0 ? 132 : 128;
                if (EN(9)) for (int cu = 255 - vcu_; cu < nsgu; cu += GRID) sgu_unit(args, l, lds, cu, tid_, lane_, wave_);
                if (EN(10) && l == 0 && vcu_ < 8) ctxf_unit(args, l, lds, vcu_, tid_, lane_, wave_);
            }
            const int bh = vcu_ >> 5, qb = vcu_ & 31;
            if (EN(12)) {
                const int nun = (l == 0 && qb < 2) ? 3 : 2;
#pragma unroll 1
                for (int ui = 0; ui < nun; ++ui) {
                    const int qrow0 = ui < 2 ? (bh >> 2) * SEQ + 256 * qb + 128 * ui : MLAT + (bh >> 2) * NCTX + 128 * qb;
                    attn_unit(args, l, lds, bh >> 2, bh & 3, qrow0, ui < 2 ? 0 : SEQ / 64, ui < 2 ? NKT : NCTX / 64, tid_, lane_, wave_, second);
                }
            } } }
        else if (kind == 2) { if (EN(5)) {
            unsigned* sp = (unsigned*)(ws + WS_CTL) + 8192 + l * 2048;
            if (EN(11)) f2_unit(args, l, lds, vcu_, tid_, lane_, wave_);
            split_arrive(sp, bar, one_launch);
            if (l == 0) ctx_branch_proj(ws, (const bf16_t*)(ws + WS_WBR), vcu_ * NWAVES + wave_, lane_);
            pg8::Gemm g{(const bf16_t*)(ws + WS_A), (const bf16_t*)(ws + WS_WBR) + (size_t)l * DM * DM, DM, DM, 0, 512, 768, 8, 4, 4, (const bf16_t*)(ws + WS_H), Wl, 16};
            FusedSched S{vcu_ >> 5, vcu_ & 31, sp, bar, one_launch, (unsigned*)(ws + WS_CTL) + CW_BAR + XB_TMO};
            EpiMY E{EpiIn{ws, nullptr, nullptr, nullptr, nullptr}, EpiY{(const unsigned char*)(ws + WS_MS), (bf16_t*)(ws + WS_Y)}};
            pg8::gemm_phase<EpiMY, FusedSched, true, true>(lds, g, S, E, tid_); } }
        else { if (EN(7)) {
            pg8::Gemm g{(const bf16_t*)(ws + WS_Y), (const bf16_t*)(ws + WS_WOUT) + (size_t)l * DM * DM, DM, DM, 0, 0, 0, 16, 16, 16, nullptr, nullptr, 0};
            TileSched S{vcu_ >> 5, vcu_ & 31, 0, 4, 1, 0, 0, 4};
            if (l == 0) ctx_out_proj(ws, (const bf16_t*)(ws + WS_WOUT), args.in[I_CTX], (const float*)(ws + WS_MODF) + 2 * 3072 + 2048, vcu_ * NWAVES + wave_, lane_);
            EpiOut E{args.in[I_X], args.out, ws, (const float*)(ws + WS_MODF) + (size_t)(l * 3) * 3072 + 2048, l};
            pg8::gemm_phase<EpiOut, TileSched, true, true>(lds, g, S, E, tid_); } }
        if (pc + 1 < args.ph_hi) { XcdBarrier b2_ = bar; asm volatile("" : "+s"(b2_.bar)); xcd_barrier(b2_); }
    }
}

extern "C" void kernel_launch(void* const* d_in, const int* in_sizes, int n_in, void* d_out, int out_size, void* d_ws, size_t ws_size, hipStream_t stream) {
    static int ready = 0;
    if (ready == 0) {
        if (n_in != 25 || out_size != MLAT * DM || ws_size < 256 * MiB) { fprintf(stderr, "kernel_launch: unexpected shapes (n_in %d out %d ws %zu)\n", n_in, out_size, ws_size); ready = -1; return; }
        int dev = 0, cus = 0, per_cu = 0;
        hipGetDevice(&dev); hipDeviceGetAttribute(&cus, hipDeviceAttributeMultiprocessorCount, dev);
        if (hipFuncSetAttribute((const void*)fwd_kernel, hipFuncAttributeMaxDynamicSharedMemorySize, LDS_BYTES) != hipSuccess) { fprintf(stderr, "kernel_launch: hipFuncSetAttribute failed\n"); ready = -1; return; }
        hipOccupancyMaxActiveBlocksPerMultiprocessor(&per_cu, (const void*)fwd_kernel, NTHREADS, LDS_BYTES);
        (void)hipGetLastError();
        if (cus != GRID || per_cu < 1) fprintf(stderr, "kernel_launch: note: %d CUs, occupancy %d blocks/CU (built for 256 CUs, 1 block/CU)\n", cus, per_cu);
        ready = (cus >= GRID) ? 1 : -1;
    }
    if (ready < 0) return;
    hipMemsetAsync((char*)d_ws + WS_CTL, 0, CTL_ZERO_BYTES, stream);
    Args a{};
    for (int i = 0; i < 25; ++i) a.in[i] = (const float*)d_in[i];
    a.out = (float*)d_out; a.ws = (unsigned char*)d_ws;
#if MK_N_LAUNCHES == 1
    a.ph_lo = 0; a.ph_hi = N_PHASES;
    hipLaunchKernelGGL(fwd_kernel, dim3(GRID), dim3(NTHREADS), LDS_BYTES, stream, a);
#else
    for (int p = 0; p < N_PHASES; ++p) { a.ph_lo = p; a.ph_hi = p + 1; hipLaunchKernelGGL(fwd_kernel, dim3(GRID), dim3(NTHREADS), LDS_BYTES, stream, a); }
#endif
}
```

```cpp
#include <hip/hip_runtime.h>
#include <cstdio>
#include <cstdint>

#ifndef MK_N_LAUNCHES
#define MK_N_LAUNCHES 1
#endif

#define LAS __attribute__((address_space(3)))
#define GAS __attribute__((address_space(1)))
typedef unsigned short bf16_t;
typedef short bf16x8 __attribute__((ext_vector_type(8)));
typedef short s16x4 __attribute__((ext_vector_type(4)));
typedef float f32x4 __attribute__((ext_vector_type(4)));
typedef float f32x2 __attribute__((ext_vector_type(2)));
typedef float f32x16 __attribute__((ext_vector_type(16)));
typedef unsigned u32x4 __attribute__((ext_vector_type(4)));
typedef unsigned u32x2 __attribute__((ext_vector_type(2)));

constexpr int DM = 1024, BATCH = 2, SEQ = 8192, NCTX = 256, DEPTH = 2;
constexpr int MLAT = BATCH * SEQ, MCTX = BATCH * NCTX, MT = MLAT + MCTX;
constexpr int NKEY = SEQ + NCTX, NKT = NKEY / 64;
constexpr int INW = 6400;
constexpr int OFF_Q = 0, OFF_K = 512, OFF_V = 1024, OFF_F = 1536, OFF_U = 1792, OFF_VC = 2048, OFF_GATE = 2304, OFF_MERGE = 3328;
constexpr int NPHYS = 6656;
constexpr float EPS = 1e-6f;
constexpr float QSCALE = 0.125f * 1.4426950408889634f;

constexpr size_t KiB = 1024, MiB = 1u << 20;
constexpr size_t WS_CTL = 0, CTL_ZERO_BYTES = 64 * KiB;
constexpr size_t WS_MODP = 1 * MiB;
constexpr size_t WS_MODF = WS_MODP + 2304 * KiB;
constexpr size_t WS_ROPE = WS_MODF + 72 * KiB;
constexpr size_t WS_TW = WS_ROPE + 16 * KiB;
constexpr size_t WS_LAM = WS_TW + 64 * KiB;
constexpr size_t WS_C128 = WS_LAM + 1 * KiB;
constexpr size_t WS_S128 = WS_C128 + 32 * KiB;
constexpr size_t WS_T64 = WS_S128 + 32 * KiB;
constexpr size_t WS_TC256 = WS_T64 + 16 * KiB;
constexpr size_t WS_WSIMG = WS_TC256 + 256 * KiB;
constexpr size_t WS_SMALL_END = WS_WSIMG + 256 * KiB;
static_assert(WS_SMALL_END <= 5 * MiB, "small tables");
constexpr size_t WS_WIN = 5 * MiB;
constexpr size_t WS_WBR = 31 * MiB;
constexpr size_t WS_WOUT = 35 * MiB;
constexpr size_t WS_CTX1 = 39 * MiB;
constexpr size_t WS_H = 41 * MiB;
constexpr size_t WS_A = 74 * MiB;
constexpr size_t WS_R = 107 * MiB;
constexpr size_t SZ_QG = (size_t)MT * 512 * 2, SZ_KIMG = (size_t)BATCH * 4 * NKT * 16384, SZ_Z2 = (size_t)MT * 512 * 2, SZ_UG = (size_t)MT * 256 * 2, SZ_GS = (size_t)MT * 768 * 2;
constexpr size_t WS_QG = WS_R, WS_KIMG = WS_QG + SZ_QG, WS_VIMG = WS_KIMG + SZ_KIMG, WS_Z2 = WS_VIMG + SZ_KIMG, WS_UG = WS_Z2 + SZ_Z2, WS_VC = WS_UG + SZ_UG, WS_GS = WS_VC + SZ_UG;
constexpr size_t WS_Y = WS_Z2;
static_assert(WS_Z2 + (size_t)MT * DM * 2 == WS_GS, "Y overlays Z2 | UG | VC exactly");
constexpr size_t WS_MS = WS_R;
constexpr size_t WS_END = WS_GS + SZ_GS;
constexpr size_t WS_X1B0 = 229 * MiB, WS_X1B1 = 215 * MiB;
constexpr int X1B_SPLIT = 13824;
constexpr size_t WS_MSC = 224 * MiB;
static_assert(WS_X1B1 >= WS_END && WS_X1B1 + (size_t)(MLAT - X1B_SPLIT) * 2048 <= WS_MSC && WS_MSC + (size_t)MCTX * 3072 <= WS_X1B0 && WS_X1B0 + (size_t)X1B_SPLIT * 2048 <= 256 * MiB, "x1b map");
static_assert(WS_MS + (size_t)MT * 3072 <= WS_Z2 && WS_END <= WS_MSC && WS_MSC + (size_t)MCTX * 3072 * 2 <= 256 * MiB, "d_ws map");

__host__ __device__ __forceinline__ size_t x1b_off(int row) { return row < X1B_SPLIT ? WS_X1B0 + (size_t)row * 2048 : WS_X1B1 + (size_t)(row - X1B_SPLIT) * 2048; }
__device__ __forceinline__ unsigned f2bf(float f) { unsigned u = __builtin_bit_cast(unsigned, f); return (u + 0x7fffu + ((u >> 16) & 1u)) >> 16; }
__device__ __forceinline__ unsigned pk2(float lo, float hi) { return f2bf(lo) | (f2bf(hi) << 16); }
__device__ __forceinline__ unsigned cvt_pk_bf16(float lo, float hi) { unsigned r; asm volatile("v_cvt_pk_bf16_f32 %0, %1, %2" : "=v"(r) : "v"(lo), "v"(hi)); return r; }
__device__ __forceinline__ float bf2f(unsigned short v) { return __builtin_bit_cast(float, (unsigned)v << 16); }
__device__ __forceinline__ float bflo(unsigned w) { return __builtin_bit_cast(float, w << 16); }
__device__ __forceinline__ float bfhi(unsigned w) { return __builtin_bit_cast(float, w & 0xffff0000u); }
__device__ __forceinline__ float fast_sigmoid(float x) { return __builtin_amdgcn_rcpf(1.0f + __builtin_amdgcn_exp2f(-1.4426950408889634f * x)); }
__device__ __forceinline__ unsigned ms_quant_pk(float x, unsigned sel, unsigned old) { const float q = __builtin_amdgcn_rcpf((1.0f / 255.0f) + __builtin_amdgcn_exp2f(__builtin_fmaf(x, -1.4426950408889634f, -7.994353436858858f)));
    return __builtin_amdgcn_cvt_pk_u8_f32(__builtin_fmaxf(q, 1.0f), sel, old); }
__device__ __forceinline__ float ub(unsigned w, int i) { return (float)((w >> (8 * i)) & 0xffu); }
__device__ __forceinline__ float fast_silu(float x) { return x * fast_sigmoid(x); }
__device__ __forceinline__ int crow(int r, int hi) { return (r & 3) + 8 * (r >> 2) + 4 * hi; }
__host__ __device__ __forceinline__ int perm32(int rho) { const int n = rho >> 4, i = rho & 15; return 8 * (i >> 2) + 4 * n + (i & 3); }
__host__ __device__ __forceinline__ int invperm32(int c) { return 16 * ((c >> 2) & 1) + 4 * (c >> 3) + (c & 3); }
#define LDS_WAIT() asm volatile("s_waitcnt lgkmcnt(0)" ::: "memory")
#define VM_WAIT() asm volatile("s_waitcnt vmcnt(0)" ::: "memory")

namespace pg8 {
constexpr int BM = 256, BK = 64, HALF = 128, HTB = HALF * BK * 2  , STAGE_BYTES = 8 * HTB;
__host__ __device__ __forceinline__ int lds_byte(int r, int c) { const int st = (r >> 4) * 2 + (c >> 5), rr = r & 15, cc = c & 31, ob = rr * 64 + cc * 2; return st * 1024 + (ob ^ (((ob >> 9) & 1) << 5)); }
__host__ __device__ __forceinline__ void stage_rc(int b, int& R, int& C) { const int st = b / 1024, sb = b % 1024, swz = sb ^ (((sb >> 9) & 1) << 5); R = (st >> 1) * 16 + swz / 64; C = (st & 1) * 32 + (swz % 64) / 2; }

struct Unit { int pm, pn, seg, set; };
struct Gemm { const bf16_t* A; const bf16_t* Bt; int lda, ldb; int k0_0, k0_1, k0_2; int nt_0, nt_1, nt_2; const bf16_t* A1; const bf16_t* Bt1; int nt_set1; };

template <class Epi, class Sched, bool ALIGN_EPI = false, bool SP2 = false>
__device__ __forceinline__ void gemm_phase(LAS unsigned char* lds, const Gemm g, const Sched& S, const Epi& E, const int tid) {
    const int wid = __builtin_amdgcn_readfirstlane(tid >> 6), lane = tid & 63, wr = wid >> 2, wc = wid & 3, fr = lane & 15, fq = lane >> 4;
    unsigned voffA[2], voffB[2];
#pragma unroll
    for (int i = 0; i < 2; ++i) { int R, C; stage_rc(tid * 16 + i * 8192, R, C); voffA[i] = (unsigned)(R * g.lda + C) * 2u; voffB[i] = (unsigned)(R * g.ldb + C) * 2u; }
    const size_t kstep = (size_t)(BK * 2);
    const size_t hstepA = (size_t)HALF * g.lda * 2, hstepB = (size_t)HALF * g.ldb * 2;
    const size_t tstepA = 2 * hstepA, tstepB = 2 * hstepB;
    const unsigned ldsw = (unsigned)wid * 1024u;
    const int aoff = lds_byte(wr * 64 + fr, fq * 8), boff = lds_byte(wc * 32 + fr, fq * 8);
#define PG8_SA(b, h) (((b) * 2 + (h)) * HTB)
#define PG8_SB(b, h) ((4 + (b) * 2 + (h)) * HTB)
#define PG8_STAGE(bufoff, gbase, voff) do { _Pragma("unroll") for (int _i = 0; _i < 2; ++_i) \
        __builtin_amdgcn_global_load_lds((const unsigned*)((const char*)(gbase) + (voff)[_i]), (LAS unsigned*)(lds + (bufoff) + ldsw + _i * 8192), 16, 0, 0); } while (0)
#define PG8_LDA(dst, b, h) do { _Pragma("unroll") for (int m = 0; m < 4; ++m) _Pragma("unroll") for (int k = 0; k < 2; ++k) dst[m][k] = *(const LAS bf16x8*)(lds + PG8_SA(b, h) + aoff + m * 2048 + k * 1024); } while (0)
#define PG8_LDB(dst, b, h) do { _Pragma("unroll") for (int n = 0; n < 2; ++n) _Pragma("unroll") for (int k = 0; k < 2; ++k) dst[n][k] = *(const LAS bf16x8*)(lds + PG8_SB(b, h) + boff + n * 2048 + k * 1024); } while (0)
#define PG8_MMA(ai, bj, At, Bt) do { __builtin_amdgcn_s_setprio(1); _Pragma("unroll") for (int m = 0; m < 4; ++m) _Pragma("unroll") for (int n = 0; n < 2; ++n) _Pragma("unroll") for (int k = 0; k < 2; ++k) \
        acc[ai][bj][m][n] = __builtin_amdgcn_mfma_f32_16x16x32_bf16(Bt[n][k], At[m][k], acc[ai][bj][m][n], 0, 0, 0); __builtin_amdgcn_s_setprio(0); } while (0)
#define PG8_WAIT_V(n) asm volatile("s_waitcnt vmcnt(" #n ")" ::: "memory")
#define PG8_WAIT_L(n) asm volatile("s_waitcnt lgkmcnt(" #n ")" ::: "memory")
#define PG8_BAR __builtin_amdgcn_s_barrier()
#define PG8_SCHED __builtin_amdgcn_sched_barrier(0)
#define PG8_K0(u) ((u).set ? 0 : ((u).seg == 0 ? g.k0_0 : ((u).seg == 1 ? g.k0_1 : g.k0_2)))
#define PG8_NT(u) ((u).set ? g.nt_set1 : ((u).seg == 0 ? g.nt_0 : ((u).seg == 1 ? g.nt_1 : g.nt_2)))
#define PG8_UA(u) ((const char*)((u).set ? g.A1 : g.A) + (size_t)(u).pm * tstepA + (size_t)PG8_K0(u) * 2)
#define PG8_UB(u) ((const char*)((u).set ? g.Bt1 : g.Bt) + (size_t)(u).pn * tstepB + (size_t)PG8_K0(u) * 2)
    Unit cur, nxt; int ui = 0;
    if (!S.next(0, cur)) return;
    f32x4 acc[2][2][4][2];
#pragma unroll
    for (int a = 0; a < 2; ++a)
#pragma unroll
        for (int b = 0; b < 2; ++b)
#pragma unroll
            for (int m = 0; m < 4; ++m)
#pragma unroll
                for (int n = 0; n < 2; ++n) acc[a][b][m][n] = (f32x4){0.f, 0.f, 0.f, 0.f};
    bf16x8 At[4][2], B0[2][2], B1[2][2];
    const char* cA = PG8_UA(cur); const char* cB = PG8_UB(cur); int nt = PG8_NT(cur);
    if constexpr (SP2) {
        PG8_STAGE(PG8_SB(0, 0), cB, voffB); PG8_STAGE(PG8_SB(0, 1), cB + hstepB, voffB); PG8_STAGE(PG8_SA(0, 0), cA, voffA); PG8_STAGE(PG8_SA(0, 1), cA + hstepA, voffA);
        if (wr == 1) PG8_BAR;
        PG8_WAIT_V(2); PG8_BAR;
        PG8_STAGE(PG8_SB(1, 0), cB + kstep, voffB); PG8_STAGE(PG8_SA(1, 0), cA + kstep, voffA); PG8_STAGE(PG8_SB(1, 1), cB + hstepB + kstep, voffB);
        PG8_WAIT_V(6); PG8_BAR;
    } else {
        PG8_STAGE(PG8_SB(0, 0), cB, voffB); PG8_STAGE(PG8_SA(0, 0), cA, voffA); PG8_STAGE(PG8_SB(0, 1), cB + hstepB, voffB); PG8_STAGE(PG8_SA(0, 1), cA + hstepA, voffA);
        if (wr == 1) PG8_BAR;
        PG8_WAIT_V(4); PG8_BAR;
        PG8_STAGE(PG8_SB(1, 0), cB + kstep, voffB); PG8_STAGE(PG8_SA(1, 0), cA + kstep, voffA); PG8_STAGE(PG8_SB(1, 1), cB + hstepB + kstep, voffB);
        PG8_WAIT_V(6); PG8_BAR;
    }
    for (;;) {
        const bool has_next = S.next(ui + 1, nxt);
        const char* nA = has_next ? PG8_UA(nxt) : cA; const char* nB = has_next ? PG8_UB(nxt) : cB;
        for (int t = 0; t < nt; t += 2) {
            const bool last = (t == nt - 2);
            if (last && has_next) S.a_ready(nxt);
            const char* a1 = cA + (size_t)(t + 1) * kstep;
            const char* a2 = last ? nA : cA + (size_t)(t + 2) * kstep; const char* b2 = last ? nB : cB + (size_t)(t + 2) * kstep;
            const char* a3 = a2 + kstep; const char* b3 = b2 + kstep;
            if constexpr (SP2) {
            PG8_LDB(B0, 0, 0); PG8_LDB(B1, 0, 1); PG8_SCHED; PG8_LDA(At, 0, 0); PG8_STAGE(PG8_SA(1, 1), a1 + hstepA, voffA);
            PG8_WAIT_V(8); PG8_WAIT_L(0); PG8_BAR; PG8_MMA(0, 0, At, B0); PG8_MMA(0, 1, At, B1); PG8_BAR; PG8_SCHED;
            PG8_LDA(At, 0, 1); PG8_STAGE(PG8_SB(0, 0), b2, voffB); PG8_STAGE(PG8_SB(0, 1), b2 + hstepB, voffB); PG8_STAGE(PG8_SA(0, 0), a2, voffA);
            PG8_WAIT_V(8); PG8_WAIT_L(0); PG8_BAR; PG8_MMA(1, 0, At, B0); PG8_MMA(1, 1, At, B1); PG8_BAR; PG8_SCHED;
            PG8_LDB(B0, 1, 0); PG8_LDB(B1, 1, 1); PG8_SCHED; PG8_LDA(At, 1, 0); PG8_STAGE(PG8_SA(0, 1), a2 + hstepA, voffA);
            PG8_WAIT_V(8); PG8_WAIT_L(0); PG8_BAR; PG8_MMA(0, 0, At, B0); PG8_MMA(0, 1, At, B1); PG8_BAR; PG8_SCHED;
            PG8_LDA(At, 1, 1); PG8_STAGE(PG8_SB(1, 0), b3, voffB); PG8_STAGE(PG8_SB(1, 1), b3 + hstepB, voffB); PG8_STAGE(PG8_SA(1, 0), a3, voffA);
            PG8_WAIT_V(8); PG8_WAIT_L(0); PG8_BAR; PG8_MMA(1, 0, At, B0); PG8_MMA(1, 1, At, B1); PG8_BAR; PG8_SCHED;
            } else {
            PG8_LDB(B0, 0, 0); PG8_SCHED; PG8_LDA(At, 0, 0); PG8_STAGE(PG8_SA(1, 1), a1 + hstepA, voffA);
            PG8_WAIT_L(8); PG8_BAR; PG8_WAIT_L(0); PG8_MMA(0, 0, At, B0); PG8_BAR; PG8_SCHED;
            PG8_LDB(B1, 0, 1); PG8_STAGE(PG8_SB(0, 0), b2, voffB);
            PG8_BAR; PG8_WAIT_L(0); PG8_MMA(0, 1, At, B1); PG8_BAR;
            PG8_LDA(At, 0, 1); PG8_STAGE(PG8_SA(0, 0), a2, voffA);
            PG8_BAR; PG8_WAIT_L(0); PG8_MMA(1, 0, At, B0); PG8_BAR; PG8_SCHED;
            PG8_STAGE(PG8_SB(0, 1), b2 + hstepB, voffB);
            PG8_WAIT_V(6); PG8_BAR; PG8_MMA(1, 1, At, B1); PG8_BAR;
            PG8_LDB(B0, 1, 0); PG8_SCHED; PG8_LDA(At, 1, 0); PG8_STAGE(PG8_SA(0, 1), a2 + hstepA, voffA);
            PG8_WAIT_L(8); PG8_BAR; PG8_WAIT_L(0); PG8_MMA(0, 0, At, B0); PG8_BAR; PG8_SCHED;
            PG8_LDB(B1, 1, 1); PG8_STAGE(PG8_SB(1, 0), b3, voffB);
            PG8_BAR; PG8_WAIT_L(0); PG8_MMA(0, 1, At, B1); PG8_BAR;
            PG8_LDA(At, 1, 1); PG8_STAGE(PG8_SA(1, 0), a3, voffA);
            PG8_BAR; PG8_WAIT_L(0); PG8_MMA(1, 0, At, B0); PG8_BAR; PG8_SCHED;
            PG8_STAGE(PG8_SB(1, 1), b3 + hstepB, voffB);
            PG8_WAIT_V(6); PG8_BAR; PG8_MMA(1, 1, At, B1); PG8_BAR;
            }
        }
        if constexpr (ALIGN_EPI) { if (wr == 0) PG8_BAR; }
        const bool reset_acc = E(acc, cur, wr, wc, fr, fq);
        if (!has_next) break;
        if (reset_acc) {
#pragma unroll
        for (int a = 0; a < 2; ++a)
#pragma unroll
            for (int b = 0; b < 2; ++b)
#pragma unroll
                for (int m = 0; m < 4; ++m)
#pragma unroll
                    for (int n = 0; n < 2; ++n) acc[a][b][m][n] = (f32x4){0.f, 0.f, 0.f, 0.f};
        }
        cur = nxt; cA = nA; cB = nB; nt = PG8_NT(cur); ++ui;
        if constexpr (ALIGN_EPI) { if (wr == 1) PG8_BAR; }
    }
    PG8_WAIT_V(0);
    if constexpr (!ALIGN_EPI) { if (wr == 0) PG8_BAR; }
    PG8_BAR;
#undef PG8_SA
#undef PG8_SB
#undef PG8_STAGE
#undef PG8_LDA
#undef PG8_LDB
#undef PG8_MMA
#undef PG8_WAIT_V
#undef PG8_WAIT_L
#undef PG8_BAR
#undef PG8_SCHED
#undef PG8_K0
#undef PG8_NT
#undef PG8_UA
#undef PG8_UB
}
}

#define XB_TMO      128
#define XB_XCNT(j)  (256  + 64 * (j))
#define XB_XSUB(j)  (1280 + 64 * (j))
#define XB_XGEN(j)  (2304 + 64 * (j))
#define XB_TOP      3328
#define XB_TOPGEN   3392
#define XCD_BAR_WORDS 3456
#define XB_SPIN_CAP (1u << 18)
__device__ __forceinline__ unsigned xb_ld(unsigned* p)              { return __hip_atomic_load(p, __ATOMIC_RELAXED, __HIP_MEMORY_SCOPE_AGENT); }
__device__ __forceinline__ unsigned xb_add(unsigned* p, unsigned v) { return __hip_atomic_fetch_add(p, v, __ATOMIC_RELAXED, __HIP_MEMORY_SCOPE_AGENT); }
__device__ __forceinline__ unsigned xb_xcc_id() { return (unsigned)__builtin_amdgcn_s_getreg((3 << 11) | 20) & 0xFu; }
#define XB_SPIN(cond, bar) do { unsigned _sp = 0; while (cond) { __builtin_amdgcn_s_sleep(1); \
    if ((++_sp & 255u) == 0u) { if (xb_ld(&(bar)[XB_TMO])) break; if (_sp > XB_SPIN_CAP) { atomicAdd(&(bar)[XB_TMO], 1u); break; } } } } while (0)
struct XcdBarrier { unsigned* bar; unsigned x; volatile LAS unsigned* st; };
__device__ __forceinline__ XcdBarrier xcd_barrier_post(unsigned* bar, volatile LAS unsigned* st) {
    XcdBarrier b; b.bar = bar; b.x = xb_xcc_id(); b.st = st;
    if (threadIdx.x == 0) (void)xb_add(&bar[XB_XCNT(b.x)], 1u);
    return b;
}
__device__ __forceinline__ void xcd_barrier_complete(unsigned* bar, unsigned x, unsigned& nloc, unsigned& nx) {
    const unsigned G = gridDim.x * gridDim.y * gridDim.z;
    unsigned sum, cnt, mine, sp = 0u;
    for (;;) {
        sum = 0u; cnt = 0u; mine = 0u;
#pragma unroll
        for (unsigned j = 0; j < 16; ++j) { const unsigned c = xb_ld(&bar[XB_XCNT(j)]); sum += c; cnt += (c > 0u) ? 1u : 0u; mine = (j == x) ? c : mine; }
        if (sum == G) break;
        __builtin_amdgcn_s_sleep(1);
        if ((++sp & 255u) == 0u) { if (xb_ld(&bar[XB_TMO])) break; if (sp > XB_SPIN_CAP) { atomicAdd(&bar[XB_TMO], 1u); break; } }
    }
    nloc = mine > 0u ? mine : 1u; nx = cnt > 0u ? cnt : 1u;
}
__device__ __forceinline__ void xcd_barrier(const XcdBarrier& b) {
    asm volatile("s_waitcnt vmcnt(0)" ::: "memory");
    __syncthreads();
    if (threadIdx.x == 0) {
        unsigned* bar = b.bar;
        __builtin_amdgcn_s_waitcnt(0);
        const unsigned nloc = b.st[0], nx = b.st[1];
        const unsigned old = xb_add(&bar[XB_XSUB(b.x)], 1u);
        const unsigned gen = old / nloc;
        if (old + 1u == (gen + 1u) * nloc) {
            __builtin_amdgcn_fence(__ATOMIC_RELEASE, "agent");
            asm volatile("s_waitcnt vmcnt(0)" ::: "memory");
            const unsigned og = xb_add(&bar[XB_TOP], 1u);
            const unsigned tg = og / nx;
            if (og + 1u == (tg + 1u) * nx) xb_add(&bar[XB_TOPGEN], 1u);
            else XB_SPIN(xb_ld(&bar[XB_TOPGEN]) == tg, bar);
            __builtin_amdgcn_fence(__ATOMIC_ACQUIRE, "agent");
            xb_add(&bar[XB_XGEN(b.x)], 1u);
            asm volatile("s_waitcnt vmcnt(0)" ::: "memory");
        } else {
            XB_SPIN(xb_ld(&bar[XB_XGEN(b.x)]) == gen, bar);
            __builtin_amdgcn_fence(__ATOMIC_ACQUIRE, "agent");
            asm volatile("s_waitcnt vmcnt(0)" ::: "memory");
        }
    }
    __syncthreads();
}


__device__ __forceinline__ void split_arrive(unsigned* sp, const XcdBarrier& b, bool hier) {
    asm volatile("s_waitcnt vmcnt(0)" ::: "memory");
    __syncthreads();
    if (threadIdx.x == 0) {
        if (hier) { const unsigned nloc = b.st[0];
            const unsigned old = xb_add(&sp[64 * b.x], 1u);
            if (old + 1u == nloc) { __builtin_amdgcn_fence(__ATOMIC_RELEASE, "agent"); asm volatile("s_waitcnt vmcnt(0)" ::: "memory"); xb_add(&sp[64 * 16], 1u); } }
        else { __builtin_amdgcn_fence(__ATOMIC_RELEASE, "agent"); asm volatile("s_waitcnt vmcnt(0)" ::: "memory"); xb_add(&sp[64 * 16], 1u); }
    }
}
__device__ __forceinline__ void split_wait(unsigned* sp, const XcdBarrier& b, bool hier, unsigned* tmo) {
    if (threadIdx.x < 64) {
        const unsigned need = hier ? b.st[1] : gridDim.x;
        unsigned spn = 0;
        while ((unsigned)__builtin_amdgcn_readfirstlane((int)xb_ld(&sp[64 * 16])) < need) { __builtin_amdgcn_s_sleep(2);
            if ((++spn & 255u) == 0u) { if (xb_ld(tmo)) break; if (spn > XB_SPIN_CAP) { if (threadIdx.x == 0) atomicAdd(tmo, 1u); break; } } }
        __builtin_amdgcn_fence(__ATOMIC_ACQUIRE, "agent");
        asm volatile("s_waitcnt vmcnt(0)" ::: "memory");
    }
    asm volatile("" ::: "memory"); __builtin_amdgcn_s_barrier(); asm volatile("" ::: "memory");
}

constexpr int NWAVES = 8, NTHREADS = 512, GRID = 256;
constexpr int LDS_BYTES = 151552;
constexpr int MISC_OFF = 131072 + 320;
constexpr int ROPE_LDS = 132096;
constexpr int CW_BAR = 4096;

struct Args {
    const float* in[25];
    float* out; unsigned char* ws;
    int ph_lo, ph_hi;
};

enum { I_X = 0, I_C, I_CTX, I_CCTX, I_WADA, I_BADA, I_GNORM, I_WIN, I_GQ, I_GK, I_LQ1, I_LK1, I_LQ2, I_LK2, I_GSUB, I_WF, I_BF, I_LNG, I_LNB, I_WS, I_BS, I_WBRA, I_WBRB, I_WBRC, I_WOUT };

__device__ __forceinline__ void transpose_item(const float* W, int ldw, int k0, int lcol0, bool perm, bf16_t* dst, int ldd, int prow0, int dcol0, LAS float* scr, int lane) {
#pragma unroll 8
    for (int i = 0; i < 32; ++i) { const int kk = 2 * i + (lane >> 5); scr[kk * 33 + (lane & 31)] = W[(size_t)(k0 + kk) * ldw + lcol0 + (lane & 31)]; }
    LDS_WAIT(); asm volatile("" ::: "memory");
    const int c = lane & 7;
#pragma unroll
    for (int j = 0; j < 4; ++j) { const int n = (lane >> 3) + 8 * j; const int jn = perm ? perm32(n) : n; const LAS float* s = scr + (8 * c) * 33 + jn;
        u32x4 o; o.x = pk2(s[0 * 33], s[1 * 33]); o.y = pk2(s[2 * 33], s[3 * 33]); o.z = pk2(s[4 * 33], s[5 * 33]); o.w = pk2(s[6 * 33], s[7 * 33]);
        *(GAS u32x4*)(dst + (size_t)(prow0 + n) * ldd + dcol0 + k0 + 8 * c) = o; }
    LDS_WAIT(); asm volatile("" ::: "memory");
}
__device__ __forceinline__ bool win_block_map(int pb, int& lcol, bool& perm) {
    const int tile = pb >> 3, w = pb & 7, bj = w >> 2, wc = w & 3;
    if (tile < 2) { lcol = OFF_Q + (4 * (tile & 1) + wc) * 64 + 32 * bj; perm = false; return true; }
    if (tile < 4) { lcol = OFF_K + (4 * (tile & 1) + wc) * 64 + 32 * bj; perm = false; return true; }
    perm = true;
    if (tile < 6) { lcol = OFF_V + 256 * (tile - 4) + 32 * w; return true; }
    if (tile < 8) return false;
    if (tile < 10) { lcol = (bj == 0 ? OFF_U : OFF_GATE + 768) + 128 * (tile - 8) + 32 * wc; return true; }
    if (tile == 10) { lcol = OFF_VC + 32 * w; return true; }
    if (tile < 14) { lcol = OFF_GATE + 256 * (tile - 11) + 32 * w; return true; }
    lcol = OFF_MERGE + 256 * (tile - 14) + 32 * w; return true;
}
__device__ __forceinline__ float cos2pi(int a, int n) { return cospif(2.0f * (float)a / (float)n); }
__device__ __forceinline__ float sin2pi(int a, int n) { return sinpif(2.0f * (float)a / (float)n); }

__device__ __forceinline__ void ph0_mods(const Args& a, int lane, int wave, int vcu);
__device__ __forceinline__ void ph0_prologue(const Args& a, LAS unsigned char* lds, int tid, int lane, int wave, int vcu, int pmask) {
    unsigned char* ws = a.ws;
    const int gw = vcu * NWAVES + wave, NGW = GRID * NWAVES;
    const int gt = vcu * NTHREADS + tid, NGT = GRID * NTHREADS;
    if (pmask & 1) {
        LAS float* scr = (LAS float*)(lds + wave * 16384);
        constexpr int I_WIN_N = DEPTH * 208 * 16;
        constexpr int I_BR_N = DEPTH * 32 * 16;
        constexpr int I_OUT_N = DEPTH * 32 * 16;
        for (int it = gw; it < I_WIN_N + I_BR_N + I_OUT_N; it += NGW) {
            int r = it;
            if (r < I_WIN_N) {
                const int l = r / (208 * 16), q = r % (208 * 16), pb = q >> 4, kb = q & 15; int lcol; bool perm;
                if (!win_block_map(pb, lcol, perm)) continue;
                transpose_item(a.in[I_WIN] + (size_t)l * DM * INW, INW, 64 * kb, lcol, perm, (bf16_t*)(ws + WS_WIN) + (size_t)l * NPHYS * DM, DM, 32 * pb, 0, scr, lane);
                continue;
            }
            r -= I_WIN_N;
            if (r < I_BR_N) {
                const int l = r / 512, q = r % 512, pb = q >> 4, kb = q & 15;
                const float* W; int ksrc;
                if (kb < 8) { W = a.in[I_WBRA] + (size_t)l * 512 * DM; ksrc = 64 * kb; } else if (kb < 12) { W = a.in[I_WBRB] + (size_t)l * 256 * DM; ksrc = 64 * (kb - 8); } else { W = a.in[I_WBRC] + (size_t)l * 256 * DM; ksrc = 64 * (kb - 12); }
                transpose_item(W, DM, ksrc, 32 * pb, true, (bf16_t*)(ws + WS_WBR) + (size_t)l * DM * DM, DM, 32 * pb, 64 * kb - ksrc, scr, lane);
                continue;
            }
            r -= I_BR_N;
            { const int l = r / 512, q = r % 512, pb = q >> 4, kb = q & 15;
              transpose_item(a.in[I_WOUT] + (size_t)l * DM * DM, DM, 64 * kb, 32 * pb, true, (bf16_t*)(ws + WS_WOUT) + (size_t)l * DM * DM, DM, 32 * pb, 0, scr, lane); }
        }
    }
    __syncthreads();
    if (pmask & 2) {
        LAS float* Wb = (LAS float*)lds;
        LAS float* TR = Wb + 64 * 65;
        LAS float* Tt = TR + 64 * 128;
        LAS float* Wf = Tt + 64 * 132;
        for (int it = GRID - 1 - vcu; it < DEPTH * 4 * 16; it += GRID) {
            const int l = it / 64, g = (it >> 4) & 3, kb = it & 15;
            const float* win = a.in[I_WIN] + (size_t)l * DM * INW; const float* wf = a.in[I_WF] + (size_t)(l * 4 + g) * 64 * 64;
            for (int e = tid; e < 4096; e += NTHREADS) { const int r = e >> 6, c = e & 63; Wb[r * 65 + c] = win[(size_t)(64 * kb + r) * INW + OFF_F + 64 * g + c]; Wf[e] = wf[e]; }
            for (int e = tid; e < 64 * 128; e += NTHREADS) { const int c = e >> 7, ri = (e >> 6) & 1, cp = e & 63; const int ph = (c * cp) & 63; TR[e] = ri ? -sin2pi(ph, 64) : cos2pi(ph, 64); }
            __syncthreads();
            const int tk = tid >> 5, tn = tid & 31;
            { f32x4 acc[4];
#pragma unroll
              for (int i = 0; i < 4; ++i) acc[i] = (f32x4){0.f, 0.f, 0.f, 0.f};
#pragma unroll 4
              for (int c = 0; c < 64; ++c) { const f32x4 bv = *(const LAS f32x4*)(TR + c * 128 + 4 * tn);
#pragma unroll
                  for (int i = 0; i < 4; ++i) acc[i] += bv * Wb[(4 * tk + i) * 65 + c]; }
#pragma unroll
              for (int i = 0; i < 4; ++i) *(LAS f32x4*)(Tt + (4 * tk + i) * 132 + 4 * tn) = acc[i]; }
            __syncthreads();
            { const int ri = tn >> 4, td = tn & 15;
              f32x4 acc[4];
#pragma unroll
              for (int i = 0; i < 4; ++i) acc[i] = (f32x4){0.f, 0.f, 0.f, 0.f};
#pragma unroll 4
              for (int cp = 0; cp < 64; ++cp) { const f32x4 bv = *(const LAS f32x4*)(Wf + cp * 64 + 4 * td);
#pragma unroll
                  for (int i = 0; i < 4; ++i) acc[i] += bv * Tt[(4 * tk + i) * 132 + ri * 64 + cp]; }
              bf16_t* dst = (bf16_t*)(ws + WS_WIN) + (size_t)l * NPHYS * DM;
#pragma unroll
              for (int e = 0; e < 4; ++e) { const int ch = 64 * g + 4 * td + e, prow = 6 * 256 + ri * 256 + (ch & ~31) + invperm32(ch & 31);
                  u32x2 w; w.x = pk2(acc[0][e], acc[1][e]); w.y = pk2(acc[2][e], acc[3][e]);
                  *(u32x2*)(dst + (size_t)prow * DM + 64 * kb + 4 * tk) = w; } }
            __syncthreads();
        }
    }
    if (pmask & 4) {
        float* ropec = (float*)(ws + WS_ROPE); float* ropes = ropec + 2048;
        for (int e = gt; e < 2048; e += NGT) { const int pos = e >> 4, f = e & 15; const float freq = powf(10000.0f, -(float)(2 * f) / 32.0f); const float ang = (float)pos * freq; ropec[e] = cosf(ang); ropes[e] = sinf(ang); }
        f32x2* tw = (f32x2*)(ws + WS_TW);
        for (int e = gt; e < 8192; e += NGT) tw[e] = (f32x2){cos2pi(e, 8192), sin2pi(e, 8192)};
        bf16_t* c128 = (bf16_t*)(ws + WS_C128); bf16_t* s128 = (bf16_t*)(ws + WS_S128);
        for (int e = gt; e < 4 * 8 * 64 * 8; e += NGT) { const int j = e & 7, ln = (e >> 3) & 63, s = (e >> 9) & 7, mb = e >> 12; const int row = 32 * mb + (ln & 31), k = 16 * s + 8 * (j >> 2) + 4 * (ln >> 5) + (j & 3);
            const int ph = (row * k) & 127; c128[e] = (bf16_t)f2bf(cos2pi(ph, 128)); s128[e] = (bf16_t)f2bf(sin2pi(ph, 128)); }
        bf16_t* t64 = (bf16_t*)(ws + WS_T64);
        for (int e = gt; e < 2 * 8 * 64 * 8; e += NGT) { const int j = e & 7, ln = (e >> 3) & 63, s = (e >> 9) & 7, mb = e >> 12; const int row = 32 * mb + (ln & 31), k = 16 * s + 8 * (j >> 2) + 4 * (ln >> 5) + (j & 3);
            const int ri = k >> 6, c = k & 63, ph = (row * c) & 63; t64[e] = (bf16_t)f2bf(ri ? sin2pi(ph, 64) : cos2pi(ph, 64)); }
        bf16_t* tc256 = (bf16_t*)(ws + WS_TC256);
        for (int e = gt; e < 8 * 32 * 64 * 8; e += NGT) { const int j = e & 7, ln = (e >> 3) & 63, s = (e >> 9) & 31, mb = e >> 14; const int row = 32 * mb + (ln & 31), k = 16 * s + 8 * (j >> 2) + 4 * (ln >> 5) + (j & 3);
            const int ri = k >> 8, n = k & 255, ph = (row * n) & 255; tc256[e] = (bf16_t)f2bf(ri ? sin2pi(ph, 256) : cos2pi(ph, 256)); }
        bf16_t* wsimg = (bf16_t*)(ws + WS_WSIMG);
        for (int e = gt; e < DEPTH * 4 * 4 * 8 * 64 * 8; e += NGT) { const int j = e & 7, ln = (e >> 3) & 63, s = (e >> 9) & 7, mb = (e >> 12) & 3, lg = e >> 14; const int row = 32 * mb + (ln & 31), k = 16 * s + 8 * (j >> 2) + 4 * (ln >> 5) + (j & 3);
            wsimg[e] = (bf16_t)f2bf(a.in[I_WS][(size_t)lg * 128 * 128 + row * 128 + k]); }
        if (gt < DEPTH) { const int l = gt; float s1 = 0.f, s2 = 0.f;
            for (int i = 0; i < 64; ++i) { s1 += a.in[I_LQ1][l * 64 + i] * a.in[I_LK1][l * 64 + i]; s2 += a.in[I_LQ2][l * 64 + i] * a.in[I_LK2][l * 64 + i]; }
            const float lam_init = 0.8f - 0.6f * expf(-0.3f * (float)l);
            float* lam = (float*)(ws + WS_LAM); lam[2 * l] = expf(s1) - expf(s2) + lam_init; lam[2 * l + 1] = 1.0f - lam_init; }
    }
}

__device__ __forceinline__ void ph0_mods(const Args& a, int lane, int wave, int vcu) {
    unsigned char* ws = a.ws; const int gw = vcu * NWAVES + wave, NGW = GRID * NWAVES;
    {
        float* part = (float*)(ws + WS_MODP);
        for (int it = gw; it < DEPTH * 12 * 32; it += NGW) {
            const int l = it / 384, q = it % 384, cc = q >> 5, kc = q & 31; const int col = 256 * cc + 4 * lane;
            const float* w = a.in[I_WADA] + (size_t)l * DM * 3072 + col;
            f32x4 s0 = {0.f, 0.f, 0.f, 0.f}, s1 = s0, s2 = s0;
#pragma unroll 8
            for (int kk = 0; kk < 32; ++kk) { const int k = 32 * kc + kk; const f32x4 wv = *(const f32x4*)(w + (size_t)k * 3072);
                const float a0 = fast_silu(a.in[I_C][k]), a1 = fast_silu(a.in[I_C][DM + k]), a2 = fast_silu(a.in[I_CCTX][k]);
                s0 += wv * a0; s1 += wv * a1; s2 += wv * a2; }
            float* p = part + ((size_t)(l * 32 + kc) * 3) * 3072 + col;
            *(f32x4*)(p) = s0; *(f32x4*)(p + 3072) = s1; *(f32x4*)(p + 2 * 3072) = s2;
        }
    }
}

__device__ __forceinline__ void prepass(const Args& a, int l, LAS unsigned char* lds, int tid, int lane, int wave, int vcu) {
    unsigned char* ws = a.ws;
    const float* part = (const float*)(ws + WS_MODP); float* modf = (float*)(ws + WS_MODF);
    if (l == 0) {
        if (tid < 72) { const int o = vcu * 72 + tid; const int ll = o / 9216, rj = o % 9216, r = rj / 3072, j = rj % 3072; float s = a.in[I_BADA][ll * 3072 + j];
#pragma unroll
            for (int kc = 0; kc < 32; ++kc) s += part[((size_t)(ll * 32 + kc) * 3 + r) * 3072 + j];
            modf[o] = s; }
    }
    const int row0 = vcu * 66, row1 = row0 + 66;
    LAS float* coef = (LAS float*)lds;
    for (int r = 0; r < 3; ++r) {
        const int lo = r == 0 ? 0 : (r == 1 ? SEQ : MLAT), hi = r == 0 ? SEQ : (r == 1 ? MLAT : MT);
        if (row1 <= lo || row0 >= hi) continue;
        for (int k = tid; k < DM; k += NTHREADS) {
            float sh, sc;
            if (l == 0) { sh = a.in[I_BADA][k]; sc = a.in[I_BADA][DM + k];
#pragma unroll
                for (int kc = 0; kc < 32; ++kc) { const float* p = part + ((size_t)(kc) * 3 + r) * 3072; sh += p[k]; sc += p[DM + k]; } }
            else { sh = modf[(size_t)(l * 3 + r) * 3072 + k]; sc = modf[(size_t)(l * 3 + r) * 3072 + DM + k]; }
            coef[(r * 2) * DM + k] = a.in[I_GNORM][l * DM + k] * (1.0f + sc); coef[(r * 2 + 1) * DM + k] = sh;
        }
    }
    __syncthreads();
    const float* xlat = l == 0 ? a.in[I_X] : a.out; const float* xctx = l == 0 ? a.in[I_CTX] : (const float*)(ws + WS_CTX1);
    bf16_t* H = (bf16_t*)(ws + WS_H);
    for (int mb = row0 + 4 * wave; mb < row1; mb += 4 * NWAVES) {
        f32x4 v[4][4]; float s2[4];
#pragma unroll
        for (int q = 0; q < 4; ++q) { const int m = (mb + q < row1) ? mb + q : mb;
            if (l == 1 && m < MLAT) { const GAS u32x2* xb = (const GAS u32x2*)(ws + x1b_off(m)) + lane;
#pragma unroll
                for (int j = 0; j < 4; ++j) { const u32x2 t = xb[64 * j]; v[q][j] = (f32x4){bflo(t.x), bfhi(t.x), bflo(t.y), bfhi(t.y)}; } }
            else { const float* xrow = m < MLAT ? xlat + (size_t)m * DM : xctx + (size_t)(m - MLAT) * DM; const GAS f32x4* xr = (const GAS f32x4*)xrow + lane;
#pragma unroll
                for (int j = 0; j < 4; ++j) v[q][j] = xr[64 * j]; } }
#pragma unroll
        for (int q = 0; q < 4; ++q) { float t = 0.f;
#pragma unroll
            for (int j = 0; j < 4; ++j) t += (v[q][j].x * v[q][j].x + v[q][j].y * v[q][j].y) + (v[q][j].z * v[q][j].z + v[q][j].w * v[q][j].w);
            s2[q] = t; }
#pragma unroll
        for (int o = 1; o < 64; o <<= 1) {
#pragma unroll
            for (int q = 0; q < 4; ++q) s2[q] += __shfl_xor(s2[q], o); }
#pragma unroll
        for (int q = 0; q < 4; ++q) { const int m = mb + q; if (m >= row1) break;
            const int r = m < SEQ ? 0 : (m < MLAT ? 1 : 2);
            const float rstd = rsqrtf(s2[q] * (1.0f / DM) + EPS);
            GAS u32x2* o8 = (GAS u32x2*)(H + (size_t)m * DM) + lane;
#pragma unroll
            for (int j = 0; j < 4; ++j) { const f32x4 ga = *(const LAS f32x4*)(coef + (r * 2) * DM + 256 * j + 4 * lane), sh = *(const LAS f32x4*)(coef + (r * 2 + 1) * DM + 256 * j + 4 * lane);
                const f32x4 h = v[q][j] * rstd * ga + sh; u32x2 w; w.x = pk2(h.x, h.y); w.y = pk2(h.z, h.w); o8[64 * j] = w; } }
    }
    __syncthreads();
}

struct TileSched {
    int x, c, pn0, npn, nseg, nctx, cpn0, cnpn;
    __device__ __forceinline__ bool next(int i, pg8::Unit& u) const {
        const int ti = i / nseg; u.seg = i - ti * nseg; u.set = 0;
        const int j = ti * 32 + c;
        if (j < 8 * npn) { u.pm = 8 * x + (j & 7); u.pn = pn0 + (j >> 3); return true; }
        const int id = (j - 8 * npn) * 8 + x;
        if (id < nctx) { u.pm = 64 + (id & 1); u.pn = cpn0 + (id >> 1); return true; }
        return false;
    }
    __device__ __forceinline__ void a_ready(const pg8::Unit&) const {}
};

struct EpiIn {
    unsigned char* ws; const float* gq; const float* gk; LAS const float* ropec; LAS const float* ropes;
    __device__ __forceinline__ bool operator()(f32x4 (&acc)[2][2][4][2], const pg8::Unit& u, int wr, int wc, int fr, int fq) const {
        const bool ctx = u.pm >= 64; const int b = ctx ? u.pm - 64 : (u.pm >> 5);
        const int rbase = u.pm * 256 + wr * 64 + fr;
        const int pn = u.pn;
        if (pn < 4) {
            const bool isK = pn >= 2; const int gi = 4 * (pn & 1) + wc, h = gi >> 1, comp = gi & 1;
            const float* gsrc = isK ? gk : gq;
            f32x4 gv[2][2];
#pragma unroll
            for (int bj = 0; bj < 2; ++bj)
#pragma unroll
                for (int n = 0; n < 2; ++n) gv[bj][n] = *(const f32x4*)(gsrc + 32 * bj + 16 * n + 4 * fq);
#pragma unroll
            for (int ai = 0; ai < 2; ++ai)
#pragma unroll
                for (int m = 0; m < 4; ++m) {
                    const int row = rbase + ai * 128 + m * 16;
                    f32x4 v[2][2]; float ss = 0.f;
#pragma unroll
                    for (int bj = 0; bj < 2; ++bj)
#pragma unroll
                        for (int n = 0; n < 2; ++n) { v[bj][n] = acc[ai][bj][m][n]; ss += (v[bj][n].x * v[bj][n].x + v[bj][n].y * v[bj][n].y) + (v[bj][n].z * v[bj][n].z + v[bj][n].w * v[bj][n].w); }
                    ss += __shfl_xor(ss, 16); ss += __shfl_xor(ss, 32);
                    const float rstd = rsqrtf(ss * (1.0f / 64.0f) + EPS);
#pragma unroll
                    for (int bj = 0; bj < 2; ++bj)
#pragma unroll
                        for (int n = 0; n < 2; ++n) v[bj][n] = v[bj][n] * rstd * gv[bj][n];
                    int kx;
                    if (!ctx) { const int ntok = row - b * SEQ; kx = ntok;
#pragma unroll
                        for (int bj = 0; bj < 2; ++bj) { const int pos = bj == 0 ? (ntok >> 6) : (ntok & 63);
                            const f32x4 c4 = *(LAS const f32x4*)(ropec + pos * 16 + 4 * fq), s4 = *(LAS const f32x4*)(ropes + pos * 16 + 4 * fq);
                            const f32x4 x1 = v[bj][0], x2 = v[bj][1]; v[bj][0] = x1 * c4 - x2 * s4; v[bj][1] = x2 * c4 + x1 * s4; } }
                    else kx = SEQ + (row - MLAT - b * NCTX);
#pragma unroll
                    for (int bj = 0; bj < 2; ++bj) {
                        f32x4 p0 = v[bj][0], p1 = v[bj][1];
                        if (!isK) { p0 = p0 * QSCALE; p1 = p1 * QSCALE; }
                        u32x4 w; w.x = cvt_pk_bf16(p0.x, p0.y); w.y = cvt_pk_bf16(p0.z, p0.w); w.z = cvt_pk_bf16(p1.x, p1.y); w.w = cvt_pk_bf16(p1.z, p1.w);
                        if (!isK) *(u32x4*)((bf16_t*)(ws + WS_QG) + ((size_t)row * 4 + h) * 128 + comp * 64 + (bj * 4 + fq) * 8) = w;
                        else *(u32x4*)(ws + WS_KIMG + ((size_t)((b * 4 + h) * NKT + (kx >> 6)) * 16 + comp * 8 + bj * 4 + fq) * 1024 + (kx & 63) * 16) = w;
                    }
                }
            return true;
        }
#pragma unroll
        for (int ai = 0; ai < 2; ++ai)
#pragma unroll
            for (int m = 0; m < 4; ++m) {
                const int row = rbase + ai * 128 + m * 16;
                if (pn == 8 || pn == 9) {
                    f32x4 p0, p1;
#pragma unroll
                    for (int e = 0; e < 4; ++e) { p0[e] = acc[ai][0][m][0][e] * fast_silu(acc[ai][1][m][0][e]); p1[e] = acc[ai][0][m][1][e] * fast_silu(acc[ai][1][m][1][e]); }
                    u32x4 w; w.x = cvt_pk_bf16(p0.x, p0.y); w.y = cvt_pk_bf16(p0.z, p0.w); w.z = cvt_pk_bf16(p1.x, p1.y); w.w = cvt_pk_bf16(p1.z, p1.w);
                    *(u32x4*)((bf16_t*)(ws + WS_UG) + (size_t)row * 256 + 128 * (pn - 8) + 32 * wc + 8 * fq) = w;
                    continue;
                }
#pragma unroll
                for (int bj = 0; bj < 2; ++bj) {
                    f32x4 p0 = acc[ai][bj][m][0], p1 = acc[ai][bj][m][1];
                    const int lc = 128 * bj + 32 * wc + 8 * fq;
                    unsigned char* dst;
                    if (pn < 6) { const int kx = ctx ? SEQ + (row - MLAT - b * NCTX) : row - b * SEQ; const int h = 2 * (pn - 4) + bj;
                        dst = ws + WS_VIMG + ((size_t)((b * 4 + h) * NKT + (kx >> 6)) * 16 + wc * 4 + ((kx & 63) >> 4)) * 1024 + (kx & 15) * 64 + fq * 16; }
                    else if (pn < 8) dst = ws + WS_Z2 + ((size_t)row * 512 + 256 * (pn - 6) + lc) * 2;
                    else if (pn == 10) dst = ws + WS_VC + ((size_t)row * 256 + lc) * 2;
                    else if (pn < 14) {
#pragma unroll
                        for (int e = 0; e < 4; ++e) { p0[e] = fast_silu(p0[e]); p1[e] = fast_silu(p1[e]); }
                        dst = ws + WS_GS + ((size_t)row * 768 + 256 * (pn - 11) + lc) * 2; }
                    else {
                        unsigned q0 = 0u, q1 = 0u;
#pragma unroll
                        for (int e = 0; e < 4; ++e) { q0 = ms_quant_pk(p0[e], e, q0); q1 = ms_quant_pk(p1[e], e, q1); }
                        unsigned char* d8 = ctx ? ws + WS_MSC + ((size_t)(row - MLAT) * 3072 + 256 * (pn - 14) + lc) : ws + WS_MS + ((size_t)row * 3072 + 256 * (pn - 14) + lc);
                        u32x2 w8; w8.x = q0; w8.y = q1; *(u32x2*)d8 = w8; continue; }
                    u32x4 w; w.x = cvt_pk_bf16(p0.x, p0.y); w.y = cvt_pk_bf16(p0.z, p0.w); w.z = cvt_pk_bf16(p1.x, p1.y); w.w = cvt_pk_bf16(p1.z, p1.w);
                    *(u32x4*)dst = w;
                }
            }
        return true;
    }
};

struct EpiY {
    const unsigned char* MS; bf16_t* Y;
    __device__ __forceinline__ bool operator()(f32x4 (&acc)[2][2][4][2], const pg8::Unit& u, int wr, int wc, int fr, int fq) const {
        const int rbase = u.pm * 256 + wr * 64 + fr; const int seg = u.seg;
#pragma unroll
        for (int ai = 0; ai < 2; ++ai) {
            u32x2 mn[4][2], md[4][2];
#pragma unroll
            for (int m = 0; m < 4; ++m)
#pragma unroll
                for (int bj = 0; bj < 2; ++bj) { const unsigned char* mp = MS + (size_t)(rbase + ai * 128 + m * 16) * 3072 + seg * 1024 + 256 * u.pn + 128 * bj + 32 * wc + 8 * fq;
                    mn[m][bj] = *(const u32x2*)mp; md[m][bj] = seg < 2 ? *(const u32x2*)(mp + 1024) : (u32x2){0u, 0u}; }
            __builtin_amdgcn_sched_barrier(0);
#pragma unroll
            for (int m = 0; m < 4; ++m) {
                const int row = rbase + ai * 128 + m * 16;
#pragma unroll
                for (int bj = 0; bj < 2; ++bj) {
                    const int col = 256 * u.pn + 128 * bj + 32 * wc + 8 * fq;
                    const u32x2 a_ = mn[m][bj], d_ = md[m][bj];
                    f32x4& p0 = acc[ai][bj][m][0]; f32x4& p1 = acc[ai][bj][m][1];
                    if (seg < 2) {
#pragma unroll
                        for (int e = 0; e < 4; ++e) { p0[e] *= ub(a_.x, e) * __builtin_amdgcn_rcpf(ub(d_.x, e)); p1[e] *= ub(a_.y, e) * __builtin_amdgcn_rcpf(ub(d_.y, e)); } }
                    else {
#pragma unroll
                        for (int e = 0; e < 4; ++e) { p0[e] *= ub(a_.x, e) * (1.0f / 255.0f); p1[e] *= ub(a_.y, e) * (1.0f / 255.0f); }
                        u32x4 w; w.x = cvt_pk_bf16(p0[0], p0[1]); w.y = cvt_pk_bf16(p0[2], p0[3]); w.z = cvt_pk_bf16(p1[0], p1[1]); w.w = cvt_pk_bf16(p1[2], p1[3]);
                        *(u32x4*)(Y + (size_t)row * DM + col) = w; }
                }
            }
            __builtin_amdgcn_sched_barrier(0);
        }
        return seg == 2;
    }
};


struct FusedSched {
    int x, c; unsigned* sp; XcdBarrier bar; bool hier; unsigned* tmo;
    __device__ __forceinline__ bool next(int i, pg8::Unit& u) const {
        if (i >= 6) return false;
        u.pm = 8 * x + (c & 7);
        if (i < 3) { u.pn = 14 + 4 * i + (c >> 3); u.seg = 0; u.set = 1; } else { u.pn = c >> 3; u.seg = i - 3; u.set = 0; }
        return true;
    }
    __device__ __forceinline__ void a_ready(const pg8::Unit& u) const { if (u.set == 0 && u.seg == 1) split_wait(sp, bar, hier, tmo); }
};
struct EpiMY {
    EpiIn ein; EpiY ey;
    __device__ __forceinline__ bool operator()(f32x4 (&acc)[2][2][4][2], const pg8::Unit& u, int wr, int wc, int fr, int fq) const { return u.set ? ein(acc, u, wr, wc, fr, fq) : ey(acc, u, wr, wc, fr, fq); }
};

struct EpiOut {
    const float* xin; float* out; unsigned char* ws; const float* gate; int layer;
    __device__ __forceinline__ bool operator()(f32x4 (&acc)[2][2][4][2], const pg8::Unit& u, int wr, int wc, int fr, int fq) const {
        const int r = u.pm >> 5;
        const int rbase = u.pm * 256 + wr * 64 + fr;
        f32x4 xa[2][2], xb[2][2], xc[2][2];
#define EO_C(g) (256 * u.pn + 128 * ((g) >> 2) + 32 * wc + 8 * fq)
#define EO_ROW(g, mm) (rbase + (((g) >> 1) & 1) * 128 + (2 * ((g) & 1) + (mm)) * 16)
#define EO_LOAD(dst, g) do { _Pragma("unroll") for (int mm = 0; mm < 2; ++mm) { \
            if (layer == 0) { const float* p_ = xin + (size_t)EO_ROW(g, mm) * DM + EO_C(g); dst[mm][0] = *(const f32x4*)p_; dst[mm][1] = *(const f32x4*)(p_ + 4); } \
            else { const u32x4 t_ = *(const u32x4*)(ws + x1b_off(EO_ROW(g, mm)) + (size_t)EO_C(g) * 2); dst[mm][0] = (f32x4){bflo(t_.x), bfhi(t_.x), bflo(t_.y), bfhi(t_.y)}; dst[mm][1] = (f32x4){bflo(t_.z), bfhi(t_.z), bflo(t_.w), bfhi(t_.w)}; } } } while (0)
#define EO_STORE(srcv, g) do { const f32x4 g0_ = *(const f32x4*)(gate + (size_t)r * 3072 + EO_C(g)), g1_ = *(const f32x4*)(gate + (size_t)r * 3072 + EO_C(g) + 4); \
            _Pragma("unroll") for (int mm = 0; mm < 2; ++mm) { \
                const f32x4 y0_ = srcv[mm][0] + g0_ * acc[((g) >> 1) & 1][(g) >> 2][2 * ((g) & 1) + mm][0], y1_ = srcv[mm][1] + g1_ * acc[((g) >> 1) & 1][(g) >> 2][2 * ((g) & 1) + mm][1]; \
                if (layer == 0) { u32x4 w_; w_.x = cvt_pk_bf16(y0_.x, y0_.y); w_.y = cvt_pk_bf16(y0_.z, y0_.w); w_.z = cvt_pk_bf16(y1_.x, y1_.y); w_.w = cvt_pk_bf16(y1_.z, y1_.w); *(u32x4*)(ws + x1b_off(EO_ROW(g, mm)) + (size_t)EO_C(g) * 2) = w_; } \
                else { float* p_ = out + (size_t)EO_ROW(g, mm) * DM + EO_C(g); *(f32x4*)p_ = y0_; *(f32x4*)(p_ + 4) = y1_; } } } while (0)
        EO_LOAD(xa, 0); EO_LOAD(xb, 1); EO_LOAD(xc, 2);
        EO_STORE(xa, 0); EO_LOAD(xa, 3);
        EO_STORE(xb, 1); EO_LOAD(xb, 4);
        EO_STORE(xc, 2); EO_LOAD(xc, 5);
        EO_STORE(xa, 3); EO_LOAD(xa, 6);
        EO_STORE(xb, 4); EO_LOAD(xb, 7);
        EO_STORE(xc, 5); EO_STORE(xa, 6); EO_STORE(xb, 7);
#undef EO_C
#undef EO_ROW
#undef EO_LOAD
#undef EO_STORE
        return true;
    }
};

__device__ __forceinline__ f32x4 mini_block(const bf16_t* A, int lda, const bf16_t* Bt, int ldb, int m0, int n0, int k0, int nk, int fr, int fq, f32x4 acc) {
    const bf16_t* ap = A + (size_t)(m0 + fr) * lda + k0 + 8 * fq; const bf16_t* bp = Bt + (size_t)(n0 + fr) * ldb + k0 + 8 * fq;
#pragma unroll 16
    for (int s = 0; s < nk; s += 32) acc = __builtin_amdgcn_mfma_f32_16x16x32_bf16(*(const bf16x8*)(bp + s), *(const bf16x8*)(ap + s), acc, 0, 0, 0);
    return acc;
}
__device__ __forceinline__ int mini_lcol(int n0, int fq) { return (n0 & ~31) + 8 * fq + 4 * ((n0 >> 4) & 1); }
__device__ __forceinline__ void ctx_merge_gates(unsigned char* ws, const bf16_t* Wl, int gw, int lane) {
    const int fr = lane & 15, fq = lane >> 4; const bf16_t* H = (const bf16_t*)(ws + WS_H); bf16_t* MS = (bf16_t*)(ws + WS_MS);
    for (int blk = gw; blk < 32 * 192; blk += GRID * NWAVES) { const int m0 = MLAT + 16 * (blk & 31), n0 = 16 * (blk >> 5);
        const f32x4 acc = mini_block(H, DM, Wl + (size_t)(14 * 256) * DM, DM, m0, n0, 0, DM, fr, fq, (f32x4){0.f, 0.f, 0.f, 0.f});
        u32x2 w; w.x = cvt_pk_bf16(fast_sigmoid(acc[0]), fast_sigmoid(acc[1])); w.y = cvt_pk_bf16(fast_sigmoid(acc[2]), fast_sigmoid(acc[3]));
        *(u32x2*)(MS + (size_t)(m0 + fr) * 3072 + mini_lcol(n0, fq)) = w; }
}
__device__ __forceinline__ void ctx_branch_proj(unsigned char* ws, const bf16_t* Wbr, int gw, int lane) {
    const int fr = lane & 15, fq = lane >> 4; const bf16_t* A = (const bf16_t*)(ws + WS_A); const unsigned char* MS = (const unsigned char*)(ws + WS_MSC) - (size_t)MLAT * 3072; bf16_t* Y = (bf16_t*)(ws + WS_Y);
    for (int blk = gw; blk < 32 * 64; blk += GRID * NWAVES) { const int m0 = MLAT + 16 * (blk & 31), n0 = 16 * (blk >> 5); const int lc = mini_lcol(n0, fq);
        f32x4 y = {0.f, 0.f, 0.f, 0.f};
#pragma unroll
        for (int seg = 0; seg < 3; ++seg) { const int k0 = seg == 0 ? 0 : (seg == 1 ? 512 : 768), nk = seg == 0 ? 512 : 256;
            const f32x4 acc = mini_block(A, DM, Wbr, DM, m0, n0, k0, nk, fr, fq, (f32x4){0.f, 0.f, 0.f, 0.f});
            const unsigned mg = *(const unsigned*)(MS + (size_t)(m0 + fr) * 3072 + seg * 1024 + lc);
            y[0] += acc[0] * ub(mg, 0) * (1.0f / 255.0f); y[1] += acc[1] * ub(mg, 1) * (1.0f / 255.0f); y[2] += acc[2] * ub(mg, 2) * (1.0f / 255.0f); y[3] += acc[3] * ub(mg, 3) * (1.0f / 255.0f); }
        u32x2 w; w.x = cvt_pk_bf16(y[0], y[1]); w.y = cvt_pk_bf16(y[2], y[3]);
        *(u32x2*)(Y + (size_t)(m0 + fr) * DM + lc) = w; }
}
__device__ __forceinline__ void ctx_out_proj(unsigned char* ws, const bf16_t* Wout, const float* ctx_in, const float* gate_ctx, int gw, int lane) {
    const int fr = lane & 15, fq = lane >> 4; const bf16_t* Y = (const bf16_t*)(ws + WS_Y); float* C1 = (float*)(ws + WS_CTX1);
    for (int blk = gw; blk < 32 * 64; blk += GRID * NWAVES) { const int m0 = MLAT + 16 * (blk & 31), n0 = 16 * (blk >> 5);
        const f32x4 acc = mini_block(Y, DM, Wout, DM, m0, n0, 0, DM, fr, fq, (f32x4){0.f, 0.f, 0.f, 0.f});
        const int col = mini_lcol(n0, fq); const size_t off = (size_t)(m0 - MLAT + fr) * DM + col;
        const f32x4 g = *(const f32x4*)(gate_ctx + col), x = *(const f32x4*)(ctx_in + off);
        *(f32x4*)(C1 + off) = x + g * acc; }
}

typedef short v4i16_t __attribute__((ext_vector_type(4)));
__device__ __forceinline__ s16x4 vtr(LAS const unsigned char* p) { return __builtin_bit_cast(s16x4, __builtin_amdgcn_ds_read_tr16_b64_v4i16((LAS v4i16_t*)p)); }
__device__ __forceinline__ int tr_lane_off(int lane) { return ((lane >> 4) & 1) * 32 + (lane & 3) * 8 + (4 * (lane >> 5) + ((lane & 15) >> 2)) * 64; }
__device__ __forceinline__ bf16x8 bfrag(LAS const unsigned char* piece_plus_laneoff) {
    const s16x4 lo = vtr(piece_plus_laneoff), hi = vtr(piece_plus_laneoff + 512);
    return (bf16x8){lo[0], lo[1], lo[2], lo[3], hi[0], hi[1], hi[2], hi[3]};
}
template <int NROWS, int NCOLS, class RP> __device__ __forceinline__ void stage_pieces(LAS unsigned char* dst, RP rp, int tid) {
    constexpr int cpr = NCOLS >> 3, total = NROWS * cpr, pcs = NCOLS >> 5, NIT = total / NTHREADS;
    static_assert(total % NTHREADS == 0, "stage_pieces: whole passes only");
    u32x4 v[NIT];
#pragma unroll
    for (int i = 0; i < NIT; ++i) { const int c = tid + i * NTHREADS, row = c / cpr, cc = c - row * cpr; v[i] = *(const u32x4*)(rp(row) + cc * 8); }
#pragma unroll
    for (int i = 0; i < NIT; ++i) { const int c = tid + i * NTHREADS, row = c / cpr, cc = c - row * cpr;
        *(LAS u32x4*)(dst + ((row >> 4) * pcs + (cc >> 2)) * 1024 + (row & 15) * 64 + (cc & 3) * 16) = v[i]; }
}
#define MFMA32(a, b, c) __builtin_amdgcn_mfma_f32_32x32x16_bf16(a, b, c, 0, 0, 0)
__device__ __forceinline__ bf16x8 afrag_img(const bf16_t* img, int KS, int mb, int s, int lane) { return *(const bf16x8*)(img + ((size_t)(mb * KS + s) * 64 + lane) * 8); }

__device__ __forceinline__ void f1_unit(unsigned char* ws, LAS unsigned char* lds, int unit, int tid, int lane, int wave) {
    const int b = unit >> 7, c = (unit >> 1) & 63, chh = unit & 1;
    bf16_t* Z2 = (bf16_t*)(ws + WS_Z2);
    const bf16_t* base = Z2 + ((size_t)(b * SEQ + c)) * 512 + chh * 128;
    stage_pieces<128, 128>(lds, [&](int r) { return base + (size_t)r * 64 * 512; }, tid);
    stage_pieces<128, 128>(lds + 32768, [&](int r) { return base + (size_t)r * 64 * 512 + 256; }, tid);
    bf16x8 cfa[8], sfa[8];
    { const bf16_t* c128_ = (const bf16_t*)(ws + WS_C128); const bf16_t* s128_ = (const bf16_t*)(ws + WS_S128);
#pragma unroll
      for (int s = 0; s < 8; ++s) { cfa[s] = afrag_img(c128_, 8, wave & 3, s, lane); sfa[s] = afrag_img(s128_, 8, wave & 3, s, lane); } }
    __syncthreads();
    const int mb = wave & 3, cbp = wave >> 2, hi = lane >> 5, r32 = lane & 31, lo = tr_lane_off(lane);
    f32x16 outr[2], t1[2], t2[2];
#pragma unroll
    for (int e = 0; e < 2; ++e) { outr[e] = f32x16{}; t1[e] = f32x16{}; t2[e] = f32x16{}; }
#pragma unroll
    for (int s = 0; s < 8; ++s) {
        const bf16x8 cf = cfa[s], sf = sfa[s];
#pragma unroll
        for (int e = 0; e < 2; ++e) {
            const bf16x8 xr = bfrag(lds + (s * 4 + 2 * cbp + e) * 1024 + lo), xi = bfrag(lds + 32768 + (s * 4 + 2 * cbp + e) * 1024 + lo);
            outr[e] = MFMA32(cf, xr, outr[e]); outr[e] = MFMA32(sf, xi, outr[e]); t1[e] = MFMA32(cf, xi, t1[e]); t2[e] = MFMA32(sf, xr, t2[e]);
        }
    }
    const f32x2* tw = (const f32x2*)(ws + WS_TW);
    f32x2 twv[16];
#pragma unroll
    for (int r = 0; r < 16; ++r) twv[r] = tw[(c * (32 * mb + crow(r, hi))) & 8191];
    __builtin_amdgcn_sched_barrier(0);
#pragma unroll
    for (int e = 0; e < 2; ++e)
#pragma unroll
        for (int r = 0; r < 16; ++r) {
            const int k1 = 32 * mb + crow(r, hi), ch = chh * 128 + 32 * (2 * cbp + e) + r32;
            const float yr = outr[e][r], yi = t1[e][r] - t2[e][r];
            const f32x2 t = twv[r];
            bf16_t* o = Z2 + ((size_t)(b * SEQ + 64 * k1 + c)) * 512 + ch;
            o[0] = (bf16_t)f2bf(yr * t.x + yi * t.y); o[256] = (bf16_t)f2bf(yi * t.x - yr * t.y);
            if ((r & 3) == 3) __builtin_amdgcn_sched_barrier(0);
        }
    __syncthreads();
}

__device__ __forceinline__ void sgu_unit(const Args& a, int l, LAS unsigned char* lds, int cu, int tid, int lane, int wave) {
    unsigned char* ws = a.ws;
    const int row0 = cu < 128 ? cu * 128 : MLAT + (cu - 128) * 128;
    const bf16_t* VC = (const bf16_t*)(ws + WS_VC);
    {
        const int tok = tid >> 2, qt = tid & 3;
        const u32x4* src = (const u32x4*)(VC + (size_t)(row0 + tok) * 256 + qt * 64);
        u32x4 raw[8]; float s = 0.f;
#pragma unroll
        for (int i = 0; i < 8; ++i) { raw[i] = src[i]; s += (bflo(raw[i].x) + bfhi(raw[i].x)) + (bflo(raw[i].y) + bfhi(raw[i].y)) + (bflo(raw[i].z) + bfhi(raw[i].z)) + (bflo(raw[i].w) + bfhi(raw[i].w)); }
        s += __shfl_xor(s, 1); s += __shfl_xor(s, 2);
        const float mu = s * (1.0f / 256.0f); float q = 0.f;
#pragma unroll
        for (int i = 0; i < 8; ++i) {
#pragma unroll
            for (int e = 0; e < 4; ++e) { const float d0 = bflo(raw[i][e]) - mu, d1 = bfhi(raw[i][e]) - mu; q += d0 * d0 + d1 * d1; } }
        q += __shfl_xor(q, 1); q += __shfl_xor(q, 2);
        const float rstd = rsqrtf(q * (1.0f / 256.0f) + EPS);
        const float* lg = a.in[I_LNG] + l * 256 + qt * 64; const float* lb = a.in[I_LNB] + l * 256 + qt * 64;
#pragma unroll
        for (int i = 0; i < 8; ++i) { u32x4 w;
#pragma unroll
            for (int e = 0; e < 4; ++e) { const int ch = 8 * i + 2 * e; w[e] = pk2((bflo(raw[i][e]) - mu) * rstd * lg[ch] + lb[ch], (bfhi(raw[i][e]) - mu) * rstd * lg[ch + 1] + lb[ch + 1]); }
            const int cc = qt * 8 + i;
            *(LAS u32x4*)(lds + ((tok >> 4) * 8 + (cc >> 2)) * 1024 + (tok & 15) * 64 + (cc & 3) * 16) = w; __builtin_amdgcn_sched_barrier(0); }
    }
    bf16x8 wa0[8], wa1[8];
    { const bf16_t* img_ = (const bf16_t*)(ws + WS_WSIMG) + (size_t)(l * 4 + (wave >> 1)) * 16384;
#pragma unroll
      for (int s = 0; s < 8; ++s) { wa0[s] = afrag_img(img_, 8, 2 * (wave & 1), s, lane); wa1[s] = afrag_img(img_, 8, 2 * (wave & 1) + 1, s, lane); } }
    __syncthreads();
    const int g = wave >> 1, ph = wave & 1, hi = lane >> 5, r32 = lane & 31, lo = tr_lane_off(lane);
    f32x16 acc[2][2];
#pragma unroll
    for (int i = 0; i < 2; ++i) { acc[i][0] = f32x16{}; acc[i][1] = f32x16{}; }
#pragma unroll
    for (int s = 0; s < 8; ++s) {
        const bf16x8 a0 = wa0[s], a1 = wa1[s];
        const bf16x8 b0 = bfrag(lds + (s * 8 + 2 * g) * 1024 + lo), b1 = bfrag(lds + (s * 8 + 2 * g + 1) * 1024 + lo);
        acc[0][0] = MFMA32(a0, b0, acc[0][0]); acc[0][1] = MFMA32(a0, b1, acc[0][1]); acc[1][0] = MFMA32(a1, b0, acc[1][0]); acc[1][1] = MFMA32(a1, b1, acc[1][1]);
    }
    const bf16_t* UG = (const bf16_t*)(ws + WS_UG); bf16_t* A = (bf16_t*)(ws + WS_A);
    const float* bs = a.in[I_BS] + (size_t)(l * 4 + g) * 128;
#pragma unroll
    for (int i = 0; i < 2; ++i)
#pragma unroll
        for (int e = 0; e < 2; ++e) {
            unsigned short ugv[16]; float bsv[16];
#pragma unroll
            for (int r = 0; r < 16; ++r) { const int p = 32 * (2 * ph + i) + crow(r, hi); ugv[r] = UG[(size_t)(row0 + p) * 256 + 64 * g + 32 * e + r32]; bsv[r] = bs[p]; }
            __builtin_amdgcn_sched_barrier(0);
#pragma unroll
            for (int r = 0; r < 16; ++r) { const int p = 32 * (2 * ph + i) + crow(r, hi), ch = 64 * g + 32 * e + r32;
                A[(size_t)(row0 + p) * DM + 768 + ch] = (bf16_t)f2bf(bf2f(ugv[r]) * (acc[i][e][r] + bsv[r])); }
            __builtin_amdgcn_sched_barrier(0);
        }
    __syncthreads();
}

__device__ __forceinline__ void ctxf_unit(const Args& a, int l, LAS unsigned char* lds, int unit, int tid, int lane, int wave) {
    unsigned char* ws = a.ws;
    const int b = unit >> 2, chq = unit & 3;
    const bf16_t* Z2 = (const bf16_t*)(ws + WS_Z2);
    stage_pieces<512, 64>(lds, [&](int k) { return Z2 + (size_t)(MLAT + b * NCTX + (k & 255)) * 512 + (k >> 8) * 256 + chq * 64; }, tid);
    __syncthreads();
    const int mb = wave, hi = lane >> 5, r32 = lane & 31, lo = tr_lane_off(lane);
    const bf16_t* img = (const bf16_t*)(ws + WS_TC256);
    f32x16 acc[2]; acc[0] = f32x16{}; acc[1] = f32x16{};
#pragma unroll
    for (int sh = 0; sh < 2; ++sh) { bf16x8 af[16];
#pragma unroll
        for (int s = 0; s < 16; ++s) af[s] = afrag_img(img, 32, mb, 16 * sh + s, lane);
#pragma unroll
        for (int s = 0; s < 16; ++s) { acc[0] = MFMA32(af[s], bfrag(lds + ((16 * sh + s) * 2) * 1024 + lo), acc[0]); acc[1] = MFMA32(af[s], bfrag(lds + ((16 * sh + s) * 2 + 1) * 1024 + lo), acc[1]); } }
    const bf16_t* GS = (const bf16_t*)(ws + WS_GS); bf16_t* A = (bf16_t*)(ws + WS_A);
#pragma unroll
    for (int e = 0; e < 2; ++e) { unsigned short gv[16]; const float bfv = a.in[I_BF][l * 256 + 64 * chq + 32 * e + r32];
#pragma unroll
        for (int r = 0; r < 16; ++r) { const size_t row = MLAT + b * NCTX + 32 * mb + crow(r, hi); gv[r] = GS[row * 768 + 512 + 64 * chq + 32 * e + r32]; }
        __builtin_amdgcn_sched_barrier(0);
#pragma unroll
        for (int r = 0; r < 16; ++r) { const size_t row = MLAT + b * NCTX + 32 * mb + crow(r, hi);
            A[row * DM + 512 + 64 * chq + 32 * e + r32] = (bf16_t)f2bf((acc[e][r] * (1.0f / 128.0f) + bfv) * bf2f(gv[r])); }
        __builtin_amdgcn_sched_barrier(0); }
    __syncthreads();
}

__device__ __forceinline__ void f2_unit(const Args& a, int l, LAS unsigned char* lds, int unit, int tid, int lane, int wave) {
    unsigned char* ws = a.ws;
    const int b = unit >> 7, k1 = unit & 127;
    const bf16_t* Z2 = (const bf16_t*)(ws + WS_Z2);
    stage_pieces<128, 256>(lds, [&](int k) { return Z2 + (size_t)(b * SEQ + 64 * k1 + (k & 63)) * 512 + (k >> 6) * 256; }, tid);
    bf16x8 ta0[8], ta1[8];
    { const bf16_t* img_ = (const bf16_t*)(ws + WS_T64);
#pragma unroll
      for (int s = 0; s < 8; ++s) { ta0[s] = afrag_img(img_, 8, 0, s, lane); ta1[s] = afrag_img(img_, 8, 1, s, lane); } }
    __syncthreads();
    const int cb = wave, hi = lane >> 5, r32 = lane & 31, lo = tr_lane_off(lane);
    f32x16 acc[2]; acc[0] = f32x16{}; acc[1] = f32x16{};
#pragma unroll
    for (int s = 0; s < 8; ++s) { const bf16x8 bf = bfrag(lds + (s * 8 + cb) * 1024 + lo);
        acc[0] = MFMA32(ta0[s], bf, acc[0]); acc[1] = MFMA32(ta1[s], bf, acc[1]); }
    const bf16_t* GS = (const bf16_t*)(ws + WS_GS); bf16_t* A = (bf16_t*)(ws + WS_A);
    const float nrm = 0.0013810679320049757f;
    const float bfv = a.in[I_BF][l * 256 + 32 * cb + r32];
#pragma unroll
    for (int mb = 0; mb < 2; ++mb) {
        unsigned short gv[16];
#pragma unroll
        for (int r = 0; r < 16; ++r) { const size_t row = (size_t)b * SEQ + k1 + 128 * (32 * mb + crow(r, hi)); gv[r] = GS[row * 768 + 512 + 32 * cb + r32]; }
        __builtin_amdgcn_sched_barrier(0);
#pragma unroll
        for (int r = 0; r < 16; ++r) { const size_t row = (size_t)b * SEQ + k1 + 128 * (32 * mb + crow(r, hi));
            A[row * DM + 512 + 32 * cb + r32] = (bf16_t)f2bf((acc[mb][r] * nrm + bfv) * bf2f(gv[r])); }
        __builtin_amdgcn_sched_barrier(0);
    }
    __syncthreads();
}

#ifndef DMA_TWICE
#define DMA_TWICE 0
#endif
#ifndef EXTRA_EXP
#define EXTRA_EXP 0
#endif
#ifndef EXTRA_MFMA
#define EXTRA_MFMA 0
#endif
__device__ __forceinline__ void glds16(const void* gsrc, unsigned lds_dst) { unsigned keep;
    asm volatile("s_mov_b32 %0, m0\n\ts_mov_b32 m0, %2\n\ts_nop 0\n\tglobal_load_lds_dwordx4 %1, off\n\ts_mov_b32 m0, %0" : "=&s"(keep) : "v"(gsrc), "s"(lds_dst) : "memory"); }
__device__ __forceinline__ void glds16x2(const void* gsrc, unsigned lds_dst) { unsigned keep;
    asm volatile("s_mov_b32 %0, m0\n\ts_mov_b32 m0, %2\n\ts_nop 0\n\tglobal_load_lds_dwordx4 %1, off\n\tglobal_load_lds_dwordx4 %1, off offset:1024\n\ts_mov_b32 m0, %0" : "=&s"(keep) : "v"(gsrc), "s"(lds_dst) : "memory"); }
__device__ __forceinline__ void attn_unit(const Args& a, int l, LAS unsigned char* lds, int b, int h, int qrow0, int t0, int nt, int tid, int lane, int wave, bool dry) {
    unsigned char* ws = a.ws;
    const int comp = wave >> 2, qg = wave & 3, hi = lane >> 5, r32 = lane & 31;
    const bf16_t* Qg = (const bf16_t*)(ws + WS_QG);
    const unsigned char* kimg = ws + WS_KIMG + (size_t)(b * 4 + h) * NKT * 16384;
    const unsigned char* vimg = ws + WS_VIMG + (size_t)(b * 4 + h) * NKT * 16384;
    bf16x8 qr[4];
    { const bf16_t* qp = Qg + ((size_t)(qrow0 + 32 * qg + r32) * 4 + h) * 128 + comp * 64 + 8 * hi;
#pragma unroll
      for (int d0 = 0; d0 < 4; ++d0) qr[d0] = *(const bf16x8*)(qp + 16 * d0); }
    asm volatile("" : "+v"(qr[0]), "+v"(qr[1]), "+v"(qr[2]), "+v"(qr[3]));
    f32x16 o[4];
#pragma unroll
    for (int d = 0; d < 4; ++d) o[d] = f32x16{};
    float lsum = 0.f;
    const int lo = tr_lane_off(lane);
    const unsigned lds0 = (unsigned)(uintptr_t)lds;
    constexpr int KSL = 16384, VBASE = 3 * KSL;
#define ATT_DMA_K(t, slotb) do { const unsigned char* s_ = kimg + (size_t)(t) * 16384 + wave * 2048 + lane * 16; const unsigned d_ = (unsigned)__builtin_amdgcn_readfirstlane((int)(lds0 + (slotb) + wave * 2048)); \
        glds16x2(s_, d_); if (DMA_TWICE) glds16x2(s_, d_); } while (0)
#define ATT_DMA_V(t, slotb) do { const unsigned char* s_ = vimg + (size_t)(t) * 16384 + wave * 2048 + lane * 16; const unsigned d_ = (unsigned)__builtin_amdgcn_readfirstlane((int)(lds0 + VBASE + (slotb) + wave * 2048)); \
        glds16x2(s_, d_); if (DMA_TWICE) glds16x2(s_, d_); } while (0)
#define ATT_WAIT_BAR(N) asm volatile("s_waitcnt vmcnt(" #N ") lgkmcnt(0)\n\ts_barrier" ::: "memory")
#define SBAR() __builtin_amdgcn_sched_barrier(0)
#define PIN(x) asm volatile("" : "+v"(x))
    LAS const unsigned char* kp0 = lds + comp * 8192 + hi * 1024 + r32 * 16;
    LAS const unsigned char* vp0 = lds + VBASE + lo;
    bf16x8 kf[8];
#define KRD(j, slotb) do { kf[j] = *(const LAS bf16x8*)(kp0 + (slotb) + ((j) >> 1) * 2048 + ((j) & 1) * 512); } while (0)
    f32x16 pA0 = f32x16{}, pA1 = f32x16{}, pB0, pB1;
    u32x4 pw0, pw1, pw2, pw3;
    bf16x8 vA[8], vB[8];
    int sl_prev = 0, sl_cur = 0, sl_next = KSL;
#define ROT() do { sl_prev = sl_cur; sl_cur = sl_next; sl_next = (sl_next == 2 * KSL) ? 0 : sl_next + KSL; } while (0)
    ATT_DMA_K(t0, 0); ATT_DMA_V(t0, 0); ATT_DMA_K(t0 + 1, KSL); ATT_DMA_K(t0 + 2, 2 * KSL);
    ATT_WAIT_BAR(0);
#pragma unroll
    for (int j = 0; j < 8; ++j) KRD(j, 0);
    ATT_WAIT_BAR(0);
#define PKW(P, B) cvt_pk_bf16(P[B], P[B + 1])
#define EX(v) __builtin_amdgcn_exp2f(v)
#define GAPA(i, C, CIN, a0, a1, a2, a3, W0, W1, PWV) do { vA[i] = bfrag(vpp_ + (i) * 1024); SBAR(); \
        C = MFMA32(kf[i], qr[(i) >> 1], CIN); if (EXTRA_MFMA) dacc = MFMA32(kf[i], qr[(i) >> 1], dacc); sacc += a0; sacc += a1; sacc += a2; sacc += a3; PIN(sacc); W0; W1; PIN(PWV); SBAR(); } while (0)
#define GAPB_V(j, d, PWV, X, B) do { o[d] = MFMA32(__builtin_bit_cast(bf16x8, PWV), vA[j], o[d]); X[B] = EX(X[B]); X[B + 1] = EX(X[B + 1]); PIN(X); if (EXTRA_EXP) { dmy = EX(dmy); PIN(dmy); } vB[j] = bfrag(vpp_ + (8 + (j)) * 1024); SBAR(); } while (0)
#define GAPB_K(j, d, PWV, X, B) do { o[d] = MFMA32(__builtin_bit_cast(bf16x8, PWV), vB[(j) - 8], o[d]); X[B] = EX(X[B]); X[B + 1] = EX(X[B + 1]); PIN(X); if (EXTRA_EXP) { dmy = EX(dmy); PIN(dmy); } KRD((j) - 8, sl_next); SBAR(); } while (0)
    const f32x16 zero16 = f32x16{}; float dmy = 0.5f; (void)dmy; f32x16 dacc = f32x16{}; (void)dacc;
#define STEP(C0, C1, P0, P1, t) do { SBAR(); \
        LAS const unsigned char* vpp_ = vp0 + sl_prev; float sacc = 0.f; \
        GAPA(0, C0, zero16, P0[0], P0[1], P0[2], P0[3],     pw0[0] = PKW(P0, 0),  pw0[1] = PKW(P0, 2),  pw0); \
        GAPA(1, C1, zero16, P0[4], P0[5], P0[6], P0[7],     pw0[2] = PKW(P0, 4),  pw0[3] = PKW(P0, 6),  pw0); \
        GAPA(2, C0, C0,     P0[8], P0[9], P0[10], P0[11],   pw1[0] = PKW(P0, 8),  pw1[1] = PKW(P0, 10), pw1); \
        GAPA(3, C1, C1,     P0[12], P0[13], P0[14], P0[15], pw1[2] = PKW(P0, 12), pw1[3] = PKW(P0, 14), pw1); \
        GAPA(4, C0, C0,     P1[0], P1[1], P1[2], P1[3],     pw2[0] = PKW(P1, 0),  pw2[1] = PKW(P1, 2),  pw2); \
        GAPA(5, C1, C1,     P1[4], P1[5], P1[6], P1[7],     pw2[2] = PKW(P1, 4),  pw2[3] = PKW(P1, 6),  pw2); \
        GAPA(6, C0, C0,     P1[8], P1[9], P1[10], P1[11],   pw3[0] = PKW(P1, 8),  pw3[1] = PKW(P1, 10), pw3); \
        GAPA(7, C1, C1,     P1[12], P1[13], P1[14], P1[15], pw3[2] = PKW(P1, 12), pw3[3] = PKW(P1, 14), pw3); \
        lsum += sacc; \
        if ((t) + 3 < nt) ATT_DMA_K(t0 + (t) + 3, sl_cur); \
        if ((t) + 1 < nt) ATT_DMA_V(t0 + (t) + 1, sl_next); \
        SBAR(); \
        GAPB_V(0, 0, pw0, C0, 0);  GAPB_V(1, 0, pw1, C0, 2);  GAPB_V(2, 0, pw2, C0, 4);  GAPB_V(3, 0, pw3, C0, 6); \
        GAPB_V(4, 1, pw0, C0, 8);  GAPB_V(5, 1, pw1, C0, 10); GAPB_V(6, 1, pw2, C0, 12); GAPB_V(7, 1, pw3, C0, 14); \
        GAPB_K(8, 2, pw0, C1, 0);  GAPB_K(9, 2, pw1, C1, 2);  GAPB_K(10, 2, pw2, C1, 4); GAPB_K(11, 2, pw3, C1, 6); \
        GAPB_K(12, 3, pw0, C1, 8); GAPB_K(13, 3, pw1, C1, 10); GAPB_K(14, 3, pw2, C1, 12); GAPB_K(15, 3, pw3, C1, 14); \
        if ((t) + 3 < nt) { if (DMA_TWICE) ATT_WAIT_BAR(8); else ATT_WAIT_BAR(4); } else ATT_WAIT_BAR(0); \
        ROT(); } while (0)
#pragma unroll 1
    for (int t = 0; t < nt; t += 2) {
        STEP(pB0, pB1, pA0, pA1, t);
        STEP(pA0, pA1, pB0, pB1, t + 1);
    }
    {
        float sacc = 0.f;
#pragma unroll
        for (int r = 0; r < 16; ++r) sacc += pA0[r] + pA1[r];
        lsum += sacc;
        pw0 = (u32x4){PKW(pA0, 0), PKW(pA0, 2), PKW(pA0, 4), PKW(pA0, 6)}; pw1 = (u32x4){PKW(pA0, 8), PKW(pA0, 10), PKW(pA0, 12), PKW(pA0, 14)};
        pw2 = (u32x4){PKW(pA1, 0), PKW(pA1, 2), PKW(pA1, 4), PKW(pA1, 6)}; pw3 = (u32x4){PKW(pA1, 8), PKW(pA1, 10), PKW(pA1, 12), PKW(pA1, 14)};
        LAS const unsigned char* vpp_ = vp0 + sl_prev;
#pragma unroll
        for (int d = 0; d < 4; ++d) {
            const bf16x8 f0 = bfrag(vpp_ + (d * 4 + 0) * 1024), f1 = bfrag(vpp_ + (d * 4 + 1) * 1024), f2 = bfrag(vpp_ + (d * 4 + 2) * 1024), f3 = bfrag(vpp_ + (d * 4 + 3) * 1024);
            o[d] = MFMA32(__builtin_bit_cast(bf16x8, pw0), f0, o[d]); o[d] = MFMA32(__builtin_bit_cast(bf16x8, pw1), f1, o[d]);
            o[d] = MFMA32(__builtin_bit_cast(bf16x8, pw2), f2, o[d]); o[d] = MFMA32(__builtin_bit_cast(bf16x8, pw3), f3, o[d]);
        }
    }
    ATT_WAIT_BAR(0);
#undef ATT_DMA_K
#undef ATT_DMA_V
#undef ATT_WAIT_BAR
#undef SBAR
#undef PIN
#undef KRD
#undef ROT
#undef PKW
#undef EX
#undef GAPA
#undef GAPB_V
#undef GAPB_K
#undef STEP
    if (EXTRA_MFMA) asm volatile("" :: "v"(dacc));
    if (dry) return;
    LAS float* ost = (LAS float*)lds;
    LAS float* lw = (LAS float*)(lds + 72 * 1024);
    lsum += __shfl_xor(lsum, 32);
    if (hi == 0) lw[wave * 32 + r32] = lsum;
    LDS_WAIT(); asm volatile("" ::: "memory");
    const float* lamp = (const float*)(ws + WS_LAM) + 2 * l;
    const float lam = lamp[0], oscale = lamp[1];
    float rl[16];
#pragma unroll
    for (int r = 0; r < 16; ++r) rl[r] = __builtin_amdgcn_rcpf(lw[wave * 32 + crow(r, hi)]);
    if (comp == 0) {
#pragma unroll
        for (int d = 0; d < 4; ++d)
#pragma unroll
            for (int r = 0; r < 16; ++r) ost[(32 * qg + crow(r, hi)) * 132 + 32 * d + r32] = o[d][r] * rl[r];
    }
    __syncthreads();
    if (comp == 1) {
#pragma unroll
        for (int d = 0; d < 4; ++d)
#pragma unroll
            for (int r = 0; r < 16; ++r) ost[(32 * qg + crow(r, hi)) * 132 + 32 * d + r32] -= lam * o[d][r] * rl[r];
    }
    __syncthreads();
    {
        const int row = tid >> 2, qt = tid & 3; const LAS float* src = ost + row * 132 + 32 * qt;
        float v[32]; float ss = 0.f;
#pragma unroll
        for (int i = 0; i < 32; ++i) { v[i] = src[i]; ss += v[i] * v[i]; }
        ss += __shfl_xor(ss, 1); ss += __shfl_xor(ss, 2);
        const float rstd = rsqrtf(ss * (1.0f / 128.0f) + EPS) * oscale;
        const size_t grow = (size_t)qrow0 + row;
        const bf16_t* gs = (const bf16_t*)(ws + WS_GS) + grow * 768 + h * 128 + 32 * qt;
        bf16_t* dst = (bf16_t*)(ws + WS_A) + grow * DM + h * 128 + 32 * qt;
        const float* gsub = a.in[I_GSUB] + l * 128 + 32 * qt;
#pragma unroll
        for (int i = 0; i < 4; ++i) { const u32x4 gw = *(const u32x4*)(gs + 8 * i); u32x4 w;
#pragma unroll
            for (int e = 0; e < 4; ++e) { const int j = 8 * i + 2 * e; w[e] = pk2(v[j] * rstd * gsub[j] * bflo(gw[e]), v[j + 1] * rstd * gsub[j + 1] * bfhi(gw[e])); }
            *(u32x4*)(dst + 8 * i) = w; }
    }
    __syncthreads();
}

#ifndef REPEAT_PHASE
#define REPEAT_PHASE (-1)
#endif
constexpr int N_PHASES = 10 + (REPEAT_PHASE >= 0 ? 1 : 0);
__global__ void __launch_bounds__(NTHREADS, 2) fwd_kernel(Args args) {
    extern __shared__ __attribute__((aligned(16))) unsigned char lds_raw[];
    LAS unsigned char* lds = (LAS unsigned char*)lds_raw;
    const int tid = threadIdx.x, lane = tid & 63, wave = __builtin_amdgcn_readfirstlane(tid >> 6);
    const int bx = blockIdx.x, vcu = (bx % 8) * (GRID / 8) + bx / 8;
    unsigned char* ws = args.ws;
    volatile LAS unsigned* MISC = (volatile LAS unsigned*)(lds + MISC_OFF);
    for (int u = tid; u < 32; u += NTHREADS) MISC[u] = 0u;
    __syncthreads();
    XcdBarrier bar; bar.bar = (unsigned*)(ws + WS_CTL) + CW_BAR; bar.x = 0; bar.st = nullptr;
    const bool one_launch = (args.ph_hi - args.ph_lo) > 1;
    if (one_launch) { bar = xcd_barrier_post((unsigned*)(ws + WS_CTL) + CW_BAR, MISC + 8);
        if (tid == 0) { unsigned nloc, nx; xcd_barrier_complete(bar.bar, bar.x, nloc, nx); MISC[8] = nloc; MISC[9] = nx; }
        __syncthreads(); }
#ifndef REPEAT_PHASE
#define REPEAT_PHASE (-1)
#endif
#ifndef PRO_PROBE
#define PRO_PROBE 15
#endif
#ifndef PHMASK
#define PHMASK 0xffff
#endif
#define EN(b) (((PHMASK) >> (b)) & 1)
#define LAUNDER() int wave_ = wave, vcu_ = vcu; asm volatile("" : "+s"(wave_)); asm volatile("" : "+s"(vcu_)); int lane_ = (int)__builtin_amdgcn_mbcnt_hi(~0u, __builtin_amdgcn_mbcnt_lo(~0u, 0u)); asm volatile("" : "+v"(lane_)); const int tid_ = wave_ * 64 + lane_; (void)lane_; (void)wave_
#pragma unroll 1
    for (int pc = args.ph_lo; pc < args.ph_hi; ++pc) {
        const int ph = (REPEAT_PHASE >= 0 && pc > REPEAT_PHASE) ? pc - 1 : pc;
        const int l = ph >= 5 ? 1 : 0;
        const bool second = (REPEAT_PHASE >= 0 && pc == REPEAT_PHASE + 1); (void)second;
        const int kind = ph == 0 ? 6 : (ph == 5 ? 7 : (ph < 5 ? ph - 1 : ph - 6));
        const bf16_t* Wl = (const bf16_t*)(ws + WS_WIN) + (size_t)l * NPHYS * DM;
        LAUNDER();
        if (kind == 6) { if (EN(0)) {
            unsigned* sp0 = (unsigned*)(ws + WS_CTL) + 8192 + 4096;
            ph0_mods(args, lane_, wave_, vcu_);
            split_arrive(sp0, bar, one_launch);
            ph0_prologue(args, lds, tid_, lane_, wave_, vcu_, second ? PRO_PROBE : 7);
            split_wait(sp0, bar, one_launch, (unsigned*)(ws + WS_CTL) + CW_BAR + XB_TMO); } }
        if (kind == 6 || kind == 7) { if (EN(1)) { int wave2 = wave, vcu2 = vcu; asm volatile("" : "+s"(wave2)); asm volatile("" : "+s"(vcu2)); int lane2 = (int)__builtin_amdgcn_mbcnt_hi(~0u, __builtin_amdgcn_mbcnt_lo(~0u, 0u)); asm volatile("" : "+v"(lane2)); const int tid2 = wave2 * 64 + lane2;
            prepass(args, kind == 6 ? 0 : 1, lds, tid2, lane2, wave2, vcu2); } }
        else if (kind == 0) { if (EN(2)) {
            pg8::Gemm g{(const bf16_t*)(ws + WS_H), Wl, DM, DM, 0, 0, 0, 16, 16, 16, nullptr, nullptr, 0};
            TileSched S{vcu_ >> 5, vcu_ & 31, 0, 14, 1, l == 0 ? 52 : 8, l == 0 ? 0 : 2, l == 0 ? 26 : 4};
            EpiIn E{ws, args.in[I_GQ] + l * 64, args.in[I_GK] + l * 64, (LAS const float*)(lds + ROPE_LDS), (LAS const float*)(lds + ROPE_LDS) + 2048};
            { const float* rt = (const float*)(ws + WS_ROPE); LAS float* rl_ = (LAS float*)(lds + ROPE_LDS);
#pragma unroll
              for (int i = 0; i < 8; ++i) rl_[tid_ + i * NTHREADS] = rt[tid_ + i * NTHREADS];
              __syncthreads(); }
            pg8::gemm_phase<EpiIn, TileSched, true, true>(lds, g, S, E, tid_); } }
        else if (kind == 1) { if (EN(4)) {
            if (!second) {
                if (EN(8)) f1_unit(ws, lds, vcu_, tid_, lane_, wave_);
                const int nsgu = l == 0 ? 132 : 128;
                if (EN(9)) for (int cu = 255 - vcu_; cu < nsgu; cu += GRID) sgu_unit(args, l, lds, cu, tid_, lane_, wave_);
                if (EN(10) && l == 0 && vcu_ < 8) ctxf_unit(args, l, lds, vcu_, tid_, lane_, wave_);
            }
            const int bh = vcu_ >> 5, qb = vcu_ & 31;
            if (EN(12)) {
                const int nun = (l == 0 && qb < 2) ? 3 : 2;
#pragma unroll 1
                for (int ui = 0; ui < nun; ++ui) {
                    const int qrow0 = ui < 2 ? (bh >> 2) * SEQ + 256 * qb + 128 * ui : MLAT + (bh >> 2) * NCTX + 128 * qb;
                    attn_unit(args, l, lds, bh >> 2, bh & 3, qrow0, ui < 2 ? 0 : SEQ / 64, ui < 2 ? NKT : NCTX / 64, tid_, lane_, wave_, second);
                }
            } } }
        else if (kind == 2) { if (EN(5)) {
            unsigned* sp = (unsigned*)(ws + WS_CTL) + 8192 + l * 2048;
            if (EN(11)) f2_unit(args, l, lds, vcu_, tid_, lane_, wave_);
            split_arrive(sp, bar, one_launch);
            if (l == 0) ctx_branch_proj(ws, (const bf16_t*)(ws + WS_WBR), vcu_ * NWAVES + wave_, lane_);
            pg8::Gemm g{(const bf16_t*)(ws + WS_A), (const bf16_t*)(ws + WS_WBR) + (size_t)l * DM * DM, DM, DM, 0, 512, 768, 8, 4, 4, (const bf16_t*)(ws + WS_H), Wl, 16};
            FusedSched S{vcu_ >> 5, vcu_ & 31, sp, bar, one_launch, (unsigned*)(ws + WS_CTL) + CW_BAR + XB_TMO};
            EpiMY E{EpiIn{ws, nullptr, nullptr, nullptr, nullptr}, EpiY{(const unsigned char*)(ws + WS_MS), (bf16_t*)(ws + WS_Y)}};
            pg8::gemm_phase<EpiMY, FusedSched, true, true>(lds, g, S, E, tid_); } }
        else { if (EN(7)) {
            pg8::Gemm g{(const bf16_t*)(ws + WS_Y), (const bf16_t*)(ws + WS_WOUT) + (size_t)l * DM * DM, DM, DM, 0, 0, 0, 16, 16, 16, nullptr, nullptr, 0};
            TileSched S{vcu_ >> 5, vcu_ & 31, 0, 4, 1, 0, 0, 4};
            if (l == 0) ctx_out_proj(ws, (const bf16_t*)(ws + WS_WOUT), args.in[I_CTX], (const float*)(ws + WS_MODF) + 2 * 3072 + 2048, vcu_ * NWAVES + wave_, lane_);
            EpiOut E{args.in[I_X], args.out, ws, (const float*)(ws + WS_MODF) + (size_t)(l * 3) * 3072 + 2048, l};
            pg8::gemm_phase<EpiOut, TileSched, true, true>(lds, g, S, E, tid_); } }
        if (pc + 1 < args.ph_hi) { XcdBarrier b2_ = bar; asm volatile("" : "+s"(b2_.bar)); xcd_barrier(b2_); }
    }
}

extern "C" void kernel_launch(void* const* d_in, const int* in_sizes, int n_in, void* d_out, int out_size, void* d_ws, size_t ws_size, hipStream_t stream) {
    static int ready = 0;
    if (ready == 0) {
        if (n_in != 25 || out_size != MLAT * DM || ws_size < 256 * MiB) { fprintf(stderr, "kernel_launch: unexpected shapes (n_in %d out %d ws %zu)\n", n_in, out_size, ws_size); ready = -1; return; }
        int dev = 0, cus = 0, per_cu = 0;
        hipGetDevice(&dev); hipDeviceGetAttribute(&cus, hipDeviceAttributeMultiprocessorCount, dev);
        if (hipFuncSetAttribute((const void*)fwd_kernel, hipFuncAttributeMaxDynamicSharedMemorySize, LDS_BYTES) != hipSuccess) { fprintf(stderr, "kernel_launch: hipFuncSetAttribute failed\n"); ready = -1; return; }
        hipOccupancyMaxActiveBlocksPerMultiprocessor(&per_cu, (const void*)fwd_kernel, NTHREADS, LDS_BYTES);
        (void)hipGetLastError();
        if (cus != GRID || per_cu < 1) fprintf(stderr, "kernel_launch: note: %d CUs, occupancy %d blocks/CU (built for 256 CUs, 1 block/CU)\n", cus, per_cu);
        ready = (cus >= GRID) ? 1 : -1;
    }
    if (ready < 0) return;
    hipMemsetAsync((char*)d_ws + WS_CTL, 0, CTL_ZERO_BYTES, stream);
    Args a{};
    for (int i = 0; i < 25; ++i) a.in[i] = (const float*)d_in[i];
    a.out = (float*)d_out; a.ws = (unsigned char*)d_ws;
#if MK_N_LAUNCHES == 1
    a.ph_lo = 0; a.ph_hi = N_PHASES;
    hipLaunchKernelGGL(fwd_kernel, dim3(GRID), dim3(NTHREADS), LDS_BYTES, stream, a);
#else
    for (int p = 0; p < N_PHASES; ++p) { a.ph_lo = p; a.ph_hi = p + 1; hipLaunchKernelGGL(fwd_kernel, dim3(GRID), dim3(NTHREADS), LDS_BYTES, stream, a); }
#endif
}
```

```cpp
#include <hip/hip_runtime.h>
#include <cstdio>
#include <cstdint>

#ifndef MK_N_LAUNCHES
#define MK_N_LAUNCHES 1
#endif

#define LAS __attribute__((address_space(3)))
#define GAS __attribute__((address_space(1)))
typedef unsigned short bf16_t;
typedef short bf16x8 __attribute__((ext_vector_type(8)));
typedef short s16x4 __attribute__((ext_vector_type(4)));
typedef float f32x4 __attribute__((ext_vector_type(4)));
typedef float f32x2 __attribute__((ext_vector_type(2)));
typedef float f32x16 __attribute__((ext_vector_type(16)));
typedef unsigned u32x4 __attribute__((ext_vector_type(4)));
typedef unsigned u32x2 __attribute__((ext_vector_type(2)));

constexpr int DM = 1024, BATCH = 2, SEQ = 8192, NCTX = 256, DEPTH = 2;
constexpr int MLAT = BATCH * SEQ, MCTX = BATCH * NCTX, MT = MLAT + MCTX;
constexpr int NKEY = SEQ + NCTX, NKT = NKEY / 64;
constexpr int INW = 6400;
constexpr int OFF_Q = 0, OFF_K = 512, OFF_V = 1024, OFF_F = 1536, OFF_U = 1792, OFF_VC = 2048, OFF_GATE = 2304, OFF_MERGE = 3328;
constexpr int NPHYS = 6656;
constexpr float EPS = 1e-6f;
constexpr float QSCALE = 0.125f * 1.4426950408889634f;

constexpr size_t KiB = 1024, MiB = 1u << 20;
constexpr size_t WS_CTL = 0, CTL_ZERO_BYTES = 64 * KiB;
constexpr size_t WS_MODP = 1 * MiB;
constexpr size_t WS_MODF = WS_MODP + 2304 * KiB;
constexpr size_t WS_ROPE = WS_MODF + 72 * KiB;
constexpr size_t WS_TW = WS_ROPE + 16 * KiB;
constexpr size_t WS_LAM = WS_TW + 64 * KiB;
constexpr size_t WS_C128 = WS_LAM + 1 * KiB;
constexpr size_t WS_S128 = WS_C128 + 32 * KiB;
constexpr size_t WS_T64 = WS_S128 + 32 * KiB;
constexpr size_t WS_TC256 = WS_T64 + 16 * KiB;
constexpr size_t WS_WSIMG = WS_TC256 + 256 * KiB;
constexpr size_t WS_SMALL_END = WS_WSIMG + 256 * KiB;
static_assert(WS_SMALL_END <= 5 * MiB, "small tables");
constexpr size_t WS_WIN = 5 * MiB;
constexpr size_t WS_WBR = 31 * MiB;
constexpr size_t WS_WOUT = 35 * MiB;
constexpr size_t WS_CTX1 = 39 * MiB;
constexpr size_t WS_H = 41 * MiB;
constexpr size_t WS_A = 74 * MiB;
constexpr size_t WS_R = 107 * MiB;
constexpr size_t SZ_QG = (size_t)MT * 512 * 2, SZ_KIMG = (size_t)BATCH * 4 * NKT * 16384, SZ_Z2 = (size_t)MT * 512 * 2, SZ_UG = (size_t)MT * 256 * 2, SZ_GS = (size_t)MT * 768 * 2;
constexpr size_t WS_QG = WS_R, WS_KIMG = WS_QG + SZ_QG, WS_VIMG = WS_KIMG + SZ_KIMG, WS_Z2 = WS_VIMG + SZ_KIMG, WS_UG = WS_Z2 + SZ_Z2, WS_VC = WS_UG + SZ_UG, WS_GS = WS_VC + SZ_UG;
constexpr size_t WS_Y = WS_Z2;
static_assert(WS_Z2 + (size_t)MT * DM * 2 == WS_GS, "Y overlays Z2 | UG | VC exactly");
constexpr size_t WS_MS = WS_R;
constexpr size_t WS_END = WS_GS + SZ_GS;
constexpr size_t WS_X1B0 = 229 * MiB, WS_X1B1 = 215 * MiB;
constexpr int X1B_SPLIT = 13824;
constexpr size_t WS_MSC = 224 * MiB;
static_assert(WS_X1B1 >= WS_END && WS_X1B1 + (size_t)(MLAT - X1B_SPLIT) * 2048 <= WS_MSC && WS_MSC + (size_t)MCTX * 3072 <= WS_X1B0 && WS_X1B0 + (size_t)X1B_SPLIT * 2048 <= 256 * MiB, "x1b map");
static_assert(WS_MS + (size_t)MT * 3072 <= WS_Z2 && WS_END <= WS_MSC && WS_MSC + (size_t)MCTX * 3072 * 2 <= 256 * MiB, "d_ws map");

__host__ __device__ __forceinline__ size_t x1b_off(int row) { return row < X1B_SPLIT ? WS_X1B0 + (size_t)row * 2048 : WS_X1B1 + (size_t)(row - X1B_SPLIT) * 2048; }
__device__ __forceinline__ unsigned f2bf(float f) { unsigned u = __builtin_bit_cast(unsigned, f); return (u + 0x7fffu + ((u >> 16) & 1u)) >> 16; }
__device__ __forceinline__ unsigned pk2(float lo, float hi) { return f2bf(lo) | (f2bf(hi) << 16); }
__device__ __forceinline__ unsigned cvt_pk_bf16(float lo, float hi) { unsigned r; asm volatile("v_cvt_pk_bf16_f32 %0, %1, %2" : "=v"(r) : "v"(lo), "v"(hi)); return r; }
__device__ __forceinline__ float bf2f(unsigned short v) { return __builtin_bit_cast(float, (unsigned)v << 16); }
__device__ __forceinline__ float bflo(unsigned w) { return __builtin_bit_cast(float, w << 16); }
__device__ __forceinline__ float bfhi(unsigned w) { return __builtin_bit_cast(float, w & 0xffff0000u); }
__device__ __forceinline__ float fast_sigmoid(float x) { return __builtin_amdgcn_rcpf(1.0f + __builtin_amdgcn_exp2f(-1.4426950408889634f * x)); }
__device__ __forceinline__ unsigned ms_quant_pk(float x, unsigned sel, unsigned old) { const float q = __builtin_amdgcn_rcpf((1.0f / 255.0f) + __builtin_amdgcn_exp2f(__builtin_fmaf(x, -1.4426950408889634f, -7.994353436858858f)));
    return __builtin_amdgcn_cvt_pk_u8_f32(__builtin_fmaxf(q, 1.0f), sel, old); }
__device__ __forceinline__ float ub(unsigned w, int i) { return (float)((w >> (8 * i)) & 0xffu); }
__device__ __forceinline__ float fast_silu(float x) { return x * fast_sigmoid(x); }
__device__ __forceinline__ int crow(int r, int hi) { return (r & 3) + 8 * (r >> 2) + 4 * hi; }
__host__ __device__ __forceinline__ int perm32(int rho) { const int n = rho >> 4, i = rho & 15; return 8 * (i >> 2) + 4 * n + (i & 3); }
__host__ __device__ __forceinline__ int invperm32(int c) { return 16 * ((c >> 2) & 1) + 4 * (c >> 3) + (c & 3); }
#define LDS_WAIT() asm volatile("s_waitcnt lgkmcnt(0)" ::: "memory")
#define VM_WAIT() asm volatile("s_waitcnt vmcnt(0)" ::: "memory")

namespace pg8 {
constexpr int BM = 256, BK = 64, HALF = 128, HTB = HALF * BK * 2  , STAGE_BYTES = 8 * HTB;
__host__ __device__ __forceinline__ int lds_byte(int r, int c) { const int st = (r >> 4) * 2 + (c >> 5), rr = r & 15, cc = c & 31, ob = rr * 64 + cc * 2; return st * 1024 + (ob ^ (((ob >> 9) & 1) << 5)); }
__host__ __device__ __forceinline__ void stage_rc(int b, int& R, int& C) { const int st = b / 1024, sb = b % 1024, swz = sb ^ (((sb >> 9) & 1) << 5); R = (st >> 1) * 16 + swz / 64; C = (st & 1) * 32 + (swz % 64) / 2; }

struct Unit { int pm, pn, seg, set; };
struct Gemm { const bf16_t* A; const bf16_t* Bt; int lda, ldb; int k0_0, k0_1, k0_2; int nt_0, nt_1, nt_2; const bf16_t* A1; const bf16_t* Bt1; int nt_set1; };

template <class Epi, class Sched, bool ALIGN_EPI = false, bool SP2 = false>
__device__ __forceinline__ void gemm_phase(LAS unsigned char* lds, const Gemm g, const Sched& S, const Epi& E, const int tid) {
    const int wid = __builtin_amdgcn_readfirstlane(tid >> 6), lane = tid & 63, wr = wid >> 2, wc = wid & 3, fr = lane & 15, fq = lane >> 4;
    unsigned voffA[2], voffB[2];
#pragma unroll
    for (int i = 0; i < 2; ++i) { int R, C; stage_rc(tid * 16 + i * 8192, R, C); voffA[i] = (unsigned)(R * g.lda + C) * 2u; voffB[i] = (unsigned)(R * g.ldb + C) * 2u; }
    const size_t kstep = (size_t)(BK * 2);
    const size_t hstepA = (size_t)HALF * g.lda * 2, hstepB = (size_t)HALF * g.ldb * 2;
    const size_t tstepA = 2 * hstepA, tstepB = 2 * hstepB;
    const unsigned ldsw = (unsigned)wid * 1024u;
    const int aoff = lds_byte(wr * 64 + fr, fq * 8), boff = lds_byte(wc * 32 + fr, fq * 8);
#define PG8_SA(b, h) (((b) * 2 + (h)) * HTB)
#define PG8_SB(b, h) ((4 + (b) * 2 + (h)) * HTB)
#define PG8_STAGE(bufoff, gbase, voff) do { _Pragma("unroll") for (int _i = 0; _i < 2; ++_i) \
        __builtin_amdgcn_global_load_lds((const unsigned*)((const char*)(gbase) + (voff)[_i]), (LAS unsigned*)(lds + (bufoff) + ldsw + _i * 8192), 16, 0, 0); } while (0)
#define PG8_LDA(dst, b, h) do { _Pragma("unroll") for (int m = 0; m < 4; ++m) _Pragma("unroll") for (int k = 0; k < 2; ++k) dst[m][k] = *(const LAS bf16x8*)(lds + PG8_SA(b, h) + aoff + m * 2048 + k * 1024); } while (0)
#define PG8_LDB(dst, b, h) do { _Pragma("unroll") for (int n = 0; n < 2; ++n) _Pragma("unroll") for (int k = 0; k < 2; ++k) dst[n][k] = *(const LAS bf16x8*)(lds + PG8_SB(b, h) + boff + n * 2048 + k * 1024); } while (0)
#define PG8_MMA(ai, bj, At, Bt) do { __builtin_amdgcn_s_setprio(1); _Pragma("unroll") for (int m = 0; m < 4; ++m) _Pragma("unroll") for (int n = 0; n < 2; ++n) _Pragma("unroll") for (int k = 0; k < 2; ++k) \
        acc[ai][bj][m][n] = __builtin_amdgcn_mfma_f32_16x16x32_bf16(Bt[n][k], At[m][k], acc[ai][bj][m][n], 0, 0, 0); __builtin_amdgcn_s_setprio(0); } while (0)
#define PG8_WAIT_V(n) asm volatile("s_waitcnt vmcnt(" #n ")" ::: "memory")
#define PG8_WAIT_L(n) asm volatile("s_waitcnt lgkmcnt(" #n ")" ::: "memory")
#define PG8_BAR __builtin_amdgcn_s_barrier()
#define PG8_SCHED __builtin_amdgcn_sched_barrier(0)
#define PG8_K0(u) ((u).set ? 0 : ((u).seg == 0 ? g.k0_0 : ((u).seg == 1 ? g.k0_1 : g.k0_2)))
#define PG8_NT(u) ((u).set ? g.nt_set1 : ((u).seg == 0 ? g.nt_0 : ((u).seg == 1 ? g.nt_1 : g.nt_2)))
#define PG8_UA(u) ((const char*)((u).set ? g.A1 : g.A) + (size_t)(u).pm * tstepA + (size_t)PG8_K0(u) * 2)
#define PG8_UB(u) ((const char*)((u).set ? g.Bt1 : g.Bt) + (size_t)(u).pn * tstepB + (size_t)PG8_K0(u) * 2)
    Unit cur, nxt; int ui = 0;
    if (!S.next(0, cur)) return;
    f32x4 acc[2][2][4][2];
#pragma unroll
    for (int a = 0; a < 2; ++a)
#pragma unroll
        for (int b = 0; b < 2; ++b)
#pragma unroll
            for (int m = 0; m < 4; ++m)
#pragma unroll
                for (int n = 0; n < 2; ++n) acc[a][b][m][n] = (f32x4){0.f, 0.f, 0.f, 0.f};
    bf16x8 At[4][2], B0[2][2], B1[2][2];
    const char* cA = PG8_UA(cur); const char* cB = PG8_UB(cur); int nt = PG8_NT(cur);
    if constexpr (SP2) {
        PG8_STAGE(PG8_SB(0, 0), cB, voffB); PG8_STAGE(PG8_SB(0, 1), cB + hstepB, voffB); PG8_STAGE(PG8_SA(0, 0), cA, voffA); PG8_STAGE(PG8_SA(0, 1), cA + hstepA, voffA);
        if (wr == 1) PG8_BAR;
        PG8_WAIT_V(2); PG8_BAR;
        PG8_STAGE(PG8_SB(1, 0), cB + kstep, voffB); PG8_STAGE(PG8_SA(1, 0), cA + kstep, voffA); PG8_STAGE(PG8_SB(1, 1), cB + hstepB + kstep, voffB);
        PG8_WAIT_V(6); PG8_BAR;
    } else {
        PG8_STAGE(PG8_SB(0, 0), cB, voffB); PG8_STAGE(PG8_SA(0, 0), cA, voffA); PG8_STAGE(PG8_SB(0, 1), cB + hstepB, voffB); PG8_STAGE(PG8_SA(0, 1), cA + hstepA, voffA);
        if (wr == 1) PG8_BAR;
        PG8_WAIT_V(4); PG8_BAR;
        PG8_STAGE(PG8_SB(1, 0), cB + kstep, voffB); PG8_STAGE(PG8_SA(1, 0), cA + kstep, voffA); PG8_STAGE(PG8_SB(1, 1), cB + hstepB + kstep, voffB);
        PG8_WAIT_V(6); PG8_BAR;
    }
    for (;;) {
        const bool has_next = S.next(ui + 1, nxt);
        const char* nA = has_next ? PG8_UA(nxt) : cA; const char* nB = has_next ? PG8_UB(nxt) : cB;
        for (int t = 0; t < nt; t += 2) {
            const bool last = (t == nt - 2);
            if (last && has_next) S.a_ready(nxt);
            const char* a1 = cA + (size_t)(t + 1) * kstep;
            const char* a2 = last ? nA : cA + (size_t)(t + 2) * kstep; const char* b2 = last ? nB : cB + (size_t)(t + 2) * kstep;
            const char* a3 = a2 + kstep; const char* b3 = b2 + kstep;
            if constexpr (SP2) {
            PG8_LDB(B0, 0, 0); PG8_LDB(B1, 0, 1); PG8_SCHED; PG8_LDA(At, 0, 0); PG8_STAGE(PG8_SA(1, 1), a1 + hstepA, voffA);
            PG8_WAIT_V(8); PG8_WAIT_L(0); PG8_BAR; PG8_MMA(0, 0, At, B0); PG8_MMA(0, 1, At, B1); PG8_BAR; PG8_SCHED;
            PG8_LDA(At, 0, 1); PG8_STAGE(PG8_SB(0, 0), b2, voffB); PG8_STAGE(PG8_SB(0, 1), b2 + hstepB, voffB); PG8_STAGE(PG8_SA(0, 0), a2, voffA);
            PG8_WAIT_V(8); PG8_WAIT_L(0); PG8_BAR; PG8_MMA(1, 0, At, B0); PG8_MMA(1, 1, At, B1); PG8_BAR; PG8_SCHED;
            PG8_LDB(B0, 1, 0); PG8_LDB(B1, 1, 1); PG8_SCHED; PG8_LDA(At, 1, 0); PG8_STAGE(PG8_SA(0, 1), a2 + hstepA, voffA);
            PG8_WAIT_V(8); PG8_WAIT_L(0); PG8_BAR; PG8_MMA(0, 0, At, B0); PG8_MMA(0, 1, At, B1); PG8_BAR; PG8_SCHED;
            PG8_LDA(At, 1, 1); PG8_STAGE(PG8_SB(1, 0), b3, voffB); PG8_STAGE(PG8_SB(1, 1), b3 + hstepB, voffB); PG8_STAGE(PG8_SA(1, 0), a3, voffA);
            PG8_WAIT_V(8); PG8_WAIT_L(0); PG8_BAR; PG8_MMA(1, 0, At, B0); PG8_MMA(1, 1, At, B1); PG8_BAR; PG8_SCHED;
            } else {
            PG8_LDB(B0, 0, 0); PG8_SCHED; PG8_LDA(At, 0, 0); PG8_STAGE(PG8_SA(1, 1), a1 + hstepA, voffA);
            PG8_WAIT_L(8); PG8_BAR; PG8_WAIT_L(0); PG8_MMA(0, 0, At, B0); PG8_BAR; PG8_SCHED;
            PG8_LDB(B1, 0, 1); PG8_STAGE(PG8_SB(0, 0), b2, voffB);
            PG8_BAR; PG8_WAIT_L(0); PG8_MMA(0, 1, At, B1); PG8_BAR;
            PG8_LDA(At, 0, 1); PG8_STAGE(PG8_SA(0, 0), a2, voffA);
            PG8_BAR; PG8_WAIT_L(0); PG8_MMA(1, 0, At, B0); PG8_BAR; PG8_SCHED;
            PG8_STAGE(PG8_SB(0, 1), b2 + hstepB, voffB);
            PG8_WAIT_V(6); PG8_BAR; PG8_MMA(1, 1, At, B1); PG8_BAR;
            PG8_LDB(B0, 1, 0); PG8_SCHED; PG8_LDA(At, 1, 0); PG8_STAGE(PG8_SA(0, 1), a2 + hstepA, voffA);
            PG8_WAIT_L(8); PG8_BAR; PG8_WAIT_L(0); PG8_MMA(0, 0, At, B0); PG8_BAR; PG8_SCHED;
            PG8_LDB(B1, 1, 1); PG8_STAGE(PG8_SB(1, 0), b3, voffB);
            PG8_BAR; PG8_WAIT_L(0); PG8_MMA(0, 1, At, B1); PG8_BAR;
            PG8_LDA(At, 1, 1); PG8_STAGE(PG8_SA(1, 0), a3, voffA);
            PG8_BAR; PG8_WAIT_L(0); PG8_MMA(1, 0, At, B0); PG8_BAR; PG8_SCHED;
            PG8_STAGE(PG8_SB(1, 1), b3 + hstepB, voffB);
            PG8_WAIT_V(6); PG8_BAR; PG8_MMA(1, 1, At, B1); PG8_BAR;
            }
        }
        if constexpr (ALIGN_EPI) { if (wr == 0) PG8_BAR; }
        const bool reset_acc = E(acc, cur, wr, wc, fr, fq);
        if (!has_next) break;
        if (reset_acc) {
#pragma unroll
        for (int a = 0; a < 2; ++a)
#pragma unroll
            for (int b = 0; b < 2; ++b)
#pragma unroll
                for (int m = 0; m < 4; ++m)
#pragma unroll
                    for (int n = 0; n < 2; ++n) acc[a][b][m][n] = (f32x4){0.f, 0.f, 0.f, 0.f};
        }
        cur = nxt; cA = nA; cB = nB; nt = PG8_NT(cur); ++ui;
        if constexpr (ALIGN_EPI) { if (wr == 1) PG8_BAR; }
    }
    PG8_WAIT_V(0);
    if constexpr (!ALIGN_EPI) { if (wr == 0) PG8_BAR; }
    PG8_BAR;
#undef PG8_SA
#undef PG8_SB
#undef PG8_STAGE
#undef PG8_LDA
#undef PG8_LDB
#undef PG8_MMA
#undef PG8_WAIT_V
#undef PG8_WAIT_L
#undef PG8_BAR
#undef PG8_SCHED
#undef PG8_K0
#undef PG8_NT
#undef PG8_UA
#undef PG8_UB
}
}

#define XB_TMO      128
#define XB_XCNT(j)  (256  + 64 * (j))
#define XB_XSUB(j)  (1280 + 64 * (j))
#define XB_XGEN(j)  (2304 + 64 * (j))
#define XB_TOP      3328
#define XB_TOPGEN   3392
#define XCD_BAR_WORDS 3456
#define XB_SPIN_CAP (1u << 18)
__device__ __forceinline__ unsigned xb_ld(unsigned* p)              { return __hip_atomic_load(p, __ATOMIC_RELAXED, __HIP_MEMORY_SCOPE_AGENT); }
__device__ __forceinline__ unsigned xb_add(unsigned* p, unsigned v) { return __hip_atomic_fetch_add(p, v, __ATOMIC_RELAXED, __HIP_MEMORY_SCOPE_AGENT); }
__device__ __forceinline__ unsigned xb_xcc_id() { return (unsigned)__builtin_amdgcn_s_getreg((3 << 11) | 20) & 0xFu; }
#define XB_SPIN(cond, bar) do { unsigned _sp = 0; while (cond) { __builtin_amdgcn_s_sleep(1); \
    if ((++_sp & 255u) == 0u) { if (xb_ld(&(bar)[XB_TMO])) break; if (_sp > XB_SPIN_CAP) { atomicAdd(&(bar)[XB_TMO], 1u); break; } } } } while (0)
struct XcdBarrier { unsigned* bar; unsigned x; volatile LAS unsigned* st; };
__device__ __forceinline__ XcdBarrier xcd_barrier_post(unsigned* bar, volatile LAS unsigned* st) {
    XcdBarrier b; b.bar = bar; b.x = xb_xcc_id(); b.st = st;
    if (threadIdx.x == 0) (void)xb_add(&bar[XB_XCNT(b.x)], 1u);
    return b;
}
__device__ __forceinline__ void xcd_barrier_complete(unsigned* bar, unsigned x, unsigned& nloc, unsigned& nx) {
    const unsigned G = gridDim.x * gridDim.y * gridDim.z;
    unsigned sum, cnt, mine, sp = 0u;
    for (;;) {
        sum = 0u; cnt = 0u; mine = 0u;
#pragma unroll
        for (unsigned j = 0; j < 16; ++j) { const unsigned c = xb_ld(&bar[XB_XCNT(j)]); sum += c; cnt += (c > 0u) ? 1u : 0u; mine = (j == x) ? c : mine; }
        if (sum == G) break;
        __builtin_amdgcn_s_sleep(1);
        if ((++sp & 255u) == 0u) { if (xb_ld(&bar[XB_TMO])) break; if (sp > XB_SPIN_CAP) { atomicAdd(&bar[XB_TMO], 1u); break; } }
    }
    nloc = mine > 0u ? mine : 1u; nx = cnt > 0u ? cnt : 1u;
}
__device__ __forceinline__ void xcd_barrier(const XcdBarrier& b) {
    asm volatile("s_waitcnt vmcnt(0)" ::: "memory");
    __syncthreads();
    if (threadIdx.x == 0) {
        unsigned* bar = b.bar;
        __builtin_amdgcn_s_waitcnt(0);
        const unsigned nloc = b.st[0], nx = b.st[1];
        const unsigned old = xb_add(&bar[XB_XSUB(b.x)], 1u);
        const unsigned gen = old / nloc;
        if (old + 1u == (gen + 1u) * nloc) {
            __builtin_amdgcn_fence(__ATOMIC_RELEASE, "agent");
            asm volatile("s_waitcnt vmcnt(0)" ::: "memory");
            const unsigned og = xb_add(&bar[XB_TOP], 1u);
            const unsigned tg = og / nx;
            if (og + 1u == (tg + 1u) * nx) xb_add(&bar[XB_TOPGEN], 1u);
            else XB_SPIN(xb_ld(&bar[XB_TOPGEN]) == tg, bar);
            __builtin_amdgcn_fence(__ATOMIC_ACQUIRE, "agent");
            xb_add(&bar[XB_XGEN(b.x)], 1u);
            asm volatile("s_waitcnt vmcnt(0)" ::: "memory");
        } else {
            XB_SPIN(xb_ld(&bar[XB_XGEN(b.x)]) == gen, bar);
            __builtin_amdgcn_fence(__ATOMIC_ACQUIRE, "agent");
            asm volatile("s_waitcnt vmcnt(0)" ::: "memory");
        }
    }
    __syncthreads();
}


__device__ __forceinline__ void split_arrive(unsigned* sp, const XcdBarrier& b, bool hier) {
    asm volatile("s_waitcnt vmcnt(0)" ::: "memory");
    __syncthreads();
    if (threadIdx.x == 0) {
        if (hier) { const unsigned nloc = b.st[0];
            const unsigned old = xb_add(&sp[64 * b.x], 1u);
            if (old + 1u == nloc) { __builtin_amdgcn_fence(__ATOMIC_RELEASE, "agent"); asm volatile("s_waitcnt vmcnt(0)" ::: "memory"); xb_add(&sp[64 * 16], 1u); } }
        else { __builtin_amdgcn_fence(__ATOMIC_RELEASE, "agent"); asm volatile("s_waitcnt vmcnt(0)" ::: "memory"); xb_add(&sp[64 * 16], 1u); }
    }
}
__device__ __forceinline__ void split_wait(unsigned* sp, const XcdBarrier& b, bool hier, unsigned* tmo) {
    if (threadIdx.x < 64) {
        const unsigned need = hier ? b.st[1] : gridDim.x;
        unsigned spn = 0;
        while ((unsigned)__builtin_amdgcn_readfirstlane((int)xb_ld(&sp[64 * 16])) < need) { __builtin_amdgcn_s_sleep(2);
            if ((++spn & 255u) == 0u) { if (xb_ld(tmo)) break; if (spn > XB_SPIN_CAP) { if (threadIdx.x == 0) atomicAdd(tmo, 1u); break; } } }
        __builtin_amdgcn_fence(__ATOMIC_ACQUIRE, "agent");
        asm volatile("s_waitcnt vmcnt(0)" ::: "memory");
    }
    asm volatile("" ::: "memory"); __builtin_amdgcn_s_barrier(); asm volatile("" ::: "memory");
}

constexpr int NWAVES = 8, NTHREADS = 512, GRID = 256;
constexpr int LDS_BYTES = 151552;
constexpr int MISC_OFF = 131072 + 320;
constexpr int ROPE_LDS = 132096;
constexpr int CW_BAR = 4096;

struct Args {
    const float* in[25];
    float* out; unsigned char* ws;
    int ph_lo, ph_hi;
};

enum { I_X = 0, I_C, I_CTX, I_CCTX, I_WADA, I_BADA, I_GNORM, I_WIN, I_GQ, I_GK, I_LQ1, I_LK1, I_LQ2, I_LK2, I_GSUB, I_WF, I_BF, I_LNG, I_LNB, I_WS, I_BS, I_WBRA, I_WBRB, I_WBRC, I_WOUT };

__device__ __forceinline__ void transpose_item(const float* W, int ldw, int k0, int lcol0, bool perm, bf16_t* dst, int ldd, int prow0, int dcol0, LAS float* scr, int lane) {
#pragma unroll 8
    for (int i = 0; i < 32; ++i) { const int kk = 2 * i + (lane >> 5); scr[kk * 33 + (lane & 31)] = W[(size_t)(k0 + kk) * ldw + lcol0 + (lane & 31)]; }
    LDS_WAIT(); asm volatile("" ::: "memory");
    const int c = lane & 7;
#pragma unroll
    for (int j = 0; j < 4; ++j) { const int n = (lane >> 3) + 8 * j; const int jn = perm ? perm32(n) : n; const LAS float* s = scr + (8 * c) * 33 + jn;
        u32x4 o; o.x = pk2(s[0 * 33], s[1 * 33]); o.y = pk2(s[2 * 33], s[3 * 33]); o.z = pk2(s[4 * 33], s[5 * 33]); o.w = pk2(s[6 * 33], s[7 * 33]);
        *(GAS u32x4*)(dst + (size_t)(prow0 + n) * ldd + dcol0 + k0 + 8 * c) = o; }
    LDS_WAIT(); asm volatile("" ::: "memory");
}
__device__ __forceinline__ bool win_block_map(int pb, int& lcol, bool& perm) {
    const int tile = pb >> 3, w = pb & 7, bj = w >> 2, wc = w & 3;
    if (tile < 2) { lcol = OFF_Q + (4 * (tile & 1) + wc) * 64 + 32 * bj; perm = false; return true; }
    if (tile < 4) { lcol = OFF_K + (4 * (tile & 1) + wc) * 64 + 32 * bj; perm = false; return true; }
    perm = true;
    if (tile < 6) { lcol = OFF_V + 256 * (tile - 4) + 32 * w; return true; }
    if (tile < 8) return false;
    if (tile < 10) { lcol = (bj == 0 ? OFF_U : OFF_GATE + 768) + 128 * (tile - 8) + 32 * wc; return true; }
    if (tile == 10) { lcol = OFF_VC + 32 * w; return true; }
    if (tile < 14) { lcol = OFF_GATE + 256 * (tile - 11) + 32 * w; return true; }
    lcol = OFF_MERGE + 256 * (tile - 14) + 32 * w; return true;
}
__device__ __forceinline__ float cos2pi(int a, int n) { return cospif(2.0f * (float)a / (float)n); }
__device__ __forceinline__ float sin2pi(int a, int n) { return sinpif(2.0f * (float)a / (float)n); }

__device__ __forceinline__ void ph0_mods(const Args& a, int lane, int wave, int vcu);
__device__ __forceinline__ void ph0_prologue(const Args& a, LAS unsigned char* lds, int tid, int lane, int wave, int vcu, int pmask) {
    unsigned char* ws = a.ws;
    const int gw = vcu * NWAVES + wave, NGW = GRID * NWAVES;
    const int gt = vcu * NTHREADS + tid, NGT = GRID * NTHREADS;
    if (pmask & 1) {
        LAS float* scr = (LAS float*)(lds + wave * 16384);
        constexpr int I_WIN_N = DEPTH * 208 * 16;
        constexpr int I_BR_N = DEPTH * 32 * 16;
        constexpr int I_OUT_N = DEPTH * 32 * 16;
        for (int it = gw; it < I_WIN_N + I_BR_N + I_OUT_N; it += NGW) {
            int r = it;
            if (r < I_WIN_N) {
                const int l = r / (208 * 16), q = r % (208 * 16), pb = q >> 4, kb = q & 15; int lcol; bool perm;
                if (!win_block_map(pb, lcol, perm)) continue;
                transpose_item(a.in[I_WIN] + (size_t)l * DM * INW, INW, 64 * kb, lcol, perm, (bf16_t*)(ws + WS_WIN) + (size_t)l * NPHYS * DM, DM, 32 * pb, 0, scr, lane);
                continue;
            }
            r -= I_WIN_N;
            if (r < I_BR_N) {
                const int l = r / 512, q = r % 512, pb = q >> 4, kb = q & 15;
                const float* W; int ksrc;
                if (kb < 8) { W = a.in[I_WBRA] + (size_t)l * 512 * DM; ksrc = 64 * kb; } else if (kb < 12) { W = a.in[I_WBRB] + (size_t)l * 256 * DM; ksrc = 64 * (kb - 8); } else { W = a.in[I_WBRC] + (size_t)l * 256 * DM; ksrc = 64 * (kb - 12); }
                transpose_item(W, DM, ksrc, 32 * pb, true, (bf16_t*)(ws + WS_WBR) + (size_t)l * DM * DM, DM, 32 * pb, 64 * kb - ksrc, scr, lane);
                continue;
            }
            r -= I_BR_N;
            { const int l = r / 512, q = r % 512, pb = q >> 4, kb = q & 15;
              transpose_item(a.in[I_WOUT] + (size_t)l * DM * DM, DM, 64 * kb, 32 * pb, true, (bf16_t*)(ws + WS_WOUT) + (size_t)l * DM * DM, DM, 32 * pb, 0, scr, lane); }
        }
    }
    __syncthreads();
    if (pmask & 2) {
        LAS float* Wb = (LAS float*)lds;
        LAS float* TR = Wb + 64 * 65;
        LAS float* Tt = TR + 64 * 128;
        LAS float* Wf = Tt + 64 * 132;
        for (int it = GRID - 1 - vcu; it < DEPTH * 4 * 16; it += GRID) {
            const int l = it / 64, g = (it >> 4) & 3, kb = it & 15;
            const float* win = a.in[I_WIN] + (size_t)l * DM * INW; const float* wf = a.in[I_WF] + (size_t)(l * 4 + g) * 64 * 64;
            for (int e = tid; e < 4096; e += NTHREADS) { const int r = e >> 6, c = e & 63; Wb[r * 65 + c] = win[(size_t)(64 * kb + r) * INW + OFF_F + 64 * g + c]; Wf[e] = wf[e]; }
            for (int e = tid; e < 64 * 128; e += NTHREADS) { const int c = e >> 7, ri = (e >> 6) & 1, cp = e & 63; const int ph = (c * cp) & 63; TR[e] = ri ? -sin2pi(ph, 64) : cos2pi(ph, 64); }
            __syncthreads();
            const int tk = tid >> 5, tn = tid & 31;
            { f32x4 acc[4];
#pragma unroll
              for (int i = 0; i < 4; ++i) acc[i] = (f32x4){0.f, 0.f, 0.f, 0.f};
#pragma unroll 4
              for (int c = 0; c < 64; ++c) { const f32x4 bv = *(const LAS f32x4*)(TR + c * 128 + 4 * tn);
#pragma unroll
                  for (int i = 0; i < 4; ++i) acc[i] += bv * Wb[(4 * tk + i) * 65 + c]; }
#pragma unroll
              for (int i = 0; i < 4; ++i) *(LAS f32x4*)(Tt + (4 * tk + i) * 132 + 4 * tn) = acc[i]; }
            __syncthreads();
            { const int ri = tn >> 4, td = tn & 15;
              f32x4 acc[4];
#pragma unroll
              for (int i = 0; i < 4; ++i) acc[i] = (f32x4){0.f, 0.f, 0.f, 0.f};
#pragma unroll 4
              for (int cp = 0; cp < 64; ++cp) { const f32x4 bv = *(const LAS f32x4*)(Wf + cp * 64 + 4 * td);
#pragma unroll
                  for (int i = 0; i < 4; ++i) acc[i] += bv * Tt[(4 * tk + i) * 132 + ri * 64 + cp]; }
              bf16_t* dst = (bf16_t*)(ws + WS_WIN) + (size_t)l * NPHYS * DM;
#pragma unroll
              for (int e = 0; e < 4; ++e) { const int ch = 64 * g + 4 * td + e, prow = 6 * 256 + ri * 256 + (ch & ~31) + invperm32(ch & 31);
                  u32x2 w; w.x = pk2(acc[0][e], acc[1][e]); w.y = pk2(acc[2][e], acc[3][e]);
                  *(u32x2*)(dst + (size_t)prow * DM + 64 * kb + 4 * tk) = w; } }
            __syncthreads();
        }
    }
    if (pmask & 4) {
        float* ropec = (float*)(ws + WS_ROPE); float* ropes = ropec + 2048;
        for (int e = gt; e < 2048; e += NGT) { const int pos = e >> 4, f = e & 15; const float freq = powf(10000.0f, -(float)(2 * f) / 32.0f); const float ang = (float)pos * freq; ropec[e] = cosf(ang); ropes[e] = sinf(ang); }
        f32x2* tw = (f32x2*)(ws + WS_TW);
        for (int e = gt; e < 8192; e += NGT) tw[e] = (f32x2){cos2pi(e, 8192), sin2pi(e, 8192)};
        bf16_t* c128 = (bf16_t*)(ws + WS_C128); bf16_t* s128 = (bf16_t*)(ws + WS_S128);
        for (int e = gt; e < 4 * 8 * 64 * 8; e += NGT) { const int j = e & 7, ln = (e >> 3) & 63, s = (e >> 9) & 7, mb = e >> 12; const int row = 32 * mb + (ln & 31), k = 16 * s + 8 * (j >> 2) + 4 * (ln >> 5) + (j & 3);
            const int ph = (row * k) & 127; c128[e] = (bf16_t)f2bf(cos2pi(ph, 128)); s128[e] = (bf16_t)f2bf(sin2pi(ph, 128)); }
        bf16_t* t64 = (bf16_t*)(ws + WS_T64);
        for (int e = gt; e < 2 * 8 * 64 * 8; e += NGT) { const int j = e & 7, ln = (e >> 3) & 63, s = (e >> 9) & 7, mb = e >> 12; const int row = 32 * mb + (ln & 31), k = 16 * s + 8 * (j >> 2) + 4 * (ln >> 5) + (j & 3);
            const int ri = k >> 6, c = k & 63, ph = (row * c) & 63; t64[e] = (bf16_t)f2bf(ri ? sin2pi(ph, 64) : cos2pi(ph, 64)); }
        bf16_t* tc256 = (bf16_t*)(ws + WS_TC256);
        for (int e = gt; e < 8 * 32 * 64 * 8; e += NGT) { const int j = e & 7, ln = (e >> 3) & 63, s = (e >> 9) & 31, mb = e >> 14; const int row = 32 * mb + (ln & 31), k = 16 * s + 8 * (j >> 2) + 4 * (ln >> 5) + (j & 3);
            const int ri = k >> 8, n = k & 255, ph = (row * n) & 255; tc256[e] = (bf16_t)f2bf(ri ? sin2pi(ph, 256) : cos2pi(ph, 256)); }
        bf16_t* wsimg = (bf16_t*)(ws + WS_WSIMG);
        for (int e = gt; e < DEPTH * 4 * 4 * 8 * 64 * 8; e += NGT) { const int j = e & 7, ln = (e >> 3) & 63, s = (e >> 9) & 7, mb = (e >> 12) & 3, lg = e >> 14; const int row = 32 * mb + (ln & 31), k = 16 * s + 8 * (j >> 2) + 4 * (ln >> 5) + (j & 3);
            wsimg[e] = (bf16_t)f2bf(a.in[I_WS][(size_t)lg * 128 * 128 + row * 128 + k]); }
        if (gt < DEPTH) { const int l = gt; float s1 = 0.f, s2 = 0.f;
            for (int i = 0; i < 64; ++i) { s1 += a.in[I_LQ1][l * 64 + i] * a.in[I_LK1][l * 64 + i]; s2 += a.in[I_LQ2][l * 64 + i] * a.in[I_LK2][l * 64 + i]; }
            const float lam_init = 0.8f - 0.6f * expf(-0.3f * (float)l);
            float* lam = (float*)(ws + WS_LAM); lam[2 * l] = expf(s1) - expf(s2) + lam_init; lam[2 * l + 1] = 1.0f - lam_init; }
    }
}

__device__ __forceinline__ void ph0_mods(const Args& a, int lane, int wave, int vcu) {
    unsigned char* ws = a.ws; const int gw = vcu * NWAVES + wave, NGW = GRID * NWAVES;
    {
        float* part = (float*)(ws + WS_MODP);
        for (int it = gw; it < DEPTH * 12 * 32; it += NGW) {
            const int l = it / 384, q = it % 384, cc = q >> 5, kc = q & 31; const int col = 256 * cc + 4 * lane;
            const float* w = a.in[I_WADA] + (size_t)l * DM * 3072 + col;
            f32x4 s0 = {0.f, 0.f, 0.f, 0.f}, s1 = s0, s2 = s0;
#pragma unroll 8
            for (int kk = 0; kk < 32; ++kk) { const int k = 32 * kc + kk; const f32x4 wv = *(const f32x4*)(w + (size_t)k * 3072);
                const float a0 = fast_silu(a.in[I_C][k]), a1 = fast_silu(a.in[I_C][DM + k]), a2 = fast_silu(a.in[I_CCTX][k]);
                s0 += wv * a0; s1 += wv * a1; s2 += wv * a2; }
            float* p = part + ((size_t)(l * 32 + kc) * 3) * 3072 + col;
            *(f32x4*)(p) = s0; *(f32x4*)(p + 3072) = s1; *(f32x4*)(p + 2 * 3072) = s2;
        }
    }
}

__device__ __forceinline__ void prepass(const Args& a, int l, LAS unsigned char* lds, int tid, int lane, int wave, int vcu) {
    unsigned char* ws = a.ws;
    const float* part = (const float*)(ws + WS_MODP); float* modf = (float*)(ws + WS_MODF);
    if (l == 0) {
        if (tid < 72) { const int o = vcu * 72 + tid; const int ll = o / 9216, rj = o % 9216, r = rj / 3072, j = rj % 3072; float s = a.in[I_BADA][ll * 3072 + j];
#pragma unroll
            for (int kc = 0; kc < 32; ++kc) s += part[((size_t)(ll * 32 + kc) * 3 + r) * 3072 + j];
            modf[o] = s; }
    }
    const int row0 = vcu * 66, row1 = row0 + 66;
    LAS float* coef = (LAS float*)lds;
    for (int r = 0; r < 3; ++r) {
        const int lo = r == 0 ? 0 : (r == 1 ? SEQ : MLAT), hi = r == 0 ? SEQ : (r == 1 ? MLAT : MT);
        if (row1 <= lo || row0 >= hi) continue;
        for (int k = tid; k < DM; k += NTHREADS) {
            float sh, sc;
            if (l == 0) { sh = a.in[I_BADA][k]; sc = a.in[I_BADA][DM + k];
#pragma unroll
                for (int kc = 0; kc < 32; ++kc) { const float* p = part + ((size_t)(kc) * 3 + r) * 3072; sh += p[k]; sc += p[DM + k]; } }
            else { sh = modf[(size_t)(l * 3 + r) * 3072 + k]; sc = modf[(size_t)(l * 3 + r) * 3072 + DM + k]; }
            coef[(r * 2) * DM + k] = a.in[I_GNORM][l * DM + k] * (1.0f + sc); coef[(r * 2 + 1) * DM + k] = sh;
        }
    }
    __syncthreads();
    const float* xlat = l == 0 ? a.in[I_X] : a.out; const float* xctx = l == 0 ? a.in[I_CTX] : (const float*)(ws + WS_CTX1);
    bf16_t* H = (bf16_t*)(ws + WS_H);
    for (int mb = row0 + 4 * wave; mb < row1; mb += 4 * NWAVES) {
        f32x4 v[4][4]; float s2[4];
#pragma unroll
        for (int q = 0; q < 4; ++q) { const int m = (mb + q < row1) ? mb + q : mb;
            if (l == 1 && m < MLAT) { const GAS u32x2* xb = (const GAS u32x2*)(ws + x1b_off(m)) + lane;
#pragma unroll
                for (int j = 0; j < 4; ++j) { const u32x2 t = xb[64 * j]; v[q][j] = (f32x4){bflo(t.x), bfhi(t.x), bflo(t.y), bfhi(t.y)}; } }
            else { const float* xrow = m < MLAT ? xlat + (size_t)m * DM : xctx + (size_t)(m - MLAT) * DM; const GAS f32x4* xr = (const GAS f32x4*)xrow + lane;
#pragma unroll
                for (int j = 0; j < 4; ++j) v[q][j] = xr[64 * j]; } }
#pragma unroll
        for (int q = 0; q < 4; ++q) { float t = 0.f;
#pragma unroll
            for (int j = 0; j < 4; ++j) t += (v[q][j].x * v[q][j].x + v[q][j].y * v[q][j].y) + (v[q][j].z * v[q][j].z + v[q][j].w * v[q][j].w);
            s2[q] = t; }
#pragma unroll
        for (int o = 1; o < 64; o <<= 1) {
#pragma unroll
            for (int q = 0; q < 4; ++q) s2[q] += __shfl_xor(s2[q], o); }
#pragma unroll
        for (int q = 0; q < 4; ++q) { const int m = mb + q; if (m >= row1) break;
            const int r = m < SEQ ? 0 : (m < MLAT ? 1 : 2);
            const float rstd = rsqrtf(s2[q] * (1.0f / DM) + EPS);
            GAS u32x2* o8 = (GAS u32x2*)(H + (size_t)m * DM) + lane;
#pragma unroll
            for (int j = 0; j < 4; ++j) { const f32x4 ga = *(const LAS f32x4*)(coef + (r * 2) * DM + 256 * j + 4 * lane), sh = *(const LAS f32x4*)(coef + (r * 2 + 1) * DM + 256 * j + 4 * lane);
                const f32x4 h = v[q][j] * rstd * ga + sh; u32x2 w; w.x = pk2(h.x, h.y); w.y = pk2(h.z, h.w); o8[64 * j] = w; } }
    }
    __syncthreads();
}

struct TileSched {
    int x, c, pn0, npn, nseg, nctx, cpn0, cnpn;
    __device__ __forceinline__ bool next(int i, pg8::Unit& u) const {
        const int ti = i / nseg; u.seg = i - ti * nseg; u.set = 0;
        const int j = ti * 32 + c;
        if (j < 8 * npn) { u.pm = 8 * x + (j & 7); u.pn = pn0 + (j >> 3); return true; }
        const int id = (j - 8 * npn) * 8 + x;
        if (id < nctx) { u.pm = 64 + (id & 1); u.pn = cpn0 + (id >> 1); return true; }
        return false;
    }
    __device__ __forceinline__ void a_ready(const pg8::Unit&) const {}
};

struct EpiIn {
    unsigned char* ws; const float* gq; const float* gk; LAS const float* ropec; LAS const float* ropes;
    __device__ __forceinline__ bool operator()(f32x4 (&acc)[2][2][4][2], const pg8::Unit& u, int wr, int wc, int fr, int fq) const {
        const bool ctx = u.pm >= 64; const int b = ctx ? u.pm - 64 : (u.pm >> 5);
        const int rbase = u.pm * 256 + wr * 64 + fr;
        const int pn = u.pn;
        if (pn < 4) {
            const bool isK = pn >= 2; const int gi = 4 * (pn & 1) + wc, h = gi >> 1, comp = gi & 1;
            const float* gsrc = isK ? gk : gq;
            f32x4 gv[2][2];
#pragma unroll
            for (int bj = 0; bj < 2; ++bj)
#pragma unroll
                for (int n = 0; n < 2; ++n) gv[bj][n] = *(const f32x4*)(gsrc + 32 * bj + 16 * n + 4 * fq);
#pragma unroll
            for (int ai = 0; ai < 2; ++ai)
#pragma unroll
                for (int m = 0; m < 4; ++m) {
                    const int row = rbase + ai * 128 + m * 16;
                    f32x4 v[2][2]; float ss = 0.f;
#pragma unroll
                    for (int bj = 0; bj < 2; ++bj)
#pragma unroll
                        for (int n = 0; n < 2; ++n) { v[bj][n] = acc[ai][bj][m][n]; ss += (v[bj][n].x * v[bj][n].x + v[bj][n].y * v[bj][n].y) + (v[bj][n].z * v[bj][n].z + v[bj][n].w * v[bj][n].w); }
                    ss += __shfl_xor(ss, 16); ss += __shfl_xor(ss, 32);
                    const float rstd = rsqrtf(ss * (1.0f / 64.0f) + EPS);
#pragma unroll
                    for (int bj = 0; bj < 2; ++bj)
#pragma unroll
                        for (int n = 0; n < 2; ++n) v[bj][n] = v[bj][n] * rstd * gv[bj][n];
                    int kx;
                    if (!ctx) { const int ntok = row - b * SEQ; kx = ntok;
#pragma unroll
                        for (int bj = 0; bj < 2; ++bj) { const int pos = bj == 0 ? (ntok >> 6) : (ntok & 63);
                            const f32x4 c4 = *(LAS const f32x4*)(ropec + pos * 16 + 4 * fq), s4 = *(LAS const f32x4*)(ropes + pos * 16 + 4 * fq);
                            const f32x4 x1 = v[bj][0], x2 = v[bj][1]; v[bj][0] = x1 * c4 - x2 * s4; v[bj][1] = x2 * c4 + x1 * s4; } }
                    else kx = SEQ + (row - MLAT - b * NCTX);
#pragma unroll
                    for (int bj = 0; bj < 2; ++bj) {
                        f32x4 p0 = v[bj][0], p1 = v[bj][1];
                        if (!isK) { p0 = p0 * QSCALE; p1 = p1 * QSCALE; }
                        u32x4 w; w.x = cvt_pk_bf16(p0.x, p0.y); w.y = cvt_pk_bf16(p0.z, p0.w); w.z = cvt_pk_bf16(p1.x, p1.y); w.w = cvt_pk_bf16(p1.z, p1.w);
                        if (!isK) *(u32x4*)((bf16_t*)(ws + WS_QG) + ((size_t)row * 4 + h) * 128 + comp * 64 + (bj * 4 + fq) * 8) = w;
                        else *(u32x4*)(ws + WS_KIMG + ((size_t)((b * 4 + h) * NKT + (kx >> 6)) * 16 + comp * 8 + bj * 4 + fq) * 1024 + (kx & 63) * 16) = w;
                    }
                }
            return true;
        }
#pragma unroll
        for (int ai = 0; ai < 2; ++ai)
#pragma unroll
            for (int m = 0; m < 4; ++m) {
                const int row = rbase + ai * 128 + m * 16;
                if (pn == 8 || pn == 9) {
                    f32x4 p0, p1;
#pragma unroll
                    for (int e = 0; e < 4; ++e) { p0[e] = acc[ai][0][m][0][e] * fast_silu(acc[ai][1][m][0][e]); p1[e] = acc[ai][0][m][1][e] * fast_silu(acc[ai][1][m][1][e]); }
                    u32x4 w; w.x = cvt_pk_bf16(p0.x, p0.y); w.y = cvt_pk_bf16(p0.z, p0.w); w.z = cvt_pk_bf16(p1.x, p1.y); w.w = cvt_pk_bf16(p1.z, p1.w);
                    *(u32x4*)((bf16_t*)(ws + WS_UG) + (size_t)row * 256 + 128 * (pn - 8) + 32 * wc + 8 * fq) = w;
                    continue;
                }
#pragma unroll
                for (int bj = 0; bj < 2; ++bj) {
                    f32x4 p0 = acc[ai][bj][m][0], p1 = acc[ai][bj][m][1];
                    const int lc = 128 * bj + 32 * wc + 8 * fq;
                    unsigned char* dst;
                    if (pn < 6) { const int kx = ctx ? SEQ + (row - MLAT - b * NCTX) : row - b * SEQ; const int h = 2 * (pn - 4) + bj;
                        dst = ws + WS_VIMG + ((size_t)((b * 4 + h) * NKT + (kx >> 6)) * 16 + wc * 4 + ((kx & 63) >> 4)) * 1024 + (kx & 15) * 64 + fq * 16; }
                    else if (pn < 8) dst = ws + WS_Z2 + ((size_t)row * 512 + 256 * (pn - 6) + lc) * 2;
                    else if (pn == 10) dst = ws + WS_VC + ((size_t)row * 256 + lc) * 2;
                    else if (pn < 14) {
#pragma unroll
                        for (int e = 0; e < 4; ++e) { p0[e] = fast_silu(p0[e]); p1[e] = fast_silu(p1[e]); }
                        dst = ws + WS_GS + ((size_t)row * 768 + 256 * (pn - 11) + lc) * 2; }
                    else {
                        unsigned q0 = 0u, q1 = 0u;
#pragma unroll
                        for (int e = 0; e < 4; ++e) { q0 = ms_quant_pk(p0[e], e, q0); q1 = ms_quant_pk(p1[e], e, q1); }
                        unsigned char* d8 = ctx ? ws + WS_MSC + ((size_t)(row - MLAT) * 3072 + 256 * (pn - 14) + lc) : ws + WS_MS + ((size_t)row * 3072 + 256 * (pn - 14) + lc);
                        u32x2 w8; w8.x = q0; w8.y = q1; *(u32x2*)d8 = w8; continue; }
                    u32x4 w; w.x = cvt_pk_bf16(p0.x, p0.y); w.y = cvt_pk_bf16(p0.z, p0.w); w.z = cvt_pk_bf16(p1.x, p1.y); w.w = cvt_pk_bf16(p1.z, p1.w);
                    *(u32x4*)dst = w;
                }
            }
        return true;
    }
};

struct EpiY {
    const unsigned char* MS; bf16_t* Y;
    __device__ __forceinline__ bool operator()(f32x4 (&acc)[2][2][4][2], const pg8::Unit& u, int wr, int wc, int fr, int fq) const {
        const int rbase = u.pm * 256 + wr * 64 + fr; const int seg = u.seg;
#pragma unroll
        for (int ai = 0; ai < 2; ++ai) {
            u32x2 mn[4][2], md[4][2];
#pragma unroll
            for (int m = 0; m < 4; ++m)
#pragma unroll
                for (int bj = 0; bj < 2; ++bj) { const unsigned char* mp = MS + (size_t)(rbase + ai * 128 + m * 16) * 3072 + seg * 1024 + 256 * u.pn + 128 * bj + 32 * wc + 8 * fq;
                    mn[m][bj] = *(const u32x2*)mp; md[m][bj] = seg < 2 ? *(const u32x2*)(mp + 1024) : (u32x2){0u, 0u}; }
            __builtin_amdgcn_sched_barrier(0);
#pragma unroll
            for (int m = 0; m < 4; ++m) {
                const int row = rbase + ai * 128 + m * 16;
#pragma unroll
                for (int bj = 0; bj < 2; ++bj) {
                    const int col = 256 * u.pn + 128 * bj + 32 * wc + 8 * fq;
                    const u32x2 a_ = mn[m][bj], d_ = md[m][bj];
                    f32x4& p0 = acc[ai][bj][m][0]; f32x4& p1 = acc[ai][bj][m][1];
                    if (seg < 2) {
#pragma unroll
                        for (int e = 0; e < 4; ++e) { p0[e] *= ub(a_.x, e) * __builtin_amdgcn_rcpf(ub(d_.x, e)); p1[e] *= ub(a_.y, e) * __builtin_amdgcn_rcpf(ub(d_.y, e)); } }
                    else {
#pragma unroll
                        for (int e = 0; e < 4; ++e) { p0[e] *= ub(a_.x, e) * (1.0f / 255.0f); p1[e] *= ub(a_.y, e) * (1.0f / 255.0f); }
                        u32x4 w; w.x = cvt_pk_bf16(p0[0], p0[1]); w.y = cvt_pk_bf16(p0[2], p0[3]); w.z = cvt_pk_bf16(p1[0], p1[1]); w.w = cvt_pk_bf16(p1[2], p1[3]);
                        *(u32x4*)(Y + (size_t)row * DM + col) = w; }
                }
            }
            __builtin_amdgcn_sched_barrier(0);
        }
        return seg == 2;
    }
};


struct FusedSched {
    int x, c; unsigned* sp; XcdBarrier bar; bool hier; unsigned* tmo;
    __device__ __forceinline__ bool next(int i, pg8::Unit& u) const {
        if (i >= 6) return false;
        u.pm = 8 * x + (c & 7);
        if (i < 3) { u.pn = 14 + 4 * i + (c >> 3); u.seg = 0; u.set = 1; } else { u.pn = c >> 3; u.seg = i - 3; u.set = 0; }
        return true;
    }
    __device__ __forceinline__ void a_ready(const pg8::Unit& u) const { if (u.set == 0 && u.seg == 1) split_wait(sp, bar, hier, tmo); }
};
struct EpiMY {
    EpiIn ein; EpiY ey;
    __device__ __forceinline__ bool operator()(f32x4 (&acc)[2][2][4][2], const pg8::Unit& u, int wr, int wc, int fr, int fq) const { return u.set ? ein(acc, u, wr, wc, fr, fq) : ey(acc, u, wr, wc, fr, fq); }
};

struct EpiOut {
    const float* xin; float* out; unsigned char* ws; const float* gate; int layer;
    __device__ __forceinline__ bool operator()(f32x4 (&acc)[2][2][4][2], const pg8::Unit& u, int wr, int wc, int fr, int fq) const {
        const int r = u.pm >> 5;
        const int rbase = u.pm * 256 + wr * 64 + fr;
        f32x4 xa[2][2], xb[2][2], xc[2][2];
#define EO_C(g) (256 * u.pn + 128 * ((g) >> 2) + 32 * wc + 8 * fq)
#define EO_ROW(g, mm) (rbase + (((g) >> 1) & 1) * 128 + (2 * ((g) & 1) + (mm)) * 16)
#define EO_LOAD(dst, g) do { _Pragma("unroll") for (int mm = 0; mm < 2; ++mm) { \
            if (layer == 0) { const float* p_ = xin + (size_t)EO_ROW(g, mm) * DM + EO_C(g); dst[mm][0] = *(const f32x4*)p_; dst[mm][1] = *(const f32x4*)(p_ + 4); } \
            else { const u32x4 t_ = *(const u32x4*)(ws + x1b_off(EO_ROW(g, mm)) + (size_t)EO_C(g) * 2); dst[mm][0] = (f32x4){bflo(t_.x), bfhi(t_.x), bflo(t_.y), bfhi(t_.y)}; dst[mm][1] = (f32x4){bflo(t_.z), bfhi(t_.z), bflo(t_.w), bfhi(t_.w)}; } } } while (0)
#define EO_STORE(srcv, g) do { const f32x4 g0_ = *(const f32x4*)(gate + (size_t)r * 3072 + EO_C(g)), g1_ = *(const f32x4*)(gate + (size_t)r * 3072 + EO_C(g) + 4); \
            _Pragma("unroll") for (int mm = 0; mm < 2; ++mm) { \
                const f32x4 y0_ = srcv[mm][0] + g0_ * acc[((g) >> 1) & 1][(g) >> 2][2 * ((g) & 1) + mm][0], y1_ = srcv[mm][1] + g1_ * acc[((g) >> 1) & 1][(g) >> 2][2 * ((g) & 1) + mm][1]; \
                if (layer == 0) { u32x4 w_; w_.x = cvt_pk_bf16(y0_.x, y0_.y); w_.y = cvt_pk_bf16(y0_.z, y0_.w); w_.z = cvt_pk_bf16(y1_.x, y1_.y); w_.w = cvt_pk_bf16(y1_.z, y1_.w); *(u32x4*)(ws + x1b_off(EO_ROW(g, mm)) + (size_t)EO_C(g) * 2) = w_; } \
                else { float* p_ = out + (size_t)EO_ROW(g, mm) * DM + EO_C(g); *(f32x4*)p_ = y0_; *(f32x4*)(p_ + 4) = y1_; } } } while (0)
        EO_LOAD(xa, 0); EO_LOAD(xb, 1); EO_LOAD(xc, 2);
        EO_STORE(xa, 0); EO_LOAD(xa, 3);
        EO_STORE(xb, 1); EO_LOAD(xb, 4);
        EO_STORE(xc, 2); EO_LOAD(xc, 5);
        EO_STORE(xa, 3); EO_LOAD(xa, 6);
        EO_STORE(xb, 4); EO_LOAD(xb, 7);
        EO_STORE(xc, 5); EO_STORE(xa, 6); EO_STORE(xb, 7);
#undef EO_C
#undef EO_ROW
#undef EO_LOAD
#undef EO_STORE
        return true;
    }
};

__device__ __forceinline__ f32x4 mini_block(const bf16_t* A, int lda, const bf16_t* Bt, int ldb, int m0, int n0, int k0, int nk, int fr, int fq, f32x4 acc) {
    const bf16_t* ap = A + (size_t)(m0 + fr) * lda + k0 + 8 * fq; const bf16_t* bp = Bt + (size_t)(n0 + fr) * ldb + k0 + 8 * fq;
#pragma unroll 16
    for (int s = 0; s < nk; s += 32) acc = __builtin_amdgcn_mfma_f32_16x16x32_bf16(*(const bf16x8*)(bp + s), *(const bf16x8*)(ap + s), acc, 0, 0, 0);
    return acc;
}
__device__ __forceinline__ int mini_lcol(int n0, int fq) { return (n0 & ~31) + 8 * fq + 4 * ((n0 >> 4) & 1); }
__device__ __forceinline__ void ctx_merge_gates(unsigned char* ws, const bf16_t* Wl, int gw, int lane) {
    const int fr = lane & 15, fq = lane >> 4; const bf16_t* H = (const bf16_t*)(ws + WS_H); bf16_t* MS = (bf16_t*)(ws + WS_MS);
    for (int blk = gw; blk < 32 * 192; blk += GRID * NWAVES) { const int m0 = MLAT + 16 * (blk & 31), n0 = 16 * (blk >> 5);
        const f32x4 acc = mini_block(H, DM, Wl + (size_t)(14 * 256) * DM, DM, m0, n0, 0, DM, fr, fq, (f32x4){0.f, 0.f, 0.f, 0.f});
        u32x2 w; w.x = cvt_pk_bf16(fast_sigmoid(acc[0]), fast_sigmoid(acc[1])); w.y = cvt_pk_bf16(fast_sigmoid(acc[2]), fast_sigmoid(acc[3]));
        *(u32x2*)(MS + (size_t)(m0 + fr) * 3072 + mini_lcol(n0, fq)) = w; }
}
__device__ __forceinline__ void ctx_branch_proj(unsigned char* ws, const bf16_t* Wbr, int gw, int lane) {
    const int fr = lane & 15, fq = lane >> 4; const bf16_t* A = (const bf16_t*)(ws + WS_A); const unsigned char* MS = (const unsigned char*)(ws + WS_MSC) - (size_t)MLAT * 3072; bf16_t* Y = (bf16_t*)(ws + WS_Y);
    for (int blk = gw; blk < 32 * 64; blk += GRID * NWAVES) { const int m0 = MLAT + 16 * (blk & 31), n0 = 16 * (blk >> 5); const int lc = mini_lcol(n0, fq);
        f32x4 y = {0.f, 0.f, 0.f, 0.f};
#pragma unroll
        for (int seg = 0; seg < 3; ++seg) { const int k0 = seg == 0 ? 0 : (seg == 1 ? 512 : 768), nk = seg == 0 ? 512 : 256;
            const f32x4 acc = mini_block(A, DM, Wbr, DM, m0, n0, k0, nk, fr, fq, (f32x4){0.f, 0.f, 0.f, 0.f});
            const unsigned mg = *(const unsigned*)(MS + (size_t)(m0 + fr) * 3072 + seg * 1024 + lc);
            y[0] += acc[0] * ub(mg, 0) * (1.0f / 255.0f); y[1] += acc[1] * ub(mg, 1) * (1.0f / 255.0f); y[2] += acc[2] * ub(mg, 2) * (1.0f / 255.0f); y[3] += acc[3] * ub(mg, 3) * (1.0f / 255.0f); }
        u32x2 w; w.x = cvt_pk_bf16(y[0], y[1]); w.y = cvt_pk_bf16(y[2], y[3]);
        *(u32x2*)(Y + (size_t)(m0 + fr) * DM + lc) = w; }
}
__device__ __forceinline__ void ctx_out_proj(unsigned char* ws, const bf16_t* Wout, const float* ctx_in, const float* gate_ctx, int gw, int lane) {
    const int fr = lane & 15, fq = lane >> 4; const bf16_t* Y = (const bf16_t*)(ws + WS_Y); float* C1 = (float*)(ws + WS_CTX1);
    for (int blk = gw; blk < 32 * 64; blk += GRID * NWAVES) { const int m0 = MLAT + 16 * (blk & 31), n0 = 16 * (blk >> 5);
        const f32x4 acc = mini_block(Y, DM, Wout, DM, m0, n0, 0, DM, fr, fq, (f32x4){0.f, 0.f, 0.f, 0.f});
        const int col = mini_lcol(n0, fq); const size_t off = (size_t)(m0 - MLAT + fr) * DM + col;
        const f32x4 g = *(const f32x4*)(gate_ctx + col), x = *(const f32x4*)(ctx_in + off);
        *(f32x4*)(C1 + off) = x + g * acc; }
}

typedef short v4i16_t __attribute__((ext_vector_type(4)));
__device__ __forceinline__ s16x4 vtr(LAS const unsigned char* p) { return __builtin_bit_cast(s16x4, __builtin_amdgcn_ds_read_tr16_b64_v4i16((LAS v4i16_t*)p)); }
__device__ __forceinline__ int tr_lane_off(int lane) { return ((lane >> 4) & 1) * 32 + (lane & 3) * 8 + (4 * (lane >> 5) + ((lane & 15) >> 2)) * 64; }
__device__ __forceinline__ bf16x8 bfrag(LAS const unsigned char* piece_plus_laneoff) {
    const s16x4 lo = vtr(piece_plus_laneoff), hi = vtr(piece_plus_laneoff + 512);
    return (bf16x8){lo[0], lo[1], lo[2], lo[3], hi[0], hi[1], hi[2], hi[3]};
}
template <int NROWS, int NCOLS, class RP> __device__ __forceinline__ void stage_pieces(LAS unsigned char* dst, RP rp, int tid) {
    constexpr int cpr = NCOLS >> 3, total = NROWS * cpr, pcs = NCOLS >> 5, NIT = total / NTHREADS;
    static_assert(total % NTHREADS == 0, "stage_pieces: whole passes only");
    u32x4 v[NIT];
#pragma unroll
    for (int i = 0; i < NIT; ++i) { const int c = tid + i * NTHREADS, row = c / cpr, cc = c - row * cpr; v[i] = *(const u32x4*)(rp(row) + cc * 8); }
#pragma unroll
    for (int i = 0; i < NIT; ++i) { const int c = tid + i * NTHREADS, row = c / cpr, cc = c - row * cpr;
        *(LAS u32x4*)(dst + ((row >> 4) * pcs + (cc >> 2)) * 1024 + (row & 15) * 64 + (cc & 3) * 16) = v[i]; }
}
#define MFMA32(a, b, c) __builtin_amdgcn_mfma_f32_32x32x16_bf16(a, b, c, 0, 0, 0)
__device__ __forceinline__ bf16x8 afrag_img(const bf16_t* img, int KS, int mb, int s, int lane) { return *(const bf16x8*)(img + ((size_t)(mb * KS + s) * 64 + lane) * 8); }

__device__ __forceinline__ void f1_unit(unsigned char* ws, LAS unsigned char* lds, int unit, int tid, int lane, int wave) {
    const int b = unit >> 7, c = (unit >> 1) & 63, chh = unit & 1;
    bf16_t* Z2 = (bf16_t*)(ws + WS_Z2);
    const bf16_t* base = Z2 + ((size_t)(b * SEQ + c)) * 512 + chh * 128;
    stage_pieces<128, 128>(lds, [&](int r) { return base + (size_t)r * 64 * 512; }, tid);
    stage_pieces<128, 128>(lds + 32768, [&](int r) { return base + (size_t)r * 64 * 512 + 256; }, tid);
    bf16x8 cfa[8], sfa[8];
    { const bf16_t* c128_ = (const bf16_t*)(ws + WS_C128); const bf16_t* s128_ = (const bf16_t*)(ws + WS_S128);
#pragma unroll
      for (int s = 0; s < 8; ++s) { cfa[s] = afrag_img(c128_, 8, wave & 3, s, lane); sfa[s] = afrag_img(s128_, 8, wave & 3, s, lane); } }
    __syncthreads();
    const int mb = wave & 3, cbp = wave >> 2, hi = lane >> 5, r32 = lane & 31, lo = tr_lane_off(lane);
    f32x16 outr[2], t1[2], t2[2];
#pragma unroll
    for (int e = 0; e < 2; ++e) { outr[e] = f32x16{}; t1[e] = f32x16{}; t2[e] = f32x16{}; }
#pragma unroll
    for (int s = 0; s < 8; ++s) {
        const bf16x8 cf = cfa[s], sf = sfa[s];
#pragma unroll
        for (int e = 0; e < 2; ++e) {
            const bf16x8 xr = bfrag(lds + (s * 4 + 2 * cbp + e) * 1024 + lo), xi = bfrag(lds + 32768 + (s * 4 + 2 * cbp + e) * 1024 + lo);
            outr[e] = MFMA32(cf, xr, outr[e]); outr[e] = MFMA32(sf, xi, outr[e]); t1[e] = MFMA32(cf, xi, t1[e]); t2[e] = MFMA32(sf, xr, t2[e]);
        }
    }
    const f32x2* tw = (const f32x2*)(ws + WS_TW);
    f32x2 twv[16];
#pragma unroll
    for (int r = 0; r < 16; ++r) twv[r] = tw[(c * (32 * mb + crow(r, hi))) & 8191];
    __builtin_amdgcn_sched_barrier(0);
#pragma unroll
    for (int e = 0; e < 2; ++e)
#pragma unroll
        for (int r = 0; r < 16; ++r) {
            const int k1 = 32 * mb + crow(r, hi), ch = chh * 128 + 32 * (2 * cbp + e) + r32;
            const float yr = outr[e][r], yi = t1[e][r] - t2[e][r];
            const f32x2 t = twv[r];
            bf16_t* o = Z2 + ((size_t)(b * SEQ + 64 * k1 + c)) * 512 + ch;
            o[0] = (bf16_t)f2bf(yr * t.x + yi * t.y); o[256] = (bf16_t)f2bf(yi * t.x - yr * t.y);
            if ((r & 3) == 3) __builtin_amdgcn_sched_barrier(0);
        }
    __syncthreads();
}

__device__ __forceinline__ void sgu_unit(const Args& a, int l, LAS unsigned char* lds, int cu, int tid, int lane, int wave) {
    unsigned char* ws = a.ws;
    const int row0 = cu < 128 ? cu * 128 : MLAT + (cu - 128) * 128;
    const bf16_t* VC = (const bf16_t*)(ws + WS_VC);
    {
        const int tok = tid >> 2, qt = tid & 3;
        const u32x4* src = (const u32x4*)(VC + (size_t)(row0 + tok) * 256 + qt * 64);
        if (tid < 128) { const float* gsrc = (tid < 64 ? a.in[I_LNG] : a.in[I_LNB]) + l * 256 + (tid & 63) * 4; *(LAS f32x4*)(lds + 65536 + tid * 16) = *(const f32x4*)gsrc; }
        u32x4 raw[8]; float s = 0.f;
#pragma unroll
        for (int i = 0; i < 8; ++i) { raw[i] = src[i]; s += (bflo(raw[i].x) + bfhi(raw[i].x)) + (bflo(raw[i].y) + bfhi(raw[i].y)) + (bflo(raw[i].z) + bfhi(raw[i].z)) + (bflo(raw[i].w) + bfhi(raw[i].w)); }
        s += __shfl_xor(s, 1); s += __shfl_xor(s, 2);
        const float mu = s * (1.0f / 256.0f); float q = 0.f;
#pragma unroll
        for (int i = 0; i < 8; ++i) {
#pragma unroll
            for (int e = 0; e < 4; ++e) { const float d0 = bflo(raw[i][e]) - mu, d1 = bfhi(raw[i][e]) - mu; q += d0 * d0 + d1 * d1; } }
        q += __shfl_xor(q, 1); q += __shfl_xor(q, 2);
        const float rstd = rsqrtf(q * (1.0f / 256.0f) + EPS);
        __syncthreads();
        LAS const float* lg = (LAS const float*)(lds + 65536) + qt * 64; LAS const float* lb = lg + 256;
#pragma unroll
        for (int i = 0; i < 8; ++i) { u32x4 w;
            const f32x4 g0 = *(LAS const f32x4*)(lg + 8 * i), g1 = *(LAS const f32x4*)(lg + 8 * i + 4), b0 = *(LAS const f32x4*)(lb + 8 * i), b1 = *(LAS const f32x4*)(lb + 8 * i + 4);
            w[0] = pk2((bflo(raw[i][0]) - mu) * rstd * g0[0] + b0[0], (bfhi(raw[i][0]) - mu) * rstd * g0[1] + b0[1]); w[1] = pk2((bflo(raw[i][1]) - mu) * rstd * g0[2] + b0[2], (bfhi(raw[i][1]) - mu) * rstd * g0[3] + b0[3]);
            w[2] = pk2((bflo(raw[i][2]) - mu) * rstd * g1[0] + b1[0], (bfhi(raw[i][2]) - mu) * rstd * g1[1] + b1[1]); w[3] = pk2((bflo(raw[i][3]) - mu) * rstd * g1[2] + b1[2], (bfhi(raw[i][3]) - mu) * rstd * g1[3] + b1[3]);
            const int cc = qt * 8 + i;
            *(LAS u32x4*)(lds + ((tok >> 4) * 8 + (cc >> 2)) * 1024 + (tok & 15) * 64 + (cc & 3) * 16) = w; __builtin_amdgcn_sched_barrier(0); }
    }
    bf16x8 wa0[8], wa1[8];
    { const bf16_t* img_ = (const bf16_t*)(ws + WS_WSIMG) + (size_t)(l * 4 + (wave >> 1)) * 16384;
#pragma unroll
      for (int s = 0; s < 8; ++s) { wa0[s] = afrag_img(img_, 8, 2 * (wave & 1), s, lane); wa1[s] = afrag_img(img_, 8, 2 * (wave & 1) + 1, s, lane); } }
    __syncthreads();
    const int g = wave >> 1, ph = wave & 1, hi = lane >> 5, r32 = lane & 31, lo = tr_lane_off(lane);
    f32x16 acc[2][2];
#pragma unroll
    for (int i = 0; i < 2; ++i) { acc[i][0] = f32x16{}; acc[i][1] = f32x16{}; }
#pragma unroll
    for (int s = 0; s < 8; ++s) {
        const bf16x8 a0 = wa0[s], a1 = wa1[s];
        const bf16x8 b0 = bfrag(lds + (s * 8 + 2 * g) * 1024 + lo), b1 = bfrag(lds + (s * 8 + 2 * g + 1) * 1024 + lo);
        acc[0][0] = MFMA32(a0, b0, acc[0][0]); acc[0][1] = MFMA32(a0, b1, acc[0][1]); acc[1][0] = MFMA32(a1, b0, acc[1][0]); acc[1][1] = MFMA32(a1, b1, acc[1][1]);
    }
    const bf16_t* UG = (const bf16_t*)(ws + WS_UG); bf16_t* A = (bf16_t*)(ws + WS_A);
    const float* bs = a.in[I_BS] + (size_t)(l * 4 + g) * 128;
#pragma unroll
    for (int i = 0; i < 2; ++i)
#pragma unroll
        for (int e = 0; e < 2; ++e) {
            unsigned short ugv[16]; float bsv[16];
#pragma unroll
            for (int r = 0; r < 16; ++r) { const int p = 32 * (2 * ph + i) + crow(r, hi); ugv[r] = UG[(size_t)(row0 + p) * 256 + 64 * g + 32 * e + r32]; bsv[r] = bs[p]; }
            __builtin_amdgcn_sched_barrier(0);
#pragma unroll
            for (int r = 0; r < 16; ++r) { const int p = 32 * (2 * ph + i) + crow(r, hi), ch = 64 * g + 32 * e + r32;
                A[(size_t)(row0 + p) * DM + 768 + ch] = (bf16_t)f2bf(bf2f(ugv[r]) * (acc[i][e][r] + bsv[r])); }
            __builtin_amdgcn_sched_barrier(0);
        }
    __syncthreads();
}

__device__ __forceinline__ void ctxf_unit(const Args& a, int l, LAS unsigned char* lds, int unit, int tid, int lane, int wave) {
    unsigned char* ws = a.ws;
    const int b = unit >> 2, chq = unit & 3;
    const bf16_t* Z2 = (const bf16_t*)(ws + WS_Z2);
    stage_pieces<512, 64>(lds, [&](int k) { return Z2 + (size_t)(MLAT + b * NCTX + (k & 255)) * 512 + (k >> 8) * 256 + chq * 64; }, tid);
    __syncthreads();
    const int mb = wave, hi = lane >> 5, r32 = lane & 31, lo = tr_lane_off(lane);
    const bf16_t* img = (const bf16_t*)(ws + WS_TC256);
    f32x16 acc[2]; acc[0] = f32x16{}; acc[1] = f32x16{};
#pragma unroll
    for (int sh = 0; sh < 2; ++sh) { bf16x8 af[16];
#pragma unroll
        for (int s = 0; s < 16; ++s) af[s] = afrag_img(img, 32, mb, 16 * sh + s, lane);
#pragma unroll
        for (int s = 0; s < 16; ++s) { acc[0] = MFMA32(af[s], bfrag(lds + ((16 * sh + s) * 2) * 1024 + lo), acc[0]); acc[1] = MFMA32(af[s], bfrag(lds + ((16 * sh + s) * 2 + 1) * 1024 + lo), acc[1]); } }
    const bf16_t* GS = (const bf16_t*)(ws + WS_GS); bf16_t* A = (bf16_t*)(ws + WS_A);
#pragma unroll
    for (int e = 0; e < 2; ++e) { unsigned short gv[16]; const float bfv = a.in[I_BF][l * 256 + 64 * chq + 32 * e + r32];
#pragma unroll
        for (int r = 0; r < 16; ++r) { const size_t row = MLAT + b * NCTX + 32 * mb + crow(r, hi); gv[r] = GS[row * 768 + 512 + 64 * chq + 32 * e + r32]; }
        __builtin_amdgcn_sched_barrier(0);
#pragma unroll
        for (int r = 0; r < 16; ++r) { const size_t row = MLAT + b * NCTX + 32 * mb + crow(r, hi);
            A[row * DM + 512 + 64 * chq + 32 * e + r32] = (bf16_t)f2bf((acc[e][r] * (1.0f / 128.0f) + bfv) * bf2f(gv[r])); }
        __builtin_amdgcn_sched_barrier(0); }
    __syncthreads();
}

__device__ __forceinline__ void f2_unit(const Args& a, int l, LAS unsigned char* lds, int unit, int tid, int lane, int wave) {
    unsigned char* ws = a.ws;
    const int b = unit >> 7, k1 = unit & 127;
    const bf16_t* Z2 = (const bf16_t*)(ws + WS_Z2);
    stage_pieces<128, 256>(lds, [&](int k) { return Z2 + (size_t)(b * SEQ + 64 * k1 + (k & 63)) * 512 + (k >> 6) * 256; }, tid);
    bf16x8 ta0[8], ta1[8];
    { const bf16_t* img_ = (const bf16_t*)(ws + WS_T64);
#pragma unroll
      for (int s = 0; s < 8; ++s) { ta0[s] = afrag_img(img_, 8, 0, s, lane); ta1[s] = afrag_img(img_, 8, 1, s, lane); } }
    __syncthreads();
    const int cb = wave, hi = lane >> 5, r32 = lane & 31, lo = tr_lane_off(lane);
    f32x16 acc[2]; acc[0] = f32x16{}; acc[1] = f32x16{};
#pragma unroll
    for (int s = 0; s < 8; ++s) { const bf16x8 bf = bfrag(lds + (s * 8 + cb) * 1024 + lo);
        acc[0] = MFMA32(ta0[s], bf, acc[0]); acc[1] = MFMA32(ta1[s], bf, acc[1]); }
    const bf16_t* GS = (const bf16_t*)(ws + WS_GS); bf16_t* A = (bf16_t*)(ws + WS_A);
    const float nrm = 0.0013810679320049757f;
    const float bfv = a.in[I_BF][l * 256 + 32 * cb + r32];
#pragma unroll
    for (int mb = 0; mb < 2; ++mb) {
        unsigned short gv[16];
#pragma unroll
        for (int r = 0; r < 16; ++r) { const size_t row = (size_t)b * SEQ + k1 + 128 * (32 * mb + crow(r, hi)); gv[r] = GS[row * 768 + 512 + 32 * cb + r32]; }
        __builtin_amdgcn_sched_barrier(0);
#pragma unroll
        for (int r = 0; r < 16; ++r) { const size_t row = (size_t)b * SEQ + k1 + 128 * (32 * mb + crow(r, hi));
            A[row * DM + 512 + 32 * cb + r32] = (bf16_t)f2bf((acc[mb][r] * nrm + bfv) * bf2f(gv[r])); }
        __builtin_amdgcn_sched_barrier(0);
    }
    __syncthreads();
}

#ifndef DMA_TWICE
#define DMA_TWICE 0
#endif
#ifndef EXTRA_EXP
#define EXTRA_EXP 0
#endif
#ifndef EXTRA_MFMA
#define EXTRA_MFMA 0
#endif
__device__ __forceinline__ void glds16(const void* gsrc, unsigned lds_dst) { unsigned keep;
    asm volatile("s_mov_b32 %0, m0\n\ts_mov_b32 m0, %2\n\ts_nop 0\n\tglobal_load_lds_dwordx4 %1, off\n\ts_mov_b32 m0, %0" : "=&s"(keep) : "v"(gsrc), "s"(lds_dst) : "memory"); }
__device__ __forceinline__ void glds16x2(const void* gsrc, unsigned lds_dst) { unsigned keep;
    asm volatile("s_mov_b32 %0, m0\n\ts_mov_b32 m0, %2\n\ts_nop 0\n\tglobal_load_lds_dwordx4 %1, off\n\tglobal_load_lds_dwordx4 %1, off offset:1024\n\ts_mov_b32 m0, %0" : "=&s"(keep) : "v"(gsrc), "s"(lds_dst) : "memory"); }
__device__ __forceinline__ void attn_unit(const Args& a, int l, LAS unsigned char* lds, int b, int h, int qrow0, int t0, int nt, int tid, int lane, int wave, bool dry) {
    unsigned char* ws = a.ws;
    const int comp = wave >> 2, qg = wave & 3, hi = lane >> 5, r32 = lane & 31;
    const bf16_t* Qg = (const bf16_t*)(ws + WS_QG);
    const unsigned char* kimg = ws + WS_KIMG + (size_t)(b * 4 + h) * NKT * 16384;
    const unsigned char* vimg = ws + WS_VIMG + (size_t)(b * 4 + h) * NKT * 16384;
    bf16x8 qr[4];
    { const bf16_t* qp = Qg + ((size_t)(qrow0 + 32 * qg + r32) * 4 + h) * 128 + comp * 64 + 8 * hi;
#pragma unroll
      for (int d0 = 0; d0 < 4; ++d0) qr[d0] = *(const bf16x8*)(qp + 16 * d0); }
    asm volatile("" : "+v"(qr[0]), "+v"(qr[1]), "+v"(qr[2]), "+v"(qr[3]));
    f32x16 o[4];
#pragma unroll
    for (int d = 0; d < 4; ++d) o[d] = f32x16{};
    float lsum = 0.f;
    const int lo = tr_lane_off(lane);
    const unsigned lds0 = (unsigned)(uintptr_t)lds;
    constexpr int KSL = 16384, VBASE = 3 * KSL;
#define ATT_DMA_K(t, slotb) do { const unsigned char* s_ = kimg + (size_t)(t) * 16384 + wave * 2048 + lane * 16; const unsigned d_ = (unsigned)__builtin_amdgcn_readfirstlane((int)(lds0 + (slotb) + wave * 2048)); \
        glds16x2(s_, d_); if (DMA_TWICE) glds16x2(s_, d_); } while (0)
#define ATT_DMA_V(t, slotb) do { const unsigned char* s_ = vimg + (size_t)(t) * 16384 + wave * 2048 + lane * 16; const unsigned d_ = (unsigned)__builtin_amdgcn_readfirstlane((int)(lds0 + VBASE + (slotb) + wave * 2048)); \
        glds16x2(s_, d_); if (DMA_TWICE) glds16x2(s_, d_); } while (0)
#define ATT_WAIT_BAR(N) asm volatile("s_waitcnt vmcnt(" #N ") lgkmcnt(0)\n\ts_barrier" ::: "memory")
#define SBAR() __builtin_amdgcn_sched_barrier(0)
#define PIN(x) asm volatile("" : "+v"(x))
    LAS const unsigned char* kp0 = lds + comp * 8192 + hi * 1024 + r32 * 16;
    LAS const unsigned char* vp0 = lds + VBASE + lo;
    bf16x8 kf[8];
#define KRD(j, slotb) do { kf[j] = *(const LAS bf16x8*)(kp0 + (slotb) + ((j) >> 1) * 2048 + ((j) & 1) * 512); } while (0)
    f32x16 pA0 = f32x16{}, pA1 = f32x16{}, pB0, pB1;
    u32x4 pw0, pw1, pw2, pw3;
    bf16x8 vA[8], vB[8];
    int sl_prev = 0, sl_cur = 0, sl_next = KSL;
#define ROT() do { sl_prev = sl_cur; sl_cur = sl_next; sl_next = (sl_next == 2 * KSL) ? 0 : sl_next + KSL; } while (0)
    ATT_DMA_K(t0, 0); ATT_DMA_V(t0, 0); ATT_DMA_K(t0 + 1, KSL); ATT_DMA_K(t0 + 2, 2 * KSL);
    ATT_WAIT_BAR(0);
#pragma unroll
    for (int j = 0; j < 8; ++j) KRD(j, 0);
    ATT_WAIT_BAR(0);
#define PKW(P, B) cvt_pk_bf16(P[B], P[B + 1])
#define EX(v) __builtin_amdgcn_exp2f(v)
#define GAPA(i, C, CIN, a0, a1, a2, a3, W0, W1, PWV) do { vA[i] = bfrag(vpp_ + (i) * 1024); SBAR(); \
        C = MFMA32(kf[i], qr[(i) >> 1], CIN); if (EXTRA_MFMA) dacc = MFMA32(kf[i], qr[(i) >> 1], dacc); sacc += a0; sacc += a1; sacc += a2; sacc += a3; PIN(sacc); W0; W1; PIN(PWV); SBAR(); } while (0)
#define GAPB_V(j, d, PWV, X, B) do { o[d] = MFMA32(__builtin_bit_cast(bf16x8, PWV), vA[j], o[d]); X[B] = EX(X[B]); X[B + 1] = EX(X[B + 1]); PIN(X); if (EXTRA_EXP) { dmy = EX(dmy); PIN(dmy); } vB[j] = bfrag(vpp_ + (8 + (j)) * 1024); SBAR(); } while (0)
#define GAPB_K(j, d, PWV, X, B) do { o[d] = MFMA32(__builtin_bit_cast(bf16x8, PWV), vB[(j) - 8], o[d]); X[B] = EX(X[B]); X[B + 1] = EX(X[B + 1]); PIN(X); if (EXTRA_EXP) { dmy = EX(dmy); PIN(dmy); } KRD((j) - 8, sl_next); SBAR(); } while (0)
    const f32x16 zero16 = f32x16{}; float dmy = 0.5f; (void)dmy; f32x16 dacc = f32x16{}; (void)dacc;
#define STEP(C0, C1, P0, P1, t) do { SBAR(); \
        LAS const unsigned char* vpp_ = vp0 + sl_prev; float sacc = 0.f; \
        GAPA(0, C0, zero16, P0[0], P0[1], P0[2], P0[3],     pw0[0] = PKW(P0, 0),  pw0[1] = PKW(P0, 2),  pw0); \
        GAPA(1, C1, zero16, P0[4], P0[5], P0[6], P0[7],     pw0[2] = PKW(P0, 4),  pw0[3] = PKW(P0, 6),  pw0); \
        GAPA(2, C0, C0,     P0[8], P0[9], P0[10], P0[11],   pw1[0] = PKW(P0, 8),  pw1[1] = PKW(P0, 10), pw1); \
        GAPA(3, C1, C1,     P0[12], P0[13], P0[14], P0[15], pw1[2] = PKW(P0, 12), pw1[3] = PKW(P0, 14), pw1); \
        GAPA(4, C0, C0,     P1[0], P1[1], P1[2], P1[3],     pw2[0] = PKW(P1, 0),  pw2[1] = PKW(P1, 2),  pw2); \
        GAPA(5, C1, C1,     P1[4], P1[5], P1[6], P1[7],     pw2[2] = PKW(P1, 4),  pw2[3] = PKW(P1, 6),  pw2); \
        GAPA(6, C0, C0,     P1[8], P1[9], P1[10], P1[11],   pw3[0] = PKW(P1, 8),  pw3[1] = PKW(P1, 10), pw3); \
        GAPA(7, C1, C1,     P1[12], P1[13], P1[14], P1[15], pw3[2] = PKW(P1, 12), pw3[3] = PKW(P1, 14), pw3); \
        lsum += sacc; \
        if ((t) + 3 < nt) ATT_DMA_K(t0 + (t) + 3, sl_cur); \
        if ((t) + 1 < nt) ATT_DMA_V(t0 + (t) + 1, sl_next); \
        SBAR(); \
        GAPB_V(0, 0, pw0, C0, 0);  GAPB_V(1, 0, pw1, C0, 2);  GAPB_V(2, 0, pw2, C0, 4);  GAPB_V(3, 0, pw3, C0, 6); \
        GAPB_V(4, 1, pw0, C0, 8);  GAPB_V(5, 1, pw1, C0, 10); GAPB_V(6, 1, pw2, C0, 12); GAPB_V(7, 1, pw3, C0, 14); \
        GAPB_K(8, 2, pw0, C1, 0);  GAPB_K(9, 2, pw1, C1, 2);  GAPB_K(10, 2, pw2, C1, 4); GAPB_K(11, 2, pw3, C1, 6); \
        GAPB_K(12, 3, pw0, C1, 8); GAPB_K(13, 3, pw1, C1, 10); GAPB_K(14, 3, pw2, C1, 12); GAPB_K(15, 3, pw3, C1, 14); \
        if ((t) + 3 < nt) { if (DMA_TWICE) ATT_WAIT_BAR(8); else ATT_WAIT_BAR(4); } else ATT_WAIT_BAR(0); \
        ROT(); } while (0)
#pragma unroll 1
    for (int t = 0; t < nt; t += 2) {
        STEP(pB0, pB1, pA0, pA1, t);
        STEP(pA0, pA1, pB0, pB1, t + 1);
    }
    {
        float sacc = 0.f;
#pragma unroll
        for (int r = 0; r < 16; ++r) sacc += pA0[r] + pA1[r];
        lsum += sacc;
        pw0 = (u32x4){PKW(pA0, 0), PKW(pA0, 2), PKW(pA0, 4), PKW(pA0, 6)}; pw1 = (u32x4){PKW(pA0, 8), PKW(pA0, 10), PKW(pA0, 12), PKW(pA0, 14)};
        pw2 = (u32x4){PKW(pA1, 0), PKW(pA1, 2), PKW(pA1, 4), PKW(pA1, 6)}; pw3 = (u32x4){PKW(pA1, 8), PKW(pA1, 10), PKW(pA1, 12), PKW(pA1, 14)};
        LAS const unsigned char* vpp_ = vp0 + sl_prev;
#pragma unroll
        for (int d = 0; d < 4; ++d) {
            const bf16x8 f0 = bfrag(vpp_ + (d * 4 + 0) * 1024), f1 = bfrag(vpp_ + (d * 4 + 1) * 1024), f2 = bfrag(vpp_ + (d * 4 + 2) * 1024), f3 = bfrag(vpp_ + (d * 4 + 3) * 1024);
            o[d] = MFMA32(__builtin_bit_cast(bf16x8, pw0), f0, o[d]); o[d] = MFMA32(__builtin_bit_cast(bf16x8, pw1), f1, o[d]);
            o[d] = MFMA32(__builtin_bit_cast(bf16x8, pw2), f2, o[d]); o[d] = MFMA32(__builtin_bit_cast(bf16x8, pw3), f3, o[d]);
        }
    }
    ATT_WAIT_BAR(0);
#undef ATT_DMA_K
#undef ATT_DMA_V
#undef ATT_WAIT_BAR
#undef SBAR
#undef PIN
#undef KRD
#undef ROT
#undef PKW
#undef EX
#undef GAPA
#undef GAPB_V
#undef GAPB_K
#undef STEP
    if (EXTRA_MFMA) asm volatile("" :: "v"(dacc));
    if (dry) return;
    LAS float* ost = (LAS float*)lds;
    LAS float* lw = (LAS float*)(lds + 72 * 1024);
    lsum += __shfl_xor(lsum, 32);
    if (hi == 0) lw[wave * 32 + r32] = lsum;
    LDS_WAIT(); asm volatile("" ::: "memory");
    const float* lamp = (const float*)(ws + WS_LAM) + 2 * l;
    const float lam = lamp[0], oscale = lamp[1];
    float rl[16];
#pragma unroll
    for (int r = 0; r < 16; ++r) rl[r] = __builtin_amdgcn_rcpf(lw[wave * 32 + crow(r, hi)]);
    if (comp == 0) {
#pragma unroll
        for (int d = 0; d < 4; ++d)
#pragma unroll
            for (int r = 0; r < 16; ++r) ost[(32 * qg + crow(r, hi)) * 132 + 32 * d + r32] = o[d][r] * rl[r];
    }
    __syncthreads();
    if (comp == 1) {
#pragma unroll
        for (int d = 0; d < 4; ++d)
#pragma unroll
            for (int r = 0; r < 16; ++r) ost[(32 * qg + crow(r, hi)) * 132 + 32 * d + r32] -= lam * o[d][r] * rl[r];
    }
    __syncthreads();
    {
        const int row = tid >> 2, qt = tid & 3; const LAS float* src = ost + row * 132 + 32 * qt;
        float v[32]; float ss = 0.f;
#pragma unroll
        for (int i = 0; i < 32; ++i) { v[i] = src[i]; ss += v[i] * v[i]; }
        ss += __shfl_xor(ss, 1); ss += __shfl_xor(ss, 2);
        const float rstd = rsqrtf(ss * (1.0f / 128.0f) + EPS) * oscale;
        const size_t grow = (size_t)qrow0 + row;
        const bf16_t* gs = (const bf16_t*)(ws + WS_GS) + grow * 768 + h * 128 + 32 * qt;
        bf16_t* dst = (bf16_t*)(ws + WS_A) + grow * DM + h * 128 + 32 * qt;
        const float* gsub = a.in[I_GSUB] + l * 128 + 32 * qt;
#pragma unroll
        for (int i = 0; i < 4; ++i) { const u32x4 gw = *(const u32x4*)(gs + 8 * i); u32x4 w;
#pragma unroll
            for (int e = 0; e < 4; ++e) { const int j = 8 * i + 2 * e; w[e] = pk2(v[j] * rstd * gsub[j] * bflo(gw[e]), v[j + 1] * rstd * gsub[j + 1] * bfhi(gw[e])); }
            *(u32x4*)(dst + 8 * i) = w; }
    }
    __syncthreads();
}

#ifndef REPEAT_PHASE
#define REPEAT_PHASE (-1)
#endif
constexpr int N_PHASES = 10 + (REPEAT_PHASE >= 0 ? 1 : 0);
__global__ void __launch_bounds__(NTHREADS, 2) fwd_kernel(Args args) {
    extern __shared__ __attribute__((aligned(16))) unsigned char lds_raw[];
    LAS unsigned char* lds = (LAS unsigned char*)lds_raw;
    const int tid = threadIdx.x, lane = tid & 63, wave = __builtin_amdgcn_readfirstlane(tid >> 6);
    const int bx = blockIdx.x, vcu = (bx % 8) * (GRID / 8) + bx / 8;
    unsigned char* ws = args.ws;
    volatile LAS unsigned* MISC = (volatile LAS unsigned*)(lds + MISC_OFF);
    for (int u = tid; u < 32; u += NTHREADS) MISC[u] = 0u;
    __syncthreads();
    XcdBarrier bar; bar.bar = (unsigned*)(ws + WS_CTL) + CW_BAR; bar.x = 0; bar.st = nullptr;
    const bool one_launch = (args.ph_hi - args.ph_lo) > 1;
    if (one_launch) { bar = xcd_barrier_post((unsigned*)(ws + WS_CTL) + CW_BAR, MISC + 8);
        if (tid == 0) { unsigned nloc, nx; xcd_barrier_complete(bar.bar, bar.x, nloc, nx); MISC[8] = nloc; MISC[9] = nx; }
        __syncthreads(); }
#ifndef REPEAT_PHASE
#define REPEAT_PHASE (-1)
#endif
#ifndef PRO_PROBE
#define PRO_PROBE 15
#endif
#ifndef PHMASK
#define PHMASK 0xffff
#endif
#define EN(b) (((PHMASK) >> (b)) & 1)
#define LAUNDER() int wave_ = wave, vcu_ = vcu; asm volatile("" : "+s"(wave_)); asm volatile("" : "+s"(vcu_)); int lane_ = (int)__builtin_amdgcn_mbcnt_hi(~0u, __builtin_amdgcn_mbcnt_lo(~0u, 0u)); asm volatile("" : "+v"(lane_)); const int tid_ = wave_ * 64 + lane_; (void)lane_; (void)wave_
#pragma unroll 1
    for (int pc = args.ph_lo; pc < args.ph_hi; ++pc) {
        const int ph = (REPEAT_PHASE >= 0 && pc > REPEAT_PHASE) ? pc - 1 : pc;
        const int l = ph >= 5 ? 1 : 0;
        const bool second = (REPEAT_PHASE >= 0 && pc == REPEAT_PHASE + 1); (void)second;
        const int kind = ph == 0 ? 6 : (ph == 5 ? 7 : (ph < 5 ? ph - 1 : ph - 6));
        const bf16_t* Wl = (const bf16_t*)(ws + WS_WIN) + (size_t)l * NPHYS * DM;
        LAUNDER();
        if (kind == 6) { if (EN(0)) {
            unsigned* sp0 = (unsigned*)(ws + WS_CTL) + 8192 + 4096;
            ph0_mods(args, lane_, wave_, vcu_);
            split_arrive(sp0, bar, one_launch);
            ph0_prologue(args, lds, tid_, lane_, wave_, vcu_, second ? PRO_PROBE : 7);
            split_wait(sp0, bar, one_launch, (unsigned*)(ws + WS_CTL) + CW_BAR + XB_TMO); } }
        if (kind == 6 || kind == 7) { if (EN(1)) { int wave2 = wave, vcu2 = vcu; asm volatile("" : "+s"(wave2)); asm volatile("" : "+s"(vcu2)); int lane2 = (int)__builtin_amdgcn_mbcnt_hi(~0u, __builtin_amdgcn_mbcnt_lo(~0u, 0u)); asm volatile("" : "+v"(lane2)); const int tid2 = wave2 * 64 + lane2;
            prepass(args, kind == 6 ? 0 : 1, lds, tid2, lane2, wave2, vcu2); } }
        else if (kind == 0) { if (EN(2)) {
            pg8::Gemm g{(const bf16_t*)(ws + WS_H), Wl, DM, DM, 0, 0, 0, 16, 16, 16, nullptr, nullptr, 0};
            TileSched S{vcu_ >> 5, vcu_ & 31, 0, 14, 1, l == 0 ? 52 : 8, l == 0 ? 0 : 2, l == 0 ? 26 : 4};
            EpiIn E{ws, args.in[I_GQ] + l * 64, args.in[I_GK] + l * 64, (LAS const float*)(lds + ROPE_LDS), (LAS const float*)(lds + ROPE_LDS) + 2048};
            { const float* rt = (const float*)(ws + WS_ROPE); LAS float* rl_ = (LAS float*)(lds + ROPE_LDS);
#pragma unroll
              for (int i = 0; i < 8; ++i) rl_[tid_ + i * NTHREADS] = rt[tid_ + i * NTHREADS];
              __syncthreads(); }
            pg8::gemm_phase<EpiIn, TileSched, true, true>(lds, g, S, E, tid_); } }
        else if (kind == 1) { if (EN(4)) {
            if (!second) {
                if (EN(8)) f1_unit(ws, lds, vcu_, tid_, lane_, wave_);
                const int nsgu = l == 0 ? 132 : 128;
                if (EN(9)) for (int cu = 255 - vcu_; cu < nsgu; cu += GRID) sgu_unit(args, l, lds, cu, tid_, lane_, wave_);
                if (EN(10) && l == 0 && vcu_ < 8) ctxf_unit(args, l, lds, vcu_, tid_, lane_, wave_);
            }
            const int bh = vcu_ >> 5, qb = vcu_ & 31;
            if (EN(12)) {
                const int nun = (l == 0 && qb < 2) ? 3 : 2;
#pragma unroll 1
                for (int ui = 0; ui < nun; ++ui) {
                    const int qrow0 = ui < 2 ? (bh >> 2) * SEQ + 256 * qb + 128 * ui : MLAT + (bh >> 2) * NCTX + 128 * qb;
                    attn_unit(args, l, lds, bh >> 2, bh & 3, qrow0, ui < 2 ? 0 : SEQ / 64, ui < 2 ? NKT : NCTX / 64, tid_, lane_, wave_, second);
                }
            } } }
        else if (kind == 2) { if (EN(5)) {
            unsigned* sp = (unsigned*)(ws + WS_CTL) + 8192 + l * 2048;
            if (EN(11)) f2_unit(args, l, lds, vcu_, tid_, lane_, wave_);
            split_arrive(sp, bar, one_launch);
            if (l == 0) ctx_branch_proj(ws, (const bf16_t*)(ws + WS_WBR), vcu_ * NWAVES + wave_, lane_);
            pg8::Gemm g{(const bf16_t*)(ws + WS_A), (const bf16_t*)(ws + WS_WBR) + (size_t)l * DM * DM, DM, DM, 0, 512, 768, 8, 4, 4, (const bf16_t*)(ws + WS_H), Wl, 16};
            FusedSched S{vcu_ >> 5, vcu_ & 31, sp, bar, one_launch, (unsigned*)(ws + WS_CTL) + CW_BAR + XB_TMO};
            EpiMY E{EpiIn{ws, nullptr, nullptr, nullptr, nullptr}, EpiY{(const unsigned char*)(ws + WS_MS), (bf16_t*)(ws + WS_Y)}};
            pg8::gemm_phase<EpiMY, FusedSched, true, true>(lds, g, S, E, tid_); } }
        else { if (EN(7)) {
            pg8::Gemm g{(const bf16_t*)(ws + WS_Y), (const bf16_t*)(ws + WS_WOUT) + (size_t)l * DM * DM, DM, DM, 0, 0, 0, 16, 16, 16, nullptr, nullptr, 0};
            TileSched S{vcu_ >> 5, vcu_ & 31, 0, 4, 1, 0, 0, 4};
            if (l == 0) ctx_out_proj(ws, (const bf16_t*)(ws + WS_WOUT), args.in[I_CTX], (const float*)(ws + WS_MODF) + 2 * 3072 + 2048, vcu_ * NWAVES + wave_, lane_);
            EpiOut E{args.in[I_X], args.out, ws, (const float*)(ws + WS_MODF) + (size_t)(l * 3) * 3072 + 2048, l};
            pg8::gemm_phase<EpiOut, TileSched, true, true>(lds, g, S, E, tid_); } }
        if (pc + 1 < args.ph_hi) { XcdBarrier b2_ = bar; asm volatile("" : "+s"(b2_.bar)); xcd_barrier(b2_); }
    }
}

extern "C" void kernel_launch(void* const* d_in, const int* in_sizes, int n_in, void* d_out, int out_size, void* d_ws, size_t ws_size, hipStream_t stream) {
    static int ready = 0;
    if (ready == 0) {
        if (n_in != 25 || out_size != MLAT * DM || ws_size < 256 * MiB) { fprintf(stderr, "kernel_launch: unexpected shapes (n_in %d out %d ws %zu)\n", n_in, out_size, ws_size); ready = -1; return; }
        int dev = 0, cus = 0, per_cu = 0;
        hipGetDevice(&dev); hipDeviceGetAttribute(&cus, hipDeviceAttributeMultiprocessorCount, dev);
        if (hipFuncSetAttribute((const void*)fwd_kernel, hipFuncAttributeMaxDynamicSharedMemorySize, LDS_BYTES) != hipSuccess) { fprintf(stderr, "kernel_launch: hipFuncSetAttribute failed\n"); ready = -1; return; }
        hipOccupancyMaxActiveBlocksPerMultiprocessor(&per_cu, (const void*)fwd_kernel, NTHREADS, LDS_BYTES);
        (void)hipGetLastError();
        if (cus != GRID || per_cu < 1) fprintf(stderr, "kernel_launch: note: %d CUs, occupancy %d blocks/CU (built for 256 CUs, 1 block/CU)\n", cus, per_cu);
        ready = (cus >= GRID) ? 1 : -1;
    }
    if (ready < 0) return;
    hipMemsetAsync((char*)d_ws + WS_CTL, 0, CTL_ZERO_BYTES, stream);
    Args a{};
    for (int i = 0; i < 25; ++i) a.in[i] = (const float*)d_in[i];
    a.out = (float*)d_out; a.ws = (unsigned char*)d_ws;
#if MK_N_LAUNCHES == 1
    a.ph_lo = 0; a.ph_hi = N_PHASES;
    hipLaunchKernelGGL(fwd_kernel, dim3(GRID), dim3(NTHREADS), LDS_BYTES, stream, a);
#else
    for (int p = 0; p < N_PHASES; ++p) { a.ph_lo = p; a.ph_hi = p + 1; hipLaunchKernelGGL(fwd_kernel, dim3(GRID), dim3(NTHREADS), LDS_BYTES, stream, a); }
#endif
}
```

```cpp
#include <hip/hip_runtime.h>
#include <cstdio>
#include <cstdint>

#ifndef MK_N_LAUNCHES
#define MK_N_LAUNCHES 1
#endif

#define LAS __attribute__((address_space(3)))
#define GAS __attribute__((address_space(1)))
typedef unsigned short bf16_t;
typedef short bf16x8 __attribute__((ext_vector_type(8)));
typedef short s16x4 __attribute__((ext_vector_type(4)));
typedef float f32x4 __attribute__((ext_vector_type(4)));
typedef float f32x2 __attribute__((ext_vector_type(2)));
typedef float f32x16 __attribute__((ext_vector_type(16)));
typedef unsigned u32x4 __attribute__((ext_vector_type(4)));
typedef unsigned u32x2 __attribute__((ext_vector_type(2)));

constexpr int DM = 1024, BATCH = 2, SEQ = 8192, NCTX = 256, DEPTH = 2;
constexpr int MLAT = BATCH * SEQ, MCTX = BATCH * NCTX, MT = MLAT + MCTX;
constexpr int NKEY = SEQ + NCTX, NKT = NKEY / 64;
constexpr int INW = 6400;
constexpr int OFF_Q = 0, OFF_K = 512, OFF_V = 1024, OFF_F = 1536, OFF_U = 1792, OFF_VC = 2048, OFF_GATE = 2304, OFF_MERGE = 3328;
constexpr int NPHYS = 6656;
constexpr float EPS = 1e-6f;
constexpr float QSCALE = 0.125f * 1.4426950408889634f;

constexpr size_t KiB = 1024, MiB = 1u << 20;
constexpr size_t WS_CTL = 0, CTL_ZERO_BYTES = 64 * KiB;
constexpr size_t WS_MODP = 1 * MiB;
constexpr size_t WS_MODF = WS_MODP + 2304 * KiB;
constexpr size_t WS_ROPE = WS_MODF + 72 * KiB;
constexpr size_t WS_TW = WS_ROPE + 16 * KiB;
constexpr size_t WS_LAM = WS_TW + 64 * KiB;
constexpr size_t WS_C128 = WS_LAM + 1 * KiB;
constexpr size_t WS_S128 = WS_C128 + 32 * KiB;
constexpr size_t WS_T64 = WS_S128 + 32 * KiB;
constexpr size_t WS_TC256 = WS_T64 + 16 * KiB;
constexpr size_t WS_WSIMG = WS_TC256 + 256 * KiB;
constexpr size_t WS_SMALL_END = WS_WSIMG + 256 * KiB;
static_assert(WS_SMALL_END <= 5 * MiB, "small tables");
constexpr size_t WS_WIN = 5 * MiB;
constexpr size_t WS_WBR = 31 * MiB;
constexpr size_t WS_WOUT = 35 * MiB;
constexpr size_t WS_CTX1 = 39 * MiB;
constexpr size_t WS_H = 41 * MiB;
constexpr size_t WS_A = 74 * MiB;
constexpr size_t WS_R = 107 * MiB;
constexpr size_t SZ_QG = (size_t)MT * 512 * 2, SZ_KIMG = (size_t)BATCH * 4 * NKT * 16384, SZ_Z2 = (size_t)MT * 512 * 2, SZ_UG = (size_t)MT * 256 * 2, SZ_GS = (size_t)MT * 768 * 2;
constexpr size_t WS_QG = WS_R, WS_KIMG = WS_QG + SZ_QG, WS_VIMG = WS_KIMG + SZ_KIMG, WS_Z2 = WS_VIMG + SZ_KIMG, WS_UG = WS_Z2 + SZ_Z2, WS_VC = WS_UG + SZ_UG, WS_GS = WS_VC + SZ_UG;
constexpr size_t WS_Y = WS_Z2;
static_assert(WS_Z2 + (size_t)MT * DM * 2 == WS_GS, "Y overlays Z2 | UG | VC exactly");
constexpr size_t WS_MS = WS_R;
constexpr size_t WS_END = WS_GS + SZ_GS;
constexpr size_t WS_X1B0 = 229 * MiB, WS_X1B1 = 215 * MiB;
constexpr int X1B_SPLIT = 13824;
constexpr size_t WS_MSC = 224 * MiB;
static_assert(WS_X1B1 >= WS_END && WS_X1B1 + (size_t)(MLAT - X1B_SPLIT) * 2048 <= WS_MSC && WS_MSC + (size_t)MCTX * 3072 <= WS_X1B0 && WS_X1B0 + (size_t)X1B_SPLIT * 2048 <= 256 * MiB, "x1b map");
static_assert(WS_MS + (size_t)MT * 3072 <= WS_Z2 && WS_END <= WS_MSC && WS_MSC + (size_t)MCTX * 3072 * 2 <= 256 * MiB, "d_ws map");

__host__ __device__ __forceinline__ size_t x1b_off(int row) { return row < X1B_SPLIT ? WS_X1B0 + (size_t)row * 2048 : WS_X1B1 + (size_t)(row - X1B_SPLIT) * 2048; }
__device__ __forceinline__ unsigned f2bf(float f) { unsigned u = __builtin_bit_cast(unsigned, f); return (u + 0x7fffu + ((u >> 16) & 1u)) >> 16; }
__device__ __forceinline__ unsigned pk2(float lo, float hi) { return f2bf(lo) | (f2bf(hi) << 16); }
__device__ __forceinline__ unsigned cvt_pk_bf16(float lo, float hi) { unsigned r; asm volatile("v_cvt_pk_bf16_f32 %0, %1, %2" : "=v"(r) : "v"(lo), "v"(hi)); return r; }
__device__ __forceinline__ float bf2f(unsigned short v) { return __builtin_bit_cast(float, (unsigned)v << 16); }
__device__ __forceinline__ float bflo(unsigned w) { return __builtin_bit_cast(float, w << 16); }
__device__ __forceinline__ float bfhi(unsigned w) { return __builtin_bit_cast(float, w & 0xffff0000u); }
__device__ __forceinline__ float fast_sigmoid(float x) { return __builtin_amdgcn_rcpf(1.0f + __builtin_amdgcn_exp2f(-1.4426950408889634f * x)); }
__device__ __forceinline__ unsigned ms_quant_pk(float x, unsigned sel, unsigned old) { const float q = __builtin_amdgcn_rcpf((1.0f / 255.0f) + __builtin_amdgcn_exp2f(__builtin_fmaf(x, -1.4426950408889634f, -7.994353436858858f)));
    return __builtin_amdgcn_cvt_pk_u8_f32(__builtin_fmaxf(q, 1.0f), sel, old); }
__device__ __forceinline__ float ub(unsigned w, int i) { return (float)((w >> (8 * i)) & 0xffu); }
__device__ __forceinline__ float fast_silu(float x) { return x * fast_sigmoid(x); }
__device__ __forceinline__ int crow(int r, int hi) { return (r & 3) + 8 * (r >> 2) + 4 * hi; }
__host__ __device__ __forceinline__ int perm32(int rho) { const int n = rho >> 4, i = rho & 15; return 8 * (i >> 2) + 4 * n + (i & 3); }
__host__ __device__ __forceinline__ int invperm32(int c) { return 16 * ((c >> 2) & 1) + 4 * (c >> 3) + (c & 3); }
#define LDS_WAIT() asm volatile("s_waitcnt lgkmcnt(0)" ::: "memory")
#define VM_WAIT() asm volatile("s_waitcnt vmcnt(0)" ::: "memory")

namespace pg8 {
constexpr int BM = 256, BK = 64, HALF = 128, HTB = HALF * BK * 2  , STAGE_BYTES = 8 * HTB;
__host__ __device__ __forceinline__ int lds_byte(int r, int c) { const int st = (r >> 4) * 2 + (c >> 5), rr = r & 15, cc = c & 31, ob = rr * 64 + cc * 2; return st * 1024 + (ob ^ (((ob >> 9) & 1) << 5)); }
__host__ __device__ __forceinline__ void stage_rc(int b, int& R, int& C) { const int st = b / 1024, sb = b % 1024, swz = sb ^ (((sb >> 9) & 1) << 5); R = (st >> 1) * 16 + swz / 64; C = (st & 1) * 32 + (swz % 64) / 2; }

struct Unit { int pm, pn, seg, set; };
struct Gemm { const bf16_t* A; const bf16_t* Bt; int lda, ldb; int k0_0, k0_1, k0_2; int nt_0, nt_1, nt_2; const bf16_t* A1; const bf16_t* Bt1; int nt_set1; };

template <class Epi, class Sched, bool ALIGN_EPI = false, bool SP2 = false, int LOOP_PAD = 0>
__device__ __forceinline__ void gemm_phase(LAS unsigned char* lds, const Gemm g, const Sched& S, const Epi& E, const int tid) {
    const int wid = __builtin_amdgcn_readfirstlane(tid >> 6), lane = tid & 63, wr = wid >> 2, wc = wid & 3, fr = lane & 15, fq = lane >> 4;
    unsigned voffA[2], voffB[2];
#pragma unroll
    for (int i = 0; i < 2; ++i) { int R, C; stage_rc(tid * 16 + i * 8192, R, C); voffA[i] = (unsigned)(R * g.lda + C) * 2u; voffB[i] = (unsigned)(R * g.ldb + C) * 2u; }
    const size_t kstep = (size_t)(BK * 2);
    const size_t hstepA = (size_t)HALF * g.lda * 2, hstepB = (size_t)HALF * g.ldb * 2;
    const size_t tstepA = 2 * hstepA, tstepB = 2 * hstepB;
    const unsigned ldsw = (unsigned)wid * 1024u;
    const int aoff = lds_byte(wr * 64 + fr, fq * 8), boff = lds_byte(wc * 32 + fr, fq * 8);
#define PG8_SA(b, h) (((b) * 2 + (h)) * HTB)
#define PG8_SB(b, h) ((4 + (b) * 2 + (h)) * HTB)
#define PG8_STAGE(bufoff, gbase, voff) do { _Pragma("unroll") for (int _i = 0; _i < 2; ++_i) \
        __builtin_amdgcn_global_load_lds((const unsigned*)((const char*)(gbase) + (voff)[_i]), (LAS unsigned*)(lds + (bufoff) + ldsw + _i * 8192), 16, 0, 0); } while (0)
#define PG8_LDA(dst, b, h) do { _Pragma("unroll") for (int m = 0; m < 4; ++m) _Pragma("unroll") for (int k = 0; k < 2; ++k) dst[m][k] = *(const LAS bf16x8*)(lds + PG8_SA(b, h) + aoff + m * 2048 + k * 1024); } while (0)
#define PG8_LDB(dst, b, h) do { _Pragma("unroll") for (int n = 0; n < 2; ++n) _Pragma("unroll") for (int k = 0; k < 2; ++k) dst[n][k] = *(const LAS bf16x8*)(lds + PG8_SB(b, h) + boff + n * 2048 + k * 1024); } while (0)
#define PG8_MMA(ai, bj, At, Bt) do { __builtin_amdgcn_s_setprio(1); _Pragma("unroll") for (int m = 0; m < 4; ++m) _Pragma("unroll") for (int n = 0; n < 2; ++n) _Pragma("unroll") for (int k = 0; k < 2; ++k) \
        acc[ai][bj][m][n] = __builtin_amdgcn_mfma_f32_16x16x32_bf16(Bt[n][k], At[m][k], acc[ai][bj][m][n], 0, 0, 0); __builtin_amdgcn_s_setprio(0); } while (0)
#define PG8_WAIT_V(n) asm volatile("s_waitcnt vmcnt(" #n ")" ::: "memory")
#define PG8_WAIT_L(n) asm volatile("s_waitcnt lgkmcnt(" #n ")" ::: "memory")
#define PG8_BAR __builtin_amdgcn_s_barrier()
#define PG8_SCHED __builtin_amdgcn_sched_barrier(0)
#define PG8_K0(u) ((u).set ? 0 : ((u).seg == 0 ? g.k0_0 : ((u).seg == 1 ? g.k0_1 : g.k0_2)))
#define PG8_NT(u) ((u).set ? g.nt_set1 : ((u).seg == 0 ? g.nt_0 : ((u).seg == 1 ? g.nt_1 : g.nt_2)))
#define PG8_UA(u) ((const char*)((u).set ? g.A1 : g.A) + (size_t)(u).pm * tstepA + (size_t)PG8_K0(u) * 2)
#define PG8_UB(u) ((const char*)((u).set ? g.Bt1 : g.Bt) + (size_t)(u).pn * tstepB + (size_t)PG8_K0(u) * 2)
    Unit cur, nxt; int ui = 0;
    if (!S.next(0, cur)) return;
    f32x4 acc[2][2][4][2];
#pragma unroll
    for (int a = 0; a < 2; ++a)
#pragma unroll
        for (int b = 0; b < 2; ++b)
#pragma unroll
            for (int m = 0; m < 4; ++m)
#pragma unroll
                for (int n = 0; n < 2; ++n) acc[a][b][m][n] = (f32x4){0.f, 0.f, 0.f, 0.f};
    bf16x8 At[4][2], B0[2][2], B1[2][2];
    const char* cA = PG8_UA(cur); const char* cB = PG8_UB(cur); int nt = PG8_NT(cur);
    if constexpr (SP2) {
        PG8_STAGE(PG8_SB(0, 0), cB, voffB); PG8_STAGE(PG8_SB(0, 1), cB + hstepB, voffB); PG8_STAGE(PG8_SA(0, 0), cA, voffA); PG8_STAGE(PG8_SA(0, 1), cA + hstepA, voffA);
        if (wr == 1) PG8_BAR;
        PG8_WAIT_V(2); PG8_BAR;
        PG8_STAGE(PG8_SB(1, 0), cB + kstep, voffB); PG8_STAGE(PG8_SA(1, 0), cA + kstep, voffA); PG8_STAGE(PG8_SB(1, 1), cB + hstepB + kstep, voffB);
        PG8_WAIT_V(6); PG8_BAR;
    } else {
        PG8_STAGE(PG8_SB(0, 0), cB, voffB); PG8_STAGE(PG8_SA(0, 0), cA, voffA); PG8_STAGE(PG8_SB(0, 1), cB + hstepB, voffB); PG8_STAGE(PG8_SA(0, 1), cA + hstepA, voffA);
        if (wr == 1) PG8_BAR;
        PG8_WAIT_V(4); PG8_BAR;
        PG8_STAGE(PG8_SB(1, 0), cB + kstep, voffB); PG8_STAGE(PG8_SA(1, 0), cA + kstep, voffA); PG8_STAGE(PG8_SB(1, 1), cB + hstepB + kstep, voffB);
        PG8_WAIT_V(6); PG8_BAR;
    }
    for (;;) {
        const bool has_next = S.next(ui + 1, nxt);
        const char* nA = has_next ? PG8_UA(nxt) : cA; const char* nB = has_next ? PG8_UB(nxt) : cB;
        asm volatile(".rept %0\n\ts_nop 0\n\t.endr" :: "i"(LOOP_PAD) : "memory");
        for (int t = 0; t < nt; t += 2) {
            const bool last = (t == nt - 2);
            if (last && has_next) S.a_ready(nxt);
            const char* a1 = cA + (size_t)(t + 1) * kstep;
            const char* a2 = last ? nA : cA + (size_t)(t + 2) * kstep; const char* b2 = last ? nB : cB + (size_t)(t + 2) * kstep;
            const char* a3 = a2 + kstep; const char* b3 = b2 + kstep;
            if constexpr (SP2) {
            PG8_LDB(B0, 0, 0); PG8_LDB(B1, 0, 1); PG8_SCHED; PG8_LDA(At, 0, 0); PG8_STAGE(PG8_SA(1, 1), a1 + hstepA, voffA);
            PG8_WAIT_V(8); PG8_WAIT_L(0); PG8_BAR; PG8_MMA(0, 0, At, B0); PG8_MMA(0, 1, At, B1); PG8_BAR; PG8_SCHED;
            PG8_LDA(At, 0, 1); PG8_STAGE(PG8_SB(0, 0), b2, voffB); PG8_STAGE(PG8_SB(0, 1), b2 + hstepB, voffB); PG8_STAGE(PG8_SA(0, 0), a2, voffA);
            PG8_WAIT_V(8); PG8_WAIT_L(0); PG8_BAR; PG8_MMA(1, 0, At, B0); PG8_MMA(1, 1, At, B1); PG8_BAR; PG8_SCHED;
            PG8_LDB(B0, 1, 0); PG8_LDB(B1, 1, 1); PG8_SCHED; PG8_LDA(At, 1, 0); PG8_STAGE(PG8_SA(0, 1), a2 + hstepA, voffA);
            PG8_WAIT_V(8); PG8_WAIT_L(0); PG8_BAR; PG8_MMA(0, 0, At, B0); PG8_MMA(0, 1, At, B1); PG8_BAR; PG8_SCHED;
            PG8_LDA(At, 1, 1); PG8_STAGE(PG8_SB(1, 0), b3, voffB); PG8_STAGE(PG8_SB(1, 1), b3 + hstepB, voffB); PG8_STAGE(PG8_SA(1, 0), a3, voffA);
            PG8_WAIT_V(8); PG8_WAIT_L(0); PG8_BAR; PG8_MMA(1, 0, At, B0); PG8_MMA(1, 1, At, B1); PG8_BAR; PG8_SCHED;
            } else {
            PG8_LDB(B0, 0, 0); PG8_SCHED; PG8_LDA(At, 0, 0); PG8_STAGE(PG8_SA(1, 1), a1 + hstepA, voffA);
            PG8_WAIT_L(8); PG8_BAR; PG8_WAIT_L(0); PG8_MMA(0, 0, At, B0); PG8_BAR; PG8_SCHED;
            PG8_LDB(B1, 0, 1); PG8_STAGE(PG8_SB(0, 0), b2, voffB);
            PG8_BAR; PG8_WAIT_L(0); PG8_MMA(0, 1, At, B1); PG8_BAR;
            PG8_LDA(At, 0, 1); PG8_STAGE(PG8_SA(0, 0), a2, voffA);
            PG8_BAR; PG8_WAIT_L(0); PG8_MMA(1, 0, At, B0); PG8_BAR; PG8_SCHED;
            PG8_STAGE(PG8_SB(0, 1), b2 + hstepB, voffB);
            PG8_WAIT_V(6); PG8_BAR; PG8_MMA(1, 1, At, B1); PG8_BAR;
            PG8_LDB(B0, 1, 0); PG8_SCHED; PG8_LDA(At, 1, 0); PG8_STAGE(PG8_SA(0, 1), a2 + hstepA, voffA);
            PG8_WAIT_L(8); PG8_BAR; PG8_WAIT_L(0); PG8_MMA(0, 0, At, B0); PG8_BAR; PG8_SCHED;
            PG8_LDB(B1, 1, 1); PG8_STAGE(PG8_SB(1, 0), b3, voffB);
            PG8_BAR; PG8_WAIT_L(0); PG8_MMA(0, 1, At, B1); PG8_BAR;
            PG8_LDA(At, 1, 1); PG8_STAGE(PG8_SA(1, 0), a3, voffA);
            PG8_BAR; PG8_WAIT_L(0); PG8_MMA(1, 0, At, B0); PG8_BAR; PG8_SCHED;
            PG8_STAGE(PG8_SB(1, 1), b3 + hstepB, voffB);
            PG8_WAIT_V(6); PG8_BAR; PG8_MMA(1, 1, At, B1); PG8_BAR;
            }
        }
        if constexpr (ALIGN_EPI) { if (wr == 0) PG8_BAR; }
        const bool reset_acc = E(acc, cur, wr, wc, fr, fq);
        if (!has_next) break;
        if (reset_acc) {
#pragma unroll
        for (int a = 0; a < 2; ++a)
#pragma unroll
            for (int b = 0; b < 2; ++b)
#pragma unroll
                for (int m = 0; m < 4; ++m)
#pragma unroll
                    for (int n = 0; n < 2; ++n) acc[a][b][m][n] = (f32x4){0.f, 0.f, 0.f, 0.f};
        }
        cur = nxt; cA = nA; cB = nB; nt = PG8_NT(cur); ++ui;
        if constexpr (ALIGN_EPI) { if (wr == 1) PG8_BAR; }
    }
    PG8_WAIT_V(0);
    if constexpr (!ALIGN_EPI) { if (wr == 0) PG8_BAR; }
    PG8_BAR;
#undef PG8_SA
#undef PG8_SB
#undef PG8_STAGE
#undef PG8_LDA
#undef PG8_LDB
#undef PG8_MMA
#undef PG8_WAIT_V
#undef PG8_WAIT_L
#undef PG8_BAR
#undef PG8_SCHED
#undef PG8_K0
#undef PG8_NT
#undef PG8_UA
#undef PG8_UB
}
}

#define XB_TMO      128
#define XB_XCNT(j)  (256  + 64 * (j))
#define XB_XSUB(j)  (1280 + 64 * (j))
#define XB_XGEN(j)  (2304 + 64 * (j))
#define XB_TOP      3328
#define XB_TOPGEN   3392
#define XCD_BAR_WORDS 3456
#define XB_SPIN_CAP (1u << 18)
__device__ __forceinline__ unsigned xb_ld(unsigned* p)              { return __hip_atomic_load(p, __ATOMIC_RELAXED, __HIP_MEMORY_SCOPE_AGENT); }
__device__ __forceinline__ unsigned xb_add(unsigned* p, unsigned v) { return __hip_atomic_fetch_add(p, v, __ATOMIC_RELAXED, __HIP_MEMORY_SCOPE_AGENT); }
__device__ __forceinline__ unsigned xb_xcc_id() { return (unsigned)__builtin_amdgcn_s_getreg((3 << 11) | 20) & 0xFu; }
#define XB_SPIN(cond, bar) do { unsigned _sp = 0; while (cond) { __builtin_amdgcn_s_sleep(1); \
    if ((++_sp & 255u) == 0u) { if (xb_ld(&(bar)[XB_TMO])) break; if (_sp > XB_SPIN_CAP) { atomicAdd(&(bar)[XB_TMO], 1u); break; } } } } while (0)
struct XcdBarrier { unsigned* bar; unsigned x; volatile LAS unsigned* st; };
__device__ __forceinline__ XcdBarrier xcd_barrier_post(unsigned* bar, volatile LAS unsigned* st) {
    XcdBarrier b; b.bar = bar; b.x = xb_xcc_id(); b.st = st;
    if (threadIdx.x == 0) (void)xb_add(&bar[XB_XCNT(b.x)], 1u);
    return b;
}
__device__ __forceinline__ void xcd_barrier_complete(unsigned* bar, unsigned x, unsigned& nloc, unsigned& nx) {
    const unsigned G = gridDim.x * gridDim.y * gridDim.z;
    unsigned sum, cnt, mine, sp = 0u;
    for (;;) {
        sum = 0u; cnt = 0u; mine = 0u;
#pragma unroll
        for (unsigned j = 0; j < 16; ++j) { const unsigned c = xb_ld(&bar[XB_XCNT(j)]); sum += c; cnt += (c > 0u) ? 1u : 0u; mine = (j == x) ? c : mine; }
        if (sum == G) break;
        __builtin_amdgcn_s_sleep(1);
        if ((++sp & 255u) == 0u) { if (xb_ld(&bar[XB_TMO])) break; if (sp > XB_SPIN_CAP) { atomicAdd(&bar[XB_TMO], 1u); break; } }
    }
    nloc = mine > 0u ? mine : 1u; nx = cnt > 0u ? cnt : 1u;
}
__device__ __forceinline__ void xcd_barrier(const XcdBarrier& b) {
    asm volatile("s_waitcnt vmcnt(0)" ::: "memory");
    __syncthreads();
    if (threadIdx.x == 0) {
        unsigned* bar = b.bar;
        __builtin_amdgcn_s_waitcnt(0);
        const unsigned nloc = b.st[0], nx = b.st[1];
        const unsigned old = xb_add(&bar[XB_XSUB(b.x)], 1u);
        const unsigned gen = old / nloc;
        if (old + 1u == (gen + 1u) * nloc) {
            __builtin_amdgcn_fence(__ATOMIC_RELEASE, "agent");
            asm volatile("s_waitcnt vmcnt(0)" ::: "memory");
            const unsigned og = xb_add(&bar[XB_TOP], 1u);
            const unsigned tg = og / nx;
            if (og + 1u == (tg + 1u) * nx) xb_add(&bar[XB_TOPGEN], 1u);
            else XB_SPIN(xb_ld(&bar[XB_TOPGEN]) == tg, bar);
            __builtin_amdgcn_fence(__ATOMIC_ACQUIRE, "agent");
            xb_add(&bar[XB_XGEN(b.x)], 1u);
            asm volatile("s_waitcnt vmcnt(0)" ::: "memory");
        } else {
            XB_SPIN(xb_ld(&bar[XB_XGEN(b.x)]) == gen, bar);
            __builtin_amdgcn_fence(__ATOMIC_ACQUIRE, "agent");
            asm volatile("s_waitcnt vmcnt(0)" ::: "memory");
        }
    }
    __syncthreads();
}


__device__ __forceinline__ void split_arrive(unsigned* sp, const XcdBarrier& b, bool hier) {
    asm volatile("s_waitcnt vmcnt(0)" ::: "memory");
    __syncthreads();
    if (threadIdx.x == 0) {
        if (hier) { const unsigned nloc = b.st[0];
            const unsigned old = xb_add(&sp[64 * b.x], 1u);
            if (old + 1u == nloc) { __builtin_amdgcn_fence(__ATOMIC_RELEASE, "agent"); asm volatile("s_waitcnt vmcnt(0)" ::: "memory"); xb_add(&sp[64 * 16], 1u); } }
        else { __builtin_amdgcn_fence(__ATOMIC_RELEASE, "agent"); asm volatile("s_waitcnt vmcnt(0)" ::: "memory"); xb_add(&sp[64 * 16], 1u); }
    }
}
__device__ __forceinline__ void split_wait(unsigned* sp, const XcdBarrier& b, bool hier, unsigned* tmo) {
    if (threadIdx.x < 64) {
        const unsigned need = hier ? b.st[1] : gridDim.x;
        unsigned spn = 0;
        while ((unsigned)__builtin_amdgcn_readfirstlane((int)xb_ld(&sp[64 * 16])) < need) { __builtin_amdgcn_s_sleep(2);
            if ((++spn & 255u) == 0u) { if (xb_ld(tmo)) break; if (spn > XB_SPIN_CAP) { if (threadIdx.x == 0) atomicAdd(tmo, 1u); break; } } }
        __builtin_amdgcn_fence(__ATOMIC_ACQUIRE, "agent");
        asm volatile("s_waitcnt vmcnt(0)" ::: "memory");
    }
    asm volatile("" ::: "memory"); __builtin_amdgcn_s_barrier(); asm volatile("" ::: "memory");
}
__device__ __forceinline__ void count_wait3(unsigned* w0, unsigned n0, unsigned* w1, unsigned n1, unsigned* w2, unsigned n2, unsigned* tmo) {
    if (threadIdx.x < 64) {
        unsigned spn = 0;
        for (;;) {
            const unsigned v0 = (unsigned)__builtin_amdgcn_readfirstlane((int)xb_ld(w0)), v1 = (unsigned)__builtin_amdgcn_readfirstlane((int)xb_ld(w1)), v2 = (unsigned)__builtin_amdgcn_readfirstlane((int)xb_ld(w2));
            if (v0 >= n0 && v1 >= n1 && v2 >= n2) break;
            __builtin_amdgcn_s_sleep(2);
            if ((++spn & 255u) == 0u) { if (xb_ld(tmo)) break; if (spn > XB_SPIN_CAP) { if (threadIdx.x == 0) atomicAdd(tmo, 1u); break; } } }
        __builtin_amdgcn_fence(__ATOMIC_ACQUIRE, "agent");
        asm volatile("s_waitcnt vmcnt(0)" ::: "memory");
    }
    asm volatile("" ::: "memory"); __builtin_amdgcn_s_barrier(); asm volatile("" ::: "memory");
}

constexpr int NWAVES = 8, NTHREADS = 512, GRID = 256;
constexpr int LDS_BYTES = 151552;
constexpr int MISC_OFF = 131072 + 320;
constexpr int ROPE_LDS = 132096;
constexpr int CW_BAR = 4096;
constexpr int CW_CTXCNT = 8192 + 6144;

struct Args {
    const float* in[25];
    float* out; unsigned char* ws;
    int ph_lo, ph_hi;
};

enum { I_X = 0, I_C, I_CTX, I_CCTX, I_WADA, I_BADA, I_GNORM, I_WIN, I_GQ, I_GK, I_LQ1, I_LK1, I_LQ2, I_LK2, I_GSUB, I_WF, I_BF, I_LNG, I_LNB, I_WS, I_BS, I_WBRA, I_WBRB, I_WBRC, I_WOUT };

__device__ __forceinline__ void transpose_item(const float* W, int ldw, int k0, int lcol0, bool perm, bf16_t* dst, int ldd, int prow0, int dcol0, LAS float* scr, int lane) {
#pragma unroll 8
    for (int i = 0; i < 32; ++i) { const int kk = 2 * i + (lane >> 5); scr[kk * 33 + (lane & 31)] = W[(size_t)(k0 + kk) * ldw + lcol0 + (lane & 31)]; }
    LDS_WAIT(); asm volatile("" ::: "memory");
    const int c = lane & 7;
#pragma unroll
    for (int j = 0; j < 4; ++j) { const int n = (lane >> 3) + 8 * j; const int jn = perm ? perm32(n) : n; const LAS float* s = scr + (8 * c) * 33 + jn;
        u32x4 o; o.x = pk2(s[0 * 33], s[1 * 33]); o.y = pk2(s[2 * 33], s[3 * 33]); o.z = pk2(s[4 * 33], s[5 * 33]); o.w = pk2(s[6 * 33], s[7 * 33]);
        *(GAS u32x4*)(dst + (size_t)(prow0 + n) * ldd + dcol0 + k0 + 8 * c) = o; }
    LDS_WAIT(); asm volatile("" ::: "memory");
}
__device__ __forceinline__ bool win_block_map(int pb, int& lcol, bool& perm) {
    const int tile = pb >> 3, w = pb & 7, bj = w >> 2, wc = w & 3;
    if (tile < 2) { lcol = OFF_Q + (4 * (tile & 1) + wc) * 64 + 32 * bj; perm = false; return true; }
    if (tile < 4) { lcol = OFF_K + (4 * (tile & 1) + wc) * 64 + 32 * bj; perm = false; return true; }
    perm = true;
    if (tile < 6) { lcol = OFF_V + 256 * (tile - 4) + 32 * w; return true; }
    if (tile < 8) return false;
    if (tile < 10) { lcol = (bj == 0 ? OFF_U : OFF_GATE + 768) + 128 * (tile - 8) + 32 * wc; return true; }
    if (tile == 10) { lcol = OFF_VC + 32 * w; return true; }
    if (tile < 14) { lcol = OFF_GATE + 256 * (tile - 11) + 32 * w; return true; }
    lcol = OFF_MERGE + 256 * (tile - 14) + 32 * w; return true;
}
__device__ __forceinline__ float cos2pi(int a, int n) { return cospif(2.0f * (float)a / (float)n); }
__device__ __forceinline__ float sin2pi(int a, int n) { return sinpif(2.0f * (float)a / (float)n); }

__device__ __forceinline__ void ph0_mods(const Args& a, int lane, int wave, int vcu);
__device__ __forceinline__ void ph0_prologue(const Args& a, LAS unsigned char* lds, int tid, int lane, int wave, int vcu, int pmask) {
    unsigned char* ws = a.ws;
    const int gw = vcu * NWAVES + wave, NGW = GRID * NWAVES;
    const int gt = vcu * NTHREADS + tid, NGT = GRID * NTHREADS;
    if (pmask & 1) {
        LAS float* scr = (LAS float*)(lds + wave * 16384);
        constexpr int I_WIN_N = DEPTH * 208 * 16;
        constexpr int I_BR_N = DEPTH * 32 * 16;
        constexpr int I_OUT_N = DEPTH * 32 * 16;
        for (int it = gw; it < I_WIN_N + I_BR_N + I_OUT_N; it += NGW) {
            int r = it;
            if (r < I_WIN_N) {
                const int l = r / (208 * 16), q = r % (208 * 16), pb = q >> 4, kb = q & 15; int lcol; bool perm;
                if (!win_block_map(pb, lcol, perm)) continue;
                transpose_item(a.in[I_WIN] + (size_t)l * DM * INW, INW, 64 * kb, lcol, perm, (bf16_t*)(ws + WS_WIN) + (size_t)l * NPHYS * DM, DM, 32 * pb, 0, scr, lane);
                continue;
            }
            r -= I_WIN_N;
            if (r < I_BR_N) {
                const int l = r / 512, q = r % 512, pb = q >> 4, kb = q & 15;
                const float* W; int ksrc;
                if (kb < 8) { W = a.in[I_WBRA] + (size_t)l * 512 * DM; ksrc = 64 * kb; } else if (kb < 12) { W = a.in[I_WBRB] + (size_t)l * 256 * DM; ksrc = 64 * (kb - 8); } else { W = a.in[I_WBRC] + (size_t)l * 256 * DM; ksrc = 64 * (kb - 12); }
                transpose_item(W, DM, ksrc, 32 * pb, true, (bf16_t*)(ws + WS_WBR) + (size_t)l * DM * DM, DM, 32 * pb, 64 * kb - ksrc, scr, lane);
                continue;
            }
            r -= I_BR_N;
            { const int l = r / 512, q = r % 512, pb = q >> 4, kb = q & 15;
              transpose_item(a.in[I_WOUT] + (size_t)l * DM * DM, DM, 64 * kb, 32 * pb, true, (bf16_t*)(ws + WS_WOUT) + (size_t)l * DM * DM, DM, 32 * pb, 0, scr, lane); }
        }
    }
    __syncthreads();
    if (pmask & 2) {
        LAS float* Wb = (LAS float*)lds;
        LAS float* TR = Wb + 64 * 65;
        LAS float* Tt = TR + 64 * 128;
        LAS float* Wf = Tt + 64 * 132;
        for (int it = GRID - 1 - vcu; it < DEPTH * 4 * 16; it += GRID) {
            const int l = it / 64, g = (it >> 4) & 3, kb = it & 15;
            const float* win = a.in[I_WIN] + (size_t)l * DM * INW; const float* wf = a.in[I_WF] + (size_t)(l * 4 + g) * 64 * 64;
            for (int e = tid; e < 4096; e += NTHREADS) { const int r = e >> 6, c = e & 63; Wb[r * 65 + c] = win[(size_t)(64 * kb + r) * INW + OFF_F + 64 * g + c]; Wf[e] = wf[e]; }
            for (int e = tid; e < 64 * 128; e += NTHREADS) { const int c = e >> 7, ri = (e >> 6) & 1, cp = e & 63; const int ph = (c * cp) & 63; TR[e] = ri ? -sin2pi(ph, 64) : cos2pi(ph, 64); }
            __syncthreads();
            const int tk = tid >> 5, tn = tid & 31;
            { f32x4 acc[4];
#pragma unroll
              for (int i = 0; i < 4; ++i) acc[i] = (f32x4){0.f, 0.f, 0.f, 0.f};
#pragma unroll 4
              for (int c = 0; c < 64; ++c) { const f32x4 bv = *(const LAS f32x4*)(TR + c * 128 + 4 * tn);
#pragma unroll
                  for (int i = 0; i < 4; ++i) acc[i] += bv * Wb[(4 * tk + i) * 65 + c]; }
#pragma unroll
              for (int i = 0; i < 4; ++i) *(LAS f32x4*)(Tt + (4 * tk + i) * 132 + 4 * tn) = acc[i]; }
            __syncthreads();
            { const int ri = tn >> 4, td = tn & 15;
              f32x4 acc[4];
#pragma unroll
              for (int i = 0; i < 4; ++i) acc[i] = (f32x4){0.f, 0.f, 0.f, 0.f};
#pragma unroll 4
              for (int cp = 0; cp < 64; ++cp) { const f32x4 bv = *(const LAS f32x4*)(Wf + cp * 64 + 4 * td);
#pragma unroll
                  for (int i = 0; i < 4; ++i) acc[i] += bv * Tt[(4 * tk + i) * 132 + ri * 64 + cp]; }
              bf16_t* dst = (bf16_t*)(ws + WS_WIN) + (size_t)l * NPHYS * DM;
#pragma unroll
              for (int e = 0; e < 4; ++e) { const int ch = 64 * g + 4 * td + e, prow = 6 * 256 + ri * 256 + (ch & ~31) + invperm32(ch & 31);
                  u32x2 w; w.x = pk2(acc[0][e], acc[1][e]); w.y = pk2(acc[2][e], acc[3][e]);
                  *(u32x2*)(dst + (size_t)prow * DM + 64 * kb + 4 * tk) = w; } }
            __syncthreads();
        }
    }
    if (pmask & 4) {
        float* ropec = (float*)(ws + WS_ROPE); float* ropes = ropec + 2048;
        for (int e = gt; e < 2048; e += NGT) { const int pos = e >> 4, f = e & 15; const float freq = powf(10000.0f, -(float)(2 * f) / 32.0f); const float ang = (float)pos * freq; ropec[e] = cosf(ang); ropes[e] = sinf(ang); }
        f32x2* tw = (f32x2*)(ws + WS_TW);
        for (int e = gt; e < 8192; e += NGT) tw[e] = (f32x2){cos2pi(e, 8192), sin2pi(e, 8192)};
        bf16_t* c128 = (bf16_t*)(ws + WS_C128); bf16_t* s128 = (bf16_t*)(ws + WS_S128);
        for (int e = gt; e < 4 * 8 * 64 * 8; e += NGT) { const int j = e & 7, ln = (e >> 3) & 63, s = (e >> 9) & 7, mb = e >> 12; const int row = 32 * mb + (ln & 31), k = 16 * s + 8 * (j >> 2) + 4 * (ln >> 5) + (j & 3);
            const int ph = (row * k) & 127; c128[e] = (bf16_t)f2bf(cos2pi(ph, 128)); s128[e] = (bf16_t)f2bf(sin2pi(ph, 128)); }
        bf16_t* t64 = (bf16_t*)(ws + WS_T64);
        for (int e = gt; e < 2 * 8 * 64 * 8; e += NGT) { const int j = e & 7, ln = (e >> 3) & 63, s = (e >> 9) & 7, mb = e >> 12; const int row = 32 * mb + (ln & 31), k = 16 * s + 8 * (j >> 2) + 4 * (ln >> 5) + (j & 3);
            const int ri = k >> 6, c = k & 63, ph = (row * c) & 63; t64[e] = (bf16_t)f2bf(ri ? sin2pi(ph, 64) : cos2pi(ph, 64)); }
        bf16_t* tc256 = (bf16_t*)(ws + WS_TC256);
        for (int e = gt; e < 8 * 32 * 64 * 8; e += NGT) { const int j = e & 7, ln = (e >> 3) & 63, s = (e >> 9) & 31, mb = e >> 14; const int row = 32 * mb + (ln & 31), k = 16 * s + 8 * (j >> 2) + 4 * (ln >> 5) + (j & 3);
            const int ri = k >> 8, n = k & 255, ph = (row * n) & 255; tc256[e] = (bf16_t)f2bf(ri ? sin2pi(ph, 256) : cos2pi(ph, 256)); }
        bf16_t* wsimg = (bf16_t*)(ws + WS_WSIMG);
        for (int e = gt; e < DEPTH * 4 * 4 * 8 * 64 * 8; e += NGT) { const int j = e & 7, ln = (e >> 3) & 63, s = (e >> 9) & 7, mb = (e >> 12) & 3, lg = e >> 14; const int row = 32 * mb + (ln & 31), k = 16 * s + 8 * (j >> 2) + 4 * (ln >> 5) + (j & 3);
            wsimg[e] = (bf16_t)f2bf(a.in[I_WS][(size_t)lg * 128 * 128 + row * 128 + k]); }
        if (gt < DEPTH) { const int l = gt; float s1 = 0.f, s2 = 0.f;
            for (int i = 0; i < 64; ++i) { s1 += a.in[I_LQ1][l * 64 + i] * a.in[I_LK1][l * 64 + i]; s2 += a.in[I_LQ2][l * 64 + i] * a.in[I_LK2][l * 64 + i]; }
            const float lam_init = 0.8f - 0.6f * expf(-0.3f * (float)l);
            float* lam = (float*)(ws + WS_LAM); lam[2 * l] = expf(s1) - expf(s2) + lam_init; lam[2 * l + 1] = 1.0f - lam_init; }
    }
}

__device__ __forceinline__ void ph0_mods(const Args& a, int lane, int wave, int vcu) {
    unsigned char* ws = a.ws; const int gw = vcu * NWAVES + wave, NGW = GRID * NWAVES;
    {
        float* part = (float*)(ws + WS_MODP);
        for (int it = gw; it < DEPTH * 12 * 32; it += NGW) {
            const int l = it / 384, q = it % 384, cc = q >> 5, kc = q & 31; const int col = 256 * cc + 4 * lane;
            const float* w = a.in[I_WADA] + (size_t)l * DM * 3072 + col;
            f32x4 s0 = {0.f, 0.f, 0.f, 0.f}, s1 = s0, s2 = s0;
#pragma unroll 8
            for (int kk = 0; kk < 32; ++kk) { const int k = 32 * kc + kk; const f32x4 wv = *(const f32x4*)(w + (size_t)k * 3072);
                const float a0 = fast_silu(a.in[I_C][k]), a1 = fast_silu(a.in[I_C][DM + k]), a2 = fast_silu(a.in[I_CCTX][k]);
                s0 += wv * a0; s1 += wv * a1; s2 += wv * a2; }
            float* p = part + ((size_t)(l * 32 + kc) * 3) * 3072 + col;
            *(f32x4*)(p) = s0; *(f32x4*)(p + 3072) = s1; *(f32x4*)(p + 2 * 3072) = s2;
        }
    }
}

__device__ __forceinline__ void prepass(const Args& a, int l, LAS unsigned char* lds, int tid, int lane, int wave, int vcu) {
    unsigned char* ws = a.ws;
    const float* part = (const float*)(ws + WS_MODP); float* modf = (float*)(ws + WS_MODF);
    if (l == 0) {
        if (tid < 72) { const int o = vcu * 72 + tid; const int ll = o / 9216, rj = o % 9216, r = rj / 3072, j = rj % 3072; float s = a.in[I_BADA][ll * 3072 + j];
#pragma unroll
            for (int kc = 0; kc < 32; ++kc) s += part[((size_t)(ll * 32 + kc) * 3 + r) * 3072 + j];
            modf[o] = s; }
    }
    const int row0 = vcu * 66, row1 = row0 + 66;
    LAS float* coef = (LAS float*)lds;
    for (int r = 0; r < 3; ++r) {
        const int lo = r == 0 ? 0 : (r == 1 ? SEQ : MLAT), hi = r == 0 ? SEQ : (r == 1 ? MLAT : MT);
        if (row1 <= lo || row0 >= hi) continue;
        for (int k = tid; k < DM; k += NTHREADS) {
            float sh, sc;
            if (l == 0) { sh = a.in[I_BADA][k]; sc = a.in[I_BADA][DM + k];
#pragma unroll
                for (int kc = 0; kc < 32; ++kc) { const float* p = part + ((size_t)(kc) * 3 + r) * 3072; sh += p[k]; sc += p[DM + k]; } }
            else { sh = modf[(size_t)(l * 3 + r) * 3072 + k]; sc = modf[(size_t)(l * 3 + r) * 3072 + DM + k]; }
            coef[(r * 2) * DM + k] = a.in[I_GNORM][l * DM + k] * (1.0f + sc); coef[(r * 2 + 1) * DM + k] = sh;
        }
    }
    __syncthreads();
    const float* xlat = l == 0 ? a.in[I_X] : a.out; const float* xctx = l == 0 ? a.in[I_CTX] : (const float*)(ws + WS_CTX1);
    bf16_t* H = (bf16_t*)(ws + WS_H);
    for (int mb = row0 + 4 * wave; mb < row1; mb += 4 * NWAVES) {
        f32x4 v[4][4]; float s2[4];
#pragma unroll
        for (int q = 0; q < 4; ++q) { const int m = (mb + q < row1) ? mb + q : mb;
            if (l == 1 && m < MLAT) { const GAS u32x2* xb = (const GAS u32x2*)(ws + x1b_off(m)) + lane;
#pragma unroll
                for (int j = 0; j < 4; ++j) { const u32x2 t = xb[64 * j]; v[q][j] = (f32x4){bflo(t.x), bfhi(t.x), bflo(t.y), bfhi(t.y)}; } }
            else { const float* xrow = m < MLAT ? xlat + (size_t)m * DM : xctx + (size_t)(m - MLAT) * DM; const GAS f32x4* xr = (const GAS f32x4*)xrow + lane;
#pragma unroll
                for (int j = 0; j < 4; ++j) v[q][j] = xr[64 * j]; } }
#pragma unroll
        for (int q = 0; q < 4; ++q) { float t = 0.f;
#pragma unroll
            for (int j = 0; j < 4; ++j) t += (v[q][j].x * v[q][j].x + v[q][j].y * v[q][j].y) + (v[q][j].z * v[q][j].z + v[q][j].w * v[q][j].w);
            s2[q] = t; }
#pragma unroll
        for (int o = 1; o < 64; o <<= 1) {
#pragma unroll
            for (int q = 0; q < 4; ++q) s2[q] += __shfl_xor(s2[q], o); }
#pragma unroll
        for (int q = 0; q < 4; ++q) { const int m = mb + q; if (m >= row1) break;
            const int r = m < SEQ ? 0 : (m < MLAT ? 1 : 2);
            const float rstd = rsqrtf(s2[q] * (1.0f / DM) + EPS);
            GAS u32x2* o8 = (GAS u32x2*)(H + (size_t)m * DM) + lane;
#pragma unroll
            for (int j = 0; j < 4; ++j) { const f32x4 ga = *(const LAS f32x4*)(coef + (r * 2) * DM + 256 * j + 4 * lane), sh = *(const LAS f32x4*)(coef + (r * 2 + 1) * DM + 256 * j + 4 * lane);
                const f32x4 h = v[q][j] * rstd * ga + sh; u32x2 w; w.x = pk2(h.x, h.y); w.y = pk2(h.z, h.w); o8[64 * j] = w; } }
    }
    __syncthreads();
}

#ifndef REGPUB
#define REGPUB 1
#endif
struct TileSched {
    int x, c, pn0, npn, nseg, nctx, cpn0, cnpn, cfirst, remap;
    __device__ __forceinline__ int col(int q) const { return pn0 + (remap ? (q < 3 ? 8 + q : (q < 11 ? q - 3 : q)) : q); }
    __device__ __forceinline__ bool next(int i, pg8::Unit& u) const {
        int ti = i / nseg; u.seg = i - ti * nseg; u.set = 0;
        if (cfirst) {
            const int id = (c - 16) * 8 + x;
            if (c >= 16 && id < nctx) { if (ti == 0) { u.pm = 64 + (id & 1); u.pn = cpn0 + (id >> 1); return true; } ti -= 1; }
            const int j = ti * 32 + c;
            if (j < 8 * npn) { u.pm = 8 * x + (j & 7); u.pn = col(j >> 3); return true; }
            return false;
        }
        const int j = ti * 32 + c;
        if (j < 8 * npn) { u.pm = 8 * x + (j & 7); u.pn = col(j >> 3); return true; }
        const int id = (j - 8 * npn) * 8 + x;
        if (id < nctx) { u.pm = 64 + (id & 1); u.pn = cpn0 + (id >> 1); return true; }
        return false;
    }
    __device__ __forceinline__ void a_ready(const pg8::Unit&) const {}
};

__device__ __forceinline__ void st16_wt(unsigned char* base, unsigned off, u32x4 w) { asm volatile("s_nop 4\n\tglobal_store_dwordx4 %0, %1, %2 sc1\n\ts_nop 1" :: "v"(off), "v"(w), "s"(base) : "memory"); }
template <bool RI> struct EpiInT {
    unsigned char* ws; const float* gq; const float* gk; LAS const float* ropec; LAS const float* ropes; unsigned* cnt;
    __device__ __forceinline__ bool operator()(f32x4 (&acc)[2][2][4][2], const pg8::Unit& u, int wr, int wc, int fr, int fq) const {
        body(acc, u, wr, wc, fr, fq);
        if (cnt != nullptr && (u.pm >= 64 || (REGPUB && u.pn >= 8 && u.pn <= 10))) { asm volatile("s_waitcnt vmcnt(0)" ::: "memory"); if ((fr | fq) == 0) (void)xb_add(cnt + 16 * (u.pm >= 64 ? 64 : u.pm), 1u); }
        return true;
    }
    __device__ __forceinline__ void body(f32x4 (&acc)[2][2][4][2], const pg8::Unit& u, int wr, int wc, int fr, int fq) const {
        const bool ctx = u.pm >= 64; const int b = ctx ? u.pm - 64 : (u.pm >> 5);
        const bool wt = cnt != nullptr && (ctx || (REGPUB && u.pn >= 8 && u.pn <= 10));
        const int rbase = u.pm * 256 + wr * 64 + fr;
        const int pn = u.pn;
        if (pn < 4) {
            const bool isK = pn >= 2; const int gi = 4 * (pn & 1) + wc, h = gi >> 1, comp = gi & 1;
            const float* gsrc = isK ? gk : gq;
            f32x4 gv[2][2];
#pragma unroll
            for (int bj = 0; bj < 2; ++bj)
#pragma unroll
                for (int n = 0; n < 2; ++n) gv[bj][n] = *(const f32x4*)(gsrc + 32 * bj + 16 * n + 4 * fq);
#pragma unroll
            for (int ai = 0; ai < 2; ++ai)
#pragma unroll
                for (int m = 0; m < 4; ++m) {
                    const int row = rbase + ai * 128 + m * 16;
                    f32x4 v[2][2]; float ss = 0.f;
#pragma unroll
                    for (int bj = 0; bj < 2; ++bj)
#pragma unroll
                        for (int n = 0; n < 2; ++n) { v[bj][n] = acc[ai][bj][m][n]; ss += (v[bj][n].x * v[bj][n].x + v[bj][n].y * v[bj][n].y) + (v[bj][n].z * v[bj][n].z + v[bj][n].w * v[bj][n].w); }
                    ss += __shfl_xor(ss, 16); ss += __shfl_xor(ss, 32);
                    const float rstd = rsqrtf(ss * (1.0f / 64.0f) + EPS);
#pragma unroll
                    for (int bj = 0; bj < 2; ++bj)
#pragma unroll
                        for (int n = 0; n < 2; ++n) v[bj][n] = v[bj][n] * rstd * gv[bj][n];
                    int kx;
                    if (!ctx) { const int ntok = row - b * SEQ; kx = ntok;
#pragma unroll
                        for (int bj = 0; bj < 2; ++bj) { const int pos = bj == 0 ? (ntok >> 6) : (ntok & 63);
                            const f32x4 c4 = *(LAS const f32x4*)(ropec + pos * 16 + 4 * fq), s4 = *(LAS const f32x4*)(ropes + pos * 16 + 4 * fq);
                            const f32x4 x1 = v[bj][0], x2 = v[bj][1]; v[bj][0] = x1 * c4 - x2 * s4; v[bj][1] = x2 * c4 + x1 * s4; } }
                    else kx = SEQ + (row - MLAT - b * NCTX);
#pragma unroll
                    for (int bj = 0; bj < 2; ++bj) {
                        f32x4 p0 = v[bj][0], p1 = v[bj][1];
                        if (!isK) { p0 = p0 * QSCALE; p1 = p1 * QSCALE; }
                        u32x4 w; w.x = cvt_pk_bf16(p0.x, p0.y); w.y = cvt_pk_bf16(p0.z, p0.w); w.z = cvt_pk_bf16(p1.x, p1.y); w.w = cvt_pk_bf16(p1.z, p1.w);
                        const unsigned dq = !isK ? (unsigned)WS_QG + (unsigned)(((row * 4 + h) * 128 + comp * 64 + (bj * 4 + fq) * 8) * 2)
                                                 : (unsigned)WS_KIMG + (unsigned)((((b * 4 + h) * NKT + (kx >> 6)) * 16 + comp * 8 + bj * 4 + fq) * 1024 + (kx & 63) * 16);
                        if (wt) st16_wt(ws, dq, w); else *(u32x4*)(ws + dq) = w;
                    }
                }
            return;
        }
#pragma unroll
        for (int ai = 0; ai < 2; ++ai)
#pragma unroll
            for (int m = 0; m < 4; ++m) {
                const int row = rbase + ai * 128 + m * 16;
                if (pn == 8 || pn == 9) {
                    f32x4 p0, p1;
#pragma unroll
                    for (int e = 0; e < 4; ++e) { p0[e] = acc[ai][0][m][0][e] * fast_silu(acc[ai][1][m][0][e]); p1[e] = acc[ai][0][m][1][e] * fast_silu(acc[ai][1][m][1][e]); }
                    u32x4 w; w.x = cvt_pk_bf16(p0.x, p0.y); w.y = cvt_pk_bf16(p0.z, p0.w); w.z = cvt_pk_bf16(p1.x, p1.y); w.w = cvt_pk_bf16(p1.z, p1.w);
                    const unsigned du = (unsigned)WS_UG + (unsigned)((row * 256 + 128 * (pn - 8) + 32 * wc + 8 * fq) * 2);
                    if (wt) st16_wt(ws, du, w); else *(u32x4*)(ws + du) = w;
                    continue;
                }
                u32x2 wprev = {0u, 0u};
#pragma unroll
                for (int bj = 0; bj < 2; ++bj) {
                    f32x4 p0 = acc[ai][bj][m][0], p1 = acc[ai][bj][m][1];
                    const int lc = 128 * bj + 32 * wc + 8 * fq;
                    unsigned dst;
                    if (pn < 6) { const int kx = ctx ? SEQ + (row - MLAT - b * NCTX) : row - b * SEQ; const int h = 2 * (pn - 4) + bj;
                        dst = (unsigned)WS_VIMG + (unsigned)((((b * 4 + h) * NKT + (kx >> 6)) * 16 + wc * 4 + ((kx & 63) >> 4)) * 1024 + (kx & 15) * 64 + fq * 16); }
                    else if (pn < 8) dst = (unsigned)WS_Z2 + (unsigned)((row * 512 + 256 * (pn - 6) + lc) * 2);
                    else if (pn == 10) dst = (unsigned)WS_VC + (unsigned)((row * 256 + lc) * 2);
                    else if (pn < 14) {
#pragma unroll
                        for (int e = 0; e < 4; ++e) { p0[e] = fast_silu(p0[e]); p1[e] = fast_silu(p1[e]); }
                        dst = (unsigned)WS_GS + (unsigned)((row * 768 + 256 * (pn - 11) + lc) * 2); }
                    else {
                        unsigned q0 = 0u, q1 = 0u;
#pragma unroll
                        for (int e = 0; e < 4; ++e) { q0 = ms_quant_pk(p0[e], e, q0); q1 = ms_quant_pk(p1[e], e, q1); }
                        unsigned char* d8;
                        if constexpr (RI) d8 = ws + ((unsigned)WS_MS + (unsigned)(((((u.pm * 4 + ((pn - 14) & 3)) * 3 + ((pn - 14) >> 2)) * 8 + ai * 4 + m)) * 8192 + ((wr * 4 + wc) * 64 + fq * 16 + fr) * 16 + bj * 8));
                        else d8 = ws + WS_MSC + ((size_t)(row - MLAT) * 3072 + 256 * (pn - 14) + lc);
                        u32x2 w8; w8.x = q0; w8.y = q1;
                        if constexpr (RI) { if (bj == 0) wprev = w8; else *(u32x4*)(d8 - 8) = (u32x4){wprev.x, wprev.y, w8.x, w8.y}; }
                        else *(u32x2*)d8 = w8;
                        continue; }
                    u32x4 w; w.x = cvt_pk_bf16(p0.x, p0.y); w.y = cvt_pk_bf16(p0.z, p0.w); w.z = cvt_pk_bf16(p1.x, p1.y); w.w = cvt_pk_bf16(p1.z, p1.w);
                    if (wt) st16_wt(ws, dst, w); else *(u32x4*)(ws + dst) = w;
                }
            }
    }
};
using EpiIn = EpiInT<false>;

struct EpiY {
    const unsigned char* MS; bf16_t* Y;
    __device__ __forceinline__ bool operator()(f32x4 (&acc)[2][2][4][2], const pg8::Unit& u, int wr, int wc, int fr, int fq) const {
        const int rbase = u.pm * 256 + wr * 64 + fr; const int seg = u.seg;
#pragma unroll
        for (int ai = 0; ai < 2; ++ai) {
            u32x2 mn[4][2], md[4][2];
            const unsigned char* mb_ = MS + ((size_t)(((u.pm * 4 + u.pn) * 3 + seg) * 8 + ai * 4)) * 8192 + ((wr * 4 + wc) * 64 + fq * 16 + fr) * 16;
#pragma unroll
            for (int m = 0; m < 4; ++m) { const u32x4 n4 = *(const u32x4*)(mb_ + m * 8192); const u32x4 d4 = seg < 2 ? *(const u32x4*)(mb_ + (8 + m) * 8192) : (u32x4){0u, 0u, 0u, 0u};
                mn[m][0] = (u32x2){n4.x, n4.y}; mn[m][1] = (u32x2){n4.z, n4.w}; md[m][0] = (u32x2){d4.x, d4.y}; md[m][1] = (u32x2){d4.z, d4.w}; }
            __builtin_amdgcn_sched_barrier(0);
#pragma unroll
            for (int m = 0; m < 4; ++m) {
                const int row = rbase + ai * 128 + m * 16;
#pragma unroll
                for (int bj = 0; bj < 2; ++bj) {
                    const int col = 256 * u.pn + 128 * bj + 32 * wc + 8 * fq;
                    const u32x2 a_ = mn[m][bj], d_ = md[m][bj];
                    f32x4& p0 = acc[ai][bj][m][0]; f32x4& p1 = acc[ai][bj][m][1];
                    if (seg < 2) {
#pragma unroll
                        for (int e = 0; e < 4; ++e) { p0[e] *= ub(a_.x, e) * __builtin_amdgcn_rcpf(ub(d_.x, e)); p1[e] *= ub(a_.y, e) * __builtin_amdgcn_rcpf(ub(d_.y, e)); } }
                    else {
#pragma unroll
                        for (int e = 0; e < 4; ++e) { p0[e] *= ub(a_.x, e) * (1.0f / 255.0f); p1[e] *= ub(a_.y, e) * (1.0f / 255.0f); }
                        u32x4 w; w.x = cvt_pk_bf16(p0[0], p0[1]); w.y = cvt_pk_bf16(p0[2], p0[3]); w.z = cvt_pk_bf16(p1[0], p1[1]); w.w = cvt_pk_bf16(p1[2], p1[3]);
                        *(u32x4*)(Y + (size_t)row * DM + col) = w; }
                }
            }
            __builtin_amdgcn_sched_barrier(0);
        }
        return seg == 2;
    }
};


struct FusedSched {
    int x, c; unsigned* sp; XcdBarrier bar; bool hier; unsigned* tmo;
    __device__ __forceinline__ bool next(int i, pg8::Unit& u) const {
        if (i >= 6) return false;
        u.pm = 8 * x + (c & 7);
        if (i < 3) { u.pn = 14 + 4 * i + (c >> 3); u.seg = 0; u.set = 1; } else { u.pn = c >> 3; u.seg = i - 3; u.set = 0; }
        return true;
    }
    __device__ __forceinline__ void a_ready(const pg8::Unit& u) const { if (u.set == 0 && u.seg == 1) split_wait(sp, bar, hier, tmo); }
};
struct EpiMY {
    EpiInT<true> ein; EpiY ey;
    __device__ __forceinline__ bool operator()(f32x4 (&acc)[2][2][4][2], const pg8::Unit& u, int wr, int wc, int fr, int fq) const { return u.set ? ein(acc, u, wr, wc, fr, fq) : ey(acc, u, wr, wc, fr, fq); }
};

struct EpiOut {
    const float* xin; float* out; unsigned char* ws; const float* gate; int layer;
    __device__ __forceinline__ bool operator()(f32x4 (&acc)[2][2][4][2], const pg8::Unit& u, int wr, int wc, int fr, int fq) const {
        const int r = u.pm >> 5;
        const int rbase = u.pm * 256 + wr * 64 + fr;
        f32x4 xa[2][2], xb[2][2], xc[2][2];
#define EO_C(g) (256 * u.pn + 128 * ((g) >> 2) + 32 * wc + 8 * fq)
#define EO_ROW(g, mm) (rbase + (((g) >> 1) & 1) * 128 + (2 * ((g) & 1) + (mm)) * 16)
#define EO_LOAD(dst, g) do { _Pragma("unroll") for (int mm = 0; mm < 2; ++mm) { \
            if (layer == 0) { const float* p_ = xin + (size_t)EO_ROW(g, mm) * DM + EO_C(g); dst[mm][0] = *(const f32x4*)p_; dst[mm][1] = *(const f32x4*)(p_ + 4); } \
            else { const u32x4 t_ = *(const u32x4*)(ws + x1b_off(EO_ROW(g, mm)) + (size_t)EO_C(g) * 2); dst[mm][0] = (f32x4){bflo(t_.x), bfhi(t_.x), bflo(t_.y), bfhi(t_.y)}; dst[mm][1] = (f32x4){bflo(t_.z), bfhi(t_.z), bflo(t_.w), bfhi(t_.w)}; } } } while (0)
#define EO_STORE(srcv, g) do { const f32x4 g0_ = *(const f32x4*)(gate + (size_t)r * 3072 + EO_C(g)), g1_ = *(const f32x4*)(gate + (size_t)r * 3072 + EO_C(g) + 4); \
            _Pragma("unroll") for (int mm = 0; mm < 2; ++mm) { \
                const f32x4 y0_ = srcv[mm][0] + g0_ * acc[((g) >> 1) & 1][(g) >> 2][2 * ((g) & 1) + mm][0], y1_ = srcv[mm][1] + g1_ * acc[((g) >> 1) & 1][(g) >> 2][2 * ((g) & 1) + mm][1]; \
                if (layer == 0) { u32x4 w_; w_.x = cvt_pk_bf16(y0_.x, y0_.y); w_.y = cvt_pk_bf16(y0_.z, y0_.w); w_.z = cvt_pk_bf16(y1_.x, y1_.y); w_.w = cvt_pk_bf16(y1_.z, y1_.w); *(u32x4*)(ws + x1b_off(EO_ROW(g, mm)) + (size_t)EO_C(g) * 2) = w_; } \
                else { float* p_ = out + (size_t)EO_ROW(g, mm) * DM + EO_C(g); *(f32x4*)p_ = y0_; *(f32x4*)(p_ + 4) = y1_; } } } while (0)
        EO_LOAD(xa, 0); EO_LOAD(xb, 1); EO_LOAD(xc, 2);
        EO_STORE(xa, 0); EO_LOAD(xa, 3);
        EO_STORE(xb, 1); EO_LOAD(xb, 4);
        EO_STORE(xc, 2); EO_LOAD(xc, 5);
        EO_STORE(xa, 3); EO_LOAD(xa, 6);
        EO_STORE(xb, 4); EO_LOAD(xb, 7);
        EO_STORE(xc, 5); EO_STORE(xa, 6); EO_STORE(xb, 7);
#undef EO_C
#undef EO_ROW
#undef EO_LOAD
#undef EO_STORE
        return true;
    }
};

__device__ __forceinline__ f32x4 mini_block(const bf16_t* A, int lda, const bf16_t* Bt, int ldb, int m0, int n0, int k0, int nk, int fr, int fq, f32x4 acc) {
    const bf16_t* ap = A + (size_t)(m0 + fr) * lda + k0 + 8 * fq; const bf16_t* bp = Bt + (size_t)(n0 + fr) * ldb + k0 + 8 * fq;
#pragma unroll 16
    for (int s = 0; s < nk; s += 32) acc = __builtin_amdgcn_mfma_f32_16x16x32_bf16(*(const bf16x8*)(bp + s), *(const bf16x8*)(ap + s), acc, 0, 0, 0);
    return acc;
}
__device__ __forceinline__ int mini_lcol(int n0, int fq) { return (n0 & ~31) + 8 * fq + 4 * ((n0 >> 4) & 1); }
__device__ __forceinline__ void ctx_merge_gates(unsigned char* ws, const bf16_t* Wl, int gw, int lane) {
    const int fr = lane & 15, fq = lane >> 4; const bf16_t* H = (const bf16_t*)(ws + WS_H); bf16_t* MS = (bf16_t*)(ws + WS_MS);
    for (int blk = gw; blk < 32 * 192; blk += GRID * NWAVES) { const int m0 = MLAT + 16 * (blk & 31), n0 = 16 * (blk >> 5);
        const f32x4 acc = mini_block(H, DM, Wl + (size_t)(14 * 256) * DM, DM, m0, n0, 0, DM, fr, fq, (f32x4){0.f, 0.f, 0.f, 0.f});
        u32x2 w; w.x = cvt_pk_bf16(fast_sigmoid(acc[0]), fast_sigmoid(acc[1])); w.y = cvt_pk_bf16(fast_sigmoid(acc[2]), fast_sigmoid(acc[3]));
        *(u32x2*)(MS + (size_t)(m0 + fr) * 3072 + mini_lcol(n0, fq)) = w; }
}

typedef short v4i16_t __attribute__((ext_vector_type(4)));
__device__ __forceinline__ s16x4 vtr(LAS const unsigned char* p) { return __builtin_bit_cast(s16x4, __builtin_amdgcn_ds_read_tr16_b64_v4i16((LAS v4i16_t*)p)); }
__device__ __forceinline__ int tr_lane_off(int lane) { return ((lane >> 4) & 1) * 32 + (lane & 3) * 8 + (4 * (lane >> 5) + ((lane & 15) >> 2)) * 64; }
__device__ __forceinline__ bf16x8 bfrag(LAS const unsigned char* piece_plus_laneoff) {
    const s16x4 lo = vtr(piece_plus_laneoff), hi = vtr(piece_plus_laneoff + 512);
    return (bf16x8){lo[0], lo[1], lo[2], lo[3], hi[0], hi[1], hi[2], hi[3]};
}
template <int NROWS, int NCOLS, class RP> __device__ __forceinline__ void stage_pieces(LAS unsigned char* dst, RP rp, int tid) {
    constexpr int cpr = NCOLS >> 3, total = NROWS * cpr, pcs = NCOLS >> 5, NIT = total / NTHREADS;
    static_assert(total % NTHREADS == 0, "stage_pieces: whole passes only");
    u32x4 v[NIT];
#pragma unroll
    for (int i = 0; i < NIT; ++i) { const int c = tid + i * NTHREADS, row = c / cpr, cc = c - row * cpr; v[i] = *(const u32x4*)(rp(row) + cc * 8); }
#pragma unroll
    for (int i = 0; i < NIT; ++i) { const int c = tid + i * NTHREADS, row = c / cpr, cc = c - row * cpr;
        *(LAS u32x4*)(dst + ((row >> 4) * pcs + (cc >> 2)) * 1024 + (row & 15) * 64 + (cc & 3) * 16) = v[i]; }
}
#define MFMA32(a, b, c) __builtin_amdgcn_mfma_f32_32x32x16_bf16(a, b, c, 0, 0, 0)
__device__ __forceinline__ bf16x8 afrag_img(const bf16_t* img, int KS, int mb, int s, int lane) { return *(const bf16x8*)(img + ((size_t)(mb * KS + s) * 64 + lane) * 8); }

#ifndef F1_REP
#define F1_REP 1
#endif
__device__ __forceinline__ void f1_unit(unsigned char* ws, LAS unsigned char* lds, int unit, int tid, int lane, int wave, bool dry = false) {
    const int b = unit >> 7, c = (unit >> 1) & 63, chh = unit & 1;
    bf16_t* Z2 = (bf16_t*)(ws + WS_Z2);
    const bf16_t* base = Z2 + ((size_t)(b * SEQ + c)) * 512 + chh * 128;
    stage_pieces<128, 128>(lds, [&](int r) { return base + (size_t)r * 64 * 512; }, tid);
    stage_pieces<128, 128>(lds + 32768, [&](int r) { return base + (size_t)r * 64 * 512 + 256; }, tid);
    bf16x8 cfa[8], sfa[8];
    { const bf16_t* c128_ = (const bf16_t*)(ws + WS_C128); const bf16_t* s128_ = (const bf16_t*)(ws + WS_S128);
#pragma unroll
      for (int s = 0; s < 8; ++s) { cfa[s] = afrag_img(c128_, 8, wave & 3, s, lane); sfa[s] = afrag_img(s128_, 8, wave & 3, s, lane); } }
    __syncthreads();
    const int mb = wave & 3, cbp = wave >> 2, hi = lane >> 5, r32 = lane & 31, lo = tr_lane_off(lane);
    f32x16 outr[2], t1[2], t2[2];
#pragma unroll
    for (int e = 0; e < 2; ++e) { outr[e] = f32x16{}; t1[e] = f32x16{}; t2[e] = f32x16{}; }
#pragma unroll
    for (int s = 0; s < 8; ++s) {
        const bf16x8 cf = cfa[s], sf = sfa[s];
#pragma unroll
        for (int e = 0; e < 2; ++e) {
            const bf16x8 xr = bfrag(lds + (s * 4 + 2 * cbp + e) * 1024 + lo), xi = bfrag(lds + 32768 + (s * 4 + 2 * cbp + e) * 1024 + lo);
            outr[e] = MFMA32(cf, xr, outr[e]); outr[e] = MFMA32(sf, xi, outr[e]); t1[e] = MFMA32(cf, xi, t1[e]); t2[e] = MFMA32(sf, xr, t2[e]);
        }
    }
    const f32x2* tw = (const f32x2*)(ws + WS_TW);
    f32x2 twv[16];
#pragma unroll
    for (int r = 0; r < 16; ++r) twv[r] = tw[(c * (32 * mb + crow(r, hi))) & 8191];
    __builtin_amdgcn_sched_barrier(0);
#pragma unroll
    for (int e = 0; e < 2; ++e)
#pragma unroll
        for (int r = 0; r < 16; ++r) {
            const int k1 = 32 * mb + crow(r, hi), ch = chh * 128 + 32 * (2 * cbp + e) + r32;
            const float yr = outr[e][r], yi = t1[e][r] - t2[e][r];
            const f32x2 t = twv[r];
            bf16_t* o = Z2 + ((size_t)(b * SEQ + 64 * k1 + c)) * 512 + ch;
            if (!dry) { o[0] = (bf16_t)f2bf(yr * t.x + yi * t.y); o[256] = (bf16_t)f2bf(yi * t.x - yr * t.y); } else asm volatile("" :: "v"(yr * t.x + yi * t.y), "v"(yi * t.x - yr * t.y));
            if ((r & 3) == 3) __builtin_amdgcn_sched_barrier(0);
        }
    __syncthreads();
}

#ifndef SGU_DRYMASK
#define SGU_DRYMASK 0
#endif
__device__ __forceinline__ void sgu_unit(const Args& a, int l, LAS unsigned char* lds, int cu, int tid, int lane, int wave, bool dry = false) {
    unsigned char* ws = a.ws;
    asm volatile("" : "+v"(tid), "+v"(lane));
    const int row0 = cu < 128 ? cu * 128 : MLAT + (cu - 128) * 128;
    const int g = wave >> 1, ph = wave & 1, hi = lane >> 5, r32 = lane & 31, lo = tr_lane_off(lane);
    const int tok = tid >> 2, qt = tid & 3, trow = tid >> 5, tch = tid & 31;
    constexpr int SP = 576, TP = 528, LNT = 73728;
    u32x4 raw[8];
    { const unsigned char* src = ws + WS_VC + ((size_t)(row0 + trow) * 256 + tch * 8) * 2;
#pragma unroll
      for (int i = 0; i < 8; ++i) raw[i] = *(const u32x4*)(src + i * 8192); }
    f32x4 lnv = (f32x4){0.f, 0.f, 0.f, 0.f};
    if (tid < 128) lnv = *(const f32x4*)((tid < 64 ? a.in[I_LNG] : a.in[I_LNB]) + l * 256 + (tid & 63) * 4);
    const bf16_t* UG = (const bf16_t*)(ws + WS_UG); bf16_t* A = (bf16_t*)(ws + WS_A);
#pragma unroll
    for (int i = 0; i < 8; ++i) *(LAS u32x4*)(lds + trow * SP + tch * 16 + i * 16 * SP) = raw[i];
    if (tid < 128) *(LAS f32x4*)(lds + LNT + tid * 16) = lnv;
    __syncthreads();
#pragma unroll
    for (int i = 0; i < 8; ++i) raw[i] = *(LAS const u32x4*)(lds + tok * SP + (i * 4 + qt) * 16);
    __syncthreads();
    {
        float s = 0.f;
#pragma unroll
        for (int i = 0; i < 8; ++i) s += (bflo(raw[i].x) + bfhi(raw[i].x)) + (bflo(raw[i].y) + bfhi(raw[i].y)) + (bflo(raw[i].z) + bfhi(raw[i].z)) + (bflo(raw[i].w) + bfhi(raw[i].w));
        s += __shfl_xor(s, 1); s += __shfl_xor(s, 2);
        const float mu = s * (1.0f / 256.0f); float q = 0.f;
#pragma unroll
        for (int i = 0; i < 8; ++i) {
#pragma unroll
            for (int e = 0; e < 4; ++e) { const float d0 = bflo(raw[i][e]) - mu, d1 = bfhi(raw[i][e]) - mu; q += d0 * d0 + d1 * d1; } }
        q += __shfl_xor(q, 1); q += __shfl_xor(q, 2);
        const float rstd = rsqrtf(q * (1.0f / 256.0f) + EPS);
        LAS const float* lg = (LAS const float*)(lds + LNT) + qt * 8; LAS const float* lb = lg + 256;
#pragma unroll
        for (int i = 0; i < 8; ++i) { u32x4 w;
            const f32x4 g0 = *(LAS const f32x4*)(lg + 32 * i), g1 = *(LAS const f32x4*)(lg + 32 * i + 4), b0 = *(LAS const f32x4*)(lb + 32 * i), b1 = *(LAS const f32x4*)(lb + 32 * i + 4);
            w[0] = pk2((bflo(raw[i][0]) - mu) * rstd * g0[0] + b0[0], (bfhi(raw[i][0]) - mu) * rstd * g0[1] + b0[1]); w[1] = pk2((bflo(raw[i][1]) - mu) * rstd * g0[2] + b0[2], (bfhi(raw[i][1]) - mu) * rstd * g0[3] + b0[3]);
            w[2] = pk2((bflo(raw[i][2]) - mu) * rstd * g1[0] + b1[0], (bfhi(raw[i][2]) - mu) * rstd * g1[1] + b1[1]); w[3] = pk2((bflo(raw[i][3]) - mu) * rstd * g1[2] + b1[2], (bfhi(raw[i][3]) - mu) * rstd * g1[3] + b1[3]);
            *(LAS u32x4*)(lds + ((tok >> 4) * 8 + i) * 1024 + (tok & 15) * 64 + qt * 16) = w; __builtin_amdgcn_sched_barrier(0); }
    }
    bf16x8 wa0[8], wa1[8];
    { const bf16_t* img_ = (const bf16_t*)(ws + WS_WSIMG) + (size_t)(l * 4 + g) * 16384;
#pragma unroll
      for (int s = 0; s < 8; ++s) { wa0[s] = afrag_img(img_, 8, 2 * ph, s, lane); wa1[s] = afrag_img(img_, 8, 2 * ph + 1, s, lane); } }
    u32x4 ugc[8]; float bsv[2];
#pragma unroll
    for (int i = 0; i < 2; ++i) bsv[i] = a.in[I_BS][(size_t)(l * 4 + g) * 128 + 32 * (2 * ph + i) + r32];
    { const unsigned char* us = (const unsigned char*)(UG + (size_t)(row0 + trow) * 256 + tch * 8);
#pragma unroll
      for (int i = 0; i < 8; ++i) ugc[i] = *(const u32x4*)(us + i * 8192); }
    __syncthreads();
    f32x16 acc[2][2];
#pragma unroll
    for (int i = 0; i < 2; ++i) { acc[i][0] = f32x16{}; acc[i][1] = f32x16{}; }
#pragma unroll
    for (int s = 0; s < 8; ++s) {
        const bf16x8 a0 = wa0[s], a1 = wa1[s];
        const bf16x8 b0 = bfrag(lds + (s * 8 + 2 * g) * 1024 + lo), b1 = bfrag(lds + (s * 8 + 2 * g + 1) * 1024 + lo);
        acc[0][0] = MFMA32(b0, a0, acc[0][0]); acc[0][1] = MFMA32(b1, a0, acc[0][1]); acc[1][0] = MFMA32(b0, a1, acc[1][0]); acc[1][1] = MFMA32(b1, a1, acc[1][1]);
    }
    __syncthreads();
#pragma unroll
    for (int i = 0; i < 2; ++i) { const int p = 32 * (2 * ph + i) + r32;
#pragma unroll
        for (int e = 0; e < 2; ++e)
#pragma unroll
            for (int rr = 0; rr < 4; ++rr) { u32x2 w;
                w.x = pk2(acc[i][e][4 * rr] + bsv[i], acc[i][e][4 * rr + 1] + bsv[i]);
                w.y = pk2(acc[i][e][4 * rr + 2] + bsv[i], acc[i][e][4 * rr + 3] + bsv[i]);
                *(LAS u32x2*)(lds + p * TP + (64 * g + 32 * e + 8 * rr + 4 * hi) * 2) = w; } }
    __syncthreads();
    if (!(dry && (SGU_DRYMASK & 1))) {
    unsigned char* dst = (unsigned char*)(A + (size_t)(row0 + trow) * DM + 768 + tch * 8);
#pragma unroll
    for (int i = 0; i < 8; ++i) { const u32x4 t = *(LAS const u32x4*)(lds + trow * TP + tch * 16 + i * 16 * TP), u = ugc[i]; u32x4 w;
#pragma unroll
        for (int e = 0; e < 4; ++e) w[e] = pk2(bflo(u[e]) * bflo(t[e]), bfhi(u[e]) * bfhi(t[e]));
        *(u32x4*)(dst + (size_t)i * 16 * DM * 2) = w; }
    }
    __syncthreads();
}

__device__ __forceinline__ void ctxf_unit(const Args& a, int l, LAS unsigned char* lds, int unit, int tid, int lane, int wave) {
    unsigned char* ws = a.ws;
    const int b = unit >> 2, chq = unit & 3;
    const bf16_t* Z2 = (const bf16_t*)(ws + WS_Z2);
    stage_pieces<512, 64>(lds, [&](int k) { return Z2 + (size_t)(MLAT + b * NCTX + (k & 255)) * 512 + (k >> 8) * 256 + chq * 64; }, tid);
    __syncthreads();
    const int mb = wave, hi = lane >> 5, r32 = lane & 31, lo = tr_lane_off(lane);
    const bf16_t* img = (const bf16_t*)(ws + WS_TC256);
    f32x16 acc[2]; acc[0] = f32x16{}; acc[1] = f32x16{};
#pragma unroll
    for (int sh = 0; sh < 2; ++sh) { bf16x8 af[16];
#pragma unroll
        for (int s = 0; s < 16; ++s) af[s] = afrag_img(img, 32, mb, 16 * sh + s, lane);
#pragma unroll
        for (int s = 0; s < 16; ++s) { acc[0] = MFMA32(af[s], bfrag(lds + ((16 * sh + s) * 2) * 1024 + lo), acc[0]); acc[1] = MFMA32(af[s], bfrag(lds + ((16 * sh + s) * 2 + 1) * 1024 + lo), acc[1]); } }
    const bf16_t* GS = (const bf16_t*)(ws + WS_GS); bf16_t* A = (bf16_t*)(ws + WS_A);
#pragma unroll
    for (int e = 0; e < 2; ++e) { unsigned short gv[16]; const float bfv = a.in[I_BF][l * 256 + 64 * chq + 32 * e + r32];
#pragma unroll
        for (int r = 0; r < 16; ++r) { const size_t row = MLAT + b * NCTX + 32 * mb + crow(r, hi); gv[r] = GS[row * 768 + 512 + 64 * chq + 32 * e + r32]; }
        __builtin_amdgcn_sched_barrier(0);
#pragma unroll
        for (int r = 0; r < 16; ++r) { const size_t row = MLAT + b * NCTX + 32 * mb + crow(r, hi);
            A[row * DM + 512 + 64 * chq + 32 * e + r32] = (bf16_t)f2bf((acc[e][r] * (1.0f / 128.0f) + bfv) * bf2f(gv[r])); }
        __builtin_amdgcn_sched_barrier(0); }
    __syncthreads();
}

__device__ __forceinline__ void f2_unit(const Args& a, int l, LAS unsigned char* lds, int unit, int tid, int lane, int wave) {
    unsigned char* ws = a.ws;
    const int b = unit >> 7, k1 = unit & 127;
    const bf16_t* Z2 = (const bf16_t*)(ws + WS_Z2);
    stage_pieces<128, 256>(lds, [&](int k) { return Z2 + (size_t)(b * SEQ + 64 * k1 + (k & 63)) * 512 + (k >> 6) * 256; }, tid);
    bf16x8 ta0[8], ta1[8];
    { const bf16_t* img_ = (const bf16_t*)(ws + WS_T64);
#pragma unroll
      for (int s = 0; s < 8; ++s) { ta0[s] = afrag_img(img_, 8, 0, s, lane); ta1[s] = afrag_img(img_, 8, 1, s, lane); } }
    __syncthreads();
    const int cb = wave, hi = lane >> 5, r32 = lane & 31, lo = tr_lane_off(lane);
    f32x16 acc[2]; acc[0] = f32x16{}; acc[1] = f32x16{};
#pragma unroll
    for (int s = 0; s < 8; ++s) { const bf16x8 bf = bfrag(lds + (s * 8 + cb) * 1024 + lo);
        acc[0] = MFMA32(ta0[s], bf, acc[0]); acc[1] = MFMA32(ta1[s], bf, acc[1]); }
    const bf16_t* GS = (const bf16_t*)(ws + WS_GS); bf16_t* A = (bf16_t*)(ws + WS_A);
    const float nrm = 0.0013810679320049757f;
    const float bfv = a.in[I_BF][l * 256 + 32 * cb + r32];
#pragma unroll
    for (int mb = 0; mb < 2; ++mb) {
        unsigned short gv[16];
#pragma unroll
        for (int r = 0; r < 16; ++r) { const size_t row = (size_t)b * SEQ + k1 + 128 * (32 * mb + crow(r, hi)); gv[r] = GS[row * 768 + 512 + 32 * cb + r32]; }
        __builtin_amdgcn_sched_barrier(0);
#pragma unroll
        for (int r = 0; r < 16; ++r) { const size_t row = (size_t)b * SEQ + k1 + 128 * (32 * mb + crow(r, hi));
            A[row * DM + 512 + 32 * cb + r32] = (bf16_t)f2bf((acc[mb][r] * nrm + bfv) * bf2f(gv[r])); }
        __builtin_amdgcn_sched_barrier(0);
    }
    __syncthreads();
}

#ifndef DMA_TWICE
#define DMA_TWICE 0
#endif
#ifndef EXTRA_EXP
#define EXTRA_EXP 0
#endif
#ifndef EXTRA_MFMA
#define EXTRA_MFMA 0
#endif
__device__ __forceinline__ void glds16(const void* gsrc, unsigned lds_dst) { unsigned keep;
    asm volatile("s_mov_b32 %0, m0\n\ts_mov_b32 m0, %2\n\ts_nop 0\n\tglobal_load_lds_dwordx4 %1, off\n\ts_mov_b32 m0, %0" : "=&s"(keep) : "v"(gsrc), "s"(lds_dst) : "memory"); }
__device__ __forceinline__ void glds16x2(const void* gsrc, unsigned lds_dst) { unsigned keep;
    asm volatile("s_mov_b32 %0, m0\n\ts_mov_b32 m0, %2\n\ts_nop 0\n\tglobal_load_lds_dwordx4 %1, off\n\tglobal_load_lds_dwordx4 %1, off offset:1024\n\ts_mov_b32 m0, %0" : "=&s"(keep) : "v"(gsrc), "s"(lds_dst) : "memory"); }
constexpr int CMM_PITCH = 1040;
__device__ __forceinline__ void ctx_mm_stage(LAS unsigned char* lds, const bf16_t* A, int arow0, const bf16_t* Bt, int brow0, int chunk, int wave, int lane) {
    const unsigned lds0 = (unsigned)(uintptr_t)lds;
#pragma unroll
    for (int i = 0; i < 12; ++i) { const int r = wave * 12 + i;
        const bf16_t* src = (r < 32 ? A + (size_t)(arow0 + r) * DM : Bt + (size_t)(brow0 + r - 32) * DM) + chunk * 512 + lane * 8;
        glds16(src, (unsigned)__builtin_amdgcn_readfirstlane((int)(lds0 + r * CMM_PITCH))); }
    asm volatile("s_waitcnt vmcnt(0)" ::: "memory");
    __syncthreads();
}
__device__ __forceinline__ f32x4 ctx_mm_steps(LAS const unsigned char* lds, int wave, int fr, int fq, int s0, int s1, f32x4 acc) {
    LAS const unsigned char* ap = lds + ((wave & 1) * 16 + fr) * CMM_PITCH + fq * 16; LAS const unsigned char* bp = lds + (32 + (wave >> 1) * 16 + fr) * CMM_PITCH + fq * 16;
#pragma unroll
    for (int s = s0; s < s1; ++s) acc = __builtin_amdgcn_mfma_f32_16x16x32_bf16(*(LAS const bf16x8*)(bp + s * 64), *(LAS const bf16x8*)(ap + s * 64), acc, 0, 0, 0);
    return acc;
}
__device__ __forceinline__ void ctx_branch_proj(unsigned char* ws, LAS unsigned char* lds, const bf16_t* Wbr, int vcu, int wave, int lane) {
    const int fr = lane & 15, fq = lane >> 4; const bf16_t* A = (const bf16_t*)(ws + WS_A); const unsigned char* MS = (const unsigned char*)(ws + WS_MSC) - (size_t)MLAT * 3072; bf16_t* Y = (bf16_t*)(ws + WS_Y);
    const int arow0 = MLAT + 32 * (vcu & 15), brow0 = 64 * (vcu >> 4);
    const int m0 = arow0 + 16 * (wave & 1), n0 = brow0 + 16 * (wave >> 1), lc = mini_lcol(n0, fq);
    unsigned mg[3];
#pragma unroll
    for (int seg = 0; seg < 3; ++seg) mg[seg] = *(const unsigned*)(MS + (size_t)(m0 + fr) * 3072 + seg * 1024 + lc);
    const f32x4 z = {0.f, 0.f, 0.f, 0.f};
    ctx_mm_stage(lds, A, arow0, Wbr, brow0, 0, wave, lane);
    const f32x4 a0 = ctx_mm_steps(lds, wave, fr, fq, 0, 16, z);
    __syncthreads();
    ctx_mm_stage(lds, A, arow0, Wbr, brow0, 1, wave, lane);
    const f32x4 a1 = ctx_mm_steps(lds, wave, fr, fq, 0, 8, z), a2 = ctx_mm_steps(lds, wave, fr, fq, 8, 16, z);
    f32x4 y;
#pragma unroll
    for (int e = 0; e < 4; ++e) y[e] = (a0[e] * ub(mg[0], e) + a1[e] * ub(mg[1], e) + a2[e] * ub(mg[2], e)) * (1.0f / 255.0f);
    u32x2 w; w.x = cvt_pk_bf16(y[0], y[1]); w.y = cvt_pk_bf16(y[2], y[3]);
    *(u32x2*)(Y + (size_t)(m0 + fr) * DM + lc) = w;
    __syncthreads();
}
__device__ __forceinline__ void ctx_out_proj(unsigned char* ws, LAS unsigned char* lds, const bf16_t* Wout, const float* ctx_in, const float* gate_ctx, int vcu, int wave, int lane) {
    const int fr = lane & 15, fq = lane >> 4; const bf16_t* Y = (const bf16_t*)(ws + WS_Y); float* C1 = (float*)(ws + WS_CTX1);
    const int arow0 = MLAT + 32 * (vcu & 15), brow0 = 64 * (vcu >> 4);
    const int m0 = arow0 + 16 * (wave & 1), n0 = brow0 + 16 * (wave >> 1);
    const int col = mini_lcol(n0, fq); const size_t off = (size_t)(m0 - MLAT + fr) * DM + col;
    const f32x4 g = *(const f32x4*)(gate_ctx + col), x = *(const f32x4*)(ctx_in + off);
    f32x4 acc = {0.f, 0.f, 0.f, 0.f};
    ctx_mm_stage(lds, Y, arow0, Wout, brow0, 0, wave, lane);
    acc = ctx_mm_steps(lds, wave, fr, fq, 0, 16, acc);
    __syncthreads();
    ctx_mm_stage(lds, Y, arow0, Wout, brow0, 1, wave, lane);
    acc = ctx_mm_steps(lds, wave, fr, fq, 0, 16, acc);
    *(f32x4*)(C1 + off) = x + g * acc;
    __syncthreads();
}
__device__ __forceinline__ void attn_unit(const Args& a, int l, LAS unsigned char* lds, int b, int h, int qrow0, int t0, int nt, int tid, int lane, int wave, bool dry) {
    unsigned char* ws = a.ws;
    const int comp = wave >> 2, qg = wave & 3, hi = lane >> 5, r32 = lane & 31;
    const bf16_t* Qg = (const bf16_t*)(ws + WS_QG);
    const unsigned char* kimg = ws + WS_KIMG + (size_t)(b * 4 + h) * NKT * 16384;
    const unsigned char* vimg = ws + WS_VIMG + (size_t)(b * 4 + h) * NKT * 16384;
    bf16x8 qr[4];
    { const bf16_t* qp = Qg + ((size_t)(qrow0 + 32 * qg + r32) * 4 + h) * 128 + comp * 64 + 8 * hi;
#pragma unroll
      for (int d0 = 0; d0 < 4; ++d0) qr[d0] = *(const bf16x8*)(qp + 16 * d0); }
    asm volatile("" : "+v"(qr[0]), "+v"(qr[1]), "+v"(qr[2]), "+v"(qr[3]));
    f32x16 o[4];
#pragma unroll
    for (int d = 0; d < 4; ++d) o[d] = f32x16{};
    float lsum = 0.f;
    const int lo = tr_lane_off(lane);
    const unsigned lds0 = (unsigned)(uintptr_t)lds;
    constexpr int KSL = 16384, VBASE = 3 * KSL;
#define ATT_DMA_K(t, slotb) do { const unsigned char* s_ = kimg + (size_t)(t) * 16384 + wave * 2048 + lane * 16; const unsigned d_ = (unsigned)__builtin_amdgcn_readfirstlane((int)(lds0 + (slotb) + wave * 2048)); \
        glds16x2(s_, d_); if (DMA_TWICE) glds16x2(s_, d_); } while (0)
#define ATT_DMA_V(t, slotb) do { const unsigned char* s_ = vimg + (size_t)(t) * 16384 + wave * 2048 + lane * 16; const unsigned d_ = (unsigned)__builtin_amdgcn_readfirstlane((int)(lds0 + VBASE + (slotb) + wave * 2048)); \
        glds16x2(s_, d_); if (DMA_TWICE) glds16x2(s_, d_); } while (0)
#define ATT_WAIT_BAR(N) asm volatile("s_waitcnt vmcnt(" #N ") lgkmcnt(0)\n\ts_barrier" ::: "memory")
#define SBAR() __builtin_amdgcn_sched_barrier(0)
#define PIN(x) asm volatile("" : "+v"(x))
    LAS const unsigned char* kp0 = lds + comp * 8192 + hi * 1024 + r32 * 16;
    LAS const unsigned char* vp0 = lds + VBASE + lo;
    bf16x8 kf[8];
#define KRD(j, slotb) do { kf[j] = *(const LAS bf16x8*)(kp0 + (slotb) + ((j) >> 1) * 2048 + ((j) & 1) * 512); } while (0)
    f32x16 pA0 = f32x16{}, pA1 = f32x16{}, pB0, pB1;
    u32x4 pw0, pw1, pw2, pw3;
    bf16x8 vA[8], vB[8];
    int sl_prev = 0, sl_cur = 0, sl_next = KSL;
#define ROT() do { sl_prev = sl_cur; sl_cur = sl_next; sl_next = (sl_next == 2 * KSL) ? 0 : sl_next + KSL; } while (0)
    ATT_DMA_K(t0, 0); ATT_DMA_V(t0, 0); ATT_DMA_K(t0 + 1, KSL); ATT_DMA_K(t0 + 2, 2 * KSL);
    ATT_WAIT_BAR(0);
#pragma unroll
    for (int j = 0; j < 8; ++j) KRD(j, 0);
    ATT_WAIT_BAR(0);
#define PKW(P, B) cvt_pk_bf16(P[B], P[B + 1])
#define EX(v) __builtin_amdgcn_exp2f(v)
#define GAPA(i, C, CIN, a0, a1, a2, a3, W0, W1, PWV) do { vA[i] = bfrag(vpp_ + (i) * 1024); SBAR(); \
        C = MFMA32(kf[i], qr[(i) >> 1], CIN); if (EXTRA_MFMA) dacc = MFMA32(kf[i], qr[(i) >> 1], dacc); sacc += a0; sacc += a1; sacc += a2; sacc += a3; PIN(sacc); W0; W1; PIN(PWV); SBAR(); } while (0)
#define GAPB_V(j, d, PWV, X, B) do { o[d] = MFMA32(__builtin_bit_cast(bf16x8, PWV), vA[j], o[d]); X[B] = EX(X[B]); X[B + 1] = EX(X[B + 1]); PIN(X); if (EXTRA_EXP) { dmy = EX(dmy); PIN(dmy); } vB[j] = bfrag(vpp_ + (8 + (j)) * 1024); SBAR(); } while (0)
#define GAPB_K(j, d, PWV, X, B) do { o[d] = MFMA32(__builtin_bit_cast(bf16x8, PWV), vB[(j) - 8], o[d]); X[B] = EX(X[B]); X[B + 1] = EX(X[B + 1]); PIN(X); if (EXTRA_EXP) { dmy = EX(dmy); PIN(dmy); } KRD((j) - 8, sl_next); SBAR(); } while (0)
    const f32x16 zero16 = f32x16{}; float dmy = 0.5f; (void)dmy; f32x16 dacc = f32x16{}; (void)dacc;
#define STEP(C0, C1, P0, P1, t) do { SBAR(); \
        LAS const unsigned char* vpp_ = vp0 + sl_prev; float sacc = 0.f; \
        GAPA(0, C0, zero16, P0[0], P0[1], P0[2], P0[3],     pw0[0] = PKW(P0, 0),  pw0[1] = PKW(P0, 2),  pw0); \
        GAPA(1, C1, zero16, P0[4], P0[5], P0[6], P0[7],     pw0[2] = PKW(P0, 4),  pw0[3] = PKW(P0, 6),  pw0); \
        GAPA(2, C0, C0,     P0[8], P0[9], P0[10], P0[11],   pw1[0] = PKW(P0, 8),  pw1[1] = PKW(P0, 10), pw1); \
        GAPA(3, C1, C1,     P0[12], P0[13], P0[14], P0[15], pw1[2] = PKW(P0, 12), pw1[3] = PKW(P0, 14), pw1); \
        GAPA(4, C0, C0,     P1[0], P1[1], P1[2], P1[3],     pw2[0] = PKW(P1, 0),  pw2[1] = PKW(P1, 2),  pw2); \
        GAPA(5, C1, C1,     P1[4], P1[5], P1[6], P1[7],     pw2[2] = PKW(P1, 4),  pw2[3] = PKW(P1, 6),  pw2); \
        GAPA(6, C0, C0,     P1[8], P1[9], P1[10], P1[11],   pw3[0] = PKW(P1, 8),  pw3[1] = PKW(P1, 10), pw3); \
        GAPA(7, C1, C1,     P1[12], P1[13], P1[14], P1[15], pw3[2] = PKW(P1, 12), pw3[3] = PKW(P1, 14), pw3); \
        lsum += sacc; \
        if ((t) + 3 < nt) ATT_DMA_K(t0 + (t) + 3, sl_cur); \
        if ((t) + 1 < nt) ATT_DMA_V(t0 + (t) + 1, sl_next); \
        SBAR(); \
        GAPB_V(0, 0, pw0, C0, 0);  GAPB_V(1, 0, pw1, C0, 2);  GAPB_V(2, 0, pw2, C0, 4);  GAPB_V(3, 0, pw3, C0, 6); \
        GAPB_V(4, 1, pw0, C0, 8);  GAPB_V(5, 1, pw1, C0, 10); GAPB_V(6, 1, pw2, C0, 12); GAPB_V(7, 1, pw3, C0, 14); \
        GAPB_K(8, 2, pw0, C1, 0);  GAPB_K(9, 2, pw1, C1, 2);  GAPB_K(10, 2, pw2, C1, 4); GAPB_K(11, 2, pw3, C1, 6); \
        GAPB_K(12, 3, pw0, C1, 8); GAPB_K(13, 3, pw1, C1, 10); GAPB_K(14, 3, pw2, C1, 12); GAPB_K(15, 3, pw3, C1, 14); \
        if ((t) + 3 < nt) { if (DMA_TWICE) ATT_WAIT_BAR(8); else ATT_WAIT_BAR(4); } else ATT_WAIT_BAR(0); \
        ROT(); } while (0)
    asm volatile(".rept 15\n\ts_nop 0\n\t.endr" ::: "memory");
#pragma unroll 1
    for (int t = 0; t < nt; t += 2) {
        STEP(pB0, pB1, pA0, pA1, t);
        STEP(pA0, pA1, pB0, pB1, t + 1);
    }
    {
        float sacc = 0.f;
#pragma unroll
        for (int r = 0; r < 16; ++r) sacc += pA0[r] + pA1[r];
        lsum += sacc;
        pw0 = (u32x4){PKW(pA0, 0), PKW(pA0, 2), PKW(pA0, 4), PKW(pA0, 6)}; pw1 = (u32x4){PKW(pA0, 8), PKW(pA0, 10), PKW(pA0, 12), PKW(pA0, 14)};
        pw2 = (u32x4){PKW(pA1, 0), PKW(pA1, 2), PKW(pA1, 4), PKW(pA1, 6)}; pw3 = (u32x4){PKW(pA1, 8), PKW(pA1, 10), PKW(pA1, 12), PKW(pA1, 14)};
        LAS const unsigned char* vpp_ = vp0 + sl_prev;
#pragma unroll
        for (int d = 0; d < 4; ++d) {
            const bf16x8 f0 = bfrag(vpp_ + (d * 4 + 0) * 1024), f1 = bfrag(vpp_ + (d * 4 + 1) * 1024), f2 = bfrag(vpp_ + (d * 4 + 2) * 1024), f3 = bfrag(vpp_ + (d * 4 + 3) * 1024);
            o[d] = MFMA32(__builtin_bit_cast(bf16x8, pw0), f0, o[d]); o[d] = MFMA32(__builtin_bit_cast(bf16x8, pw1), f1, o[d]);
            o[d] = MFMA32(__builtin_bit_cast(bf16x8, pw2), f2, o[d]); o[d] = MFMA32(__builtin_bit_cast(bf16x8, pw3), f3, o[d]);
        }
    }
    ATT_WAIT_BAR(0);
#undef ATT_DMA_K
#undef ATT_DMA_V
#undef ATT_WAIT_BAR
#undef SBAR
#undef PIN
#undef KRD
#undef ROT
#undef PKW
#undef EX
#undef GAPA
#undef GAPB_V
#undef GAPB_K
#undef STEP
    if (EXTRA_MFMA) asm volatile("" :: "v"(dacc));
    if (dry) return;
    LAS float* ost = (LAS float*)lds;
    LAS float* lw = (LAS float*)(lds + 72 * 1024);
    lsum += __shfl_xor(lsum, 32);
    if (hi == 0) lw[wave * 32 + r32] = lsum;
    LDS_WAIT(); asm volatile("" ::: "memory");
    const float* lamp = (const float*)(ws + WS_LAM) + 2 * l;
    const float lam = lamp[0], oscale = lamp[1];
    float rl[16];
#pragma unroll
    for (int r = 0; r < 16; ++r) rl[r] = __builtin_amdgcn_rcpf(lw[wave * 32 + crow(r, hi)]);
    if (comp == 0) {
#pragma unroll
        for (int d = 0; d < 4; ++d)
#pragma unroll
            for (int r = 0; r < 16; ++r) ost[(32 * qg + crow(r, hi)) * 132 + 32 * d + r32] = o[d][r] * rl[r];
    }
    __syncthreads();
    if (comp == 1) {
#pragma unroll
        for (int d = 0; d < 4; ++d)
#pragma unroll
            for (int r = 0; r < 16; ++r) ost[(32 * qg + crow(r, hi)) * 132 + 32 * d + r32] -= lam * o[d][r] * rl[r];
    }
    __syncthreads();
    {
        const int oct = tid & 7;
        const float* gsub = a.in[I_GSUB] + l * 128 + 8 * oct;
        f32x4 gsb[2][2];
#pragma unroll
        for (int k = 0; k < 2; ++k) { gsb[k][0] = *(const f32x4*)(gsub + 64 * k); gsb[k][1] = *(const f32x4*)(gsub + 64 * k + 4); }
        u32x4 gw[2][2];
#pragma unroll
        for (int j2 = 0; j2 < 2; ++j2) { const size_t grow = (size_t)qrow0 + (tid >> 3) + 64 * j2;
#pragma unroll
            for (int k = 0; k < 2; ++k) gw[j2][k] = *(const u32x4*)((const bf16_t*)(ws + WS_GS) + grow * 768 + h * 128 + 64 * k + 8 * oct); }
#pragma unroll
        for (int j2 = 0; j2 < 2; ++j2) { const int row = (tid >> 3) + 64 * j2; const size_t grow = (size_t)qrow0 + row;
            f32x4 v[2][2]; float ss = 0.f;
#pragma unroll
            for (int k = 0; k < 2; ++k)
#pragma unroll
                for (int q = 0; q < 2; ++q) { v[k][q] = *(const LAS f32x4*)(ost + row * 132 + 64 * k + 8 * oct + 4 * q); ss += (v[k][q].x * v[k][q].x + v[k][q].y * v[k][q].y) + (v[k][q].z * v[k][q].z + v[k][q].w * v[k][q].w); }
            ss += __shfl_xor(ss, 1); ss += __shfl_xor(ss, 2); ss += __shfl_xor(ss, 4);
            const float rstd = rsqrtf(ss * (1.0f / 128.0f) + EPS) * oscale;
            bf16_t* dst = (bf16_t*)(ws + WS_A) + grow * DM + h * 128 + 8 * oct;
#pragma unroll
            for (int k = 0; k < 2; ++k) { const f32x4 p0 = v[k][0] * rstd * gsb[k][0], p1 = v[k][1] * rstd * gsb[k][1]; const u32x4 g_ = gw[j2][k]; u32x4 w;
                w.x = pk2(p0.x * bflo(g_.x), p0.y * bfhi(g_.x)); w.y = pk2(p0.z * bflo(g_.y), p0.w * bfhi(g_.y)); w.z = pk2(p1.x * bflo(g_.z), p1.y * bfhi(g_.z)); w.w = pk2(p1.z * bflo(g_.w), p1.w * bfhi(g_.w));
                *(u32x4*)(dst + 64 * k) = w; } }
    }
    __syncthreads();
}

#ifndef REPEAT_PHASE
#define REPEAT_PHASE (-1)
#endif
constexpr int N_PHASES = 10 + (REPEAT_PHASE >= 0 ? 1 : 0);
__global__ void __launch_bounds__(NTHREADS, 2) fwd_kernel(Args args) {
    extern __shared__ __attribute__((aligned(16))) unsigned char lds_raw[];
    LAS unsigned char* lds = (LAS unsigned char*)lds_raw;
    const int tid = threadIdx.x, lane = tid & 63, wave = __builtin_amdgcn_readfirstlane(tid >> 6);
    const int bx = blockIdx.x, vcu = (bx % 8) * (GRID / 8) + bx / 8;
    unsigned char* ws = args.ws;
    volatile LAS unsigned* MISC = (volatile LAS unsigned*)(lds + MISC_OFF);
    for (int u = tid; u < 32; u += NTHREADS) MISC[u] = 0u;
    __syncthreads();
    XcdBarrier bar; bar.bar = (unsigned*)(ws + WS_CTL) + CW_BAR; bar.x = 0; bar.st = nullptr;
    const bool one_launch = (args.ph_hi - args.ph_lo) > 1;
    if (one_launch) { bar = xcd_barrier_post((unsigned*)(ws + WS_CTL) + CW_BAR, MISC + 8);
        if (tid == 0) { unsigned nloc, nx; xcd_barrier_complete(bar.bar, bar.x, nloc, nx); MISC[8] = nloc; MISC[9] = nx; }
        __syncthreads(); }
#ifndef REPEAT_PHASE
#define REPEAT_PHASE (-1)
#endif
#ifndef TAILSKIP
#define TAILSKIP 0
#endif
#ifndef F2_REP
#define F2_REP 1
#endif
#ifndef REPEAT_FULL
#define REPEAT_FULL 0
#endif
#ifndef PRO_PROBE
#define PRO_PROBE 15
#endif
#ifndef TAIL_SGU
#define TAIL_SGU 1
#endif
#ifndef REMAP_ON
#define REMAP_ON 1
#endif
#ifndef SGU_REP
#define SGU_REP 1
#endif
#ifndef PHMASK
#define PHMASK 0xffff
#endif
#define EN(b) (((PHMASK) >> (b)) & 1)
#define LAUNDER() int wave_ = wave, vcu_ = vcu; asm volatile("" : "+s"(wave_)); asm volatile("" : "+s"(vcu_)); int lane_ = (int)__builtin_amdgcn_mbcnt_hi(~0u, __builtin_amdgcn_mbcnt_lo(~0u, 0u)); asm volatile("" : "+v"(lane_)); const int tid_ = wave_ * 64 + lane_; (void)lane_; (void)wave_
#pragma unroll 1
    for (int pc = args.ph_lo; pc < args.ph_hi; ++pc) {
        const int ph = (REPEAT_PHASE >= 0 && pc > REPEAT_PHASE) ? pc - 1 : pc;
        const int l = ph >= 5 ? 1 : 0;
        const bool second = (REPEAT_PHASE >= 0 && pc == REPEAT_PHASE + 1 && !REPEAT_FULL); (void)second;
        const bool rep2 = (REPEAT_PHASE >= 0 && pc == REPEAT_PHASE + 1); (void)rep2;
        const int kind = ph == 0 ? 6 : (ph == 5 ? 7 : (ph < 5 ? ph - 1 : ph - 6));
        const bf16_t* Wl = (const bf16_t*)(ws + WS_WIN) + (size_t)l * NPHYS * DM;
        LAUNDER();
        if (kind == 6) { if (EN(0)) {
            unsigned* sp0 = (unsigned*)(ws + WS_CTL) + 8192 + 4096;
            ph0_mods(args, lane_, wave_, vcu_);
            split_arrive(sp0, bar, one_launch);
            ph0_prologue(args, lds, tid_, lane_, wave_, vcu_, second ? PRO_PROBE : 7);
            split_wait(sp0, bar, one_launch, (unsigned*)(ws + WS_CTL) + CW_BAR + XB_TMO); } }
        if (kind == 6 || kind == 7) { if (EN(1)) { int wave2 = wave, vcu2 = vcu; asm volatile("" : "+s"(wave2)); asm volatile("" : "+s"(vcu2)); int lane2 = (int)__builtin_amdgcn_mbcnt_hi(~0u, __builtin_amdgcn_mbcnt_lo(~0u, 0u)); asm volatile("" : "+v"(lane2)); const int tid2 = wave2 * 64 + lane2;
            prepass(args, kind == 6 ? 0 : 1, lds, tid2, lane2, wave2, vcu2); } }
        else if (kind == 0 || kind == 1) {
            int tw = -1, sk0 = 0, skst = 0, snk = 0; bool small = kind == 1 && EN(4);
            if (kind == 0) { if (EN(2)) {
                unsigned* cw = (unsigned*)(ws + WS_CTL) + CW_CTXCNT;
                pg8::Gemm g{(const bf16_t*)(ws + WS_H), Wl, DM, DM, 0, 0, 0, 16, 16, 16, nullptr, nullptr, 0};
                TileSched S{vcu_ >> 5, vcu_ & 31, 0, 14, 1, l == 0 ? 52 : 8, l == 0 ? 0 : 2, l == 0 ? 26 : 4, l == 0 ? 1 : 0, REMAP_ON};
                EpiIn E{ws, args.in[I_GQ] + l * 64, args.in[I_GK] + l * 64, (LAS const float*)(lds + ROPE_LDS), (LAS const float*)(lds + ROPE_LDS) + 2048, cw};
                { const float* rt = (const float*)(ws + WS_ROPE); LAS float* rl_ = (LAS float*)(lds + ROPE_LDS);
#pragma unroll
                  for (int i = 0; i < 8; ++i) rl_[tid_ + i * NTHREADS] = rt[tid_ + i * NTHREADS];
                  __syncthreads(); }
                pg8::gemm_phase<EpiIn, TileSched, true, true, 8>(lds, g, S, E, tid_);
                { int vcu4 = vcu; asm volatile("" : "+s"(vcu4)); const int x4 = vcu4 >> 5, t4 = (vcu4 & 31) - (l == 0 ? 23 : 17);
                    if (t4 >= 0) { tw = t4; small = true;
                        if (l == 0) { if (t4 >= 3) { sk0 = t4 - 3; skst = 6; snk = t4 <= 5 ? 3 : 2; } else if (t4 == 2) { sk0 = 15; snk = 1; } }
                        else { sk0 = t4; skst = 15; snk = t4 == 0 ? 2 : 1; }
                        __syncthreads();
                        unsigned* wz = cw + 16 * 64; const unsigned nr = 24u * (unsigned)(l + 1);
                        const bool cx = l == 0 && t4 <= 2;
                        unsigned* w0 = snk > 0 ? cw + 16 * (8 * x4 + (sk0 >> 1)) : wz;
                        unsigned* w1 = snk > 1 ? cw + 16 * (8 * x4 + ((sk0 + skst) >> 1)) : wz;
                        unsigned* w2 = snk > 2 ? cw + 16 * (8 * x4 + ((sk0 + 2 * skst) >> 1)) : wz;
                        count_wait3(w0, snk > 0 ? nr : 0u, w1, snk > 1 ? nr : 0u, w2, snk > 2 ? nr : (cx ? 52u * NWAVES : 0u), (unsigned*)(ws + WS_CTL) + CW_BAR + XB_TMO); } } } }
            if (small) {
                int wave3 = wave, vcu3 = vcu; asm volatile("" : "+s"(wave3)); asm volatile("" : "+s"(vcu3)); int lane3 = (int)__builtin_amdgcn_mbcnt_hi(~0u, __builtin_amdgcn_mbcnt_lo(~0u, 0u)); asm volatile("" : "+v"(lane3)); const int tid3 = wave3 * 64 + lane3;
                const bool mainp = tw < 0; const int x3 = vcu3 >> 5;
                if (!second) {
                    if (EN(8) && mainp) for (int rep_ = F1_REP - 1; rep_ >= 0; --rep_) { int t6 = tid3, l6 = lane3; asm volatile("" : "+v"(t6), "+v"(l6)); f1_unit(ws, lds, vcu3, t6, l6, wave3, rep_ > 0); }
                    if (EN(9) && !mainp && !(rep2 && (TAILSKIP & 2))) for (int rep_ = 0; rep_ < SGU_REP; ++rep_) {
                        const int nit = snk + ((l == 0 && tw == 2 && x3 < 4) ? 1 : 0);
#pragma unroll 1
                        for (int it = 0; it < nit; ++it) sgu_unit(args, l, lds, it < snk ? 16 * x3 + sk0 + skst * it : 128 + x3, tid3, lane3, wave3, rep_ > 0); }
                    if (EN(10) && l == 0 && tw == 2 && !(rep2 && (TAILSKIP & 4))) ctxf_unit(args, l, lds, x3, tid3, lane3, wave3);
                }
                if (EN(12)) {
                    int lane5 = (int)__builtin_amdgcn_mbcnt_hi(~0u, __builtin_amdgcn_mbcnt_lo(~0u, 0u)); asm volatile("" : "+v"(lane5)); const int tid5 = wave3 * 64 + lane5;
                    const int nun = mainp ? 2 : ((l == 0 && tw < 2 && !(rep2 && (TAILSKIP & 1))) ? 1 : 0);
#pragma unroll 1
                    for (int ui = 0; ui < nun; ++ui) {
                        const int wq = x3 + 8 * (tw & 1);
                        const int bh = mainp ? vcu3 >> 5 : wq >> 1;
                        const int qrow0 = mainp ? (bh >> 2) * SEQ + 256 * (vcu3 & 31) + 128 * ui : MLAT + (bh >> 2) * NCTX + 128 * (wq & 1);
                        attn_unit(args, l, lds, bh >> 2, bh & 3, qrow0, mainp ? 0 : SEQ / 64, mainp ? NKT : NCTX / 64, tid5, lane5, wave3, second);
                    }
                } } }
        else if (kind == 2) { if (EN(5)) {
            unsigned* sp = (unsigned*)(ws + WS_CTL) + 8192 + l * 2048;
            if (EN(11) && !rep2) for (int rep_ = 0; rep_ < F2_REP; ++rep_) { int t6 = tid_, l6 = lane_; asm volatile("" : "+v"(t6), "+v"(l6)); f2_unit(args, l, lds, vcu_, t6, l6, wave_); }
            split_arrive(sp, bar, one_launch);
            if (l == 0) ctx_branch_proj(ws, lds, (const bf16_t*)(ws + WS_WBR), vcu_, wave_, lane_);
            pg8::Gemm g{(const bf16_t*)(ws + WS_A), (const bf16_t*)(ws + WS_WBR) + (size_t)l * DM * DM, DM, DM, 0, 512, 768, 8, 4, 4, (const bf16_t*)(ws + WS_H), Wl, 16};
            FusedSched S{vcu_ >> 5, vcu_ & 31, sp, bar, one_launch, (unsigned*)(ws + WS_CTL) + CW_BAR + XB_TMO};
            EpiMY E{EpiInT<true>{ws, nullptr, nullptr, nullptr, nullptr, nullptr}, EpiY{(const unsigned char*)(ws + WS_MS), (bf16_t*)(ws + WS_Y)}};
            pg8::gemm_phase<EpiMY, FusedSched, true, true, 24>(lds, g, S, E, tid_); } }
        else { if (EN(7)) {
            pg8::Gemm g{(const bf16_t*)(ws + WS_Y), (const bf16_t*)(ws + WS_WOUT) + (size_t)l * DM * DM, DM, DM, 0, 0, 0, 16, 16, 16, nullptr, nullptr, 0};
            TileSched S{vcu_ >> 5, vcu_ & 31, 0, 4, 1, 0, 0, 4, 0, 0};
            if (l == 0) ctx_out_proj(ws, lds, (const bf16_t*)(ws + WS_WOUT), args.in[I_CTX], (const float*)(ws + WS_MODF) + 2 * 3072 + 2048, vcu_, wave_, lane_);
            EpiOut E{args.in[I_X], args.out, ws, (const float*)(ws + WS_MODF) + (size_t)(l * 3) * 3072 + 2048, l};
            pg8::gemm_phase<EpiOut, TileSched, true, true, 13>(lds, g, S, E, tid_); } }
        if (pc + 1 < args.ph_hi) { XcdBarrier b2_ = bar; asm volatile("" : "+s"(b2_.bar)); xcd_barrier(b2_); }
    }
}

extern "C" void kernel_launch(void* const* d_in, const int* in_sizes, int n_in, void* d_out, int out_size, void* d_ws, size_t ws_size, hipStream_t stream) {
    static int ready = 0;
    if (ready == 0) {
        if (n_in != 25 || out_size != MLAT * DM || ws_size < 256 * MiB) { fprintf(stderr, "kernel_launch: unexpected shapes (n_in %d out %d ws %zu)\n", n_in, out_size, ws_size); ready = -1; return; }
        int dev = 0, cus = 0, per_cu = 0;
        hipGetDevice(&dev); hipDeviceGetAttribute(&cus, hipDeviceAttributeMultiprocessorCount, dev);
        if (hipFuncSetAttribute((const void*)fwd_kernel, hipFuncAttributeMaxDynamicSharedMemorySize, LDS_BYTES) != hipSuccess) { fprintf(stderr, "kernel_launch: hipFuncSetAttribute failed\n"); ready = -1; return; }
        hipOccupancyMaxActiveBlocksPerMultiprocessor(&per_cu, (const void*)fwd_kernel, NTHREADS, LDS_BYTES);
        (void)hipGetLastError();
        if (cus != GRID || per_cu < 1) fprintf(stderr, "kernel_launch: note: %d CUs, occupancy %d blocks/CU (built for 256 CUs, 1 block/CU)\n", cus, per_cu);
        ready = (cus >= GRID) ? 1 : -1;
    }
    if (ready < 0) return;
    hipMemsetAsync((char*)d_ws + WS_CTL, 0, CTL_ZERO_BYTES, stream);
    Args a{};
    for (int i = 0; i < 25; ++i) a.in[i] = (const float*)d_in[i];
    a.out = (float*)d_out; a.ws = (unsigned char*)d_ws;
#if MK_N_LAUNCHES == 1
    a.ph_lo = 0; a.ph_hi = N_PHASES;
    hipLaunchKernelGGL(fwd_kernel, dim3(GRID), dim3(NTHREADS), LDS_BYTES, stream, a);
#else
    for (int p = 0; p < N_PHASES; ++p) { a.ph_lo = p; a.ph_hi = p + 1; hipLaunchKernelGGL(fwd_kernel, dim3(GRID), dim3(NTHREADS), LDS_BYTES, stream, a); }
#endif
}
```
